# Optimizing an MI355X kernel written in HIP

```python
import functools
import jax, jax.numpy as jnp
from jax import lax
import numpy as np

D_MODEL = 1024
BATCH = 32
SEQ = 2048
DEPTH = 2

CTX_LEN = 256
GRID_W = 64
RWKV_HEADS = 8
RWKV_HEAD = 64
RWKV_W = RWKV_HEADS * RWKV_HEAD
DECAY_LORA = 64
AAA_LORA = 64
GATE_LORA = 128
LNX_EPS = 64e-5
ATT_HEADS = 8
KV_HEADS = 2
HEAD_DIM = 64
GROUPS = ATT_HEADS // KV_HEADS
ATT_W = ATT_HEADS * HEAD_DIM
KV_W = KV_HEADS * HEAD_DIM
Q_BLOCK = 128
ROPE_THETA = 10000.0
ROPE_AXIS_DIM = HEAD_DIM // 2
N_BRANCH = 2
R_COLS = 3 * RWKV_W + DECAY_LORA + AAA_LORA + GATE_LORA
A_COLS = ATT_W + 2 * KV_W
G_COLS = N_BRANCH * D_MODEL
N_IN = R_COLS + A_COLS + G_COLS
FFN_DIM = 3584
N_EXPERTS = 8
TOP_K = 2
MOE_BLOCK = 512
N_DENSE = (DEPTH + 1) // 2
N_MOE = DEPTH // 2
NORM_EPS = 1e-6

kernel_name = "hybrid_rwkv7_gqa_moe_dit_block"

F32 = jnp.float32


def rmsnorm(x, gain):
    xf = x.astype(F32)
    y = xf * lax.rsqrt(jnp.mean(xf * xf, axis=-1, keepdims=True) + NORM_EPS)
    return (y * gain.astype(F32)).astype(x.dtype)


def centred_shift(p, mu):
    zero = jnp.zeros_like(p[:, :1])
    prev = jnp.concatenate([zero, p[:, :-1]], axis=1)
    nxt = jnp.concatenate([p[:, 1:], zero], axis=1)
    return p + mu[0] * (prev - p) + mu[1] * (nxt - p)


def rwkv_prepare(pr, mu, w0, w2, a0, a2, g2, k_k, k_a):
    B, T, _ = pr.shape
    heads = lambda t: t.reshape(B, T, RWKV_HEADS, RWKV_HEAD)
    pr = centred_shift(pr, mu)
    cuts = [RWKV_W, 2 * RWKV_W, 3 * RWKV_W, 3 * RWKV_W + DECAY_LORA, 3 * RWKV_W + DECAY_LORA + AAA_LORA]
    r, k, v, wd, ad, gd = jnp.split(pr, cuts, axis=-1)
    kkf = heads(k * k_k).astype(F32)
    kk = kkf / jnp.maximum(jnp.sqrt(jnp.sum(kkf * kkf, axis=-1, keepdims=True)), 1e-12)
    tw = jnp.tanh(wd)
    decays, keys, bs = [], [], []
    for d in range(2):
        z = (w0[d] + tw @ w2[d]).astype(F32)
        decay = jnp.exp(-jnp.exp(-jax.nn.softplus(-z) - 0.5))
        a = jax.nn.sigmoid(a0[d] + ad @ a2[d])
        decays.append(heads(decay))
        keys.append(heads(k * (1 + (a - 1) * k_a)))
        bs.append(kk * heads(a).astype(F32))
    g = jax.nn.sigmoid(gd) @ g2
    return heads(r), heads(v), kk, g, decays, keys, bs


def wkv_scan(state, r, decay, k, v, kk, b, reverse):
    xs = tuple(jnp.moveaxis(t.astype(F32), 1, 0) for t in (r, decay, k, v, -kk, b))

    def step(S, inp):
        r_t, w_t, k_t, v_t, a_t, b_t = inp
        Sa = jnp.einsum('bhvk,bhk->bhv', S, a_t)
        S = S * w_t[:, :, None, :] + Sa[..., None] * b_t[:, :, None, :] + v_t[..., None] * k_t[:, :, None, :]
        return S, jnp.einsum('bhvk,bhk->bhv', S, r_t)

    S, ys = lax.scan(step, state, xs, reverse=reverse)
    return S, jnp.moveaxis(ys, 0, 1)


def rwkv_output(y, r, keys, v, g, r_k, lnx_w, lnx_b):
    B, T = y.shape[:2]
    mean = jnp.mean(y, axis=-1, keepdims=True)
    var = jnp.mean(jnp.square(y - mean), axis=-1, keepdims=True)
    yn = ((y - mean) * lax.rsqrt(var + LNX_EPS)).reshape(B, T, RWKV_W)
    yn = (yn * lnx_w.astype(F32) + lnx_b.astype(F32)).astype(v.dtype)
    kbar = 0.5 * (keys[0] + keys[1])
    bonus = jnp.sum(r * kbar * r_k, axis=-1, keepdims=True) * v
    return (yn + bonus.reshape(B, T, RWKV_W)) * g


def head_rms(t, gain):
    tf = t.astype(F32)
    return (tf * lax.rsqrt(jnp.mean(tf * tf, axis=-1, keepdims=True) + NORM_EPS) * gain.astype(F32)).astype(t.dtype)


def attn_qkv(pa, q_norm, k_norm):
    B, T, _ = pa.shape
    q = pa[..., :ATT_W].reshape(B, T, KV_HEADS, GROUPS, HEAD_DIM)
    k = pa[..., ATT_W:ATT_W + KV_W].reshape(B, T, KV_HEADS, HEAD_DIM)
    v = pa[..., ATT_W + KV_W:].reshape(B, T, KV_HEADS, HEAD_DIM)
    return head_rms(q, q_norm), head_rms(k, k_norm), v


def rope_2d_tables(n_tokens):
    rows = n_tokens // GRID_W
    row, col = jnp.meshgrid(jnp.arange(rows), jnp.arange(GRID_W), indexing='ij')
    inv = ROPE_THETA ** (-jnp.arange(0, ROPE_AXIS_DIM, 2, dtype=F32) / ROPE_AXIS_DIM)
    ang = jnp.concatenate([row.reshape(-1, 1).astype(F32) * inv, col.reshape(-1, 1).astype(F32) * inv], axis=-1)
    return jnp.cos(ang), jnp.sin(ang)


def apply_rope(t, cos, sin):
    shp = t.shape
    tp = t.astype(F32).reshape(shp[:-1] + (HEAD_DIM // 2, 2))
    bshape = (1, shp[1]) + (1,) * (len(shp) - 3) + (HEAD_DIM // 2,)
    c, s = cos.reshape(bshape), sin.reshape(bshape)
    x0, x1 = tp[..., 0], tp[..., 1]
    return jnp.stack([x0 * c - x1 * s, x0 * s + x1 * c], axis=-1).reshape(shp).astype(t.dtype)


def block_attention(q, k, v):
    B, T = q.shape[:2]
    nb = T // Q_BLOCK
    qb = jnp.moveaxis(q.reshape(B, nb, Q_BLOCK, KV_HEADS, GROUPS, HEAD_DIM), 1, 0)
    scale = HEAD_DIM ** -0.5

    def one(qblk):
        s = jnp.einsum('bqhgd,bkhd->bhgqk', qblk, k).astype(F32) * scale
        p = jax.nn.softmax(s, axis=-1).astype(v.dtype)
        return jnp.einsum('bhgqk,bkhd->bqhgd', p, v)

    o = lax.map(one, qb)
    return jnp.moveaxis(o, 0, 1).reshape(B, T, ATT_W)


def merge_branches(pg, y_rwkv, y_att, w_pa, w_pb, w_o):
    gate_a = jax.nn.sigmoid(pg[..., :D_MODEL])
    gate_b = jax.nn.sigmoid(pg[..., D_MODEL:])
    return (gate_a * (y_rwkv @ w_pa) + gate_b * (y_att @ w_pb)) @ w_o


def swiglu(h, wg, wu, wd):
    return (jax.nn.silu(h @ wg) * (h @ wu)) @ wd


def moe_swiglu(h, router, wg, wu, wd):
    shp = h.shape
    hf = h.reshape(-1, D_MODEL)
    T = hf.shape[0]
    logits = (hf @ router).astype(F32)
    top_logit, top_idx = lax.top_k(logits, TOP_K)
    top_w = jax.nn.softmax(top_logit, axis=-1)
    n_assign = T * TOP_K
    e_flat = top_idx.reshape(-1).astype(jnp.int32)
    tok_flat = jnp.repeat(jnp.arange(T, dtype=jnp.int32), TOP_K)
    w_flat = top_w.reshape(-1)
    order = jnp.argsort(e_flat)
    e_sorted = e_flat[order]
    counts = jnp.zeros((N_EXPERTS,), jnp.int32).at[e_flat].add(1)
    starts = jnp.cumsum(counts) - counts
    padded = (counts + MOE_BLOCK - 1) // MOE_BLOCK * MOE_BLOCK
    pends = jnp.cumsum(padded)
    pstarts = pends - padded
    dest = pstarts[e_sorted] + jnp.arange(n_assign, dtype=jnp.int32) - starts[e_sorted]
    n_pad = (-(-n_assign // MOE_BLOCK) + N_EXPERTS) * MOE_BLOCK
    tok_buf = jnp.zeros((n_pad,), jnp.int32).at[dest].set(tok_flat[order])
    w_buf = jnp.zeros((n_pad,), F32).at[dest].set(w_flat[order])
    nblk = n_pad // MOE_BLOCK
    blk_start = jnp.arange(nblk, dtype=jnp.int32) * MOE_BLOCK
    blk_e = jnp.minimum(jnp.searchsorted(pends, blk_start, side='right'), N_EXPERTS - 1).astype(jnp.int32)
    xb = hf[tok_buf].reshape(nblk, MOE_BLOCK, D_MODEL)

    def expert_block(args):
        xblk, e = args
        return swiglu(xblk, wg[e], wu[e], wd[e])

    yb = lax.map(expert_block, (xb, blk_e)).reshape(n_pad, D_MODEL)
    out = jnp.zeros_like(hf).at[tok_buf].add(yb * w_buf[:, None].astype(hf.dtype))
    return out.reshape(shp)


def setup_inputs(seed: int = 0) -> dict:
    key = jax.random.key(seed)
    ks = iter(jax.random.split(key, 48))
    nrm = lambda shape, scale: jax.random.normal(next(ks), shape, F32) * scale
    uni = lambda shape, lo, hi: jax.random.uniform(next(ks), shape, F32, lo, hi)
    D = D_MODEL
    return {
        "x": nrm((BATCH, SEQ, D), 1.0),
        "c": nrm((BATCH, D), 1.0),
        "ctx": nrm((BATCH, CTX_LEN, D), 1.0),
        "c_ctx": nrm((D,), 1.0),
        "ada_w": nrm((DEPTH, D, 6 * D), 0.5 * D ** -0.5),
        "ada_b": nrm((DEPTH, 6 * D), 0.02),
        "norm1": 1.0 + nrm((DEPTH, D), 0.05),
        "norm2": 1.0 + nrm((DEPTH, D), 0.05),
        "w_in": nrm((DEPTH, D, N_IN), D ** -0.5),
        "shift_mu": uni((DEPTH, 2, R_COLS), 0.0, 0.5),
        "rwkv_w0": uni((DEPTH, 2, RWKV_W), -6.0, 1.0),
        "rwkv_w2": nrm((DEPTH, 2, DECAY_LORA, RWKV_W), 0.1),
        "rwkv_a0": nrm((DEPTH, 2, RWKV_W), 0.1),
        "rwkv_a2": nrm((DEPTH, 2, AAA_LORA, RWKV_W), AAA_LORA ** -0.5),
        "rwkv_g2": nrm((DEPTH, GATE_LORA, RWKV_W), GATE_LORA ** -0.5),
        "rwkv_kk": 0.85 + nrm((DEPTH, RWKV_W), 0.05),
        "rwkv_ka": 1.0 + nrm((DEPTH, RWKV_W), 0.05),
        "rwkv_rk": nrm((DEPTH, RWKV_HEADS, RWKV_HEAD), 0.1),
        "lnx_w": 1.0 + nrm((DEPTH, RWKV_W), 0.05),
        "lnx_b": nrm((DEPTH, RWKV_W), 0.02),
        "q_norm": 1.0 + nrm((DEPTH, HEAD_DIM), 0.05),
        "k_norm": 1.0 + nrm((DEPTH, HEAD_DIM), 0.05),
        "w_pa": nrm((DEPTH, RWKV_W, D), RWKV_W ** -0.5),
        "w_pb": nrm((DEPTH, ATT_W, D), ATT_W ** -0.5),
        "w_o": nrm((DEPTH, D, D), D ** -0.5),
        "ffn_wg": nrm((N_DENSE, D, FFN_DIM), D ** -0.5),
        "ffn_wu": nrm((N_DENSE, D, FFN_DIM), D ** -0.5),
        "ffn_wd": nrm((N_DENSE, FFN_DIM, D), FFN_DIM ** -0.5),
        "router": nrm((N_MOE, D, N_EXPERTS), D ** -0.5),
        "moe_wg": nrm((N_MOE, N_EXPERTS, D, FFN_DIM), D ** -0.5),
        "moe_wu": nrm((N_MOE, N_EXPERTS, D, FFN_DIM), D ** -0.5),
        "moe_wd": nrm((N_MOE, N_EXPERTS, FFN_DIM, D), FFN_DIM ** -0.5),
        "final_norm": 1.0 + nrm((D,), 0.05),
    }


def reference(x, c, ctx, c_ctx, ada_w, ada_b, norm1, norm2, w_in, shift_mu, rwkv_w0, rwkv_w2, rwkv_a0, rwkv_a2,
              rwkv_g2, rwkv_kk, rwkv_ka, rwkv_rk, lnx_w, lnx_b, q_norm, k_norm, w_pa, w_pb, w_o,
              ffn_wg, ffn_wu, ffn_wd, router, moe_wg, moe_wu, moe_wd, final_norm):
    B, T, _ = x.shape
    cos, sin = rope_2d_tables(T)
    c_act = jax.nn.silu(c)
    cc_act = jax.nn.silu(c_ctx)
    xc = ctx
    zero_state = jnp.zeros((B, RWKV_HEADS, RWKV_HEAD, RWKV_HEAD), F32)
    for l in range(DEPTH):
        last = l == DEPTH - 1
        mod = (c_act @ ada_w[l] + ada_b[l])[:, None, :]
        modc = cc_act @ ada_w[l] + ada_b[l]
        sh1, sc1, gt1, sh2, sc2, gt2 = jnp.split(mod, 6, axis=-1)
        csh1, csc1, cgt1, csh2, csc2, cgt2 = jnp.split(modc, 6, axis=-1)

        h = rmsnorm(x, norm1[l]) * (1 + sc1) + sh1
        hc = rmsnorm(xc, norm1[l]) * (1 + csc1) + csh1
        p = h @ w_in[l]
        pc = hc @ w_in[l]

        rw = (shift_mu[l], rwkv_w0[l], rwkv_w2[l], rwkv_a0[l], rwkv_a2[l], rwkv_g2[l], rwkv_kk[l], rwkv_ka[l])
        lr, lv, lkk, lg, ldec, lkeys, lbs = rwkv_prepare(p[..., :R_COLS], *rw)
        cr, cv, ckk, cg, cdec, ckeys, cbs = rwkv_prepare(pc[..., :R_COLS], *rw)
        y_lat_dirs, y_ctx_dirs = [], []
        for d in range(2):
            rev = d == 1
            s_ctx, yc_d = wkv_scan(zero_state, cr, cdec[d], ckeys[d], cv, ckk, cbs[d], rev)
            _, yl_d = wkv_scan(s_ctx, lr, ldec[d], lkeys[d], lv, lkk, lbs[d], rev)
            y_lat_dirs.append(yl_d)
            y_ctx_dirs.append(yc_d)
        y_rwkv = rwkv_output(y_lat_dirs[0] + y_lat_dirs[1], lr, lkeys, lv, lg, rwkv_rk[l], lnx_w[l], lnx_b[l])

        q, k, v = attn_qkv(p[..., R_COLS:R_COLS + A_COLS], q_norm[l], k_norm[l])
        qc, kc, vc = attn_qkv(pc[..., R_COLS:R_COLS + A_COLS], q_norm[l], k_norm[l])
        q = apply_rope(q, cos, sin)
        k = apply_rope(k, cos, sin)
        y_att = block_attention(q, jnp.concatenate([k, kc], axis=1), jnp.concatenate([v, vc], axis=1))

        x = x + gt1 * merge_branches(p[..., R_COLS + A_COLS:], y_rwkv, y_att, w_pa[l], w_pb[l], w_o[l])
        if not last:
            yc_rwkv = rwkv_output(y_ctx_dirs[0] + y_ctx_dirs[1], cr, ckeys, cv, cg, rwkv_rk[l], lnx_w[l], lnx_b[l])
            yc_att = block_attention(qc, kc, vc)
            xc = xc + cgt1 * merge_branches(pc[..., R_COLS + A_COLS:], yc_rwkv, yc_att, w_pa[l], w_pb[l], w_o[l])

        if l % 2 == 0:
            ffn = functools.partial(swiglu, wg=ffn_wg[l // 2], wu=ffn_wu[l // 2], wd=ffn_wd[l // 2])
        else:
            ffn = functools.partial(moe_swiglu, router=router[l // 2], wg=moe_wg[l // 2], wu=moe_wu[l // 2], wd=moe_wd[l // 2])
        h2 = rmsnorm(x, norm2[l]) * (1 + sc2) + sh2
        x = x + gt2 * ffn(h2)
        if not last:
            hc2 = rmsnorm(xc, norm2[l]) * (1 + csc2) + csh2
            xc = xc + cgt2 * ffn(hc2)
    return rmsnorm(x, final_norm)
```

```cpp
#include <hip/hip_runtime.h>
#include <hip/hip_bf16.h>
#include <cstdio>
#include <cstdint>
#include <cmath>

#ifndef MK_FUSED
#define MK_FUSED 0
#endif

constexpr int DM = 1024, NB = 32, TL = 2048, TC = 256;
constexpr int NL = NB * TL;
constexpr int NC = NB * TC;
constexpr int MA = NL + NC;
constexpr int RW = 512, RCOLS = 1792, ACOLS = 768, GCOLS = 2048, NIN = 4608;
constexpr int FF = 3584, NE = 8;
constexpr int KVT = TL + TC;
constexpr int MOE_ROWS = 2 * NL + NE * 256;
constexpr int MOE_CH_TILES = 64;
constexpr int MOE_NCHUNK = (MOE_ROWS / 256 + MOE_CH_TILES - 1) / MOE_CH_TILES;

constexpr size_t MiB = 1u << 20;
constexpr size_t WS_CTL = 0, CTL_ZERO_BYTES = 1 * MiB;
constexpr size_t WS_MOD = 1 * MiB;
constexpr size_t WS_ROPE = 3 * MiB;
constexpr size_t WS_LORA = 4 * MiB;
constexpr size_t WS_BONUS = 5 * MiB;
constexpr size_t WS_MOETAB = 10 * MiB;
constexpr size_t WS_WIN = 16 * MiB;
constexpr size_t WS_WPA = 34 * MiB;
constexpr size_t WS_WPB = 36 * MiB;
constexpr size_t WS_WO = 38 * MiB;
constexpr size_t WS_WGU = 42 * MiB;
constexpr size_t WS_WDN = 56 * MiB;
constexpr size_t WS_XC = 64 * MiB;
constexpr size_t WS_H = 96 * MiB;
constexpr size_t WS_YF = 96 * MiB, WS_YB = 168 * MiB;
constexpr size_t WS_PR = 240 * MiB;
constexpr size_t WS_MG = 240 * MiB;
constexpr size_t WS_Q = 492 * MiB;
constexpr size_t WS_KB = 564 * MiB, WS_VB = 582 * MiB;
constexpr size_t WS_G = 600 * MiB;
constexpr size_t WS_YR = 888 * MiB;
constexpr size_t WS_ACT = 240 * MiB;
constexpr size_t WS_MW = 224 * MiB;
constexpr size_t WS_XB = 392 * MiB;
constexpr size_t WS_YM = 652 * MiB;
constexpr size_t WS_ACTC = 912 * MiB;
constexpr size_t WS_END = 1024 * MiB;
static_assert(WS_H + (size_t)MA * DM * 2 <= WS_PR && WS_PR + (size_t)MA * RCOLS * 2 <= WS_Q && WS_Q + (size_t)MA * 512 * 2 <= WS_KB, "ws map 1");
static_assert(WS_KB + (size_t)MA * 128 * 2 <= WS_VB && WS_VB + (size_t)MA * 128 * 2 <= WS_G && WS_G + (size_t)MA * GCOLS * 2 <= WS_YR && WS_YR + (size_t)MA * 512 * 2 <= WS_END, "ws map 2");
static_assert(WS_ACT + (size_t)MA * FF * 2 <= WS_END && WS_H + (size_t)NL * DM * 2 <= WS_MW && WS_MW + (size_t)NE * 21 * MiB <= WS_XB, "ws map 3");
static_assert(WS_XB + (size_t)MOE_ROWS * DM * 2 <= WS_YM && WS_YM + (size_t)MOE_ROWS * DM * 2 <= WS_ACTC && WS_ACTC + (size_t)MOE_CH_TILES * 256 * FF * 2 <= WS_END, "ws map 4");
static_assert(WS_WDN + (size_t)DM * FF * 2 <= WS_XC && WS_BONUS + (size_t)2 * MA * 8 * 4 <= WS_MOETAB, "ws map 5");
constexpr size_t MT_TOKE = 0;
constexpr size_t MT_TOKW = 512 * 1024;
constexpr size_t MT_TOKS = 1024 * 1024;
constexpr int CW_TMO = 0, CW_CODE = 1;
constexpr int CW_BAR = 4096;
constexpr int CW_HIST = 8192;
constexpr int CW_CURS = 8192 + 64 * 8;

constexpr int NWAVES = 8;
constexpr int LDS_BYTES = 147456;
constexpr int MISC_OFF = LDS_BYTES - 1024;
constexpr int PTAB_OFF = LDS_BYTES - 512;
constexpr int RING_BYTES = 131072;

#define GAS __attribute__((address_space(1)))
#define LAS __attribute__((address_space(3)))
typedef unsigned short bf16;
typedef unsigned v4u __attribute__((ext_vector_type(4)));
typedef unsigned v2u __attribute__((ext_vector_type(2)));
typedef float f32x4 __attribute__((ext_vector_type(4)));
typedef float f32x2 __attribute__((ext_vector_type(2)));
typedef short bf16x8 __attribute__((ext_vector_type(8)));
typedef GAS unsigned gu32;
#define RLX_AGENT __ATOMIC_RELAXED, __HIP_MEMORY_SCOPE_AGENT
#define LDS_WAIT() asm volatile("s_waitcnt lgkmcnt(0)" ::: "memory")
#define VM_WAIT() asm volatile("s_waitcnt vmcnt(0)" ::: "memory")
__device__ __forceinline__ float bf2f(unsigned b) { return __uint_as_float(b << 16); }
__device__ __forceinline__ float bflo(unsigned w) { return __uint_as_float(w << 16); }
__device__ __forceinline__ float bfhi(unsigned w) { return __uint_as_float(w & 0xffff0000u); }
__device__ __forceinline__ unsigned pk2(float lo, float hi) { unsigned r; asm volatile("v_cvt_pk_bf16_f32 %0, %1, %2" : "=v"(r) : "v"(lo), "v"(hi)); return r; }
__device__ __forceinline__ float sigmoidf_(float x) { return 1.0f / (1.0f + __expf(-x)); }
__device__ __forceinline__ float wave_sum(float v) {
#pragma unroll
    for (int o = 1; o < 64; o <<= 1) v += __shfl_xor(v, o);
    return v;
}
__device__ __forceinline__ int row_bi(int m) { return m < NL ? (m >> 11) : 32; }
__device__ __forceinline__ int row_kv(int m) { return m < NL ? (m >> 11) * KVT + (m & 2047) : ((m - NL) >> 8) * KVT + TL + ((m - NL) & 255); }
namespace pg8 {
#define PG8_LAS __attribute__((address_space(3)))
typedef unsigned short bf16_t;
typedef short bf16x8 __attribute__((ext_vector_type(8)));
typedef float f32x4 __attribute__((ext_vector_type(4)));
typedef unsigned u32x4 __attribute__((ext_vector_type(4)));
constexpr int BM = 256, BK = 64, HALF = 128, HTB = HALF * BK * 2  , STAGE_BYTES = 8 * HTB, NXCD = 8, WGM = 8;

__host__ __device__ __forceinline__ int lds_byte(int r, int c) { const int st = (r >> 4) * 2 + (c >> 5), rr = r & 15, cc = c & 31, ob = rr * 64 + cc * 2; return st * 1024 + (ob ^ (((ob >> 9) & 1) << 5)); }
__host__ __device__ __forceinline__ void stage_rc(int b, int& R, int& C) { const int st = b / 1024, sb = b % 1024, swz = sb ^ (((sb >> 9) & 1) << 5); R = (st >> 1) * 16 + swz / 64; C = (st & 1) * 32 + (swz % 64) / 2; }
__host__ __device__ __forceinline__ int perm32(int rho) { const int n = rho >> 4, i = rho & 15; return 8 * (i >> 2) + 4 * n + (i & 3); }

struct Unit { int pm, pn; };

struct StdOrder {
    const char* A; const char* Bt; size_t tstep; int nM, nN, nwg, G, c;
    __device__ void init(const void* A_, const void* Bt_, int K, int nM_, int nN_, int G_, int c_) { A = (const char*)A_; Bt = (const char*)Bt_; tstep = (size_t)BM * K * 2; nM = nM_; nN = nN_; nwg = nM * nN; G = G_; c = c_; }
    __device__ bool next(int i, Unit& u) const {
        const long L = (long)i * G + c; if (L >= nwg) return false;
        int wgid = (int)L; { const int q = nwg / NXCD, r = nwg % NXCD, xcd = wgid % NXCD, off = wgid / NXCD; wgid = (xcd < r ? xcd * (q + 1) : r * (q + 1) + (xcd - r) * q) + off; }
        const int nig = WGM * nN, gid = wgid / nig, fm = gid * WGM, gsz = (nM - fm) < WGM ? (nM - fm) : WGM;
        u.pm = fm + ((wgid % nig) % gsz); u.pn = (wgid % nig) / gsz; return true;
    }
    __device__ __forceinline__ const char* a_base(const Unit& u) const { return A + (size_t)u.pm * tstep; }
    __device__ __forceinline__ const char* b_base(const Unit& u) const { return Bt + (size_t)u.pn * tstep; }
    __device__ __forceinline__ void a_ready(const Unit&) const {}
    __device__ __forceinline__ void done(const Unit&) const {}
};
template <class Epi, class Sched, bool ALIGN_EPI = false, bool SP2 = false>
__device__ __forceinline__ void gemm_phase(PG8_LAS unsigned char* lds, const int K, const Sched& S, const Epi& E) {
    int tid_l = threadIdx.x; asm volatile("" : "+v"(tid_l));
    const int tid = tid_l, wid = __builtin_amdgcn_readfirstlane(tid >> 6), lane = tid & 63, wr = wid >> 2, wc = wid & 3, fr = lane & 15, fq = lane >> 4;
    const int nt = K / BK;
    unsigned voffA[2], voffB[2];
#pragma unroll
    for (int i = 0; i < 2; ++i) { int R, C; stage_rc(tid * 16 + i * 8192, R, C); const int Rb = Epi::PERM ? ((R & ~31) + perm32(R & 31)) : R;
        voffA[i] = (unsigned)(R * K + C) * 2u; voffB[i] = (unsigned)(Rb * K + C) * 2u; }
    const size_t kstep = (size_t)(BK * 2);
    const size_t hstep = (size_t)HALF * K * 2;
    const unsigned ldsw = (unsigned)wid * 1024u;
    const int aoff = lds_byte(wr * 64 + fr, fq * 8), boff = lds_byte(wc * 32 + fr, fq * 8);
#define PG8_SA(b, h) (((b) * 2 + (h)) * HTB)
#define PG8_SB(b, h) ((4 + (b) * 2 + (h)) * HTB)
#define PG8_STAGE(bufoff, gbase, voff) do { _Pragma("unroll") for (int _i = 0; _i < 2; ++_i) \
        __builtin_amdgcn_global_load_lds((const unsigned*)((const char*)(gbase) + (voff)[_i]), (PG8_LAS unsigned*)(lds + (bufoff) + ldsw + _i * 8192), 16, 0, 0); } while (0)
#define PG8_LDA(dst, b, h) do { _Pragma("unroll") for (int m = 0; m < 4; ++m) _Pragma("unroll") for (int k = 0; k < 2; ++k) dst[m][k] = *(const PG8_LAS bf16x8*)(lds + PG8_SA(b, h) + aoff + m * 2048 + k * 1024); } while (0)
#define PG8_LDB(dst, b, h) do { _Pragma("unroll") for (int n = 0; n < 2; ++n) _Pragma("unroll") for (int k = 0; k < 2; ++k) dst[n][k] = *(const PG8_LAS bf16x8*)(lds + PG8_SB(b, h) + boff + n * 2048 + k * 1024); } while (0)
#define PG8_MMA(ai, bj, At, Bt) do { __builtin_amdgcn_s_setprio(1); _Pragma("unroll") for (int m = 0; m < 4; ++m) _Pragma("unroll") for (int n = 0; n < 2; ++n) _Pragma("unroll") for (int k = 0; k < 2; ++k) \
        acc[ai][bj][m][n] = __builtin_amdgcn_mfma_f32_16x16x32_bf16(Bt[n][k], At[m][k], acc[ai][bj][m][n], 0, 0, 0); __builtin_amdgcn_s_setprio(0); } while (0)
#define PG8_WAIT_V(n) asm volatile("s_waitcnt vmcnt(" #n ")" ::: "memory")
#define PG8_WAIT_L(n) asm volatile("s_waitcnt lgkmcnt(" #n ")" ::: "memory")
#define PG8_BAR __builtin_amdgcn_s_barrier()
#define PG8_SCHED __builtin_amdgcn_sched_barrier(0)
    Unit cur, nxt; int ui = 0;
    if (!S.next(0, cur)) return;
    f32x4 acc[2][2][4][2];
#pragma unroll
    for (int a = 0; a < 2; ++a)
#pragma unroll
        for (int b = 0; b < 2; ++b)
#pragma unroll
            for (int m = 0; m < 4; ++m)
#pragma unroll
                for (int n = 0; n < 2; ++n) acc[a][b][m][n] = (f32x4){0.f, 0.f, 0.f, 0.f};
    bf16x8 At[4][2], B0[2][2], B1[2][2];
    const char* cA = S.a_base(cur); const char* cB = S.b_base(cur);
    S.a_ready(cur);
    if constexpr (SP2) {
        PG8_STAGE(PG8_SB(0, 0), cB, voffB); PG8_STAGE(PG8_SB(0, 1), cB + hstep, voffB); PG8_STAGE(PG8_SA(0, 0), cA, voffA); PG8_STAGE(PG8_SA(0, 1), cA + hstep, voffA);
        if (wr == 1) PG8_BAR;
        PG8_WAIT_V(2); PG8_BAR;
        PG8_STAGE(PG8_SB(1, 0), cB + kstep, voffB); PG8_STAGE(PG8_SA(1, 0), cA + kstep, voffA); PG8_STAGE(PG8_SB(1, 1), cB + hstep + kstep, voffB);
        PG8_WAIT_V(6); PG8_BAR;
    } else {
        PG8_STAGE(PG8_SB(0, 0), cB, voffB); PG8_STAGE(PG8_SA(0, 0), cA, voffA); PG8_STAGE(PG8_SB(0, 1), cB + hstep, voffB); PG8_STAGE(PG8_SA(0, 1), cA + hstep, voffA);
        if (wr == 1) PG8_BAR;
        PG8_WAIT_V(4); PG8_BAR;
        PG8_STAGE(PG8_SB(1, 0), cB + kstep, voffB); PG8_STAGE(PG8_SA(1, 0), cA + kstep, voffA); PG8_STAGE(PG8_SB(1, 1), cB + hstep + kstep, voffB);
        PG8_WAIT_V(6); PG8_BAR;
    }
    for (;;) {
        const bool has_next = S.next(ui + 1, nxt);
        const char* nA = has_next ? S.a_base(nxt) : cA; const char* nB = has_next ? S.b_base(nxt) : cB;
        for (int t = 0; t < nt; t += 2) {
            const bool last = (t == nt - 2);
            const char* a1 = cA + (size_t)(t + 1) * kstep;
            const char* a2 = last ? nA : cA + (size_t)(t + 2) * kstep; const char* b2 = last ? nB : cB + (size_t)(t + 2) * kstep;
            const char* a3 = a2 + kstep; const char* b3 = b2 + kstep;
            if (last && has_next) S.a_ready(nxt);
            if constexpr (SP2) {
            PG8_LDB(B0, 0, 0); PG8_LDB(B1, 0, 1); PG8_SCHED; PG8_LDA(At, 0, 0); PG8_STAGE(PG8_SA(1, 1), a1 + hstep, voffA);
            PG8_WAIT_V(8); PG8_WAIT_L(0); PG8_BAR; PG8_MMA(0, 0, At, B0); PG8_MMA(0, 1, At, B1); PG8_BAR; PG8_SCHED;
            PG8_LDA(At, 0, 1); PG8_STAGE(PG8_SB(0, 0), b2, voffB); PG8_STAGE(PG8_SB(0, 1), b2 + hstep, voffB); PG8_STAGE(PG8_SA(0, 0), a2, voffA);
            PG8_WAIT_V(8); PG8_WAIT_L(0); PG8_BAR; PG8_MMA(1, 0, At, B0); PG8_MMA(1, 1, At, B1); PG8_BAR; PG8_SCHED;
            PG8_LDB(B0, 1, 0); PG8_LDB(B1, 1, 1); PG8_SCHED; PG8_LDA(At, 1, 0); PG8_STAGE(PG8_SA(0, 1), a2 + hstep, voffA);
            PG8_WAIT_V(8); PG8_WAIT_L(0); PG8_BAR; PG8_MMA(0, 0, At, B0); PG8_MMA(0, 1, At, B1); PG8_BAR; PG8_SCHED;
            PG8_LDA(At, 1, 1); PG8_STAGE(PG8_SB(1, 0), b3, voffB); PG8_STAGE(PG8_SB(1, 1), b3 + hstep, voffB); PG8_STAGE(PG8_SA(1, 0), a3, voffA);
            PG8_WAIT_V(8); PG8_WAIT_L(0); PG8_BAR; PG8_MMA(1, 0, At, B0); PG8_MMA(1, 1, At, B1); PG8_BAR; PG8_SCHED;
            } else {
            PG8_LDB(B0, 0, 0); PG8_SCHED; PG8_LDA(At, 0, 0); PG8_STAGE(PG8_SA(1, 1), a1 + hstep, voffA);
            PG8_WAIT_L(8); PG8_BAR; PG8_WAIT_L(0); PG8_MMA(0, 0, At, B0); PG8_BAR; PG8_SCHED;
            PG8_LDB(B1, 0, 1); PG8_STAGE(PG8_SB(0, 0), b2, voffB);
            PG8_BAR; PG8_WAIT_L(0); PG8_MMA(0, 1, At, B1); PG8_BAR;
            PG8_LDA(At, 0, 1); PG8_STAGE(PG8_SA(0, 0), a2, voffA);
            PG8_BAR; PG8_WAIT_L(0); PG8_MMA(1, 0, At, B0); PG8_BAR; PG8_SCHED;
            PG8_STAGE(PG8_SB(0, 1), b2 + hstep, voffB);
            PG8_WAIT_V(6); PG8_BAR; PG8_MMA(1, 1, At, B1); PG8_BAR;
            PG8_LDB(B0, 1, 0); PG8_SCHED; PG8_LDA(At, 1, 0); PG8_STAGE(PG8_SA(0, 1), a2 + hstep, voffA);
            PG8_WAIT_L(8); PG8_BAR; PG8_WAIT_L(0); PG8_MMA(0, 0, At, B0); PG8_BAR; PG8_SCHED;
            PG8_LDB(B1, 1, 1); PG8_STAGE(PG8_SB(1, 0), b3, voffB);
            PG8_BAR; PG8_WAIT_L(0); PG8_MMA(0, 1, At, B1); PG8_BAR;
            PG8_LDA(At, 1, 1); PG8_STAGE(PG8_SA(1, 0), a3, voffA);
            PG8_BAR; PG8_WAIT_L(0); PG8_MMA(1, 0, At, B0); PG8_BAR; PG8_SCHED;
            PG8_STAGE(PG8_SB(1, 1), b3 + hstep, voffB);
            PG8_WAIT_V(6); PG8_BAR; PG8_MMA(1, 1, At, B1); PG8_BAR;
            }
        }
        if constexpr (ALIGN_EPI) { if (wr == 0) PG8_BAR; }
        if constexpr (!Epi::AFTER_DRAIN) { E(acc, cur, wr, wc, fr, fq); S.done(cur); }
        if (!has_next) break;
#pragma unroll
        for (int a = 0; a < 2; ++a)
#pragma unroll
            for (int b = 0; b < 2; ++b)
#pragma unroll
                for (int m = 0; m < 4; ++m)
#pragma unroll
                    for (int n = 0; n < 2; ++n) acc[a][b][m][n] = (f32x4){0.f, 0.f, 0.f, 0.f};
        cur = nxt; cA = nA; cB = nB; ++ui;
        if constexpr (ALIGN_EPI) { if (wr == 1) PG8_BAR; }
    }
    PG8_WAIT_V(0);
    if constexpr (!ALIGN_EPI) { if (wr == 0) PG8_BAR; }
    PG8_BAR;
    if constexpr (Epi::AFTER_DRAIN) { E.fused(acc, cur, wr, wc, fr, fq, lds, wid, lane); S.done(cur); }
#undef PG8_SA
#undef PG8_SB
#undef PG8_STAGE
#undef PG8_LDA
#undef PG8_LDB
#undef PG8_MMA
#undef PG8_WAIT_V
#undef PG8_WAIT_L
#undef PG8_BAR
#undef PG8_SCHED
}
}

#include <hip/hip_bf16.h>
#include <cmath>
namespace attn_body {
using bf16=__hip_bfloat16;
using bf16x8=__attribute__((ext_vector_type(8)))short;
using s16x4=__attribute__((ext_vector_type(4)))short;
using f32x16=__attribute__((ext_vector_type(16)))float;
using u32x4=__attribute__((ext_vector_type(4)))unsigned;
constexpr int D=64,QP=512,KP=128;
constexpr int NW=8,QBLK=32,QB=QBLK*NW,KVBLK=64;
constexpr int ATTN_UNIT_ROWS=QB;
__device__ __forceinline__ int crow(int r,int hi){return (r&3)+8*(r>>2)+4*hi;}
#define SBAR() __builtin_amdgcn_sched_barrier(0)
__device__ __forceinline__ void cmask(f32x16&p0,f32x16&p1,int jb,int qrel,int hi){
  const float NEG=-INFINITY; int kb=64*jb+4*hi;
  #pragma unroll
  for(int r=0;r<16;++r){int kv=kb+(r&3)+8*(r>>2); if(kv>qrel)p0[r]=NEG; if(kv+32>qrel)p1[r]=NEG;}
}

constexpr int NSLOT=3, SLOTB=8192;
constexpr int LDS_K=0, LDS_V=NSLOT*SLOTB, LDS_WS=2*NSLOT*SLOTB, LDS_OST=LDS_WS+NW*64*4, LDS_BYTES=LDS_OST+NW*4096;
constexpr float C2=0.125f*1.4426950408889634f;
__device__ __forceinline__ void glds16(const void*gsrc,unsigned lds_dst){unsigned keep;
  asm volatile("s_mov_b32 %0, m0\n\ts_mov_b32 m0, %2\n\ts_nop 0\n\tglobal_load_lds_dwordx4 %1, off\n\ts_mov_b32 m0, %0":"=&s"(keep):"v"(gsrc),"s"(lds_dst):"memory");}
__device__ __forceinline__ float max3f(float a,float b,float c){float r;asm("v_max3_f32 %0, %1, %2, %3":"=v"(r):"v"(a),"v"(b),"v"(c));return r;}
__device__ __forceinline__ float max2f(float a,float b){float r;asm("v_max_f32_e32 %0, %1, %2":"=v"(r):"v"(a),"v"(b));return r;}
__device__ __forceinline__ float fadd_s(float a,float b){float r;asm("v_add_f32_e32 %0, %1, %2":"=v"(r):"v"(a),"v"(b));return r;}
__device__ __forceinline__ float fsub_s(float a,float b){float r;asm("v_sub_f32_e32 %0, %1, %2":"=v"(r):"v"(a),"v"(b));return r;}
typedef float f32x2_t __attribute__((ext_vector_type(2))); typedef __bf16 bf16x2_t __attribute__((ext_vector_type(2)));
__device__ __forceinline__ unsigned cvtpk_s(float lo,float hi){f32x2_t v={lo,hi};bf16x2_t b=__builtin_convertvector(v,bf16x2_t);return __builtin_bit_cast(unsigned,b);}
#define WAIT_BAR(N) asm volatile("s_waitcnt vmcnt(" #N ") lgkmcnt(0)\n\ts_barrier":::"memory")

__device__ __forceinline__ void qkt(f32x16&p0,f32x16&p1,const char*Kslot,const bf16x8*qr,const f32x16&negm,int r32,int hi){
  const char*kb=Kslot+hi*1024+r32*16;
  #pragma unroll
  for(int d0=0;d0<4;++d0){
    const bf16x8 b0=*reinterpret_cast<const bf16x8*>(kb+d0*2048);
    const bf16x8 b1=*reinterpret_cast<const bf16x8*>(kb+d0*2048+512);
    if(d0==0){p0=__builtin_amdgcn_mfma_f32_32x32x16_bf16(b0,qr[0],negm,0,0,0);p1=__builtin_amdgcn_mfma_f32_32x32x16_bf16(b1,qr[0],negm,0,0,0);}
    else{p0=__builtin_amdgcn_mfma_f32_32x32x16_bf16(b0,qr[d0],p0,0,0,0);p1=__builtin_amdgcn_mfma_f32_32x32x16_bf16(b1,qr[d0],p1,0,0,0);}}
}
typedef __attribute__((address_space(3))) const char* lds_cptr;
typedef short v4i16_t __attribute__((ext_vector_type(4)));
__device__ __forceinline__ void kload8(bf16x8*kf,lds_cptr kp){
  kf[0]=*(const __attribute__((address_space(3))) bf16x8*)(kp);      kf[1]=*(const __attribute__((address_space(3))) bf16x8*)(kp+512);
  kf[2]=*(const __attribute__((address_space(3))) bf16x8*)(kp+2048); kf[3]=*(const __attribute__((address_space(3))) bf16x8*)(kp+2560);
  kf[4]=*(const __attribute__((address_space(3))) bf16x8*)(kp+4096); kf[5]=*(const __attribute__((address_space(3))) bf16x8*)(kp+4608);
  kf[6]=*(const __attribute__((address_space(3))) bf16x8*)(kp+6144); kf[7]=*(const __attribute__((address_space(3))) bf16x8*)(kp+6656);
}
__device__ __forceinline__ void kload2(bf16x8*kf,lds_cptr kp,int j){ kf[2*j]=*(const __attribute__((address_space(3))) bf16x8*)(kp+j*2048); kf[2*j+1]=*(const __attribute__((address_space(3))) bf16x8*)(kp+j*2048+512); }
__device__ __forceinline__ s16x4 vtr(lds_cptr p){ return __builtin_bit_cast(s16x4,__builtin_amdgcn_ds_read_tr16_b64_v4i16((__attribute__((address_space(3))) v4i16_t*)p)); }
__device__ __forceinline__ float rowmax(const f32x16&p0,const f32x16&p1){
  float a=max3f(p0[0],p0[1],p1[0]),b=max3f(p0[2],p0[3],p1[1]);a=max3f(a,p1[2],p1[3]);
  #pragma unroll
  for(int r=4;r<16;r+=4){a=max3f(a,p0[r],p0[r+1]);b=max3f(b,p0[r+2],p0[r+3]);a=max3f(a,p1[r],p1[r+1]);b=max3f(b,p1[r+2],p1[r+3]);}
  const float m=max2f(a,b);
  auto rr=__builtin_amdgcn_permlane32_swap(__float_as_uint(m),__float_as_uint(m),false,false);
  return max2f(__uint_as_float(rr[0]),__uint_as_float(rr[1]));
}
__device__ __forceinline__ void pv(f32x16*o,int vb,bf16x8 pa0,bf16x8 pa1,bf16x8 pa2,bf16x8 pa3){
  #pragma unroll
  for(int d0=0;d0<2;++d0){s16x4 lo[4],hi[4];
    #pragma unroll
    for(int ks=0;ks<4;++ks){
      asm volatile("ds_read_b64_tr_b16 %0,%1 offset:%c2":"=&v"(lo[ks]):"v"(vb),"i"(d0*4096+ks*1024):"memory");
      asm volatile("ds_read_b64_tr_b16 %0,%1 offset:%c2":"=&v"(hi[ks]):"v"(vb),"i"(d0*4096+ks*1024+512):"memory");}
    asm volatile("s_waitcnt lgkmcnt(0)":::"memory");SBAR();
    #define PK(k) (bf16x8){lo[k][0],lo[k][1],lo[k][2],lo[k][3],hi[k][0],hi[k][1],hi[k][2],hi[k][3]}
    o[d0]=__builtin_amdgcn_mfma_f32_32x32x16_bf16(pa0,PK(0),o[d0],0,0,0);
    o[d0]=__builtin_amdgcn_mfma_f32_32x32x16_bf16(pa1,PK(1),o[d0],0,0,0);
    o[d0]=__builtin_amdgcn_mfma_f32_32x32x16_bf16(pa2,PK(2),o[d0],0,0,0);
    o[d0]=__builtin_amdgcn_mfma_f32_32x32x16_bf16(pa3,PK(3),o[d0],0,0,0);
    #undef PK
  }
}

#ifndef ATTN_STORE16
#define ATTN_STORE16(p,v) (*(u32x4*)(p)=(v))
#endif
template<int THRL> __device__ __forceinline__ void attn_unit(const bf16*Qu,const bf16*__restrict__ Kh,const bf16*__restrict__ Vh,bf16*Ou,const int NT,char*shm){
  int tid_l=threadIdx.x; asm volatile("":"+v"(tid_l));
  const int tid=tid_l,lane=tid&63,r32=lane&31,hi=lane>>5; const int wid=__builtin_amdgcn_readfirstlane(tid>>6);
  const bf16*Qw=Qu+(long)(wid*QBLK)*QP;
  const unsigned lds0=(unsigned)(uintptr_t)shm;
  float*wsf=(float*)(shm+LDS_WS)+wid*64;
  const bf16*ksrc=Kh+(long)lane*KP+wid*8;
  const bf16*vsrc=Vh+(long)(16*(wid&3)+(lane>>2))*KP+(wid>>2)*32+(lane&3)*8;
  const unsigned kdst=lds0+LDS_K+wid*1024, vdst=lds0+LDS_V+wid*1024;
  #define DMA_K(t,slot) glds16(ksrc+(long)(t)*KVBLK*KP,(unsigned)__builtin_amdgcn_readfirstlane(kdst+(slot)))
  #define DMA_V(t,slot) glds16(vsrc+(long)(t)*KVBLK*KP,(unsigned)__builtin_amdgcn_readfirstlane(vdst+(slot)))
  const int vb0=(int)(lds0+LDS_V)+((lane>>4)&1)*32+(lane&3)*8+(4*hi+((lane&15)>>2))*64;
  const char*Kbase=shm+LDS_K; bf16x8 kf[8];
  const lds_cptr shm3=(lds_cptr)shm; const lds_cptr kp0=shm3+LDS_K+hi*1024+r32*16; const lds_cptr vp0=shm3+LDS_V+((lane>>4)&1)*32+(lane&3)*8+(4*hi+((lane&15)>>2))*64;
  DMA_K(0,0);DMA_V(0,0);DMA_K(1,SLOTB);
  bf16x8 qr[4];
  #pragma unroll
  for(int d0=0;d0<4;++d0)qr[d0]=*reinterpret_cast<const bf16x8*>(&Qw[(long)r32*QP+d0*16+hi*8]);
  float mhat=0.f,l_reg=0.f;f32x16 o[2];o[0]=f32x16{};o[1]=f32x16{};f32x16 negm=f32x16{};asm volatile("":"+v"(negm));
  #define CMASK(P0,P1,t) do{}while(0)
  bool resc=false;
  #define START(P0,P1) do{ const float rm=rowmax(P0,P1); resc=false; \
    { const float dl=rm; mhat=fadd_s(mhat,dl); \
      _Pragma("unroll") for(int r=0;r<16;++r){P0[r]=fsub_s(P0[r],dl);P1[r]=fsub_s(P1[r],dl);} \
      _Pragma("unroll") for(int r=0;r<16;++r)negm[r]=-mhat; asm volatile("":"+v"(negm)); } \
    _Pragma("unroll") for(int r=0;r<16;++r)P0[r]=__builtin_amdgcn_exp2f(P0[r]); }while(0)
  #define RESC() do{ if(resc){ asm volatile("s_waitcnt lgkmcnt(0)":::"memory"); \
      _Pragma("unroll") for(int d_=0;d_<2;++d_) _Pragma("unroll") for(int r=0;r<16;++r)o[d_][r]*=wsf[crow(r,hi)]; } }while(0)
  f32x16 pA0,pA1,pB0,pB1;
  int sl_prev=0,sl_cur=0,sl_next=SLOTB;
  #define ROT() do{sl_prev=sl_cur;sl_cur=sl_next;sl_next=(sl_next==(NSLOT-1)*SLOTB)?0:sl_next+SLOTB;}while(0)
  DMA_K(2,2*SLOTB);
  WAIT_BAR(3);
  qkt(pA0,pA1,Kbase,qr,negm,r32,hi);asm volatile("s_nop 15\n\ts_nop 7":"+v"(pA0),"+v"(pA1));CMASK(pA0,pA1,0);
  START(pA0,pA1);
  _Pragma("unroll") for(int r=0;r<16;++r)pA1[r]=__builtin_amdgcn_exp2f(pA1[r]);
  WAIT_BAR(0);
  DMA_K(3,0);DMA_V(1,SLOTB);
  ROT();
  kload8(kf,kp0+sl_cur);
  WAIT_BAR(2);
  s16x4 vlo[8],vhi[8]; u32x4 pw0,pw1,pw2,pw3;
  #define PKW(P,B) cvtpk_s(P[B],P[B+1])
  #define PAF(k) __builtin_bit_cast(bf16x8,pw##k)
  #define VFR(i) (bf16x8){vlo[i][0],vlo[i][1],vlo[i][2],vlo[i][3],vhi[i][0],vhi[i][1],vhi[i][2],vhi[i][3]}
  #define PIN(x) asm volatile("":"+v"(x))
  #define MX3(a,b,c) __builtin_fmaxf(__builtin_fmaxf((a),(b)),(c))
  #define GAPA(MF,A0,A1,A2,A3,W0,W1,PW) do{ MF; sacc+=A0; sacc+=A1; sacc+=A2; sacc+=A3; PIN(sacc); W0; W1; PIN(PW); SBAR(); }while(0)
  #define EX(v) __builtin_amdgcn_exp2f(v)
  #define GAPB(MF,X,B) do{ MF; X[B]=EX(X[B]); X[B+1]=EX(X[B+1]); X[B+2]=EX(X[B+2]); X[B+3]=EX(X[B+3]); PIN(X); SBAR(); }while(0)
  #define VRD(i) do{ vlo[i]=vtr(vp_+(((i)>>2)*4096+((i)&3)*1024)); vhi[i]=vtr(vp_+(((i)>>2)*4096+((i)&3)*1024+512)); }while(0)
  #define KRD(G,j) do{ if(G){ kload2(kf,kp0+sl_next,j); SBAR(); } }while(0)
  #define STEP(C0,C1,P0,P1,t,GK,GV,GL) do{ SBAR(); \
    const lds_cptr vp_=vp0+sl_prev; \
    VRD(0); SBAR(); float sacc=(P0[0]+P0[1]); \
    GAPA(C0=__builtin_amdgcn_mfma_f32_32x32x16_bf16(kf[0],qr[0],negm,0,0,0), P0[2],P0[3],P0[4],P0[5],     pw0[0]=PKW(P0,0), pw0[1]=PKW(P0,2), pw0); \
    VRD(4); SBAR(); GAPA(C1=__builtin_amdgcn_mfma_f32_32x32x16_bf16(kf[1],qr[0],negm,0,0,0), P0[6],P0[7],P0[8],P0[9],     pw0[2]=PKW(P0,4), pw0[3]=PKW(P0,6), pw0); \
    VRD(1); SBAR(); GAPA(C0=__builtin_amdgcn_mfma_f32_32x32x16_bf16(kf[2],qr[1],C0,0,0,0),   P0[10],P0[11],P0[12],P0[13], pw1[0]=PKW(P0,8), pw1[1]=PKW(P0,10), pw1); \
    VRD(5); SBAR(); GAPA(C1=__builtin_amdgcn_mfma_f32_32x32x16_bf16(kf[3],qr[1],C1,0,0,0),   P0[14],P0[15],P1[0],P1[1],   pw1[2]=PKW(P0,12),pw1[3]=PKW(P0,14), pw1); \
    VRD(2); SBAR(); GAPA(C0=__builtin_amdgcn_mfma_f32_32x32x16_bf16(kf[4],qr[2],C0,0,0,0),   P1[2],P1[3],P1[4],P1[5],     pw2[0]=PKW(P1,0), pw2[1]=PKW(P1,2), pw2); \
    VRD(6); SBAR(); GAPA(C1=__builtin_amdgcn_mfma_f32_32x32x16_bf16(kf[5],qr[2],C1,0,0,0),   P1[6],P1[7],P1[8],P1[9],     pw2[2]=PKW(P1,4), pw2[3]=PKW(P1,6), pw2); \
    VRD(3); SBAR(); GAPA(C0=__builtin_amdgcn_mfma_f32_32x32x16_bf16(kf[6],qr[3],C0,0,0,0),   P1[10],P1[11],P1[12],P1[13], pw3[0]=PKW(P1,8), pw3[1]=PKW(P1,10), pw3); \
    VRD(7); SBAR(); GAPA(C1=__builtin_amdgcn_mfma_f32_32x32x16_bf16(kf[7],qr[3],C1,0,0,0),   P1[14],P1[15],0.f,0.f,       pw3[2]=PKW(P1,12),pw3[3]=PKW(P1,14), pw3); \
    l_reg+=sacc; \
    if(GK){DMA_K((t)+3,sl_cur);} if(GV){DMA_V((t)+1,sl_next);} \
    CMASK(C0,C1,t); \
    { float a=MX3(C0[0],C0[1],C1[0]),b=MX3(C0[2],C0[3],C1[1]); a=MX3(a,C1[2],C1[3]); \
      _Pragma("unroll") for(int r=4;r<16;r+=4){a=MX3(a,C0[r],C0[r+1]);b=MX3(b,C0[r+2],C0[r+3]);a=MX3(a,C1[r],C1[r+1]);b=MX3(b,C1[r+2],C1[r+3]);} \
      float rm=__builtin_fmaxf(a,b); { auto rr=__builtin_amdgcn_permlane32_swap(__float_as_uint(rm),__float_as_uint(rm),false,false); rm=__builtin_fmaxf(__uint_as_float(rr[0]),__uint_as_float(rr[1])); } \
      resc=false; \
      if(__builtin_expect(__any(rm>(float)THRL),0)){ const float dl=__builtin_fmaxf(rm,0.f); mhat+=dl; \
        _Pragma("unroll") for(int r=0;r<16;++r){C0[r]-=dl;C1[r]-=dl;} \
        _Pragma("unroll") for(int r=0;r<16;++r)negm[r]=-mhat; asm volatile("":"+v"(negm)); \
        const float f=__builtin_amdgcn_exp2f(-dl); l_reg*=f; if(hi==0)wsf[r32]=f; resc=true; } } \
    SBAR(); \
    GAPB(o[0]=__builtin_amdgcn_mfma_f32_32x32x16_bf16(PAF(0),VFR(0),o[0],0,0,0), C0,0); \
    GAPB(o[1]=__builtin_amdgcn_mfma_f32_32x32x16_bf16(PAF(0),VFR(4),o[1],0,0,0), C0,4); \
    KRD(GL,0); GAPB(o[0]=__builtin_amdgcn_mfma_f32_32x32x16_bf16(PAF(1),VFR(1),o[0],0,0,0), C0,8); \
    KRD(GL,1); GAPB(o[1]=__builtin_amdgcn_mfma_f32_32x32x16_bf16(PAF(1),VFR(5),o[1],0,0,0), C0,12); \
    KRD(GL,2); GAPB(o[0]=__builtin_amdgcn_mfma_f32_32x32x16_bf16(PAF(2),VFR(2),o[0],0,0,0), C1,0); \
    KRD(GL,3); GAPB(o[1]=__builtin_amdgcn_mfma_f32_32x32x16_bf16(PAF(2),VFR(6),o[1],0,0,0), C1,4); \
    GAPB(o[0]=__builtin_amdgcn_mfma_f32_32x32x16_bf16(PAF(3),VFR(3),o[0],0,0,0), C1,8); \
    GAPB(o[1]=__builtin_amdgcn_mfma_f32_32x32x16_bf16(PAF(3),VFR(7),o[1],0,0,0), C1,12); \
    }while(0)
  int t=1;
  for(;t+5<NT;t+=2){
    STEP(pB0,pB1,pA0,pA1,t,true,true,true);     WAIT_BAR(2); RESC(); ROT();
    STEP(pA0,pA1,pB0,pB1,t+1,true,true,true);   WAIT_BAR(2); RESC(); ROT();
  }
  #define ENDW(tt) do{ if((tt)+3<NT){WAIT_BAR(2);} else if((tt)+2<NT){WAIT_BAR(1);} else {WAIT_BAR(0);} }while(0)
  for(;t+1<NT;t+=2){
    STEP(pB0,pB1,pA0,pA1,t,(t+3<NT),(t+1<NT),(t+1<NT));       ENDW(t);   RESC(); ROT();
    STEP(pA0,pA1,pB0,pB1,t+1,(t+4<NT),(t+2<NT),(t+2<NT));     ENDW(t+1); RESC(); ROT();
  }
  STEP(pB0,pB1,pA0,pA1,NT-1,false,false,false); RESC();
  { float sacc=pB0[0]+pB0[1]; _Pragma("unroll") for(int r=2;r<16;++r)sacc+=pB0[r]; _Pragma("unroll") for(int r=0;r<16;++r)sacc+=pB1[r]; l_reg+=sacc;
    pw0=(u32x4){PKW(pB0,0),PKW(pB0,2),PKW(pB0,4),PKW(pB0,6)};pw1=(u32x4){PKW(pB0,8),PKW(pB0,10),PKW(pB0,12),PKW(pB0,14)};pw2=(u32x4){PKW(pB1,0),PKW(pB1,2),PKW(pB1,4),PKW(pB1,6)};pw3=(u32x4){PKW(pB1,8),PKW(pB1,10),PKW(pB1,12),PKW(pB1,14)};
    SBAR(); pv(o,vb0+sl_cur,PAF(0),PAF(1),PAF(2),PAF(3)); }
  #undef PKW
  #undef PAF
  #undef VFR
  #undef PIN
  #undef MX3
  #undef GAPA
  #undef GAPB
  #undef EX
  #undef VRD
  #undef KRD
  #undef STEP
  #undef ENDW
  {auto rr=__builtin_amdgcn_permlane32_swap(__float_as_uint(l_reg),__float_as_uint(l_reg),false,false);l_reg=__uint_as_float(rr[0])+__uint_as_float(rr[1]);}
  if(hi==0)wsf[32+r32]=l_reg;asm volatile("s_waitcnt lgkmcnt(0)":::"memory");
  float rli[16];
  #pragma unroll
  for(int r=0;r<16;++r)rli[r]=__builtin_amdgcn_rcpf(wsf[32+crow(r,hi)]);
  bf16*Ow=Ou+(long)(wid*QBLK)*QP;
  { bf16*stg=(bf16*)(shm+LDS_OST)+wid*2048;
    #pragma unroll
    for(int r=0;r<16;++r){const int orow=crow(r,hi);
      #pragma unroll
      for(int d0=0;d0<2;++d0)stg[orow*64+d0*32+r32]=__float2bfloat16(o[d0][r]*rli[r]);}
    asm volatile("s_waitcnt lgkmcnt(0)":::"memory");
    #pragma unroll
    for(int i=0;i<4;++i){const int row=i*8+(lane>>3),ch=lane&7; const u32x4 v=*(const u32x4*)(stg+row*64+ch*8); ATTN_STORE16(Ow+(long)row*QP+ch*8,v);} }
  asm volatile("s_waitcnt lgkmcnt(0)\n\ts_barrier":::"memory");
  #undef DMA_K
  #undef DMA_V
  #undef CMASK
  #undef START
  #undef RESC
  #undef ROT
}
constexpr int ATTN_LDS_BYTES=LDS_BYTES;
#undef SBAR
#undef WAIT_BAR
}

#define XB_TMO      128
#define XB_XCNT(j)  (256  + 64 * (j))
#define XB_XSUB(j)  (1280 + 64 * (j))
#define XB_XGEN(j)  (2304 + 64 * (j))
#define XB_TOP      3328
#define XB_TOPGEN   3392
#define XCD_BAR_WORDS 3456
#define XB_SPIN_CAP (1u << 18)

__device__ __forceinline__ unsigned xb_ld(unsigned* p)              { return __hip_atomic_load(p, __ATOMIC_RELAXED, __HIP_MEMORY_SCOPE_AGENT); }
__device__ __forceinline__ unsigned xb_add(unsigned* p, unsigned v) { return __hip_atomic_fetch_add(p, v, __ATOMIC_RELAXED, __HIP_MEMORY_SCOPE_AGENT); }
__device__ __forceinline__ unsigned xb_xcc_id() { return (unsigned)__builtin_amdgcn_s_getreg((3 << 11) | 20) & 0xFu; }
#define XB_SPIN(cond, bar) do { unsigned _sp = 0; while (cond) { __builtin_amdgcn_s_sleep(1); \
    if ((++_sp & 255u) == 0u) { if (xb_ld(&(bar)[XB_TMO])) break; if (_sp > XB_SPIN_CAP) { atomicAdd(&(bar)[XB_TMO], 1u); break; } } } } while (0)

struct XcdBarrier {
    unsigned* bar; unsigned x;
    volatile LAS unsigned* st;
};

__device__ __forceinline__ XcdBarrier xcd_barrier_post(unsigned* bar, volatile LAS unsigned* st) {
    XcdBarrier b; b.bar = bar; b.x = xb_xcc_id(); b.st = st;
    if (threadIdx.x == 0) (void)xb_add(&bar[XB_XCNT(b.x)], 1u);
    return b;
}
__device__ __forceinline__ void xcd_barrier_complete(unsigned* bar, unsigned x, unsigned& nloc, unsigned& nx) {
    const unsigned G = gridDim.x * gridDim.y * gridDim.z;
    unsigned sum, cnt, mine, sp = 0u;
    for (;;) {
        sum = 0u; cnt = 0u; mine = 0u;
#pragma unroll
        for (unsigned j = 0; j < 16; ++j) { const unsigned c = xb_ld(&bar[XB_XCNT(j)]); sum += c; cnt += (c > 0u) ? 1u : 0u; mine = (j == x) ? c : mine; }
        if (sum == G) break;
        __builtin_amdgcn_s_sleep(1);
        if ((++sp & 255u) == 0u) { if (xb_ld(&bar[XB_TMO])) break; if (sp > XB_SPIN_CAP) { atomicAdd(&bar[XB_TMO], 1u); break; } }
    }
    nloc = mine > 0u ? mine : 1u; nx = cnt > 0u ? cnt : 1u;
}

__device__ __forceinline__ void xcd_barrier(const XcdBarrier& b) {
    asm volatile("s_waitcnt vmcnt(0)" ::: "memory");
    __syncthreads();
    if (threadIdx.x == 0) {
        unsigned* bar = b.bar;
        __builtin_amdgcn_s_waitcnt(0);
        unsigned nloc = b.st[0], nx = b.st[1];
        if (nloc == 0u) { xcd_barrier_complete(bar, b.x, nloc, nx); b.st[0] = nloc; b.st[1] = nx; }
        const unsigned old = xb_add(&bar[XB_XSUB(b.x)], 1u);
        const unsigned gen = old / nloc;
        if (old + 1u == (gen + 1u) * nloc) {
            __builtin_amdgcn_fence(__ATOMIC_RELEASE, "agent");
            asm volatile("s_waitcnt vmcnt(0)" ::: "memory");
            const unsigned og = xb_add(&bar[XB_TOP], 1u);
            const unsigned tg = og / nx;
            if (og + 1u == (tg + 1u) * nx) xb_add(&bar[XB_TOPGEN], 1u);
            else XB_SPIN(xb_ld(&bar[XB_TOPGEN]) == tg, bar);
            __builtin_amdgcn_fence(__ATOMIC_ACQUIRE, "agent");
            xb_add(&bar[XB_XGEN(b.x)], 1u);
            asm volatile("s_waitcnt vmcnt(0)" ::: "memory");
        } else {
            XB_SPIN(xb_ld(&bar[XB_XGEN(b.x)]) == gen, bar);
            __builtin_amdgcn_fence(__ATOMIC_ACQUIRE, "agent");
            asm volatile("s_waitcnt vmcnt(0)" ::: "memory");
        }
    }
    __syncthreads();
}

struct Args { const float* in[33]; float* out; unsigned char* ws; int mode, l, site, chunk; };
struct Frame {
    LAS unsigned char* lds; volatile LAS unsigned* MISC; gu32* ctl;
    int tid, lane, wave, vcu, G;
    unsigned char* ws; float* out;
};
#define WSP(T, off) ((T*)(F.ws + (off)))
__device__ __forceinline__ const float* inptr(LAS unsigned char* lds, int i) { const LAS unsigned* p = (const LAS unsigned*)(lds + PTAB_OFF) + 2 * i; const unsigned lo = __builtin_amdgcn_readfirstlane(p[0]), hi = __builtin_amdgcn_readfirstlane(p[1]); return (const float*)(((unsigned long long)hi << 32) | lo); }
#define INP(i) inptr(F.lds, (i))

__device__ __forceinline__ void conv_item(const float* W, int Nsrc, int k0, int c0, bf16* WT, int K, int drow0, LAS float* scr, int lane) {
#pragma unroll 8
    for (int i = 0; i < 32; ++i) { const int kk = 2 * i + (lane >> 5); scr[kk * 33 + (lane & 31)] = W[(size_t)(k0 + kk) * Nsrc + c0 + (lane & 31)]; }
    LDS_WAIT(); asm volatile("" ::: "memory");
    const int c = lane & 7;
#pragma unroll
    for (int j = 0; j < 4; ++j) { const int n = (lane >> 3) + 8 * j; const LAS float* s = scr + (8 * c) * 33 + n;
        v4u o; o.x = pk2(s[0 * 33], s[1 * 33]); o.y = pk2(s[2 * 33], s[3 * 33]); o.z = pk2(s[4 * 33], s[5 * 33]); o.w = pk2(s[6 * 33], s[7 * 33]);
        *(GAS v4u*)(WT + (size_t)(drow0 + n) * K + k0 + 8 * c) = o; }
    LDS_WAIT(); asm volatile("" ::: "memory");
}
__device__ __forceinline__ void conv_plain(int item, const float* W, int K, int N, bf16* WT, LAS float* scr, int lane) {
    const int ng = N / 32, kb = item / ng, g = item % ng; conv_item(W, N, 64 * kb, 32 * g, WT, K, 32 * g, scr, lane);
}
__device__ __forceinline__ void conv_gu(int item, const float* W, bf16* WT, int off, LAS float* scr, int lane) {
    const int ng = FF / 32, kb = item / ng, g = item % ng; conv_item(W, FF, 64 * kb, 32 * g, WT, DM, 256 * (g >> 2) + off + 32 * (g & 3), scr, lane);
}
__device__ __forceinline__ void mod_task(Frame& F, int task) {
    const int l = task / 96, nb = task % 96;
    LAS float* S = (LAS float*)F.lds;
    for (int i = F.tid; i < 33 * 1024; i += 512) { const int bi = i >> 10, k = i & 1023; const float c = bi < 32 ? INP(1)[bi * 1024 + k] : INP(3)[k]; S[k * 33 + bi] = c / (1.0f + __expf(-c)); }
    __syncthreads();
    const float* W = INP(4) + (size_t)l * DM * 6144 + nb * 64 + F.lane;
    float acc[33];
#pragma unroll
    for (int bi = 0; bi < 33; ++bi) acc[bi] = 0.f;
    const int k0 = F.wave * 128;
    for (int k = k0; k < k0 + 128; ++k) { const float w = W[(size_t)k * 6144];
#pragma unroll
        for (int bi = 0; bi < 33; ++bi) acc[bi] = fmaf(S[k * 33 + bi], w, acc[bi]); }
    __syncthreads();
    LAS float* P = (LAS float*)F.lds;
#pragma unroll
    for (int bi = 0; bi < 33; ++bi) P[(F.wave * 33 + bi) * 64 + F.lane] = acc[bi];
    __syncthreads();
    float* mod = WSP(float, WS_MOD);
    for (int o = F.tid; o < 33 * 64; o += 512) { const int bi = o >> 6, cc = o & 63; float s = 0.f;
#pragma unroll
        for (int w = 0; w < 8; ++w) s += P[(w * 33 + bi) * 64 + cc];
        const int n = nb * 64 + cc; mod[(size_t)(l * 33 + bi) * 6144 + n] = s + INP(5)[l * 6144 + n]; }
    __syncthreads();
}
__device__ __forceinline__ void p0_prologue(Frame& F) {
    for (int t = F.vcu; t < 192; t += F.G) mod_task(F, t);
    if (F.vcu == F.G - 1) { float* rt = WSP(float, WS_ROPE);
        for (int i = F.tid; i < 1024; i += 512) { const int pos = i >> 4, f = i & 15; const float inv = powf(10000.0f, -(float)f / 16.0f); const float a = (float)pos * inv; rt[i] = cosf(a); rt[1024 + i] = sinf(a); } }
    LAS float* scr = (LAS float*)(F.lds + F.wave * 8448);
    const int gw = F.vcu * NWAVES + F.wave, NGW = F.G * NWAVES;
    constexpr int I_IN = 16 * 144, I_P = 8 * 32, I_O = 16 * 32, I_GU = 16 * 112, I_DN = 56 * 32, I_L = 16, I_G2 = 32;
    constexpr int NITEMS = 2 * I_IN + 4 * I_P + 2 * I_O + 2 * I_GU + I_DN + 8 * I_L + 2 * I_G2;
    bf16* lora = WSP(bf16, WS_LORA);
    for (int it = gw; it < NITEMS; it += NGW) {
        int r = it;
        if (r < 2 * I_IN) { const int l = r / I_IN; conv_plain(r % I_IN, INP(8) + (size_t)l * DM * NIN, DM, NIN, WSP(bf16, WS_WIN) + (size_t)l * NIN * DM, scr, F.lane); continue; } r -= 2 * I_IN;
        if (r < 2 * I_P) { const int l = r / I_P; conv_plain(r % I_P, INP(22) + (size_t)l * RW * DM, RW, DM, WSP(bf16, WS_WPA) + (size_t)l * DM * RW, scr, F.lane); continue; } r -= 2 * I_P;
        if (r < 2 * I_P) { const int l = r / I_P; conv_plain(r % I_P, INP(23) + (size_t)l * RW * DM, RW, DM, WSP(bf16, WS_WPB) + (size_t)l * DM * RW, scr, F.lane); continue; } r -= 2 * I_P;
        if (r < 2 * I_O) { const int l = r / I_O; conv_plain(r % I_O, INP(24) + (size_t)l * DM * DM, DM, DM, WSP(bf16, WS_WO) + (size_t)l * DM * DM, scr, F.lane); continue; } r -= 2 * I_O;
        if (r < I_GU) { conv_gu(r, INP(25), WSP(bf16, WS_WGU), 0, scr, F.lane); continue; } r -= I_GU;
        if (r < I_GU) { conv_gu(r, INP(26), WSP(bf16, WS_WGU), 128, scr, F.lane); continue; } r -= I_GU;
        if (r < I_DN) { conv_plain(r, INP(27), FF, DM, WSP(bf16, WS_WDN), scr, F.lane); continue; } r -= I_DN;
        if (r < 4 * I_L) { const int ld = r / I_L; conv_plain(r % I_L, INP(11) + (size_t)ld * 64 * RW, 64, RW, lora + (size_t)ld * RW * 64, scr, F.lane); continue; } r -= 4 * I_L;
        if (r < 4 * I_L) { const int ld = r / I_L; conv_plain(r % I_L, INP(13) + (size_t)ld * 64 * RW, 64, RW, lora + (size_t)(4 + ld) * RW * 64, scr, F.lane); continue; } r -= 4 * I_L;
        { const int l = r / I_G2; conv_plain(r % I_G2, INP(14) + (size_t)l * 128 * RW, 128, RW, lora + (size_t)8 * RW * 64 + (size_t)l * RW * 128, scr, F.lane); }
    }
}
__device__ __forceinline__ void moe_conv(Frame& F) {
    LAS float* scr = (LAS float*)(F.lds + F.wave * 8448);
    const int gw = F.vcu * NWAVES + F.wave, NGW = F.G * NWAVES;
    constexpr int I_GU = 16 * 112, I_DN = 56 * 32, I_E = 2 * I_GU + I_DN;
    for (int it = gw; it < NE * I_E; it += NGW) {
        const int e = it / I_E; int r = it % I_E; bf16* base = WSP(bf16, WS_MW) + (size_t)e * (21 * MiB / 2);
        if (r < I_GU) { conv_gu(r, INP(29) + (size_t)e * DM * FF, base, 0, scr, F.lane); continue; } r -= I_GU;
        if (r < I_GU) { conv_gu(r, INP(30) + (size_t)e * DM * FF, base, 128, scr, F.lane); continue; } r -= I_GU;
        conv_plain(r, INP(31) + (size_t)e * FF * DM, FF, DM, base + (size_t)2 * FF * DM, scr, F.lane);
    }
}

template <bool ROUTER>
__device__ __forceinline__ void norm_mod_phase(Frame& F, int l, int which, const float* xlat, const float* xctx, int nrows, bf16* H) {
    const int gw = F.vcu * NWAVES + F.wave, NGW = F.G * NWAVES;
    const float* gain = INP(which ? 7 : 6) + l * DM;
    const float* modl = WSP(float, WS_MOD) + (size_t)l * 33 * 6144 + (which ? 3072 : 0);
    for (int m = gw; m < nrows; m += NGW) {
        const float* xr = m < NL ? xlat + (size_t)m * DM : xctx + (size_t)(m - NL) * DM;
        const float* mv = modl + (size_t)row_bi(m) * 6144;
        f32x4 v[4]; float s = 0.f;
#pragma unroll
        for (int j = 0; j < 4; ++j) { v[j] = *(const f32x4*)(xr + 4 * F.lane + 256 * j); s += (v[j].x * v[j].x + v[j].y * v[j].y) + (v[j].z * v[j].z + v[j].w * v[j].w); }
        const float rstd = 1.0f / sqrtf(wave_sum(s) * (1.0f / DM) + 1e-6f);
        float lg[8];
        if (ROUTER) {
#pragma unroll
            for (int e = 0; e < 8; ++e) lg[e] = 0.f; }
#pragma unroll
        for (int j = 0; j < 4; ++j) { const int c = 4 * F.lane + 256 * j;
            const f32x4 g = *(const f32x4*)(gain + c), sh = *(const f32x4*)(mv + c), sc = *(const f32x4*)(mv + 1024 + c);
            const f32x4 hv = v[j] * rstd * g * (sc + 1.0f) + sh;
            v2u o; o.x = pk2(hv.x, hv.y); o.y = pk2(hv.z, hv.w);
            *(v2u*)(H + (size_t)m * DM + c) = o;
            if (ROUTER) { const float* rw = INP(28) + (size_t)c * 8;
#pragma unroll
                for (int q = 0; q < 4; ++q) { const f32x4 r0 = *(const f32x4*)(rw + q * 8), r1 = *(const f32x4*)(rw + q * 8 + 4); const float hq = hv[q];
                    lg[0] = fmaf(hq, r0.x, lg[0]); lg[1] = fmaf(hq, r0.y, lg[1]); lg[2] = fmaf(hq, r0.z, lg[2]); lg[3] = fmaf(hq, r0.w, lg[3]);
                    lg[4] = fmaf(hq, r1.x, lg[4]); lg[5] = fmaf(hq, r1.y, lg[5]); lg[6] = fmaf(hq, r1.z, lg[6]); lg[7] = fmaf(hq, r1.w, lg[7]); } }
        }
        if (ROUTER) {
#pragma unroll
            for (int e = 0; e < 8; ++e) lg[e] = wave_sum(lg[e]);
            int e0 = 0; float l0 = lg[0];
#pragma unroll
            for (int e = 1; e < 8; ++e) if (lg[e] > l0) { l0 = lg[e]; e0 = e; }
            int e1 = -1; float l1 = -INFINITY;
#pragma unroll
            for (int e = 0; e < 8; ++e) if (e != e0 && lg[e] > l1) { l1 = lg[e]; e1 = e; }
            const float w1 = 1.0f / (1.0f + __expf(l0 - l1)), w0 = 1.0f - w1;
            if (F.lane == 0) {
                int* te = (int*)(F.ws + WS_MOETAB + MT_TOKE) + 2 * m; float* tw = (float*)(F.ws + WS_MOETAB + MT_TOKW) + 2 * m;
                te[0] = e0; te[1] = e1; tw[0] = w0; tw[1] = w1;
                __hip_atomic_fetch_add((LAS unsigned*)&F.MISC[16 + e0], 1u, __ATOMIC_RELAXED, __HIP_MEMORY_SCOPE_WORKGROUP); __hip_atomic_fetch_add((LAS unsigned*)&F.MISC[16 + e1], 1u, __ATOMIC_RELAXED, __HIP_MEMORY_SCOPE_WORKGROUP);
            }
        }
    }
    if (ROUTER) { __syncthreads(); if (F.tid < 8) { const unsigned c = F.MISC[16 + F.tid]; if (c) __hip_atomic_fetch_add(F.ctl + CW_HIST + 64 * F.tid, c, RLX_AGENT); } __syncthreads(); }
}

using pg8::Unit;
struct EpiIn {
    static constexpr bool PERM = true, AFTER_DRAIN = false;
    bf16 *PR, *Q, *KB, *VB, *G;
    __device__ __forceinline__ void operator()(const f32x4 (&acc)[2][2][4][2], const Unit& u, int wr, int wc, int fr, int fq) const {
        const int row0 = u.pm * 256 + wr * 64 + fr, cb = wc * 32 + 8 * fq, pn = u.pn;
#pragma unroll
        for (int ai = 0; ai < 2; ++ai)
#pragma unroll
            for (int m = 0; m < 4; ++m) { const int r = row0 + ai * 128 + m * 16;
#pragma unroll
                for (int bj = 0; bj < 2; ++bj) { f32x4 v0 = acc[ai][bj][m][0], v1 = acc[ai][bj][m][1]; bf16* dst;
                    if (pn < 7) dst = PR + (size_t)r * RCOLS + pn * 256 + bj * 128 + cb;
                    else if (pn < 9) dst = Q + (size_t)r * 512 + (pn - 7) * 256 + bj * 128 + cb;
                    else if (pn == 9) dst = (bj == 0 ? KB : VB) + (size_t)row_kv(r) * 128 + cb;
                    else { dst = G + (size_t)r * GCOLS + (pn - 10) * 256 + bj * 128 + cb;
#pragma unroll
                        for (int q = 0; q < 4; ++q) { v0[q] = sigmoidf_(v0[q]); v1[q] = sigmoidf_(v1[q]); } }
                    v4u w; w.x = pk2(v0[0], v0[1]); w.y = pk2(v0[2], v0[3]); w.z = pk2(v1[0], v1[1]); w.w = pk2(v1[2], v1[3]);
                    *(v4u*)dst = w; } }
    }
};
template <int MODE> struct EpiMerge {
    static constexpr bool PERM = true, AFTER_DRAIN = false;
    const bf16* G; bf16* MG;
    __device__ __forceinline__ void operator()(const f32x4 (&acc)[2][2][4][2], const Unit& u, int wr, int wc, int fr, int fq) const {
        const int row0 = u.pm * 256 + wr * 64 + fr, col0 = u.pn * 256 + wc * 32 + 8 * fq;
#pragma unroll
        for (int ai = 0; ai < 2; ++ai)
#pragma unroll
            for (int m = 0; m < 4; ++m) { const int r = row0 + ai * 128 + m * 16;
#pragma unroll
                for (int bj = 0; bj < 2; ++bj) { const int c = col0 + bj * 128;
                    const v4u g = *(const v4u*)(G + (size_t)r * GCOLS + MODE * DM + c);
                    const f32x4 a0 = acc[ai][bj][m][0], a1 = acc[ai][bj][m][1];
                    float o[8] = { bflo(g.x) * a0[0], bfhi(g.x) * a0[1], bflo(g.y) * a0[2], bfhi(g.y) * a0[3], bflo(g.z) * a1[0], bfhi(g.z) * a1[1], bflo(g.w) * a1[2], bfhi(g.w) * a1[3] };
                    bf16* dst = MG + (size_t)r * DM + c;
                    if (MODE == 1) { const v4u p = *(const v4u*)dst; o[0] += bflo(p.x); o[1] += bfhi(p.x); o[2] += bflo(p.y); o[3] += bfhi(p.y); o[4] += bflo(p.z); o[5] += bfhi(p.z); o[6] += bflo(p.w); o[7] += bfhi(p.w); }
                    v4u w; w.x = pk2(o[0], o[1]); w.y = pk2(o[2], o[3]); w.z = pk2(o[4], o[5]); w.w = pk2(o[6], o[7]);
                    *(v4u*)dst = w; } }
    }
};
struct EpiRes {
    static constexpr bool PERM = false, AFTER_DRAIN = false;
    const float *base_lat, *base_ctx; float *out_lat, *out_ctx; const float* gt;
    __device__ __forceinline__ void operator()(const f32x4 (&acc)[2][2][4][2], const Unit& u, int wr, int wc, int fr, int fq) const {
        const bool lat = u.pm < NL / 256; const int bi = lat ? (u.pm >> 3) : 32;
        const int rr0 = (lat ? u.pm * 256 : u.pm * 256 - NL) + wr * 64 + fr, col0 = u.pn * 256 + wc * 32 + 4 * fq;
        const float* bp = lat ? base_lat : base_ctx; float* op = lat ? out_lat : out_ctx; const float* gv = gt + (size_t)bi * 6144 + col0;
        f32x4 g[2][2];
#pragma unroll
        for (int bj = 0; bj < 2; ++bj)
#pragma unroll
            for (int n = 0; n < 2; ++n) g[bj][n] = *(const f32x4*)(gv + bj * 128 + n * 16);
#pragma unroll
        for (int ai = 0; ai < 2; ++ai)
#pragma unroll
            for (int m = 0; m < 4; ++m) { const size_t off = (size_t)(rr0 + ai * 128 + m * 16) * DM + col0;
#pragma unroll
                for (int bj = 0; bj < 2; ++bj)
#pragma unroll
                    for (int n = 0; n < 2; ++n) { const f32x4 b = *(const f32x4*)(bp + off + bj * 128 + n * 16); *(f32x4*)(op + off + bj * 128 + n * 16) = b + g[bj][n] * acc[ai][bj][m][n]; }
                asm volatile("" ::: "memory"); }
    }
};
struct EpiGU {
    static constexpr bool PERM = true, AFTER_DRAIN = false;
    bf16* ACT; int pm0;
    __device__ __forceinline__ void operator()(const f32x4 (&acc)[2][2][4][2], const Unit& u, int wr, int wc, int fr, int fq) const {
        const int row0 = (u.pm - pm0) * 256 + wr * 64 + fr, col0 = u.pn * 128 + wc * 32 + 8 * fq;
#pragma unroll
        for (int ai = 0; ai < 2; ++ai)
#pragma unroll
            for (int m = 0; m < 4; ++m) { const int r = row0 + ai * 128 + m * 16; float o[8];
#pragma unroll
                for (int n = 0; n < 2; ++n)
#pragma unroll
                    for (int q = 0; q < 4; ++q) { const float gte = acc[ai][0][m][n][q], up = acc[ai][1][m][n][q]; o[4 * n + q] = gte * sigmoidf_(gte) * up; }
                v4u w; w.x = pk2(o[0], o[1]); w.y = pk2(o[2], o[3]); w.z = pk2(o[4], o[5]); w.w = pk2(o[6], o[7]);
                *(v4u*)(ACT + (size_t)r * FF + col0) = w; }
    }
};
struct EpiStore {
    static constexpr bool PERM = true, AFTER_DRAIN = false;
    bf16* O;
    __device__ __forceinline__ void operator()(const f32x4 (&acc)[2][2][4][2], const Unit& u, int wr, int wc, int fr, int fq) const {
        const int row0 = u.pm * 256 + wr * 64 + fr, col0 = u.pn * 256 + wc * 32 + 8 * fq;
#pragma unroll
        for (int ai = 0; ai < 2; ++ai)
#pragma unroll
            for (int m = 0; m < 4; ++m) { const int r = row0 + ai * 128 + m * 16;
#pragma unroll
                for (int bj = 0; bj < 2; ++bj) { const f32x4 v0 = acc[ai][bj][m][0], v1 = acc[ai][bj][m][1];
                    v4u w; w.x = pk2(v0[0], v0[1]); w.y = pk2(v0[2], v0[3]); w.z = pk2(v1[0], v1[1]); w.w = pk2(v1[2], v1[3]);
                    *(v4u*)(O + (size_t)r * DM + col0 + bj * 128) = w; } }
    }
};
struct MoeOrder {
    const char* A; const char* W; size_t a_tstep, b_tstep, w_estep; int tile0, a_tile0, ntl, nN, G, c; const LAS int* tile_e;
    __device__ bool next(int i, Unit& u) const { const long L = (long)i * G + c; if (L >= (long)ntl * nN) return false; u.pn = (int)(L / ntl); u.pm = tile0 + (int)(L % ntl); return true; }
    __device__ __forceinline__ const char* a_base(const Unit& u) const { return A + (size_t)(u.pm - a_tile0) * a_tstep; }
    __device__ __forceinline__ const char* b_base(const Unit& u) const { return W + (size_t)tile_e[u.pm] * w_estep + (size_t)u.pn * b_tstep; }
    __device__ __forceinline__ void a_ready(const Unit&) const {}
    __device__ __forceinline__ void done(const Unit&) const {}
};

__device__ __forceinline__ void qk_phase(Frame& F, int l) {
    const int gw = F.vcu * NWAVES + F.wave, NGW = F.G * NWAVES, lane = F.lane, d0 = 8 * (lane & 7);
    const float* rt = WSP(float, WS_ROPE);
    bf16* Q = WSP(bf16, WS_Q); bf16* KB = WSP(bf16, WS_KB);
    float gq[8], gk[8];
#pragma unroll
    for (int e = 0; e < 8; ++e) { gq[e] = INP(20)[l * 64 + d0 + e]; gk[e] = INP(21)[l * 64 + d0 + e]; }
    for (int m = gw; m < MA; m += NGW) {
        const bool lat = m < NL; const int t = m & 2047, pr = t >> 6, pc = t & 63;
        float cs[4], sn[4];
        if (lat) {
#pragma unroll
            for (int pi = 0; pi < 4; ++pi) { const int i = 4 * (lane & 7) + pi, pos = i < 16 ? pr : pc, f = i & 15; cs[pi] = rt[pos * 16 + f]; sn[pi] = rt[1024 + pos * 16 + f]; } }
        { bf16* p = Q + (size_t)m * 512 + 8 * lane; const v4u w = *(const v4u*)p;
          float x[8] = { bflo(w.x), bfhi(w.x), bflo(w.y), bfhi(w.y), bflo(w.z), bfhi(w.z), bflo(w.w), bfhi(w.w) };
          float ss = 0.f;
#pragma unroll
          for (int e = 0; e < 8; ++e) ss += x[e] * x[e];
          ss += __shfl_xor(ss, 1); ss += __shfl_xor(ss, 2); ss += __shfl_xor(ss, 4);
          const float r = 1.0f / sqrtf(ss * (1.0f / 64.0f) + 1e-6f);
#pragma unroll
          for (int e = 0; e < 8; ++e) x[e] = x[e] * r * gq[e];
          if (lat) {
#pragma unroll
              for (int pi = 0; pi < 4; ++pi) { const float x0 = x[2 * pi], x1 = x[2 * pi + 1]; x[2 * pi] = x0 * cs[pi] - x1 * sn[pi]; x[2 * pi + 1] = x0 * sn[pi] + x1 * cs[pi]; } }
          const float C2 = attn_body::C2;
          v4u o; o.x = pk2(x[0] * C2, x[1] * C2); o.y = pk2(x[2] * C2, x[3] * C2); o.z = pk2(x[4] * C2, x[5] * C2); o.w = pk2(x[6] * C2, x[7] * C2);
          *(v4u*)p = o; }
        { bf16* p = KB + (size_t)row_kv(m) * 128 + 8 * (lane & 15); v4u w = (v4u){0u, 0u, 0u, 0u}; if (lane < 16) w = *(const v4u*)p;
          float x[8] = { bflo(w.x), bfhi(w.x), bflo(w.y), bfhi(w.y), bflo(w.z), bfhi(w.z), bflo(w.w), bfhi(w.w) };
          float ss = 0.f;
#pragma unroll
          for (int e = 0; e < 8; ++e) ss += x[e] * x[e];
          ss += __shfl_xor(ss, 1); ss += __shfl_xor(ss, 2); ss += __shfl_xor(ss, 4);
          const float r = 1.0f / sqrtf(ss * (1.0f / 64.0f) + 1e-6f);
#pragma unroll
          for (int e = 0; e < 8; ++e) x[e] = x[e] * r * gk[e];
          if (lat) {
#pragma unroll
              for (int pi = 0; pi < 4; ++pi) { const float x0 = x[2 * pi], x1 = x[2 * pi + 1]; x[2 * pi] = x0 * cs[pi] - x1 * sn[pi]; x[2 * pi + 1] = x0 * sn[pi] + x1 * cs[pi]; } }
          v4u o; o.x = pk2(x[0], x[1]); o.y = pk2(x[2], x[3]); o.z = pk2(x[4], x[5]); o.w = pk2(x[6], x[7]);
          if (lane < 16) *(v4u*)p = o; }
    }
}

constexpr int SC_RAW = 0, SC_SV = 11520, SC_KT = SC_SV + 24576, SC_KK = SC_KT + 4096, SC_TWA = SC_KK + 4096, SC_ADA = SC_TWA + 2304, SC_YO = SC_ADA + 2304, SC_BON = SC_YO + 4096, SC_DIR = SC_BON + 256;
static_assert(2 * SC_DIR <= RING_BYTES, "scan LDS");
__device__ __forceinline__ float dpp_quad_sum(float v) {
    v += __builtin_bit_cast(float, __builtin_amdgcn_mov_dpp(__builtin_bit_cast(int, v), 0xB1, 0xF, 0xF, true));
    v += __builtin_bit_cast(float, __builtin_amdgcn_mov_dpp(__builtin_bit_cast(int, v), 0x4E, 0xF, 0xF, true));
    return v;
}
__device__ __forceinline__ void scan_phase(Frame& F, int l) {
    const int d = F.tid >> 8, dt = F.tid & 255, w4 = F.wave & 3, lane = F.lane;
    LAS unsigned char* L = F.lds + d * SC_DIR;
    LAS float* SV = (LAS float*)(L + SC_SV); LAS float* KT = (LAS float*)(L + SC_KT); LAS float* KK = (LAS float*)(L + SC_KK);
    LAS float* YO = (LAS float*)(L + SC_YO); LAS float* BON = (LAS float*)(L + SC_BON);
    const bf16* PR = WSP(bf16, WS_PR);
    bf16* Yd = WSP(bf16, d == 0 ? WS_YF : WS_YB);
    float* bonus = WSP(float, WS_BONUS) + (size_t)d * MA * 8;
    const int j = dt >> 4, cg = dt & 15;
    const int st_j = d == 0 ? j : 15 - j;
    for (int p = F.vcu; p < NB * 8; p += F.G) {
        const int b = p >> 3, h = p & 7;
        const bf16* w2t = WSP(bf16, WS_LORA) + (size_t)((l * 2 + d) * RW + h * 64 + 16 * w4 + (lane & 15)) * 64 + 8 * (lane >> 4);
        const bf16* a2t = w2t + (size_t)4 * RW * 64;
        const int ccol = h * 64 + 16 * w4 + (lane & 15);
        const float w0c = INP(10)[(l * 2 + d) * RW + ccol], a0c = INP(12)[(l * 2 + d) * RW + ccol], kac = INP(16)[l * RW + ccol], rkc = INP(17)[l * RW + ccol];
        const float* mup = INP(9) + (size_t)(l * 2) * RCOLS + 4 * cg; const float* kkp = INP(15) + l * RW + h * 64 + 4 * cg;
        float S[16];
#pragma unroll
        for (int i = 0; i < 16; ++i) S[i] = 0.f;
        v4u raw[3];
#define SC_GEOM(c) const int s0_ = 16 * (c); const bool isctx_ = s0_ < TC; const int pos0_ = isctx_ ? s0_ : s0_ - TC; const int len_ = isctx_ ? TC : TL; \
        const int rowbase_ = isctx_ ? NL + b * TC : b * TL; const int toklo_ = d == 0 ? pos0_ : len_ - 16 - pos0_;
#define SC_LOAD(c) do { SC_GEOM(c) _Pragma("unroll") for (int i = 0; i < 3; ++i) { const int pp = dt + 256 * i; raw[i] = (v4u){0u, 0u, 0u, 0u}; \
            if (pp < 720) { const int row = pp / 40, rem = pp % 40, grp = rem >> 3, c8 = rem & 7; const int tr = toklo_ - 1 + row; \
                const int gc = grp == 0 ? h * 64 : grp == 1 ? 512 + h * 64 : grp == 2 ? 1024 + h * 64 : grp == 3 ? 1536 : 1600; \
                if (tr >= 0 && tr < len_) raw[i] = *(const v4u*)(PR + (size_t)(rowbase_ + tr) * RCOLS + gc + 8 * c8); } } } while (0)
        SC_LOAD(0);
        for (int c = 0; c < KVT / 16; ++c) {
            SC_GEOM(c)
#pragma unroll
            for (int i = 0; i < 3; ++i) { const int pp = dt + 256 * i; if (pp < 720) { const int row = pp / 40, rem = pp % 40; *(LAS v4u*)(L + SC_RAW + (row * 320 + rem * 8) * 2) = raw[i]; } }
            __syncthreads();
            if (c + 1 < KVT / 16) SC_LOAD(c + 1);
            {
                f32x4 xs[5];
#pragma unroll
                for (int g = 0; g < 5; ++g) {
                    const v2u a0 = *(const LAS v2u*)(L + SC_RAW + ((j + 0) * 320 + g * 64 + 4 * cg) * 2), a1 = *(const LAS v2u*)(L + SC_RAW + ((j + 1) * 320 + g * 64 + 4 * cg) * 2), a2 = *(const LAS v2u*)(L + SC_RAW + ((j + 2) * 320 + g * 64 + 4 * cg) * 2);
                    const f32x4 x0 = (f32x4){bflo(a0.x), bfhi(a0.x), bflo(a0.y), bfhi(a0.y)}, x1 = (f32x4){bflo(a1.x), bfhi(a1.x), bflo(a1.y), bfhi(a1.y)}, x2 = (f32x4){bflo(a2.x), bfhi(a2.x), bflo(a2.y), bfhi(a2.y)};
                    const int gc = g == 0 ? h * 64 : g == 1 ? 512 + h * 64 : g == 2 ? 1024 + h * 64 : g == 3 ? 1536 : 1600;
                    const f32x4 mu0 = *(const f32x4*)(mup + gc), mu1 = *(const f32x4*)(mup + RCOLS + gc);
                    xs[g] = x1 + mu0 * (x0 - x1) + mu1 * (x2 - x1);
                }
                *(LAS f32x4*)(SV + (0 * 16 + st_j) * 64 + 4 * cg) = xs[0];
                *(LAS f32x4*)(SV + (3 * 16 + st_j) * 64 + 4 * cg) = xs[2];
                *(LAS f32x4*)(KT + j * 64 + 4 * cg) = xs[1];
                const f32x4 kkf = xs[1] * *(const f32x4*)kkp; float ss = (kkf.x * kkf.x + kkf.y * kkf.y) + (kkf.z * kkf.z + kkf.w * kkf.w);
                ss += __shfl_xor(ss, 1); ss += __shfl_xor(ss, 2); ss += __shfl_xor(ss, 4); ss += __shfl_xor(ss, 8);
                const float inv = 1.0f / fmaxf(sqrtf(ss), 1e-12f); const f32x4 kk = kkf * inv;
                *(LAS f32x4*)(KK + j * 64 + 4 * cg) = kk;
                *(LAS f32x4*)(SV + (4 * 16 + st_j) * 64 + 4 * cg) = -kk;
                v2u tw; tw.x = pk2(tanhf(xs[3].x), tanhf(xs[3].y)); tw.y = pk2(tanhf(xs[3].z), tanhf(xs[3].w));
                *(LAS v2u*)(L + SC_TWA + (j * 72 + 4 * cg) * 2) = tw;
                v2u ad; ad.x = pk2(xs[4].x, xs[4].y); ad.y = pk2(xs[4].z, xs[4].w);
                *(LAS v2u*)(L + SC_ADA + (j * 72 + 4 * cg) * 2) = ad;
            }
            __syncthreads();
            {
                const int ao = ((lane & 15) * 72 + 8 * (lane >> 4)) * 2;
                const bf16x8 At0 = *(const LAS bf16x8*)(L + SC_TWA + ao), At1 = *(const LAS bf16x8*)(L + SC_TWA + ao + 64), Aa0 = *(const LAS bf16x8*)(L + SC_ADA + ao), Aa1 = *(const LAS bf16x8*)(L + SC_ADA + ao + 64);
                const bf16x8 Bw0 = *(const bf16x8*)w2t, Bw1 = *(const bf16x8*)(w2t + 32), Ba0 = *(const bf16x8*)a2t, Ba1 = *(const bf16x8*)(a2t + 32);
                f32x4 zw = (f32x4){0.f, 0.f, 0.f, 0.f}, za = (f32x4){0.f, 0.f, 0.f, 0.f};
                zw = __builtin_amdgcn_mfma_f32_16x16x32_bf16(At0, Bw0, zw, 0, 0, 0); zw = __builtin_amdgcn_mfma_f32_16x16x32_bf16(At1, Bw1, zw, 0, 0, 0);
                za = __builtin_amdgcn_mfma_f32_16x16x32_bf16(Aa0, Ba0, za, 0, 0, 0); za = __builtin_amdgcn_mfma_f32_16x16x32_bf16(Aa1, Ba1, za, 0, 0, 0);
                const int cl = 16 * w4 + (lane & 15);
#pragma unroll
                for (int i = 0; i < 4; ++i) { const int jj = 4 * (lane >> 4) + i, st = d == 0 ? jj : 15 - jj;
                    const float sg = sigmoidf_(w0c + zw[i]); SV[(1 * 16 + st) * 64 + cl] = __expf(-0.6065306597f * sg);
                    const float al = sigmoidf_(a0c + za[i]);
                    const float kv = KT[jj * 64 + cl] * (1.0f + (al - 1.0f) * kac); SV[(2 * 16 + st) * 64 + cl] = kv;
                    SV[(5 * 16 + st) * 64 + cl] = KK[jj * 64 + cl] * al;
                    float bp = SV[(0 * 16 + st) * 64 + cl] * kv * rkc;
                    bp += __shfl_xor(bp, 1); bp += __shfl_xor(bp, 2); bp += __shfl_xor(bp, 4); bp += __shfl_xor(bp, 8);
                    if ((lane & 15) == 0) BON[w4 * 16 + jj] = bp; }
            }
            __syncthreads();
            {
                const int ri = 16 * w4 + (lane >> 2), q = lane & 3;
#pragma unroll 1
                for (int s = 0; s < 16; ++s) {
                    const LAS float* base = SV + s * 64 + 16 * q;
                    f32x4 na[4], wv[4], bv[4], kv[4], rv[4];
#pragma unroll
                    for (int i = 0; i < 4; ++i) { na[i] = *(const LAS f32x4*)(base + 4 * 16 * 64 + 4 * i); wv[i] = *(const LAS f32x4*)(base + 1 * 16 * 64 + 4 * i); bv[i] = *(const LAS f32x4*)(base + 5 * 16 * 64 + 4 * i);
                        kv[i] = *(const LAS f32x4*)(base + 2 * 16 * 64 + 4 * i); rv[i] = *(const LAS f32x4*)(base + 4 * i); }
                    const float vi = SV[(3 * 16 + s) * 64 + ri];
                    float d0 = 0.f, d1 = 0.f, d2 = 0.f, d3 = 0.f;
#pragma unroll
                    for (int i = 0; i < 4; ++i) { d0 = fmaf(S[4 * i], na[i].x, d0); d1 = fmaf(S[4 * i + 1], na[i].y, d1); d2 = fmaf(S[4 * i + 2], na[i].z, d2); d3 = fmaf(S[4 * i + 3], na[i].w, d3); }
                    const float sa = dpp_quad_sum((d0 + d1) + (d2 + d3));
                    float y0 = 0.f, y1 = 0.f, y2 = 0.f, y3 = 0.f;
#pragma unroll
                    for (int i = 0; i < 4; ++i) {
                        S[4 * i] = fmaf(vi, kv[i].x, fmaf(sa, bv[i].x, S[4 * i] * wv[i].x)); S[4 * i + 1] = fmaf(vi, kv[i].y, fmaf(sa, bv[i].y, S[4 * i + 1] * wv[i].y));
                        S[4 * i + 2] = fmaf(vi, kv[i].z, fmaf(sa, bv[i].z, S[4 * i + 2] * wv[i].z)); S[4 * i + 3] = fmaf(vi, kv[i].w, fmaf(sa, bv[i].w, S[4 * i + 3] * wv[i].w));
                        y0 = fmaf(S[4 * i], rv[i].x, y0); y1 = fmaf(S[4 * i + 1], rv[i].y, y1); y2 = fmaf(S[4 * i + 2], rv[i].z, y2); y3 = fmaf(S[4 * i + 3], rv[i].w, y3); }
                    const float y = dpp_quad_sum((y0 + y1) + (y2 + y3));
                    if (q == 0) YO[s * 64 + ri] = y;
                }
            }
            __syncthreads();
            if (dt < 128) { const int s = dt >> 3, c8 = dt & 7; const int tok = d == 0 ? pos0_ + s : len_ - 1 - (pos0_ + s);
                const f32x4 a = *(const LAS f32x4*)(YO + s * 64 + 8 * c8), bq = *(const LAS f32x4*)(YO + s * 64 + 8 * c8 + 4);
                v4u w; w.x = pk2(a.x, a.y); w.y = pk2(a.z, a.w); w.z = pk2(bq.x, bq.y); w.w = pk2(bq.z, bq.w);
                *(v4u*)(Yd + (size_t)(rowbase_ + tok) * RW + h * 64 + 8 * c8) = w; }
            else if (dt < 144) { const int jj = dt - 128; bonus[(size_t)(rowbase_ + toklo_ + jj) * 8 + h] = (BON[jj] + BON[16 + jj]) + (BON[32 + jj] + BON[48 + jj]); }
        }
        __syncthreads();
#undef SC_LOAD
#undef SC_GEOM
    }
}

__device__ __forceinline__ void rwkv_out_phase(Frame& F, int l, int nrows) {
    const int gw = F.vcu * NWAVES + F.wave, NGW = F.G * NWAVES, lane = F.lane, jr = lane & 15, fq = lane >> 4;
    const bf16* PR = WSP(bf16, WS_PR); const bf16* YF = WSP(bf16, WS_YF); const bf16* YB = WSP(bf16, WS_YB); bf16* YR = WSP(bf16, WS_YR);
    const float* bon0 = WSP(float, WS_BONUS); const float* bon1 = bon0 + (size_t)MA * 8;
    const bf16* g2t = WSP(bf16, WS_LORA) + (size_t)8 * RW * 64 + (size_t)l * RW * 128;
    const float* m0 = INP(9) + (size_t)(l * 2) * RCOLS; const float* m1 = m0 + RCOLS;
    const float* lw = INP(18) + l * RW; const float* lb = INP(19) + l * RW;
    for (int unit = gw; unit < nrows / 16; unit += NGW) {
        const int m = unit * 16 + jr;
        const int pos = m < NL ? (m & 2047) : ((m - NL) & 255), len = m < NL ? TL : TC;
        const bool hp = pos > 0, hn = pos < len - 1;
        const bf16* pr = PR + (size_t)m * RCOLS;
        bf16x8 Af[4];
#pragma unroll
        for (int ks = 0; ks < 4; ++ks) { const int col = 1664 + 8 * fq + 32 * ks;
            const v4u z = (v4u){0u, 0u, 0u, 0u}; const v4u w1 = *(const v4u*)(pr + col); const v4u w0 = hp ? *(const v4u*)(pr - RCOLS + col) : z; const v4u w2 = hn ? *(const v4u*)(pr + RCOLS + col) : z;
            const unsigned u0[4] = {w0.x, w0.y, w0.z, w0.w}, u1[4] = {w1.x, w1.y, w1.z, w1.w}, u2[4] = {w2.x, w2.y, w2.z, w2.w}; unsigned o[4];
#pragma unroll
            for (int e = 0; e < 4; ++e) { const f32x2 a = *(const f32x2*)(m0 + col + 2 * e), bq = *(const f32x2*)(m1 + col + 2 * e);
                const float xl = bflo(u1[e]), xh = bfhi(u1[e]);
                const float vl = xl + a.x * (bflo(u0[e]) - xl) + bq.x * (bflo(u2[e]) - xl), vh = xh + a.y * (bfhi(u0[e]) - xh) + bq.y * (bfhi(u2[e]) - xh);
                o[e] = pk2(sigmoidf_(vl), sigmoidf_(vh)); }
            Af[ks] = __builtin_bit_cast(bf16x8, (v4u){o[0], o[1], o[2], o[3]}); }
        for (int hh = 0; hh < 8; ++hh) {
            const float bon = 0.5f * (bon0[(size_t)m * 8 + hh] + bon1[(size_t)m * 8 + hh]);
            f32x4 y[4], g[4];
#pragma unroll
            for (int nt = 0; nt < 4; ++nt) { const int c0 = hh * 64 + 16 * nt;
                f32x4 acc = (f32x4){0.f, 0.f, 0.f, 0.f};
#pragma unroll
                for (int ks = 0; ks < 4; ++ks) { const bf16x8 Bf = *(const bf16x8*)(g2t + (size_t)(c0 + jr) * 128 + 8 * fq + 32 * ks); acc = __builtin_amdgcn_mfma_f32_16x16x32_bf16(Bf, Af[ks], acc, 0, 0, 0); }
                g[nt] = acc;
                const int col = c0 + 4 * fq; const v2u a = *(const v2u*)(YF + (size_t)m * RW + col), bq = *(const v2u*)(YB + (size_t)m * RW + col);
                y[nt] = (f32x4){bflo(a.x) + bflo(bq.x), bfhi(a.x) + bfhi(bq.x), bflo(a.y) + bflo(bq.y), bfhi(a.y) + bfhi(bq.y)}; }
            float s = 0.f;
#pragma unroll
            for (int nt = 0; nt < 4; ++nt) s += (y[nt].x + y[nt].y) + (y[nt].z + y[nt].w);
            s += __shfl_xor(s, 16); s += __shfl_xor(s, 32);
            const float mean = s * (1.0f / 64.0f); float qv = 0.f;
#pragma unroll
            for (int nt = 0; nt < 4; ++nt) { y[nt] = y[nt] - mean; qv += (y[nt].x * y[nt].x + y[nt].y * y[nt].y) + (y[nt].z * y[nt].z + y[nt].w * y[nt].w); }
            qv += __shfl_xor(qv, 16); qv += __shfl_xor(qv, 32);
            const float rstd = 1.0f / sqrtf(qv * (1.0f / 64.0f) + 64e-5f);
#pragma unroll
            for (int nt = 0; nt < 4; ++nt) { const int col = hh * 64 + 16 * nt + 4 * fq, vc = 1024 + col;
                const v2u z = (v2u){0u, 0u}; const v2u w1 = *(const v2u*)(pr + vc); const v2u w0 = hp ? *(const v2u*)(pr - RCOLS + vc) : z; const v2u w2 = hn ? *(const v2u*)(pr + RCOLS + vc) : z;
                const f32x4 x0 = (f32x4){bflo(w0.x), bfhi(w0.x), bflo(w0.y), bfhi(w0.y)}, x1 = (f32x4){bflo(w1.x), bfhi(w1.x), bflo(w1.y), bfhi(w1.y)}, x2 = (f32x4){bflo(w2.x), bfhi(w2.x), bflo(w2.y), bfhi(w2.y)};
                const f32x4 vs = x1 + *(const f32x4*)(m0 + vc) * (x0 - x1) + *(const f32x4*)(m1 + vc) * (x2 - x1);
                const f32x4 o = (y[nt] * rstd * *(const f32x4*)(lw + col) + *(const f32x4*)(lb + col) + vs * bon) * g[nt];
                v2u w; w.x = pk2(o.x, o.y); w.y = pk2(o.z, o.w);
                *(v2u*)(YR + (size_t)m * RW + col) = w; }
        }
    }
}

__device__ __forceinline__ void attn_phase(Frame& F, int l, char* lds_generic) {
    typedef attn_body::bf16 abf;
    abf* Q = (abf*)(F.ws + WS_Q); const abf* KB = (const abf*)(F.ws + WS_KB); const abf* VB = (const abf*)(F.ws + WS_VB);
    for (int p = F.vcu; p < NB * 8; p += F.G) {
        const int b = p >> 3, hq = p & 7, kvh = hq >> 2;
        const abf* Kh = KB + (size_t)b * KVT * 128 + kvh * 64; const abf* Vh = VB + (size_t)b * KVT * 128 + kvh * 64;
        const int nu = l == 0 ? 9 : 8;
        for (int u = 0; u < nu; ++u) {
            const bool cx = u == 8;
            abf* Qu = Q + (size_t)(cx ? NL + b * TC : b * TL + u * 256) * 512 + hq * 64;
            attn_body::attn_unit<8>(Qu, cx ? Kh + (size_t)TL * 128 : Kh, cx ? Vh + (size_t)TL * 128 : Vh, Qu, cx ? TC / 64 : KVT / 64, lds_generic);
        }
    }
}

__device__ __forceinline__ int moe_tiles(Frame& F, LAS int* tile_e) {
    int nt = 0;
    for (int e = 0; e < NE; ++e) { const int cnt = (int)__hip_atomic_load(F.ctl + CW_HIST + 64 * e, RLX_AGENT); const int t = (cnt + 255) >> 8;
        for (int i = F.tid; i < t; i += 512) tile_e[nt + i] = e; nt += t; }
    __syncthreads();
    return nt;
}
__device__ __forceinline__ void moe_slots(Frame& F) {
    volatile LAS unsigned* M = F.MISC;
    const int* toke = (const int*)(F.ws + WS_MOETAB + MT_TOKE); int* toks = (int*)(F.ws + WS_MOETAB + MT_TOKS);
    const bf16* H2 = WSP(bf16, WS_H); bf16* XB = WSP(bf16, WS_XB);
    LAS int* slotl = (LAS int*)F.lds;
    for (int tb = F.vcu; tb < NL / 256; tb += F.G) {
        if (F.tid < 8) M[32 + F.tid] = 0u;
        if (F.tid == 0) { unsigned ps = 0; for (int e = 0; e < NE; ++e) { M[48 + e] = ps; const unsigned cnt = __hip_atomic_load(F.ctl + CW_HIST + 64 * e, RLX_AGENT); ps += ((cnt + 255u) >> 8) << 8; } }
        __syncthreads();
        int e_my = 0, rank = 0;
        { const int a = F.tid; e_my = toke[(size_t)tb * 512 + a]; rank = (int)__hip_atomic_fetch_add((LAS unsigned*)&M[32 + e_my], 1u, __ATOMIC_RELAXED, __HIP_MEMORY_SCOPE_WORKGROUP); }
        __syncthreads();
        if (F.tid < 8) M[40 + F.tid] = __hip_atomic_fetch_add(F.ctl + CW_CURS + 64 * F.tid, M[32 + F.tid], RLX_AGENT);
        __syncthreads();
        const int slot = (int)(M[48 + e_my] + M[40 + e_my]) + rank;
        toks[(size_t)tb * 512 + F.tid] = slot; slotl[F.tid] = slot;
        __syncthreads();
        for (int a = F.wave; a < 512; a += NWAVES) { const int tok = tb * 256 + (a >> 1); const int sl = slotl[a];
            const v4u* src = (const v4u*)(H2 + (size_t)tok * DM); v4u* dst = (v4u*)(XB + (size_t)sl * DM);
            const v4u x0 = src[F.lane], x1 = src[64 + F.lane]; dst[F.lane] = x0; dst[64 + F.lane] = x1; }
        __syncthreads();
    }
}
__device__ __forceinline__ void moe_final(Frame& F) {
    const int gw = F.vcu * NWAVES + F.wave, NGW = F.G * NWAVES;
    const int* toks = (const int*)(F.ws + WS_MOETAB + MT_TOKS); const float* tokw = (const float*)(F.ws + WS_MOETAB + MT_TOKW);
    const bf16* YM = WSP(bf16, WS_YM); const float* gt = WSP(float, WS_MOD) + (size_t)33 * 6144 + 5120;
    for (int m = gw; m < NL; m += NGW) {
        const int s0 = toks[2 * m], s1 = toks[2 * m + 1]; const float w0 = tokw[2 * m], w1 = tokw[2 * m + 1];
        const float* gv = gt + (size_t)(m >> 11) * 6144; float* xr = F.out + (size_t)m * DM;
        f32x4 v[4]; float s = 0.f;
#pragma unroll
        for (int j = 0; j < 4; ++j) { const int c = 4 * F.lane + 256 * j;
            const v2u a = *(const v2u*)(YM + (size_t)s0 * DM + c), bq = *(const v2u*)(YM + (size_t)s1 * DM + c);
            const f32x4 ya = (f32x4){bflo(a.x), bfhi(a.x), bflo(a.y), bfhi(a.y)}, yb = (f32x4){bflo(bq.x), bfhi(bq.x), bflo(bq.y), bfhi(bq.y)};
            v[j] = *(const f32x4*)(xr + c) + *(const f32x4*)(gv + c) * (ya * w0 + yb * w1);
            s += (v[j].x * v[j].x + v[j].y * v[j].y) + (v[j].z * v[j].z + v[j].w * v[j].w); }
        const float rstd = 1.0f / sqrtf(wave_sum(s) * (1.0f / DM) + 1e-6f);
#pragma unroll
        for (int j = 0; j < 4; ++j) { const int c = 4 * F.lane + 256 * j; *(f32x4*)(xr + c) = v[j] * rstd * *(const f32x4*)(INP(32) + c); }
    }
}
__global__ void __launch_bounds__(NWAVES * 64, 2) fwd_kernel(Args args) {
    extern __shared__ __attribute__((aligned(16))) unsigned char lds[];
    Frame F;
    F.lds = (LAS unsigned char*)lds;
    F.MISC = (volatile LAS unsigned*)(F.lds + MISC_OFF);
    F.tid = threadIdx.x; F.lane = F.tid & 63; F.wave = __builtin_amdgcn_readfirstlane(F.tid >> 6);
    F.G = gridDim.x; { const int bx = blockIdx.x; F.vcu = (F.G % 8 == 0) ? (bx % 8) * (F.G / 8) + bx / 8 : bx; }
    F.ws = args.ws; F.out = args.out; F.ctl = (gu32*)(args.ws + WS_CTL);
    for (int u = F.tid; u < 128; u += NWAVES * 64) ((LAS unsigned*)(F.lds + MISC_OFF))[u] = 0u;
    if (F.tid < 33) { const unsigned long long pv = (unsigned long long)args.in[F.tid]; ((LAS unsigned*)(F.lds + PTAB_OFF))[2 * F.tid] = (unsigned)pv; ((LAS unsigned*)(F.lds + PTAB_OFF))[2 * F.tid + 1] = (unsigned)(pv >> 32); }
    __syncthreads();
    const int vcu0 = F.vcu;
    const bool fused = args.mode == 0;
    XcdBarrier bar; bar.bar = (unsigned*)(F.ctl + CW_BAR); bar.x = 0; bar.st = nullptr;
    if (fused) bar = xcd_barrier_post((unsigned*)(F.ctl + CW_BAR), F.MISC + 8);
#ifndef SITE_MASK
#define SITE_MASK 0xFFFF
#endif
#define RUN(L, S) (((SITE_MASK >> (S)) & 1) && (fused || (args.l == (L) && args.site == (S))))
#define GRID_BAR() do { if (fused) xcd_barrier(bar); } while (0)
#define SITE_BEGIN() do { int t_ = threadIdx.x; asm volatile("" : "+v"(t_)); F.tid = t_; F.lane = t_ & 63; F.wave = __builtin_amdgcn_readfirstlane(t_ >> 6); int v_ = vcu0; asm volatile("" : "+s"(v_)); F.vcu = v_; unsigned long long w_ = (unsigned long long)args.ws, o_ = (unsigned long long)args.out; asm volatile("" : "+s"(w_), "+s"(o_)); F.ws = (unsigned char*)w_; F.out = (float*)o_; F.ctl = (gu32*)(F.ws + WS_CTL); } while (0)
    float* const XC = WSP(float, WS_XC);
    float* const MOD = WSP(float, WS_MOD);
    LAS int* const tile_e = (LAS int*)(F.lds + RING_BYTES);

    if (RUN(0, 0)) { SITE_BEGIN(); p0_prologue(F); GRID_BAR(); }

    for (int l = 0; l < 2; ++l) {
        const float* xlat = l == 0 ? INP(0) : (const float*)F.out;
        const float* xctx = l == 0 ? INP(2) : (const float*)XC;
        const int nM_mix = l == 0 ? MA / 256 : NL / 256;
        if (RUN(l, 1)) { SITE_BEGIN(); norm_mod_phase<false>(F, l, 0, xlat, xctx, MA, WSP(bf16, WS_H)); GRID_BAR(); }
        if (RUN(l, 2)) { SITE_BEGIN();
            pg8::StdOrder S; S.init(WSP(bf16, WS_H), WSP(bf16, WS_WIN) + (size_t)l * NIN * DM, DM, MA / 256, NIN / 256, F.G, (int)blockIdx.x);
            EpiIn E{WSP(bf16, WS_PR), WSP(bf16, WS_Q), WSP(bf16, WS_KB), WSP(bf16, WS_VB), WSP(bf16, WS_G)};
            pg8::gemm_phase<EpiIn, pg8::StdOrder, true, true>(F.lds, DM, S, E);
            GRID_BAR();
        }
        if (RUN(l, 3)) { SITE_BEGIN();
#ifndef NO_SCAN
            scan_phase(F, l);
#endif
#ifndef NO_QK
            qk_phase(F, l);
#endif
            GRID_BAR(); }
        if (RUN(l, 4)) { SITE_BEGIN(); attn_phase(F, l, (char*)lds); rwkv_out_phase(F, l, nM_mix * 256); GRID_BAR(); }
        if (RUN(l, 5)) { SITE_BEGIN();
            { pg8::StdOrder S; S.init(WSP(bf16, WS_YR), WSP(bf16, WS_WPA) + (size_t)l * DM * RW, RW, nM_mix, DM / 256, F.G, (int)blockIdx.x);
              EpiMerge<0> E{WSP(bf16, WS_G), WSP(bf16, WS_MG)};
              pg8::gemm_phase<EpiMerge<0>, pg8::StdOrder, true, true>(F.lds, RW, S, E); }
            __syncthreads();
            { pg8::StdOrder S; S.init(WSP(bf16, WS_Q), WSP(bf16, WS_WPB) + (size_t)l * DM * RW, RW, nM_mix, DM / 256, F.G, (int)blockIdx.x);
              EpiMerge<1> E{WSP(bf16, WS_G), WSP(bf16, WS_MG)};
              pg8::gemm_phase<EpiMerge<1>, pg8::StdOrder, true, true>(F.lds, RW, S, E); }
            GRID_BAR();
        }
        if (RUN(l, 6)) { SITE_BEGIN();
            pg8::StdOrder S; S.init(WSP(bf16, WS_MG), WSP(bf16, WS_WO) + (size_t)l * DM * DM, DM, nM_mix, DM / 256, F.G, (int)blockIdx.x);
            EpiRes E{xlat, xctx, F.out, XC, MOD + (size_t)l * 33 * 6144 + 2048};
            pg8::gemm_phase<EpiRes, pg8::StdOrder, true, true>(F.lds, DM, S, E);
            GRID_BAR();
        }
        if (RUN(l, 7)) { SITE_BEGIN();
            if (l == 0) norm_mod_phase<false>(F, l, 1, F.out, XC, MA, WSP(bf16, WS_H));
            else norm_mod_phase<true>(F, l, 1, F.out, XC, NL, WSP(bf16, WS_H));
            GRID_BAR();
        }
        if (l == 0) {
            if (RUN(0, 8)) { SITE_BEGIN();
                pg8::StdOrder S; S.init(WSP(bf16, WS_H), WSP(bf16, WS_WGU), DM, MA / 256, 2 * FF / 256, F.G, (int)blockIdx.x);
                EpiGU E{WSP(bf16, WS_ACT), 0};
                pg8::gemm_phase<EpiGU, pg8::StdOrder, true, true>(F.lds, DM, S, E);
                GRID_BAR();
            }
            if (RUN(0, 9)) { SITE_BEGIN();
                pg8::StdOrder S; S.init(WSP(bf16, WS_ACT), WSP(bf16, WS_WDN), FF, MA / 256, DM / 256, F.G, (int)blockIdx.x);
                EpiRes E{F.out, XC, F.out, XC, MOD + 5120};
                pg8::gemm_phase<EpiRes, pg8::StdOrder, true, true>(F.lds, FF, S, E);
                GRID_BAR();
            }
        } else {
            if (RUN(1, 10)) { SITE_BEGIN(); moe_conv(F); __syncthreads(); moe_slots(F); GRID_BAR(); }
            int ntile = 0;
            if (fused || args.site == 11 || args.site == 12) ntile = moe_tiles(F, tile_e);
            for (int ch = 0; ch < MOE_NCHUNK; ++ch) {
                if (!fused && ch != args.chunk) continue;
                const int t0 = ch * MOE_CH_TILES; if (t0 >= ntile) break;
                const int ntl = (ntile - t0) < MOE_CH_TILES ? (ntile - t0) : MOE_CH_TILES;
                if (RUN(1, 11)) { SITE_BEGIN();
                    MoeOrder S{(const char*)(F.ws + WS_XB), (const char*)(F.ws + WS_MW), (size_t)256 * DM * 2, (size_t)256 * DM * 2, (size_t)21 * MiB, t0, 0, ntl, 2 * FF / 256, F.G, (int)blockIdx.x, tile_e};
                    EpiGU E{WSP(bf16, WS_ACTC), t0};
                    pg8::gemm_phase<EpiGU, MoeOrder, true, true>(F.lds, DM, S, E);
                    GRID_BAR();
                }
                if (RUN(1, 12)) { SITE_BEGIN();
                    MoeOrder S{(const char*)(F.ws + WS_ACTC), (const char*)(F.ws + WS_MW) + (size_t)2 * FF * DM * 2, (size_t)256 * FF * 2, (size_t)256 * FF * 2, (size_t)21 * MiB, t0, t0, ntl, DM / 256, F.G, (int)blockIdx.x, tile_e};
                    EpiStore E{WSP(bf16, WS_YM)};
                    pg8::gemm_phase<EpiStore, MoeOrder, true, true>(F.lds, FF, S, E);
                    GRID_BAR();
                }
            }
            if (RUN(1, 13)) { SITE_BEGIN(); moe_final(F); }
        }
    }
#undef RUN
#undef GRID_BAR
}

extern "C" void kernel_launch(void* const* d_in, const int* in_sizes, int n_in, void* d_out, int out_size, void* d_ws, size_t ws_size, hipStream_t stream) {
    static int grid = 0;
    if (grid == 0) {
        if (n_in != 33 || in_sizes[0] != NL * DM || out_size != NL * DM || ws_size < WS_END) { fprintf(stderr, "kernel_launch: unexpected problem (n_in %d, x %d, out %d, ws %zu < %zu); nothing launched\n", n_in, n_in > 0 ? in_sizes[0] : -1, out_size, ws_size, (size_t)WS_END); grid = -1; return; }
        int dev = 0, cus = 0, per_cu = 0;
        if (hipGetDevice(&dev) != hipSuccess || hipDeviceGetAttribute(&cus, hipDeviceAttributeMultiprocessorCount, dev) != hipSuccess) { fprintf(stderr, "kernel_launch: device query failed\n"); grid = -1; return; }
        if (hipFuncSetAttribute((const void*)fwd_kernel, hipFuncAttributeMaxDynamicSharedMemorySize, LDS_BYTES) != hipSuccess) { fprintf(stderr, "kernel_launch: hipFuncSetAttribute failed\n"); grid = -1; return; }
        if (hipOccupancyMaxActiveBlocksPerMultiprocessor(&per_cu, (const void*)fwd_kernel, NWAVES * 64, LDS_BYTES) != hipSuccess || per_cu < 1) { fprintf(stderr, "kernel_launch: occupancy query reports %d workgroups per CU\n", per_cu); }
        (void)hipGetLastError();
        grid = cus;
        fprintf(stderr, "kernel_launch: grid %d, occupancy query %d\n", grid, per_cu);
    }
    if (grid < 0) return;
    if (hipMemsetAsync((char*)d_ws + WS_CTL, 0, CTL_ZERO_BYTES, stream) != hipSuccess) { fprintf(stderr, "kernel_launch: memset failed\n"); return; }
    Args a{};
    for (int i = 0; i < 33; ++i) a.in[i] = (const float*)d_in[i];
    a.out = (float*)d_out; a.ws = (unsigned char*)d_ws;
#if MK_FUSED
    a.mode = 0; a.l = 0; a.site = 0; a.chunk = 0;
    hipLaunchKernelGGL(fwd_kernel, dim3(grid), dim3(NWAVES * 64), LDS_BYTES, stream, a);
#else
    a.mode = 1;
    auto step = [&](int l, int site, int chunk) { a.l = l; a.site = site; a.chunk = chunk; hipLaunchKernelGGL(fwd_kernel, dim3(grid), dim3(NWAVES * 64), LDS_BYTES, stream, a); };
    step(0, 0, 0);
    for (int l = 0; l < 2; ++l) {
        for (int s = 1; s <= 7; ++s) step(l, s, 0);
        if (l == 0) { step(0, 8, 0); step(0, 9, 0); }
        else { step(1, 10, 0); for (int ch = 0; ch < MOE_NCHUNK; ++ch) { step(1, 11, ch); step(1, 12, ch); } step(1, 13, 0); }
    }
#endif
    const hipError_t le = hipPeekAtLastError();
    if (le != hipSuccess) fprintf(stderr, "kernel_launch: launch failed: %s\n", hipGetErrorName(le));
}
```

```cpp
#include <hip/hip_runtime.h>
#include <hip/hip_bf16.h>
#include <cstdio>
#include <cstdint>
#include <cmath>

#ifndef MK_FUSED
#define MK_FUSED 1
#endif

constexpr int DM = 1024, NB = 32, TL = 2048, TC = 256;
constexpr int NL = NB * TL;
constexpr int NC = NB * TC;
constexpr int MA = NL + NC;
constexpr int RW = 512, RCOLS = 1792, ACOLS = 768, GCOLS = 2048, NIN = 4608;
constexpr int FF = 3584, NE = 8;
constexpr int KVT = TL + TC;
constexpr int MOE_ROWS = 2 * NL + NE * 256;
constexpr int MOE_CH_TILES = 64;
constexpr int MOE_NCHUNK = (MOE_ROWS / 256 + MOE_CH_TILES - 1) / MOE_CH_TILES;

constexpr size_t MiB = 1u << 20;
constexpr size_t WS_CTL = 0, CTL_ZERO_BYTES = 1 * MiB;
constexpr size_t WS_MOD = 1 * MiB;
constexpr size_t WS_ROPE = 3 * MiB;
constexpr size_t WS_LORA = 4 * MiB;
constexpr size_t WS_BONUS = 5 * MiB;
constexpr size_t WS_MOETAB = 10 * MiB;
constexpr size_t WS_WIN = 16 * MiB;
constexpr size_t WS_WPA = 34 * MiB;
constexpr size_t WS_WPB = 36 * MiB;
constexpr size_t WS_WO = 38 * MiB;
constexpr size_t WS_WGU = 42 * MiB;
constexpr size_t WS_WDN = 56 * MiB;
constexpr size_t WS_XC = 64 * MiB;
constexpr size_t WS_H = 96 * MiB;
constexpr size_t WS_YF = 96 * MiB, WS_YB = 168 * MiB;
constexpr size_t WS_PR = 240 * MiB;
constexpr size_t WS_MG = 240 * MiB;
constexpr size_t WS_Q = 492 * MiB;
constexpr size_t WS_KB = 564 * MiB, WS_VB = 582 * MiB;
constexpr size_t WS_G = 600 * MiB;
constexpr size_t WS_YR = 888 * MiB;
constexpr size_t WS_ACT = 240 * MiB;
constexpr size_t WS_MW = 224 * MiB;
constexpr size_t WS_XB = 392 * MiB;
constexpr size_t WS_YM = 652 * MiB;
constexpr size_t WS_ACTC = 912 * MiB;
constexpr size_t WS_END = 1024 * MiB;
static_assert(WS_H + (size_t)MA * DM * 2 <= WS_PR && WS_PR + (size_t)MA * RCOLS * 2 <= WS_Q && WS_Q + (size_t)MA * 512 * 2 <= WS_KB, "ws map 1");
static_assert(WS_KB + (size_t)MA * 128 * 2 <= WS_VB && WS_VB + (size_t)MA * 128 * 2 <= WS_G && WS_G + (size_t)MA * GCOLS * 2 <= WS_YR && WS_YR + (size_t)MA * 512 * 2 <= WS_END, "ws map 2");
static_assert(WS_ACT + (size_t)MA * FF * 2 <= WS_END && WS_H + (size_t)NL * DM * 2 <= WS_MW && WS_MW + (size_t)NE * 21 * MiB <= WS_XB, "ws map 3");
static_assert(WS_XB + (size_t)MOE_ROWS * DM * 2 <= WS_YM && WS_YM + (size_t)MOE_ROWS * DM * 2 <= WS_ACTC && WS_ACTC + (size_t)MOE_CH_TILES * 256 * FF * 2 <= WS_END, "ws map 4");
static_assert(WS_WDN + (size_t)DM * FF * 2 <= WS_XC && WS_BONUS + (size_t)2 * MA * 8 * 4 <= WS_MOETAB, "ws map 5");
constexpr size_t MT_TOKE = 0;
constexpr size_t MT_TOKW = 512 * 1024;
constexpr size_t MT_TOKS = 1024 * 1024;
constexpr int CW_TMO = 0, CW_CODE = 1;
constexpr int CW_BAR = 4096;
constexpr int CW_HIST = 8192;
constexpr int CW_CURS = 8192 + 64 * 8;

constexpr int NWAVES = 8;
constexpr int LDS_BYTES = 147456;
constexpr int MISC_OFF = LDS_BYTES - 1024;
constexpr int PTAB_OFF = LDS_BYTES - 512;
constexpr int RING_BYTES = 131072;

#define GAS __attribute__((address_space(1)))
#define LAS __attribute__((address_space(3)))
typedef unsigned short bf16;
typedef unsigned v4u __attribute__((ext_vector_type(4)));
typedef unsigned v2u __attribute__((ext_vector_type(2)));
typedef float f32x4 __attribute__((ext_vector_type(4)));
typedef float f32x2 __attribute__((ext_vector_type(2)));
typedef short bf16x8 __attribute__((ext_vector_type(8)));
typedef GAS unsigned gu32;
#define RLX_AGENT __ATOMIC_RELAXED, __HIP_MEMORY_SCOPE_AGENT
#define LDS_WAIT() asm volatile("s_waitcnt lgkmcnt(0)" ::: "memory")
#define VM_WAIT() asm volatile("s_waitcnt vmcnt(0)" ::: "memory")
__device__ __forceinline__ float bf2f(unsigned b) { return __uint_as_float(b << 16); }
__device__ __forceinline__ float bflo(unsigned w) { return __uint_as_float(w << 16); }
__device__ __forceinline__ float bfhi(unsigned w) { return __uint_as_float(w & 0xffff0000u); }
__device__ __forceinline__ unsigned pk2(float lo, float hi) { unsigned r; asm volatile("v_cvt_pk_bf16_f32 %0, %1, %2" : "=v"(r) : "v"(lo), "v"(hi)); return r; }
__device__ __forceinline__ float sigmoidf_(float x) { return 1.0f / (1.0f + __expf(-x)); }
__device__ __forceinline__ float wave_sum(float v) {
#pragma unroll
    for (int o = 1; o < 64; o <<= 1) v += __shfl_xor(v, o);
    return v;
}
__device__ __forceinline__ int row_bi(int m) { return m < NL ? (m >> 11) : 32; }
__device__ __forceinline__ int row_kv(int m) { return m < NL ? (m >> 11) * KVT + (m & 2047) : ((m - NL) >> 8) * KVT + TL + ((m - NL) & 255); }
namespace pg8 {
#define PG8_LAS __attribute__((address_space(3)))
typedef unsigned short bf16_t;
typedef short bf16x8 __attribute__((ext_vector_type(8)));
typedef float f32x4 __attribute__((ext_vector_type(4)));
typedef unsigned u32x4 __attribute__((ext_vector_type(4)));
constexpr int BM = 256, BK = 64, HALF = 128, HTB = HALF * BK * 2  , STAGE_BYTES = 8 * HTB, NXCD = 8, WGM = 8;

__host__ __device__ __forceinline__ int lds_byte(int r, int c) { const int st = (r >> 4) * 2 + (c >> 5), rr = r & 15, cc = c & 31, ob = rr * 64 + cc * 2; return st * 1024 + (ob ^ (((ob >> 9) & 1) << 5)); }
__host__ __device__ __forceinline__ void stage_rc(int b, int& R, int& C) { const int st = b / 1024, sb = b % 1024, swz = sb ^ (((sb >> 9) & 1) << 5); R = (st >> 1) * 16 + swz / 64; C = (st & 1) * 32 + (swz % 64) / 2; }
__host__ __device__ __forceinline__ int perm32(int rho) { const int n = rho >> 4, i = rho & 15; return 8 * (i >> 2) + 4 * n + (i & 3); }

struct Unit { int pm, pn; };

struct StdOrder {
    const char* A; const char* Bt; size_t tstep; int nM, nN, nwg, G, c;
    __device__ void init(const void* A_, const void* Bt_, int K, int nM_, int nN_, int G_, int c_) { A = (const char*)A_; Bt = (const char*)Bt_; tstep = (size_t)BM * K * 2; nM = nM_; nN = nN_; nwg = nM * nN; G = G_; c = c_; }
    __device__ bool next(int i, Unit& u) const {
        const long L = (long)i * G + c; if (L >= nwg) return false;
        int wgid = (int)L; { const int q = nwg / NXCD, r = nwg % NXCD, xcd = wgid % NXCD, off = wgid / NXCD; wgid = (xcd < r ? xcd * (q + 1) : r * (q + 1) + (xcd - r) * q) + off; }
        const int nig = WGM * nN, gid = wgid / nig, fm = gid * WGM, gsz = (nM - fm) < WGM ? (nM - fm) : WGM;
        u.pm = fm + ((wgid % nig) % gsz); u.pn = (wgid % nig) / gsz; return true;
    }
    __device__ __forceinline__ const char* a_base(const Unit& u) const { return A + (size_t)u.pm * tstep; }
    __device__ __forceinline__ const char* b_base(const Unit& u) const { return Bt + (size_t)u.pn * tstep; }
    __device__ __forceinline__ void a_ready(const Unit&) const {}
    __device__ __forceinline__ void done(const Unit&) const {}
};
template <class Epi, class Sched, bool ALIGN_EPI = false, bool SP2 = false>
__device__ __forceinline__ void gemm_phase(PG8_LAS unsigned char* lds, const int K, const Sched& S, const Epi& E) {
    int tid_l = threadIdx.x; asm volatile("" : "+v"(tid_l));
    const int tid = tid_l, wid = __builtin_amdgcn_readfirstlane(tid >> 6), lane = tid & 63, wr = wid >> 2, wc = wid & 3, fr = lane & 15, fq = lane >> 4;
    const int nt = K / BK;
    unsigned voffA[2], voffB[2];
#pragma unroll
    for (int i = 0; i < 2; ++i) { int R, C; stage_rc(tid * 16 + i * 8192, R, C); const int Rb = Epi::PERM ? ((R & ~31) + perm32(R & 31)) : R;
        voffA[i] = (unsigned)(R * K + C) * 2u; voffB[i] = (unsigned)(Rb * K + C) * 2u; }
    const size_t kstep = (size_t)(BK * 2);
    const size_t hstep = (size_t)HALF * K * 2;
    const unsigned ldsw = (unsigned)wid * 1024u;
    const int aoff = lds_byte(wr * 64 + fr, fq * 8), boff = lds_byte(wc * 32 + fr, fq * 8);
#define PG8_SA(b, h) (((b) * 2 + (h)) * HTB)
#define PG8_SB(b, h) ((4 + (b) * 2 + (h)) * HTB)
#define PG8_STAGE(bufoff, gbase, voff) do { _Pragma("unroll") for (int _i = 0; _i < 2; ++_i) \
        __builtin_amdgcn_global_load_lds((const unsigned*)((const char*)(gbase) + (voff)[_i]), (PG8_LAS unsigned*)(lds + (bufoff) + ldsw + _i * 8192), 16, 0, 0); } while (0)
#define PG8_LDA(dst, b, h) do { _Pragma("unroll") for (int m = 0; m < 4; ++m) _Pragma("unroll") for (int k = 0; k < 2; ++k) dst[m][k] = *(const PG8_LAS bf16x8*)(lds + PG8_SA(b, h) + aoff + m * 2048 + k * 1024); } while (0)
#define PG8_LDB(dst, b, h) do { _Pragma("unroll") for (int n = 0; n < 2; ++n) _Pragma("unroll") for (int k = 0; k < 2; ++k) dst[n][k] = *(const PG8_LAS bf16x8*)(lds + PG8_SB(b, h) + boff + n * 2048 + k * 1024); } while (0)
#define PG8_MMA(ai, bj, At, Bt) do { __builtin_amdgcn_s_setprio(1); _Pragma("unroll") for (int m = 0; m < 4; ++m) _Pragma("unroll") for (int n = 0; n < 2; ++n) _Pragma("unroll") for (int k = 0; k < 2; ++k) \
        acc[ai][bj][m][n] = __builtin_amdgcn_mfma_f32_16x16x32_bf16(Bt[n][k], At[m][k], acc[ai][bj][m][n], 0, 0, 0); __builtin_amdgcn_s_setprio(0); } while (0)
#define PG8_WAIT_V(n) asm volatile("s_waitcnt vmcnt(" #n ")" ::: "memory")
#define PG8_WAIT_L(n) asm volatile("s_waitcnt lgkmcnt(" #n ")" ::: "memory")
#define PG8_BAR __builtin_amdgcn_s_barrier()
#define PG8_SCHED __builtin_amdgcn_sched_barrier(0)
    Unit cur, nxt; int ui = 0;
    if (!S.next(0, cur)) return;
    f32x4 acc[2][2][4][2];
#pragma unroll
    for (int a = 0; a < 2; ++a)
#pragma unroll
        for (int b = 0; b < 2; ++b)
#pragma unroll
            for (int m = 0; m < 4; ++m)
#pragma unroll
                for (int n = 0; n < 2; ++n) acc[a][b][m][n] = (f32x4){0.f, 0.f, 0.f, 0.f};
    bf16x8 At[4][2], B0[2][2], B1[2][2];
    const char* cA = S.a_base(cur); const char* cB = S.b_base(cur);
    S.a_ready(cur);
    if constexpr (SP2) {
        PG8_STAGE(PG8_SB(0, 0), cB, voffB); PG8_STAGE(PG8_SB(0, 1), cB + hstep, voffB); PG8_STAGE(PG8_SA(0, 0), cA, voffA); PG8_STAGE(PG8_SA(0, 1), cA + hstep, voffA);
        if (wr == 1) PG8_BAR;
        PG8_WAIT_V(2); PG8_BAR;
        PG8_STAGE(PG8_SB(1, 0), cB + kstep, voffB); PG8_STAGE(PG8_SA(1, 0), cA + kstep, voffA); PG8_STAGE(PG8_SB(1, 1), cB + hstep + kstep, voffB);
        PG8_WAIT_V(6); PG8_BAR;
    } else {
        PG8_STAGE(PG8_SB(0, 0), cB, voffB); PG8_STAGE(PG8_SA(0, 0), cA, voffA); PG8_STAGE(PG8_SB(0, 1), cB + hstep, voffB); PG8_STAGE(PG8_SA(0, 1), cA + hstep, voffA);
        if (wr == 1) PG8_BAR;
        PG8_WAIT_V(4); PG8_BAR;
        PG8_STAGE(PG8_SB(1, 0), cB + kstep, voffB); PG8_STAGE(PG8_SA(1, 0), cA + kstep, voffA); PG8_STAGE(PG8_SB(1, 1), cB + hstep + kstep, voffB);
        PG8_WAIT_V(6); PG8_BAR;
    }
    for (;;) {
        const bool has_next = S.next(ui + 1, nxt);
        const char* nA = has_next ? S.a_base(nxt) : cA; const char* nB = has_next ? S.b_base(nxt) : cB;
        for (int t = 0; t < nt; t += 2) {
            const bool last = (t == nt - 2);
            const char* a1 = cA + (size_t)(t + 1) * kstep;
            const char* a2 = last ? nA : cA + (size_t)(t + 2) * kstep; const char* b2 = last ? nB : cB + (size_t)(t + 2) * kstep;
            const char* a3 = a2 + kstep; const char* b3 = b2 + kstep;
            if (last && has_next) S.a_ready(nxt);
            if constexpr (SP2) {
            PG8_LDB(B0, 0, 0); PG8_LDB(B1, 0, 1); PG8_SCHED; PG8_LDA(At, 0, 0); PG8_STAGE(PG8_SA(1, 1), a1 + hstep, voffA);
            PG8_WAIT_V(8); PG8_WAIT_L(0); PG8_BAR; PG8_MMA(0, 0, At, B0); PG8_MMA(0, 1, At, B1); PG8_BAR; PG8_SCHED;
            PG8_LDA(At, 0, 1); PG8_STAGE(PG8_SB(0, 0), b2, voffB); PG8_STAGE(PG8_SB(0, 1), b2 + hstep, voffB); PG8_STAGE(PG8_SA(0, 0), a2, voffA);
            PG8_WAIT_V(8); PG8_WAIT_L(0); PG8_BAR; PG8_MMA(1, 0, At, B0); PG8_MMA(1, 1, At, B1); PG8_BAR; PG8_SCHED;
            PG8_LDB(B0, 1, 0); PG8_LDB(B1, 1, 1); PG8_SCHED; PG8_LDA(At, 1, 0); PG8_STAGE(PG8_SA(0, 1), a2 + hstep, voffA);
            PG8_WAIT_V(8); PG8_WAIT_L(0); PG8_BAR; PG8_MMA(0, 0, At, B0); PG8_MMA(0, 1, At, B1); PG8_BAR; PG8_SCHED;
            PG8_LDA(At, 1, 1); PG8_STAGE(PG8_SB(1, 0), b3, voffB); PG8_STAGE(PG8_SB(1, 1), b3 + hstep, voffB); PG8_STAGE(PG8_SA(1, 0), a3, voffA);
            PG8_WAIT_V(8); PG8_WAIT_L(0); PG8_BAR; PG8_MMA(1, 0, At, B0); PG8_MMA(1, 1, At, B1); PG8_BAR; PG8_SCHED;
            } else {
            PG8_LDB(B0, 0, 0); PG8_SCHED; PG8_LDA(At, 0, 0); PG8_STAGE(PG8_SA(1, 1), a1 + hstep, voffA);
            PG8_WAIT_L(8); PG8_BAR; PG8_WAIT_L(0); PG8_MMA(0, 0, At, B0); PG8_BAR; PG8_SCHED;
            PG8_LDB(B1, 0, 1); PG8_STAGE(PG8_SB(0, 0), b2, voffB);
            PG8_BAR; PG8_WAIT_L(0); PG8_MMA(0, 1, At, B1); PG8_BAR;
            PG8_LDA(At, 0, 1); PG8_STAGE(PG8_SA(0, 0), a2, voffA);
            PG8_BAR; PG8_WAIT_L(0); PG8_MMA(1, 0, At, B0); PG8_BAR; PG8_SCHED;
            PG8_STAGE(PG8_SB(0, 1), b2 + hstep, voffB);
            PG8_WAIT_V(6); PG8_BAR; PG8_MMA(1, 1, At, B1); PG8_BAR;
            PG8_LDB(B0, 1, 0); PG8_SCHED; PG8_LDA(At, 1, 0); PG8_STAGE(PG8_SA(0, 1), a2 + hstep, voffA);
            PG8_WAIT_L(8); PG8_BAR; PG8_WAIT_L(0); PG8_MMA(0, 0, At, B0); PG8_BAR; PG8_SCHED;
            PG8_LDB(B1, 1, 1); PG8_STAGE(PG8_SB(1, 0), b3, voffB);
            PG8_BAR; PG8_WAIT_L(0); PG8_MMA(0, 1, At, B1); PG8_BAR;
            PG8_LDA(At, 1, 1); PG8_STAGE(PG8_SA(1, 0), a3, voffA);
            PG8_BAR; PG8_WAIT_L(0); PG8_MMA(1, 0, At, B0); PG8_BAR; PG8_SCHED;
            PG8_STAGE(PG8_SB(1, 1), b3 + hstep, voffB);
            PG8_WAIT_V(6); PG8_BAR; PG8_MMA(1, 1, At, B1); PG8_BAR;
            }
        }
        if constexpr (ALIGN_EPI) { if (wr == 0) PG8_BAR; }
        if constexpr (!Epi::AFTER_DRAIN) { E(acc, cur, wr, wc, fr, fq); S.done(cur); }
        if (!has_next) break;
#pragma unroll
        for (int a = 0; a < 2; ++a)
#pragma unroll
            for (int b = 0; b < 2; ++b)
#pragma unroll
                for (int m = 0; m < 4; ++m)
#pragma unroll
                    for (int n = 0; n < 2; ++n) acc[a][b][m][n] = (f32x4){0.f, 0.f, 0.f, 0.f};
        cur = nxt; cA = nA; cB = nB; ++ui;
        if constexpr (ALIGN_EPI) { if (wr == 1) PG8_BAR; }
    }
    PG8_WAIT_V(0);
    if constexpr (!ALIGN_EPI) { if (wr == 0) PG8_BAR; }
    PG8_BAR;
    if constexpr (Epi::AFTER_DRAIN) { E.fused(acc, cur, wr, wc, fr, fq, lds, wid, lane); S.done(cur); }
#undef PG8_SA
#undef PG8_SB
#undef PG8_STAGE
#undef PG8_LDA
#undef PG8_LDB
#undef PG8_MMA
#undef PG8_WAIT_V
#undef PG8_WAIT_L
#undef PG8_BAR
#undef PG8_SCHED
}
}

#include <hip/hip_bf16.h>
#include <cmath>
namespace attn_body {
using bf16=__hip_bfloat16;
using bf16x8=__attribute__((ext_vector_type(8)))short;
using s16x4=__attribute__((ext_vector_type(4)))short;
using f32x16=__attribute__((ext_vector_type(16)))float;
using u32x4=__attribute__((ext_vector_type(4)))unsigned;
constexpr int D=64,QP=512,KP=128;
constexpr int NW=8,QBLK=32,QB=QBLK*NW,KVBLK=64;
constexpr int ATTN_UNIT_ROWS=QB;
__device__ __forceinline__ int crow(int r,int hi){return (r&3)+8*(r>>2)+4*hi;}
#define SBAR() __builtin_amdgcn_sched_barrier(0)
__device__ __forceinline__ void cmask(f32x16&p0,f32x16&p1,int jb,int qrel,int hi){
  const float NEG=-INFINITY; int kb=64*jb+4*hi;
  #pragma unroll
  for(int r=0;r<16;++r){int kv=kb+(r&3)+8*(r>>2); if(kv>qrel)p0[r]=NEG; if(kv+32>qrel)p1[r]=NEG;}
}

constexpr int NSLOT=3, SLOTB=8192;
constexpr int LDS_K=0, LDS_V=NSLOT*SLOTB, LDS_WS=2*NSLOT*SLOTB, LDS_OST=LDS_WS+NW*64*4, LDS_BYTES=LDS_OST+NW*4096;
constexpr float C2=0.125f*1.4426950408889634f;
__device__ __forceinline__ void glds16(const void*gsrc,unsigned lds_dst){unsigned keep;
  asm volatile("s_mov_b32 %0, m0\n\ts_mov_b32 m0, %2\n\ts_nop 0\n\tglobal_load_lds_dwordx4 %1, off\n\ts_mov_b32 m0, %0":"=&s"(keep):"v"(gsrc),"s"(lds_dst):"memory");}
__device__ __forceinline__ float max3f(float a,float b,float c){float r;asm("v_max3_f32 %0, %1, %2, %3":"=v"(r):"v"(a),"v"(b),"v"(c));return r;}
__device__ __forceinline__ float max2f(float a,float b){float r;asm("v_max_f32_e32 %0, %1, %2":"=v"(r):"v"(a),"v"(b));return r;}
__device__ __forceinline__ float fadd_s(float a,float b){float r;asm("v_add_f32_e32 %0, %1, %2":"=v"(r):"v"(a),"v"(b));return r;}
__device__ __forceinline__ float fsub_s(float a,float b){float r;asm("v_sub_f32_e32 %0, %1, %2":"=v"(r):"v"(a),"v"(b));return r;}
typedef float f32x2_t __attribute__((ext_vector_type(2))); typedef __bf16 bf16x2_t __attribute__((ext_vector_type(2)));
__device__ __forceinline__ unsigned cvtpk_s(float lo,float hi){f32x2_t v={lo,hi};bf16x2_t b=__builtin_convertvector(v,bf16x2_t);return __builtin_bit_cast(unsigned,b);}
#define WAIT_BAR(N) asm volatile("s_waitcnt vmcnt(" #N ") lgkmcnt(0)\n\ts_barrier":::"memory")

__device__ __forceinline__ void qkt(f32x16&p0,f32x16&p1,const char*Kslot,const bf16x8*qr,const f32x16&negm,int r32,int hi){
  const char*kb=Kslot+hi*1024+r32*16;
  #pragma unroll
  for(int d0=0;d0<4;++d0){
    const bf16x8 b0=*reinterpret_cast<const bf16x8*>(kb+d0*2048);
    const bf16x8 b1=*reinterpret_cast<const bf16x8*>(kb+d0*2048+512);
    if(d0==0){p0=__builtin_amdgcn_mfma_f32_32x32x16_bf16(b0,qr[0],negm,0,0,0);p1=__builtin_amdgcn_mfma_f32_32x32x16_bf16(b1,qr[0],negm,0,0,0);}
    else{p0=__builtin_amdgcn_mfma_f32_32x32x16_bf16(b0,qr[d0],p0,0,0,0);p1=__builtin_amdgcn_mfma_f32_32x32x16_bf16(b1,qr[d0],p1,0,0,0);}}
}
typedef __attribute__((address_space(3))) const char* lds_cptr;
typedef short v4i16_t __attribute__((ext_vector_type(4)));
__device__ __forceinline__ void kload8(bf16x8*kf,lds_cptr kp){
  kf[0]=*(const __attribute__((address_space(3))) bf16x8*)(kp);      kf[1]=*(const __attribute__((address_space(3))) bf16x8*)(kp+512);
  kf[2]=*(const __attribute__((address_space(3))) bf16x8*)(kp+2048); kf[3]=*(const __attribute__((address_space(3))) bf16x8*)(kp+2560);
  kf[4]=*(const __attribute__((address_space(3))) bf16x8*)(kp+4096); kf[5]=*(const __attribute__((address_space(3))) bf16x8*)(kp+4608);
  kf[6]=*(const __attribute__((address_space(3))) bf16x8*)(kp+6144); kf[7]=*(const __attribute__((address_space(3))) bf16x8*)(kp+6656);
}
__device__ __forceinline__ void kload2(bf16x8*kf,lds_cptr kp,int j){ kf[2*j]=*(const __attribute__((address_space(3))) bf16x8*)(kp+j*2048); kf[2*j+1]=*(const __attribute__((address_space(3))) bf16x8*)(kp+j*2048+512); }
__device__ __forceinline__ s16x4 vtr(lds_cptr p){ return __builtin_bit_cast(s16x4,__builtin_amdgcn_ds_read_tr16_b64_v4i16((__attribute__((address_space(3))) v4i16_t*)p)); }
__device__ __forceinline__ float rowmax(const f32x16&p0,const f32x16&p1){
  float a=max3f(p0[0],p0[1],p1[0]),b=max3f(p0[2],p0[3],p1[1]);a=max3f(a,p1[2],p1[3]);
  #pragma unroll
  for(int r=4;r<16;r+=4){a=max3f(a,p0[r],p0[r+1]);b=max3f(b,p0[r+2],p0[r+3]);a=max3f(a,p1[r],p1[r+1]);b=max3f(b,p1[r+2],p1[r+3]);}
  const float m=max2f(a,b);
  auto rr=__builtin_amdgcn_permlane32_swap(__float_as_uint(m),__float_as_uint(m),false,false);
  return max2f(__uint_as_float(rr[0]),__uint_as_float(rr[1]));
}
__device__ __forceinline__ void pv(f32x16*o,int vb,bf16x8 pa0,bf16x8 pa1,bf16x8 pa2,bf16x8 pa3){
  #pragma unroll
  for(int d0=0;d0<2;++d0){s16x4 lo[4],hi[4];
    #pragma unroll
    for(int ks=0;ks<4;++ks){
      asm volatile("ds_read_b64_tr_b16 %0,%1 offset:%c2":"=&v"(lo[ks]):"v"(vb),"i"(d0*4096+ks*1024):"memory");
      asm volatile("ds_read_b64_tr_b16 %0,%1 offset:%c2":"=&v"(hi[ks]):"v"(vb),"i"(d0*4096+ks*1024+512):"memory");}
    asm volatile("s_waitcnt lgkmcnt(0)":::"memory");SBAR();
    #define PK(k) (bf16x8){lo[k][0],lo[k][1],lo[k][2],lo[k][3],hi[k][0],hi[k][1],hi[k][2],hi[k][3]}
    o[d0]=__builtin_amdgcn_mfma_f32_32x32x16_bf16(pa0,PK(0),o[d0],0,0,0);
    o[d0]=__builtin_amdgcn_mfma_f32_32x32x16_bf16(pa1,PK(1),o[d0],0,0,0);
    o[d0]=__builtin_amdgcn_mfma_f32_32x32x16_bf16(pa2,PK(2),o[d0],0,0,0);
    o[d0]=__builtin_amdgcn_mfma_f32_32x32x16_bf16(pa3,PK(3),o[d0],0,0,0);
    #undef PK
  }
}

#ifndef ATTN_STORE16
#define ATTN_STORE16(p,v) (*(u32x4*)(p)=(v))
#endif
template<int THRL> __device__ __forceinline__ void attn_unit(const bf16*Qu,const bf16*__restrict__ Kh,const bf16*__restrict__ Vh,bf16*Ou,const int NT,char*shm){
  int tid_l=threadIdx.x; asm volatile("":"+v"(tid_l));
  const int tid=tid_l,lane=tid&63,r32=lane&31,hi=lane>>5; const int wid=__builtin_amdgcn_readfirstlane(tid>>6);
  const bf16*Qw=Qu+(long)(wid*QBLK)*QP;
  const unsigned lds0=(unsigned)(uintptr_t)shm;
  float*wsf=(float*)(shm+LDS_WS)+wid*64;
  const bf16*ksrc=Kh+(long)lane*KP+wid*8;
  const bf16*vsrc=Vh+(long)(16*(wid&3)+(lane>>2))*KP+(wid>>2)*32+(lane&3)*8;
  const unsigned kdst=lds0+LDS_K+wid*1024, vdst=lds0+LDS_V+wid*1024;
  #define DMA_K(t,slot) glds16(ksrc+(long)(t)*KVBLK*KP,(unsigned)__builtin_amdgcn_readfirstlane(kdst+(slot)))
  #define DMA_V(t,slot) glds16(vsrc+(long)(t)*KVBLK*KP,(unsigned)__builtin_amdgcn_readfirstlane(vdst+(slot)))
  const int vb0=(int)(lds0+LDS_V)+((lane>>4)&1)*32+(lane&3)*8+(4*hi+((lane&15)>>2))*64;
  const char*Kbase=shm+LDS_K; bf16x8 kf[8];
  const lds_cptr shm3=(lds_cptr)shm; const lds_cptr kp0=shm3+LDS_K+hi*1024+r32*16; const lds_cptr vp0=shm3+LDS_V+((lane>>4)&1)*32+(lane&3)*8+(4*hi+((lane&15)>>2))*64;
  DMA_K(0,0);DMA_V(0,0);DMA_K(1,SLOTB);
  bf16x8 qr[4];
  #pragma unroll
  for(int d0=0;d0<4;++d0)qr[d0]=*reinterpret_cast<const bf16x8*>(&Qw[(long)r32*QP+d0*16+hi*8]);
  float mhat=0.f,l_reg=0.f;f32x16 o[2];o[0]=f32x16{};o[1]=f32x16{};f32x16 negm=f32x16{};asm volatile("":"+v"(negm));
  #define CMASK(P0,P1,t) do{}while(0)
  bool resc=false;
  #define START(P0,P1) do{ const float rm=rowmax(P0,P1); resc=false; \
    { const float dl=rm; mhat=fadd_s(mhat,dl); \
      _Pragma("unroll") for(int r=0;r<16;++r){P0[r]=fsub_s(P0[r],dl);P1[r]=fsub_s(P1[r],dl);} \
      _Pragma("unroll") for(int r=0;r<16;++r)negm[r]=-mhat; asm volatile("":"+v"(negm)); } \
    _Pragma("unroll") for(int r=0;r<16;++r)P0[r]=__builtin_amdgcn_exp2f(P0[r]); }while(0)
  #define RESC() do{ if(resc){ asm volatile("s_waitcnt lgkmcnt(0)":::"memory"); \
      _Pragma("unroll") for(int d_=0;d_<2;++d_) _Pragma("unroll") for(int r=0;r<16;++r)o[d_][r]*=wsf[crow(r,hi)]; } }while(0)
  f32x16 pA0,pA1,pB0,pB1;
  int sl_prev=0,sl_cur=0,sl_next=SLOTB;
  #define ROT() do{sl_prev=sl_cur;sl_cur=sl_next;sl_next=(sl_next==(NSLOT-1)*SLOTB)?0:sl_next+SLOTB;}while(0)
  DMA_K(2,2*SLOTB);
  WAIT_BAR(3);
  qkt(pA0,pA1,Kbase,qr,negm,r32,hi);asm volatile("s_nop 15\n\ts_nop 7":"+v"(pA0),"+v"(pA1));CMASK(pA0,pA1,0);
  START(pA0,pA1);
  _Pragma("unroll") for(int r=0;r<16;++r)pA1[r]=__builtin_amdgcn_exp2f(pA1[r]);
  WAIT_BAR(0);
  DMA_K(3,0);DMA_V(1,SLOTB);
  ROT();
  kload8(kf,kp0+sl_cur);
  WAIT_BAR(2);
  s16x4 vlo[8],vhi[8]; u32x4 pw0,pw1,pw2,pw3;
  #define PKW(P,B) cvtpk_s(P[B],P[B+1])
  #define PAF(k) __builtin_bit_cast(bf16x8,pw##k)
  #define VFR(i) (bf16x8){vlo[i][0],vlo[i][1],vlo[i][2],vlo[i][3],vhi[i][0],vhi[i][1],vhi[i][2],vhi[i][3]}
  #define PIN(x) asm volatile("":"+v"(x))
  #define MX3(a,b,c) __builtin_fmaxf(__builtin_fmaxf((a),(b)),(c))
  #define GAPA(MF,A0,A1,A2,A3,W0,W1,PW) do{ MF; sacc+=A0; sacc+=A1; sacc+=A2; sacc+=A3; PIN(sacc); W0; W1; PIN(PW); SBAR(); }while(0)
  #define EX(v) __builtin_amdgcn_exp2f(v)
  #define GAPB(MF,X,B) do{ MF; X[B]=EX(X[B]); X[B+1]=EX(X[B+1]); X[B+2]=EX(X[B+2]); X[B+3]=EX(X[B+3]); PIN(X); SBAR(); }while(0)
  #define VRD(i) do{ vlo[i]=vtr(vp_+(((i)>>2)*4096+((i)&3)*1024)); vhi[i]=vtr(vp_+(((i)>>2)*4096+((i)&3)*1024+512)); }while(0)
  #define KRD(G,j) do{ if(G){ kload2(kf,kp0+sl_next,j); SBAR(); } }while(0)
  #define STEP(C0,C1,P0,P1,t,GK,GV,GL) do{ SBAR(); \
    const lds_cptr vp_=vp0+sl_prev; \
    VRD(0); SBAR(); float sacc=(P0[0]+P0[1]); \
    GAPA(C0=__builtin_amdgcn_mfma_f32_32x32x16_bf16(kf[0],qr[0],negm,0,0,0), P0[2],P0[3],P0[4],P0[5],     pw0[0]=PKW(P0,0), pw0[1]=PKW(P0,2), pw0); \
    VRD(4); SBAR(); GAPA(C1=__builtin_amdgcn_mfma_f32_32x32x16_bf16(kf[1],qr[0],negm,0,0,0), P0[6],P0[7],P0[8],P0[9],     pw0[2]=PKW(P0,4), pw0[3]=PKW(P0,6), pw0); \
    VRD(1); SBAR(); GAPA(C0=__builtin_amdgcn_mfma_f32_32x32x16_bf16(kf[2],qr[1],C0,0,0,0),   P0[10],P0[11],P0[12],P0[13], pw1[0]=PKW(P0,8), pw1[1]=PKW(P0,10), pw1); \
    VRD(5); SBAR(); GAPA(C1=__builtin_amdgcn_mfma_f32_32x32x16_bf16(kf[3],qr[1],C1,0,0,0),   P0[14],P0[15],P1[0],P1[1],   pw1[2]=PKW(P0,12),pw1[3]=PKW(P0,14), pw1); \
    VRD(2); SBAR(); GAPA(C0=__builtin_amdgcn_mfma_f32_32x32x16_bf16(kf[4],qr[2],C0,0,0,0),   P1[2],P1[3],P1[4],P1[5],     pw2[0]=PKW(P1,0), pw2[1]=PKW(P1,2), pw2); \
    VRD(6); SBAR(); GAPA(C1=__builtin_amdgcn_mfma_f32_32x32x16_bf16(kf[5],qr[2],C1,0,0,0),   P1[6],P1[7],P1[8],P1[9],     pw2[2]=PKW(P1,4), pw2[3]=PKW(P1,6), pw2); \
    VRD(3); SBAR(); GAPA(C0=__builtin_amdgcn_mfma_f32_32x32x16_bf16(kf[6],qr[3],C0,0,0,0),   P1[10],P1[11],P1[12],P1[13], pw3[0]=PKW(P1,8), pw3[1]=PKW(P1,10), pw3); \
    VRD(7); SBAR(); GAPA(C1=__builtin_amdgcn_mfma_f32_32x32x16_bf16(kf[7],qr[3],C1,0,0,0),   P1[14],P1[15],0.f,0.f,       pw3[2]=PKW(P1,12),pw3[3]=PKW(P1,14), pw3); \
    l_reg+=sacc; \
    if(GK){DMA_K((t)+3,sl_cur);} if(GV){DMA_V((t)+1,sl_next);} \
    CMASK(C0,C1,t); \
    { float a=MX3(C0[0],C0[1],C1[0]),b=MX3(C0[2],C0[3],C1[1]); a=MX3(a,C1[2],C1[3]); \
      _Pragma("unroll") for(int r=4;r<16;r+=4){a=MX3(a,C0[r],C0[r+1]);b=MX3(b,C0[r+2],C0[r+3]);a=MX3(a,C1[r],C1[r+1]);b=MX3(b,C1[r+2],C1[r+3]);} \
      float rm=__builtin_fmaxf(a,b); { auto rr=__builtin_amdgcn_permlane32_swap(__float_as_uint(rm),__float_as_uint(rm),false,false); rm=__builtin_fmaxf(__uint_as_float(rr[0]),__uint_as_float(rr[1])); } \
      resc=false; \
      if(__builtin_expect(__any(rm>(float)THRL),0)){ const float dl=__builtin_fmaxf(rm,0.f); mhat+=dl; \
        _Pragma("unroll") for(int r=0;r<16;++r){C0[r]-=dl;C1[r]-=dl;} \
        _Pragma("unroll") for(int r=0;r<16;++r)negm[r]=-mhat; asm volatile("":"+v"(negm)); \
        const float f=__builtin_amdgcn_exp2f(-dl); l_reg*=f; if(hi==0)wsf[r32]=f; resc=true; } } \
    SBAR(); \
    GAPB(o[0]=__builtin_amdgcn_mfma_f32_32x32x16_bf16(PAF(0),VFR(0),o[0],0,0,0), C0,0); \
    GAPB(o[1]=__builtin_amdgcn_mfma_f32_32x32x16_bf16(PAF(0),VFR(4),o[1],0,0,0), C0,4); \
    KRD(GL,0); GAPB(o[0]=__builtin_amdgcn_mfma_f32_32x32x16_bf16(PAF(1),VFR(1),o[0],0,0,0), C0,8); \
    KRD(GL,1); GAPB(o[1]=__builtin_amdgcn_mfma_f32_32x32x16_bf16(PAF(1),VFR(5),o[1],0,0,0), C0,12); \
    KRD(GL,2); GAPB(o[0]=__builtin_amdgcn_mfma_f32_32x32x16_bf16(PAF(2),VFR(2),o[0],0,0,0), C1,0); \
    KRD(GL,3); GAPB(o[1]=__builtin_amdgcn_mfma_f32_32x32x16_bf16(PAF(2),VFR(6),o[1],0,0,0), C1,4); \
    GAPB(o[0]=__builtin_amdgcn_mfma_f32_32x32x16_bf16(PAF(3),VFR(3),o[0],0,0,0), C1,8); \
    GAPB(o[1]=__builtin_amdgcn_mfma_f32_32x32x16_bf16(PAF(3),VFR(7),o[1],0,0,0), C1,12); \
    }while(0)
  int t=1;
  for(;t+5<NT;t+=2){
    STEP(pB0,pB1,pA0,pA1,t,true,true,true);     WAIT_BAR(2); RESC(); ROT();
    STEP(pA0,pA1,pB0,pB1,t+1,true,true,true);   WAIT_BAR(2); RESC(); ROT();
  }
  #define ENDW(tt) do{ if((tt)+3<NT){WAIT_BAR(2);} else if((tt)+2<NT){WAIT_BAR(1);} else {WAIT_BAR(0);} }while(0)
  for(;t+1<NT;t+=2){
    STEP(pB0,pB1,pA0,pA1,t,(t+3<NT),(t+1<NT),(t+1<NT));       ENDW(t);   RESC(); ROT();
    STEP(pA0,pA1,pB0,pB1,t+1,(t+4<NT),(t+2<NT),(t+2<NT));     ENDW(t+1); RESC(); ROT();
  }
  STEP(pB0,pB1,pA0,pA1,NT-1,false,false,false); RESC();
  { float sacc=pB0[0]+pB0[1]; _Pragma("unroll") for(int r=2;r<16;++r)sacc+=pB0[r]; _Pragma("unroll") for(int r=0;r<16;++r)sacc+=pB1[r]; l_reg+=sacc;
    pw0=(u32x4){PKW(pB0,0),PKW(pB0,2),PKW(pB0,4),PKW(pB0,6)};pw1=(u32x4){PKW(pB0,8),PKW(pB0,10),PKW(pB0,12),PKW(pB0,14)};pw2=(u32x4){PKW(pB1,0),PKW(pB1,2),PKW(pB1,4),PKW(pB1,6)};pw3=(u32x4){PKW(pB1,8),PKW(pB1,10),PKW(pB1,12),PKW(pB1,14)};
    SBAR(); pv(o,vb0+sl_cur,PAF(0),PAF(1),PAF(2),PAF(3)); }
  #undef PKW
  #undef PAF
  #undef VFR
  #undef PIN
  #undef MX3
  #undef GAPA
  #undef GAPB
  #undef EX
  #undef VRD
  #undef KRD
  #undef STEP
  #undef ENDW
  {auto rr=__builtin_amdgcn_permlane32_swap(__float_as_uint(l_reg),__float_as_uint(l_reg),false,false);l_reg=__uint_as_float(rr[0])+__uint_as_float(rr[1]);}
  if(hi==0)wsf[32+r32]=l_reg;asm volatile("s_waitcnt lgkmcnt(0)":::"memory");
  float rli[16];
  #pragma unroll
  for(int r=0;r<16;++r)rli[r]=__builtin_amdgcn_rcpf(wsf[32+crow(r,hi)]);
  bf16*Ow=Ou+(long)(wid*QBLK)*QP;
  { bf16*stg=(bf16*)(shm+LDS_OST)+wid*2048;
    #pragma unroll
    for(int r=0;r<16;++r){const int orow=crow(r,hi);
      #pragma unroll
      for(int d0=0;d0<2;++d0)stg[orow*64+d0*32+r32]=__float2bfloat16(o[d0][r]*rli[r]);}
    asm volatile("s_waitcnt lgkmcnt(0)":::"memory");
    #pragma unroll
    for(int i=0;i<4;++i){const int row=i*8+(lane>>3),ch=lane&7; const u32x4 v=*(const u32x4*)(stg+row*64+ch*8); ATTN_STORE16(Ow+(long)row*QP+ch*8,v);} }
  asm volatile("s_waitcnt lgkmcnt(0)\n\ts_barrier":::"memory");
  #undef DMA_K
  #undef DMA_V
  #undef CMASK
  #undef START
  #undef RESC
  #undef ROT
}
constexpr int ATTN_LDS_BYTES=LDS_BYTES;
#undef SBAR
#undef WAIT_BAR
}

#define XB_TMO      128
#define XB_XCNT(j)  (256  + 64 * (j))
#define XB_XSUB(j)  (1280 + 64 * (j))
#define XB_XGEN(j)  (2304 + 64 * (j))
#define XB_TOP      3328
#define XB_TOPGEN   3392
#define XCD_BAR_WORDS 3456
#define XB_SPIN_CAP (1u << 18)

__device__ __forceinline__ unsigned xb_ld(unsigned* p)              { return __hip_atomic_load(p, __ATOMIC_RELAXED, __HIP_MEMORY_SCOPE_AGENT); }
__device__ __forceinline__ unsigned xb_add(unsigned* p, unsigned v) { return __hip_atomic_fetch_add(p, v, __ATOMIC_RELAXED, __HIP_MEMORY_SCOPE_AGENT); }
__device__ __forceinline__ unsigned xb_xcc_id() { return (unsigned)__builtin_amdgcn_s_getreg((3 << 11) | 20) & 0xFu; }
#define XB_SPIN(cond, bar) do { unsigned _sp = 0; while (cond) { __builtin_amdgcn_s_sleep(1); \
    if ((++_sp & 255u) == 0u) { if (xb_ld(&(bar)[XB_TMO])) break; if (_sp > XB_SPIN_CAP) { atomicAdd(&(bar)[XB_TMO], 1u); break; } } } } while (0)

struct XcdBarrier {
    unsigned* bar; unsigned x;
    volatile LAS unsigned* st;
};

__device__ __forceinline__ XcdBarrier xcd_barrier_post(unsigned* bar, volatile LAS unsigned* st) {
    XcdBarrier b; b.bar = bar; b.x = xb_xcc_id(); b.st = st;
    if (threadIdx.x == 0) (void)xb_add(&bar[XB_XCNT(b.x)], 1u);
    return b;
}
__device__ __forceinline__ void xcd_barrier_complete(unsigned* bar, unsigned x, unsigned& nloc, unsigned& nx) {
    const unsigned G = gridDim.x * gridDim.y * gridDim.z;
    unsigned sum, cnt, mine, sp = 0u;
    for (;;) {
        sum = 0u; cnt = 0u; mine = 0u;
#pragma unroll
        for (unsigned j = 0; j < 16; ++j) { const unsigned c = xb_ld(&bar[XB_XCNT(j)]); sum += c; cnt += (c > 0u) ? 1u : 0u; mine = (j == x) ? c : mine; }
        if (sum == G) break;
        __builtin_amdgcn_s_sleep(1);
        if ((++sp & 255u) == 0u) { if (xb_ld(&bar[XB_TMO])) break; if (sp > XB_SPIN_CAP) { atomicAdd(&bar[XB_TMO], 1u); break; } }
    }
    nloc = mine > 0u ? mine : 1u; nx = cnt > 0u ? cnt : 1u;
}

__device__ __forceinline__ void xcd_barrier(const XcdBarrier& b) {
    asm volatile("s_waitcnt vmcnt(0)" ::: "memory");
    __syncthreads();
    if (threadIdx.x == 0) {
        unsigned* bar = b.bar;
        __builtin_amdgcn_s_waitcnt(0);
        unsigned nloc = b.st[0], nx = b.st[1];
        if (nloc == 0u) { xcd_barrier_complete(bar, b.x, nloc, nx); b.st[0] = nloc; b.st[1] = nx; }
        const unsigned old = xb_add(&bar[XB_XSUB(b.x)], 1u);
        const unsigned gen = old / nloc;
        if (old + 1u == (gen + 1u) * nloc) {
            __builtin_amdgcn_fence(__ATOMIC_RELEASE, "agent");
            asm volatile("s_waitcnt vmcnt(0)" ::: "memory");
            const unsigned og = xb_add(&bar[XB_TOP], 1u);
            const unsigned tg = og / nx;
            if (og + 1u == (tg + 1u) * nx) xb_add(&bar[XB_TOPGEN], 1u);
            else XB_SPIN(xb_ld(&bar[XB_TOPGEN]) == tg, bar);
            __builtin_amdgcn_fence(__ATOMIC_ACQUIRE, "agent");
            xb_add(&bar[XB_XGEN(b.x)], 1u);
            asm volatile("s_waitcnt vmcnt(0)" ::: "memory");
        } else {
            XB_SPIN(xb_ld(&bar[XB_XGEN(b.x)]) == gen, bar);
            __builtin_amdgcn_fence(__ATOMIC_ACQUIRE, "agent");
            asm volatile("s_waitcnt vmcnt(0)" ::: "memory");
        }
    }
    __syncthreads();
}

struct Args { const float* in[33]; float* out; unsigned char* ws; int mode, l, site, chunk; };
struct Frame {
    LAS unsigned char* lds; volatile LAS unsigned* MISC; gu32* ctl;
    int tid, lane, wave, vcu, G;
    unsigned char* ws; float* out;
};
#define WSP(T, off) ((T*)(F.ws + (off)))
__device__ __forceinline__ const float* inptr(LAS unsigned char* lds, int i) { const LAS unsigned* p = (const LAS unsigned*)(lds + PTAB_OFF) + 2 * i; const unsigned lo = __builtin_amdgcn_readfirstlane(p[0]), hi = __builtin_amdgcn_readfirstlane(p[1]); return (const float*)(((unsigned long long)hi << 32) | lo); }
#define INP(i) inptr(F.lds, (i))

__device__ __forceinline__ void conv_item(const float* W, int Nsrc, int k0, int c0, bf16* WT, int K, int drow0, LAS float* scr, int lane) {
#pragma unroll 8
    for (int i = 0; i < 32; ++i) { const int kk = 2 * i + (lane >> 5); scr[kk * 33 + (lane & 31)] = W[(size_t)(k0 + kk) * Nsrc + c0 + (lane & 31)]; }
    LDS_WAIT(); asm volatile("" ::: "memory");
    const int c = lane & 7;
#pragma unroll
    for (int j = 0; j < 4; ++j) { const int n = (lane >> 3) + 8 * j; const LAS float* s = scr + (8 * c) * 33 + n;
        v4u o; o.x = pk2(s[0 * 33], s[1 * 33]); o.y = pk2(s[2 * 33], s[3 * 33]); o.z = pk2(s[4 * 33], s[5 * 33]); o.w = pk2(s[6 * 33], s[7 * 33]);
        *(GAS v4u*)(WT + (size_t)(drow0 + n) * K + k0 + 8 * c) = o; }
    LDS_WAIT(); asm volatile("" ::: "memory");
}
__device__ __forceinline__ void conv_plain(int item, const float* W, int K, int N, bf16* WT, LAS float* scr, int lane) {
    const int ng = N / 32, kb = item / ng, g = item % ng; conv_item(W, N, 64 * kb, 32 * g, WT, K, 32 * g, scr, lane);
}
__device__ __forceinline__ void conv_gu(int item, const float* W, bf16* WT, int off, LAS float* scr, int lane) {
    const int ng = FF / 32, kb = item / ng, g = item % ng; conv_item(W, FF, 64 * kb, 32 * g, WT, DM, 256 * (g >> 2) + off + 32 * (g & 3), scr, lane);
}
__device__ __forceinline__ void mod_task(Frame& F, int task) {
    const int l = task / 96, nb = task % 96;
    LAS float* S = (LAS float*)F.lds;
    for (int i = F.tid; i < 33 * 1024; i += 512) { const int bi = i >> 10, k = i & 1023; const float c = bi < 32 ? INP(1)[bi * 1024 + k] : INP(3)[k]; S[k * 33 + bi] = c / (1.0f + __expf(-c)); }
    __syncthreads();
    const float* W = INP(4) + (size_t)l * DM * 6144 + nb * 64 + F.lane;
    float acc[33];
#pragma unroll
    for (int bi = 0; bi < 33; ++bi) acc[bi] = 0.f;
    const int k0 = F.wave * 128;
    for (int k = k0; k < k0 + 128; ++k) { const float w = W[(size_t)k * 6144];
#pragma unroll
        for (int bi = 0; bi < 33; ++bi) acc[bi] = fmaf(S[k * 33 + bi], w, acc[bi]); }
    __syncthreads();
    LAS float* P = (LAS float*)F.lds;
#pragma unroll
    for (int bi = 0; bi < 33; ++bi) P[(F.wave * 33 + bi) * 64 + F.lane] = acc[bi];
    __syncthreads();
    float* mod = WSP(float, WS_MOD);
    for (int o = F.tid; o < 33 * 64; o += 512) { const int bi = o >> 6, cc = o & 63; float s = 0.f;
#pragma unroll
        for (int w = 0; w < 8; ++w) s += P[(w * 33 + bi) * 64 + cc];
        const int n = nb * 64 + cc; mod[(size_t)(l * 33 + bi) * 6144 + n] = s + INP(5)[l * 6144 + n]; }
    __syncthreads();
}
__device__ __forceinline__ void p0_prologue(Frame& F) {
    for (int t = F.vcu; t < 192; t += F.G) mod_task(F, t);
    if (F.vcu == F.G - 1) { float* rt = WSP(float, WS_ROPE);
        for (int i = F.tid; i < 1024; i += 512) { const int pos = i >> 4, f = i & 15; const float inv = powf(10000.0f, -(float)f / 16.0f); const float a = (float)pos * inv; rt[i] = cosf(a); rt[1024 + i] = sinf(a); } }
    LAS float* scr = (LAS float*)(F.lds + F.wave * 8448);
    const int gw = F.vcu * NWAVES + F.wave, NGW = F.G * NWAVES;
    constexpr int I_IN = 16 * 144, I_P = 8 * 32, I_O = 16 * 32, I_GU = 16 * 112, I_DN = 56 * 32, I_L = 16, I_G2 = 32;
    constexpr int NITEMS = 2 * I_IN + 4 * I_P + 2 * I_O + 2 * I_GU + I_DN + 8 * I_L + 2 * I_G2;
    bf16* lora = WSP(bf16, WS_LORA);
    for (int it = gw; it < NITEMS; it += NGW) {
        int r = it;
        if (r < 2 * I_IN) { const int l = r / I_IN; conv_plain(r % I_IN, INP(8) + (size_t)l * DM * NIN, DM, NIN, WSP(bf16, WS_WIN) + (size_t)l * NIN * DM, scr, F.lane); continue; } r -= 2 * I_IN;
        if (r < 2 * I_P) { const int l = r / I_P; conv_plain(r % I_P, INP(22) + (size_t)l * RW * DM, RW, DM, WSP(bf16, WS_WPA) + (size_t)l * DM * RW, scr, F.lane); continue; } r -= 2 * I_P;
        if (r < 2 * I_P) { const int l = r / I_P; conv_plain(r % I_P, INP(23) + (size_t)l * RW * DM, RW, DM, WSP(bf16, WS_WPB) + (size_t)l * DM * RW, scr, F.lane); continue; } r -= 2 * I_P;
        if (r < 2 * I_O) { const int l = r / I_O; conv_plain(r % I_O, INP(24) + (size_t)l * DM * DM, DM, DM, WSP(bf16, WS_WO) + (size_t)l * DM * DM, scr, F.lane); continue; } r -= 2 * I_O;
        if (r < I_GU) { conv_gu(r, INP(25), WSP(bf16, WS_WGU), 0, scr, F.lane); continue; } r -= I_GU;
        if (r < I_GU) { conv_gu(r, INP(26), WSP(bf16, WS_WGU), 128, scr, F.lane); continue; } r -= I_GU;
        if (r < I_DN) { conv_plain(r, INP(27), FF, DM, WSP(bf16, WS_WDN), scr, F.lane); continue; } r -= I_DN;
        if (r < 4 * I_L) { const int ld = r / I_L; conv_plain(r % I_L, INP(11) + (size_t)ld * 64 * RW, 64, RW, lora + (size_t)ld * RW * 64, scr, F.lane); continue; } r -= 4 * I_L;
        if (r < 4 * I_L) { const int ld = r / I_L; conv_plain(r % I_L, INP(13) + (size_t)ld * 64 * RW, 64, RW, lora + (size_t)(4 + ld) * RW * 64, scr, F.lane); continue; } r -= 4 * I_L;
        { const int l = r / I_G2; conv_plain(r % I_G2, INP(14) + (size_t)l * 128 * RW, 128, RW, lora + (size_t)8 * RW * 64 + (size_t)l * RW * 128, scr, F.lane); }
    }
}
__device__ __forceinline__ void moe_conv(Frame& F) {
    LAS float* scr = (LAS float*)(F.lds + F.wave * 8448);
    const int gw = F.vcu * NWAVES + F.wave, NGW = F.G * NWAVES;
    constexpr int I_GU = 16 * 112, I_DN = 56 * 32, I_E = 2 * I_GU + I_DN;
    for (int it = gw; it < NE * I_E; it += NGW) {
        const int e = it / I_E; int r = it % I_E; bf16* base = WSP(bf16, WS_MW) + (size_t)e * (21 * MiB / 2);
        if (r < I_GU) { conv_gu(r, INP(29) + (size_t)e * DM * FF, base, 0, scr, F.lane); continue; } r -= I_GU;
        if (r < I_GU) { conv_gu(r, INP(30) + (size_t)e * DM * FF, base, 128, scr, F.lane); continue; } r -= I_GU;
        conv_plain(r, INP(31) + (size_t)e * FF * DM, FF, DM, base + (size_t)2 * FF * DM, scr, F.lane);
    }
}

template <bool ROUTER>
__device__ __forceinline__ void norm_mod_phase(Frame& F, int l, int which, const float* xlat, const float* xctx, int nrows, bf16* H) {
    const int gw = F.vcu * NWAVES + F.wave, NGW = F.G * NWAVES;
    const float* gain = INP(which ? 7 : 6) + l * DM;
    const float* modl = WSP(float, WS_MOD) + (size_t)l * 33 * 6144 + (which ? 3072 : 0);
    for (int m = gw; m < nrows; m += NGW) {
        const float* xr = m < NL ? xlat + (size_t)m * DM : xctx + (size_t)(m - NL) * DM;
        const float* mv = modl + (size_t)row_bi(m) * 6144;
        f32x4 v[4]; float s = 0.f;
#pragma unroll
        for (int j = 0; j < 4; ++j) { v[j] = *(const f32x4*)(xr + 4 * F.lane + 256 * j); s += (v[j].x * v[j].x + v[j].y * v[j].y) + (v[j].z * v[j].z + v[j].w * v[j].w); }
        const float rstd = 1.0f / sqrtf(wave_sum(s) * (1.0f / DM) + 1e-6f);
        float lg[8];
        if (ROUTER) {
#pragma unroll
            for (int e = 0; e < 8; ++e) lg[e] = 0.f; }
#pragma unroll
        for (int j = 0; j < 4; ++j) { const int c = 4 * F.lane + 256 * j;
            const f32x4 g = *(const f32x4*)(gain + c), sh = *(const f32x4*)(mv + c), sc = *(const f32x4*)(mv + 1024 + c);
            const f32x4 hv = v[j] * rstd * g * (sc + 1.0f) + sh;
            v2u o; o.x = pk2(hv.x, hv.y); o.y = pk2(hv.z, hv.w);
            *(v2u*)(H + (size_t)m * DM + c) = o;
            if (ROUTER) { const float* rw = INP(28) + (size_t)c * 8;
#pragma unroll
                for (int q = 0; q < 4; ++q) { const f32x4 r0 = *(const f32x4*)(rw + q * 8), r1 = *(const f32x4*)(rw + q * 8 + 4); const float hq = hv[q];
                    lg[0] = fmaf(hq, r0.x, lg[0]); lg[1] = fmaf(hq, r0.y, lg[1]); lg[2] = fmaf(hq, r0.z, lg[2]); lg[3] = fmaf(hq, r0.w, lg[3]);
                    lg[4] = fmaf(hq, r1.x, lg[4]); lg[5] = fmaf(hq, r1.y, lg[5]); lg[6] = fmaf(hq, r1.z, lg[6]); lg[7] = fmaf(hq, r1.w, lg[7]); } }
        }
        if (ROUTER) {
#pragma unroll
            for (int e = 0; e < 8; ++e) lg[e] = wave_sum(lg[e]);
            int e0 = 0; float l0 = lg[0];
#pragma unroll
            for (int e = 1; e < 8; ++e) if (lg[e] > l0) { l0 = lg[e]; e0 = e; }
            int e1 = -1; float l1 = -INFINITY;
#pragma unroll
            for (int e = 0; e < 8; ++e) if (e != e0 && lg[e] > l1) { l1 = lg[e]; e1 = e; }
            const float w1 = 1.0f / (1.0f + __expf(l0 - l1)), w0 = 1.0f - w1;
            if (F.lane == 0) {
                int* te = (int*)(F.ws + WS_MOETAB + MT_TOKE) + 2 * m; float* tw = (float*)(F.ws + WS_MOETAB + MT_TOKW) + 2 * m;
                te[0] = e0; te[1] = e1; tw[0] = w0; tw[1] = w1;
                __hip_atomic_fetch_add((LAS unsigned*)&F.MISC[16 + e0], 1u, __ATOMIC_RELAXED, __HIP_MEMORY_SCOPE_WORKGROUP); __hip_atomic_fetch_add((LAS unsigned*)&F.MISC[16 + e1], 1u, __ATOMIC_RELAXED, __HIP_MEMORY_SCOPE_WORKGROUP);
            }
        }
    }
    if (ROUTER) { __syncthreads(); if (F.tid < 8) { const unsigned c = F.MISC[16 + F.tid]; if (c) __hip_atomic_fetch_add(F.ctl + CW_HIST + 64 * F.tid, c, RLX_AGENT); } __syncthreads(); }
}

using pg8::Unit;
struct EpiIn {
    static constexpr bool PERM = true, AFTER_DRAIN = false;
    bf16 *PR, *Q, *KB, *VB, *G;
    __device__ __forceinline__ void operator()(const f32x4 (&acc)[2][2][4][2], const Unit& u, int wr, int wc, int fr, int fq) const {
        const int row0 = u.pm * 256 + wr * 64 + fr, cb = wc * 32 + 8 * fq, pn = u.pn;
#pragma unroll
        for (int ai = 0; ai < 2; ++ai)
#pragma unroll
            for (int m = 0; m < 4; ++m) { const int r = row0 + ai * 128 + m * 16;
#pragma unroll
                for (int bj = 0; bj < 2; ++bj) { f32x4 v0 = acc[ai][bj][m][0], v1 = acc[ai][bj][m][1]; bf16* dst;
                    if (pn < 7) dst = PR + (size_t)r * RCOLS + pn * 256 + bj * 128 + cb;
                    else if (pn < 9) dst = Q + (size_t)r * 512 + (pn - 7) * 256 + bj * 128 + cb;
                    else if (pn == 9) dst = (bj == 0 ? KB : VB) + (size_t)row_kv(r) * 128 + cb;
                    else { dst = G + (size_t)r * GCOLS + (pn - 10) * 256 + bj * 128 + cb;
#pragma unroll
                        for (int q = 0; q < 4; ++q) { v0[q] = sigmoidf_(v0[q]); v1[q] = sigmoidf_(v1[q]); } }
                    v4u w; w.x = pk2(v0[0], v0[1]); w.y = pk2(v0[2], v0[3]); w.z = pk2(v1[0], v1[1]); w.w = pk2(v1[2], v1[3]);
                    *(v4u*)dst = w; } }
    }
};
template <int MODE> struct EpiMerge {
    static constexpr bool PERM = true, AFTER_DRAIN = false;
    const bf16* G; bf16* MG;
    __device__ __forceinline__ void operator()(const f32x4 (&acc)[2][2][4][2], const Unit& u, int wr, int wc, int fr, int fq) const {
        const int row0 = u.pm * 256 + wr * 64 + fr, col0 = u.pn * 256 + wc * 32 + 8 * fq;
#pragma unroll
        for (int ai = 0; ai < 2; ++ai)
#pragma unroll
            for (int m = 0; m < 4; ++m) { const int r = row0 + ai * 128 + m * 16;
#pragma unroll
                for (int bj = 0; bj < 2; ++bj) { const int c = col0 + bj * 128;
                    const v4u g = *(const v4u*)(G + (size_t)r * GCOLS + MODE * DM + c);
                    const f32x4 a0 = acc[ai][bj][m][0], a1 = acc[ai][bj][m][1];
                    float o[8] = { bflo(g.x) * a0[0], bfhi(g.x) * a0[1], bflo(g.y) * a0[2], bfhi(g.y) * a0[3], bflo(g.z) * a1[0], bfhi(g.z) * a1[1], bflo(g.w) * a1[2], bfhi(g.w) * a1[3] };
                    bf16* dst = MG + (size_t)r * DM + c;
                    if (MODE == 1) { const v4u p = *(const v4u*)dst; o[0] += bflo(p.x); o[1] += bfhi(p.x); o[2] += bflo(p.y); o[3] += bfhi(p.y); o[4] += bflo(p.z); o[5] += bfhi(p.z); o[6] += bflo(p.w); o[7] += bfhi(p.w); }
                    v4u w; w.x = pk2(o[0], o[1]); w.y = pk2(o[2], o[3]); w.z = pk2(o[4], o[5]); w.w = pk2(o[6], o[7]);
                    *(v4u*)dst = w; } }
    }
};
struct EpiRes {
    static constexpr bool PERM = false, AFTER_DRAIN = false;
    const float *base_lat, *base_ctx; float *out_lat, *out_ctx; const float* gt;
    __device__ __forceinline__ void operator()(const f32x4 (&acc)[2][2][4][2], const Unit& u, int wr, int wc, int fr, int fq) const {
        const bool lat = u.pm < NL / 256; const int bi = lat ? (u.pm >> 3) : 32;
        const int rr0 = (lat ? u.pm * 256 : u.pm * 256 - NL) + wr * 64 + fr, col0 = u.pn * 256 + wc * 32 + 4 * fq;
        const float* bp = lat ? base_lat : base_ctx; float* op = lat ? out_lat : out_ctx; const float* gv = gt + (size_t)bi * 6144 + col0;
        f32x4 g[2][2];
#pragma unroll
        for (int bj = 0; bj < 2; ++bj)
#pragma unroll
            for (int n = 0; n < 2; ++n) g[bj][n] = *(const f32x4*)(gv + bj * 128 + n * 16);
#pragma unroll
        for (int ai = 0; ai < 2; ++ai)
#pragma unroll
            for (int m = 0; m < 4; ++m) { const size_t off = (size_t)(rr0 + ai * 128 + m * 16) * DM + col0;
#pragma unroll
                for (int bj = 0; bj < 2; ++bj)
#pragma unroll
                    for (int n = 0; n < 2; ++n) { const f32x4 b = *(const f32x4*)(bp + off + bj * 128 + n * 16); *(f32x4*)(op + off + bj * 128 + n * 16) = b + g[bj][n] * acc[ai][bj][m][n]; }
                asm volatile("" ::: "memory"); }
    }
};
struct EpiGU {
    static constexpr bool PERM = true, AFTER_DRAIN = false;
    bf16* ACT; int pm0;
    __device__ __forceinline__ void operator()(const f32x4 (&acc)[2][2][4][2], const Unit& u, int wr, int wc, int fr, int fq) const {
        const int row0 = (u.pm - pm0) * 256 + wr * 64 + fr, col0 = u.pn * 128 + wc * 32 + 8 * fq;
#pragma unroll
        for (int ai = 0; ai < 2; ++ai)
#pragma unroll
            for (int m = 0; m < 4; ++m) { const int r = row0 + ai * 128 + m * 16; float o[8];
#pragma unroll
                for (int n = 0; n < 2; ++n)
#pragma unroll
                    for (int q = 0; q < 4; ++q) { const float gte = acc[ai][0][m][n][q], up = acc[ai][1][m][n][q]; o[4 * n + q] = gte * sigmoidf_(gte) * up; }
                v4u w; w.x = pk2(o[0], o[1]); w.y = pk2(o[2], o[3]); w.z = pk2(o[4], o[5]); w.w = pk2(o[6], o[7]);
                *(v4u*)(ACT + (size_t)r * FF + col0) = w; }
    }
};
struct EpiStore {
    static constexpr bool PERM = true, AFTER_DRAIN = false;
    bf16* O;
    __device__ __forceinline__ void operator()(const f32x4 (&acc)[2][2][4][2], const Unit& u, int wr, int wc, int fr, int fq) const {
        const int row0 = u.pm * 256 + wr * 64 + fr, col0 = u.pn * 256 + wc * 32 + 8 * fq;
#pragma unroll
        for (int ai = 0; ai < 2; ++ai)
#pragma unroll
            for (int m = 0; m < 4; ++m) { const int r = row0 + ai * 128 + m * 16;
#pragma unroll
                for (int bj = 0; bj < 2; ++bj) { const f32x4 v0 = acc[ai][bj][m][0], v1 = acc[ai][bj][m][1];
                    v4u w; w.x = pk2(v0[0], v0[1]); w.y = pk2(v0[2], v0[3]); w.z = pk2(v1[0], v1[1]); w.w = pk2(v1[2], v1[3]);
                    *(v4u*)(O + (size_t)r * DM + col0 + bj * 128) = w; } }
    }
};
struct MoeOrder {
    const char* A; const char* W; size_t a_tstep, b_tstep, w_estep; int tile0, a_tile0, ntl, nN, G, c; const LAS int* tile_e;
    __device__ bool next(int i, Unit& u) const { const long L = (long)i * G + c; if (L >= (long)ntl * nN) return false; u.pn = (int)(L / ntl); u.pm = tile0 + (int)(L % ntl); return true; }
    __device__ __forceinline__ const char* a_base(const Unit& u) const { return A + (size_t)(u.pm - a_tile0) * a_tstep; }
    __device__ __forceinline__ const char* b_base(const Unit& u) const { return W + (size_t)tile_e[u.pm] * w_estep + (size_t)u.pn * b_tstep; }
    __device__ __forceinline__ void a_ready(const Unit&) const {}
    __device__ __forceinline__ void done(const Unit&) const {}
};

__device__ __forceinline__ void qk_phase(Frame& F, int l) {
    const int gw = F.vcu * NWAVES + F.wave, NGW = F.G * NWAVES, lane = F.lane, d0 = 8 * (lane & 7);
    const float* rt = WSP(float, WS_ROPE);
    bf16* Q = WSP(bf16, WS_Q); bf16* KB = WSP(bf16, WS_KB);
    float gq[8], gk[8];
#pragma unroll
    for (int e = 0; e < 8; ++e) { gq[e] = INP(20)[l * 64 + d0 + e]; gk[e] = INP(21)[l * 64 + d0 + e]; }
    for (int m = gw; m < MA; m += NGW) {
        const bool lat = m < NL; const int t = m & 2047, pr = t >> 6, pc = t & 63;
        float cs[4], sn[4];
        if (lat) {
#pragma unroll
            for (int pi = 0; pi < 4; ++pi) { const int i = 4 * (lane & 7) + pi, pos = i < 16 ? pr : pc, f = i & 15; cs[pi] = rt[pos * 16 + f]; sn[pi] = rt[1024 + pos * 16 + f]; } }
        { bf16* p = Q + (size_t)m * 512 + 8 * lane; const v4u w = *(const v4u*)p;
          float x[8] = { bflo(w.x), bfhi(w.x), bflo(w.y), bfhi(w.y), bflo(w.z), bfhi(w.z), bflo(w.w), bfhi(w.w) };
          float ss = 0.f;
#pragma unroll
          for (int e = 0; e < 8; ++e) ss += x[e] * x[e];
          ss += __shfl_xor(ss, 1); ss += __shfl_xor(ss, 2); ss += __shfl_xor(ss, 4);
          const float r = 1.0f / sqrtf(ss * (1.0f / 64.0f) + 1e-6f);
#pragma unroll
          for (int e = 0; e < 8; ++e) x[e] = x[e] * r * gq[e];
          if (lat) {
#pragma unroll
              for (int pi = 0; pi < 4; ++pi) { const float x0 = x[2 * pi], x1 = x[2 * pi + 1]; x[2 * pi] = x0 * cs[pi] - x1 * sn[pi]; x[2 * pi + 1] = x0 * sn[pi] + x1 * cs[pi]; } }
          const float C2 = attn_body::C2;
          v4u o; o.x = pk2(x[0] * C2, x[1] * C2); o.y = pk2(x[2] * C2, x[3] * C2); o.z = pk2(x[4] * C2, x[5] * C2); o.w = pk2(x[6] * C2, x[7] * C2);
          *(v4u*)p = o; }
        { bf16* p = KB + (size_t)row_kv(m) * 128 + 8 * (lane & 15); v4u w = (v4u){0u, 0u, 0u, 0u}; if (lane < 16) w = *(const v4u*)p;
          float x[8] = { bflo(w.x), bfhi(w.x), bflo(w.y), bfhi(w.y), bflo(w.z), bfhi(w.z), bflo(w.w), bfhi(w.w) };
          float ss = 0.f;
#pragma unroll
          for (int e = 0; e < 8; ++e) ss += x[e] * x[e];
          ss += __shfl_xor(ss, 1); ss += __shfl_xor(ss, 2); ss += __shfl_xor(ss, 4);
          const float r = 1.0f / sqrtf(ss * (1.0f / 64.0f) + 1e-6f);
#pragma unroll
          for (int e = 0; e < 8; ++e) x[e] = x[e] * r * gk[e];
          if (lat) {
#pragma unroll
              for (int pi = 0; pi < 4; ++pi) { const float x0 = x[2 * pi], x1 = x[2 * pi + 1]; x[2 * pi] = x0 * cs[pi] - x1 * sn[pi]; x[2 * pi + 1] = x0 * sn[pi] + x1 * cs[pi]; } }
          v4u o; o.x = pk2(x[0], x[1]); o.y = pk2(x[2], x[3]); o.z = pk2(x[4], x[5]); o.w = pk2(x[6], x[7]);
          if (lane < 16) *(v4u*)p = o; }
    }
}

constexpr int SC_RAW = 0, SC_SV = 11520, SC_KT = SC_SV + 24576, SC_KK = SC_KT + 4096, SC_TWA = SC_KK + 4096, SC_ADA = SC_TWA + 2304, SC_YO = SC_ADA + 2304, SC_BON = SC_YO + 4096, SC_DIR = SC_BON + 256;
static_assert(2 * SC_DIR <= RING_BYTES, "scan LDS");
__device__ __forceinline__ float dpp_quad_sum(float v) {
    v += __builtin_bit_cast(float, __builtin_amdgcn_mov_dpp(__builtin_bit_cast(int, v), 0xB1, 0xF, 0xF, true));
    v += __builtin_bit_cast(float, __builtin_amdgcn_mov_dpp(__builtin_bit_cast(int, v), 0x4E, 0xF, 0xF, true));
    return v;
}
__device__ __forceinline__ void scan_phase(Frame& F, int l) {
    const int d = F.tid >> 8, dt = F.tid & 255, w4 = F.wave & 3, lane = F.lane;
    LAS unsigned char* L = F.lds + d * SC_DIR;
    LAS float* SV = (LAS float*)(L + SC_SV); LAS float* KT = (LAS float*)(L + SC_KT); LAS float* KK = (LAS float*)(L + SC_KK);
    LAS float* YO = (LAS float*)(L + SC_YO); LAS float* BON = (LAS float*)(L + SC_BON);
    const bf16* PR = WSP(bf16, WS_PR);
    bf16* Yd = WSP(bf16, d == 0 ? WS_YF : WS_YB);
    float* bonus = WSP(float, WS_BONUS) + (size_t)d * MA * 8;
    const int j = dt >> 4, cg = dt & 15;
    const int st_j = d == 0 ? j : 15 - j;
    for (int p = F.vcu; p < NB * 8; p += F.G) {
        const int b = p >> 3, h = p & 7;
        const bf16* w2t = WSP(bf16, WS_LORA) + (size_t)((l * 2 + d) * RW + h * 64 + 16 * w4 + (lane & 15)) * 64 + 8 * (lane >> 4);
        const bf16* a2t = w2t + (size_t)4 * RW * 64;
        const int ccol = h * 64 + 16 * w4 + (lane & 15);
        const float w0c = INP(10)[(l * 2 + d) * RW + ccol], a0c = INP(12)[(l * 2 + d) * RW + ccol], kac = INP(16)[l * RW + ccol], rkc = INP(17)[l * RW + ccol];
        const float* mup = INP(9) + (size_t)(l * 2) * RCOLS + 4 * cg; const float* kkp = INP(15) + l * RW + h * 64 + 4 * cg;
        float S[16];
#pragma unroll
        for (int i = 0; i < 16; ++i) S[i] = 0.f;
        v4u raw[3];
#define SC_GEOM(c) const int s0_ = 16 * (c); const bool isctx_ = s0_ < TC; const int pos0_ = isctx_ ? s0_ : s0_ - TC; const int len_ = isctx_ ? TC : TL; \
        const int rowbase_ = isctx_ ? NL + b * TC : b * TL; const int toklo_ = d == 0 ? pos0_ : len_ - 16 - pos0_;
#define SC_LOAD(c) do { SC_GEOM(c) _Pragma("unroll") for (int i = 0; i < 3; ++i) { const int pp = dt + 256 * i; raw[i] = (v4u){0u, 0u, 0u, 0u}; \
            if (pp < 720) { const int row = pp / 40, rem = pp % 40, grp = rem >> 3, c8 = rem & 7; const int tr = toklo_ - 1 + row; \
                const int gc = grp == 0 ? h * 64 : grp == 1 ? 512 + h * 64 : grp == 2 ? 1024 + h * 64 : grp == 3 ? 1536 : 1600; \
                if (tr >= 0 && tr < len_) raw[i] = *(const v4u*)(PR + (size_t)(rowbase_ + tr) * RCOLS + gc + 8 * c8); } } } while (0)
        SC_LOAD(0);
        for (int c = 0; c < KVT / 16; ++c) {
            SC_GEOM(c)
#pragma unroll
            for (int i = 0; i < 3; ++i) { const int pp = dt + 256 * i; if (pp < 720) { const int row = pp / 40, rem = pp % 40; *(LAS v4u*)(L + SC_RAW + (row * 320 + rem * 8) * 2) = raw[i]; } }
            __syncthreads();
            if (c + 1 < KVT / 16) SC_LOAD(c + 1);
            {
                f32x4 xs[5];
#pragma unroll
                for (int g = 0; g < 5; ++g) {
                    const v2u a0 = *(const LAS v2u*)(L + SC_RAW + ((j + 0) * 320 + g * 64 + 4 * cg) * 2), a1 = *(const LAS v2u*)(L + SC_RAW + ((j + 1) * 320 + g * 64 + 4 * cg) * 2), a2 = *(const LAS v2u*)(L + SC_RAW + ((j + 2) * 320 + g * 64 + 4 * cg) * 2);
                    const f32x4 x0 = (f32x4){bflo(a0.x), bfhi(a0.x), bflo(a0.y), bfhi(a0.y)}, x1 = (f32x4){bflo(a1.x), bfhi(a1.x), bflo(a1.y), bfhi(a1.y)}, x2 = (f32x4){bflo(a2.x), bfhi(a2.x), bflo(a2.y), bfhi(a2.y)};
                    const int gc = g == 0 ? h * 64 : g == 1 ? 512 + h * 64 : g == 2 ? 1024 + h * 64 : g == 3 ? 1536 : 1600;
                    const f32x4 mu0 = *(const f32x4*)(mup + gc), mu1 = *(const f32x4*)(mup + RCOLS + gc);
                    xs[g] = x1 + mu0 * (x0 - x1) + mu1 * (x2 - x1);
                }
                *(LAS f32x4*)(SV + (0 * 16 + st_j) * 64 + 4 * cg) = xs[0];
                *(LAS f32x4*)(SV + (3 * 16 + st_j) * 64 + 4 * cg) = xs[2];
                *(LAS f32x4*)(KT + j * 64 + 4 * cg) = xs[1];
                const f32x4 kkf = xs[1] * *(const f32x4*)kkp; float ss = (kkf.x * kkf.x + kkf.y * kkf.y) + (kkf.z * kkf.z + kkf.w * kkf.w);
                ss += __shfl_xor(ss, 1); ss += __shfl_xor(ss, 2); ss += __shfl_xor(ss, 4); ss += __shfl_xor(ss, 8);
                const float inv = 1.0f / fmaxf(sqrtf(ss), 1e-12f); const f32x4 kk = kkf * inv;
                *(LAS f32x4*)(KK + j * 64 + 4 * cg) = kk;
                *(LAS f32x4*)(SV + (4 * 16 + st_j) * 64 + 4 * cg) = -kk;
                v2u tw; tw.x = pk2(tanhf(xs[3].x), tanhf(xs[3].y)); tw.y = pk2(tanhf(xs[3].z), tanhf(xs[3].w));
                *(LAS v2u*)(L + SC_TWA + (j * 72 + 4 * cg) * 2) = tw;
                v2u ad; ad.x = pk2(xs[4].x, xs[4].y); ad.y = pk2(xs[4].z, xs[4].w);
                *(LAS v2u*)(L + SC_ADA + (j * 72 + 4 * cg) * 2) = ad;
            }
            __syncthreads();
            {
                const int ao = ((lane & 15) * 72 + 8 * (lane >> 4)) * 2;
                const bf16x8 At0 = *(const LAS bf16x8*)(L + SC_TWA + ao), At1 = *(const LAS bf16x8*)(L + SC_TWA + ao + 64), Aa0 = *(const LAS bf16x8*)(L + SC_ADA + ao), Aa1 = *(const LAS bf16x8*)(L + SC_ADA + ao + 64);
                const bf16x8 Bw0 = *(const bf16x8*)w2t, Bw1 = *(const bf16x8*)(w2t + 32), Ba0 = *(const bf16x8*)a2t, Ba1 = *(const bf16x8*)(a2t + 32);
                f32x4 zw = (f32x4){0.f, 0.f, 0.f, 0.f}, za = (f32x4){0.f, 0.f, 0.f, 0.f};
                zw = __builtin_amdgcn_mfma_f32_16x16x32_bf16(At0, Bw0, zw, 0, 0, 0); zw = __builtin_amdgcn_mfma_f32_16x16x32_bf16(At1, Bw1, zw, 0, 0, 0);
                za = __builtin_amdgcn_mfma_f32_16x16x32_bf16(Aa0, Ba0, za, 0, 0, 0); za = __builtin_amdgcn_mfma_f32_16x16x32_bf16(Aa1, Ba1, za, 0, 0, 0);
                const int cl = 16 * w4 + (lane & 15);
#pragma unroll
                for (int i = 0; i < 4; ++i) { const int jj = 4 * (lane >> 4) + i, st = d == 0 ? jj : 15 - jj;
                    const float sg = sigmoidf_(w0c + zw[i]); SV[(1 * 16 + st) * 64 + cl] = __expf(-0.6065306597f * sg);
                    const float al = sigmoidf_(a0c + za[i]);
                    const float kv = KT[jj * 64 + cl] * (1.0f + (al - 1.0f) * kac); SV[(2 * 16 + st) * 64 + cl] = kv;
                    SV[(5 * 16 + st) * 64 + cl] = KK[jj * 64 + cl] * al;
                    float bp = SV[(0 * 16 + st) * 64 + cl] * kv * rkc;
                    bp += __shfl_xor(bp, 1); bp += __shfl_xor(bp, 2); bp += __shfl_xor(bp, 4); bp += __shfl_xor(bp, 8);
                    if ((lane & 15) == 0) BON[w4 * 16 + jj] = bp; }
            }
            __syncthreads();
            {
                const int ri = 16 * w4 + (lane >> 2), q = lane & 3;
#pragma unroll 1
                for (int s = 0; s < 16; ++s) {
                    const LAS float* base = SV + s * 64 + 16 * q;
                    f32x4 na[4], wv[4], bv[4], kv[4], rv[4];
#pragma unroll
                    for (int i = 0; i < 4; ++i) { na[i] = *(const LAS f32x4*)(base + 4 * 16 * 64 + 4 * i); wv[i] = *(const LAS f32x4*)(base + 1 * 16 * 64 + 4 * i); bv[i] = *(const LAS f32x4*)(base + 5 * 16 * 64 + 4 * i);
                        kv[i] = *(const LAS f32x4*)(base + 2 * 16 * 64 + 4 * i); rv[i] = *(const LAS f32x4*)(base + 4 * i); }
                    const float vi = SV[(3 * 16 + s) * 64 + ri];
                    float d0 = 0.f, d1 = 0.f, d2 = 0.f, d3 = 0.f;
#pragma unroll
                    for (int i = 0; i < 4; ++i) { d0 = fmaf(S[4 * i], na[i].x, d0); d1 = fmaf(S[4 * i + 1], na[i].y, d1); d2 = fmaf(S[4 * i + 2], na[i].z, d2); d3 = fmaf(S[4 * i + 3], na[i].w, d3); }
                    const float sa = dpp_quad_sum((d0 + d1) + (d2 + d3));
                    float y0 = 0.f, y1 = 0.f, y2 = 0.f, y3 = 0.f;
#pragma unroll
                    for (int i = 0; i < 4; ++i) {
                        S[4 * i] = fmaf(vi, kv[i].x, fmaf(sa, bv[i].x, S[4 * i] * wv[i].x)); S[4 * i + 1] = fmaf(vi, kv[i].y, fmaf(sa, bv[i].y, S[4 * i + 1] * wv[i].y));
                        S[4 * i + 2] = fmaf(vi, kv[i].z, fmaf(sa, bv[i].z, S[4 * i + 2] * wv[i].z)); S[4 * i + 3] = fmaf(vi, kv[i].w, fmaf(sa, bv[i].w, S[4 * i + 3] * wv[i].w));
                        y0 = fmaf(S[4 * i], rv[i].x, y0); y1 = fmaf(S[4 * i + 1], rv[i].y, y1); y2 = fmaf(S[4 * i + 2], rv[i].z, y2); y3 = fmaf(S[4 * i + 3], rv[i].w, y3); }
                    const float y = dpp_quad_sum((y0 + y1) + (y2 + y3));
                    if (q == 0) YO[s * 64 + ri] = y;
                }
            }
            __syncthreads();
            if (dt < 128) { const int s = dt >> 3, c8 = dt & 7; const int tok = d == 0 ? pos0_ + s : len_ - 1 - (pos0_ + s);
                const f32x4 a = *(const LAS f32x4*)(YO + s * 64 + 8 * c8), bq = *(const LAS f32x4*)(YO + s * 64 + 8 * c8 + 4);
                v4u w; w.x = pk2(a.x, a.y); w.y = pk2(a.z, a.w); w.z = pk2(bq.x, bq.y); w.w = pk2(bq.z, bq.w);
                *(v4u*)(Yd + (size_t)(rowbase_ + tok) * RW + h * 64 + 8 * c8) = w; }
            else if (dt < 144) { const int jj = dt - 128; bonus[(size_t)(rowbase_ + toklo_ + jj) * 8 + h] = (BON[jj] + BON[16 + jj]) + (BON[32 + jj] + BON[48 + jj]); }
        }
        __syncthreads();
#undef SC_LOAD
#undef SC_GEOM
    }
}

__device__ __forceinline__ void rwkv_out_phase(Frame& F, int l, int nrows) {
    const int gw = F.vcu * NWAVES + F.wave, NGW = F.G * NWAVES, lane = F.lane, jr = lane & 15, fq = lane >> 4;
    const bf16* PR = WSP(bf16, WS_PR); const bf16* YF = WSP(bf16, WS_YF); const bf16* YB = WSP(bf16, WS_YB); bf16* YR = WSP(bf16, WS_YR);
    const float* bon0 = WSP(float, WS_BONUS); const float* bon1 = bon0 + (size_t)MA * 8;
    const bf16* g2t = WSP(bf16, WS_LORA) + (size_t)8 * RW * 64 + (size_t)l * RW * 128;
    const float* m0 = INP(9) + (size_t)(l * 2) * RCOLS; const float* m1 = m0 + RCOLS;
    const float* lw = INP(18) + l * RW; const float* lb = INP(19) + l * RW;
    for (int unit = gw; unit < nrows / 16; unit += NGW) {
        const int m = unit * 16 + jr;
        const int pos = m < NL ? (m & 2047) : ((m - NL) & 255), len = m < NL ? TL : TC;
        const bool hp = pos > 0, hn = pos < len - 1;
        const bf16* pr = PR + (size_t)m * RCOLS;
        bf16x8 Af[4];
#pragma unroll
        for (int ks = 0; ks < 4; ++ks) { const int col = 1664 + 8 * fq + 32 * ks;
            const v4u z = (v4u){0u, 0u, 0u, 0u}; const v4u w1 = *(const v4u*)(pr + col); const v4u w0 = hp ? *(const v4u*)(pr - RCOLS + col) : z; const v4u w2 = hn ? *(const v4u*)(pr + RCOLS + col) : z;
            const unsigned u0[4] = {w0.x, w0.y, w0.z, w0.w}, u1[4] = {w1.x, w1.y, w1.z, w1.w}, u2[4] = {w2.x, w2.y, w2.z, w2.w}; unsigned o[4];
#pragma unroll
            for (int e = 0; e < 4; ++e) { const f32x2 a = *(const f32x2*)(m0 + col + 2 * e), bq = *(const f32x2*)(m1 + col + 2 * e);
                const float xl = bflo(u1[e]), xh = bfhi(u1[e]);
                const float vl = xl + a.x * (bflo(u0[e]) - xl) + bq.x * (bflo(u2[e]) - xl), vh = xh + a.y * (bfhi(u0[e]) - xh) + bq.y * (bfhi(u2[e]) - xh);
                o[e] = pk2(sigmoidf_(vl), sigmoidf_(vh)); }
            Af[ks] = __builtin_bit_cast(bf16x8, (v4u){o[0], o[1], o[2], o[3]}); }
        for (int hh = 0; hh < 8; ++hh) {
            const float bon = 0.5f * (bon0[(size_t)m * 8 + hh] + bon1[(size_t)m * 8 + hh]);
            f32x4 y[4], g[4];
#pragma unroll
            for (int nt = 0; nt < 4; ++nt) { const int c0 = hh * 64 + 16 * nt;
                f32x4 acc = (f32x4){0.f, 0.f, 0.f, 0.f};
#pragma unroll
                for (int ks = 0; ks < 4; ++ks) { const bf16x8 Bf = *(const bf16x8*)(g2t + (size_t)(c0 + jr) * 128 + 8 * fq + 32 * ks); acc = __builtin_amdgcn_mfma_f32_16x16x32_bf16(Bf, Af[ks], acc, 0, 0, 0); }
                g[nt] = acc;
                const int col = c0 + 4 * fq; const v2u a = *(const v2u*)(YF + (size_t)m * RW + col), bq = *(const v2u*)(YB + (size_t)m * RW + col);
                y[nt] = (f32x4){bflo(a.x) + bflo(bq.x), bfhi(a.x) + bfhi(bq.x), bflo(a.y) + bflo(bq.y), bfhi(a.y) + bfhi(bq.y)}; }
            float s = 0.f;
#pragma unroll
            for (int nt = 0; nt < 4; ++nt) s += (y[nt].x + y[nt].y) + (y[nt].z + y[nt].w);
            s += __shfl_xor(s, 16); s += __shfl_xor(s, 32);
            const float mean = s * (1.0f / 64.0f); float qv = 0.f;
#pragma unroll
            for (int nt = 0; nt < 4; ++nt) { y[nt] = y[nt] - mean; qv += (y[nt].x * y[nt].x + y[nt].y * y[nt].y) + (y[nt].z * y[nt].z + y[nt].w * y[nt].w); }
            qv += __shfl_xor(qv, 16); qv += __shfl_xor(qv, 32);
            const float rstd = 1.0f / sqrtf(qv * (1.0f / 64.0f) + 64e-5f);
#pragma unroll
            for (int nt = 0; nt < 4; ++nt) { const int col = hh * 64 + 16 * nt + 4 * fq, vc = 1024 + col;
                const v2u z = (v2u){0u, 0u}; const v2u w1 = *(const v2u*)(pr + vc); const v2u w0 = hp ? *(const v2u*)(pr - RCOLS + vc) : z; const v2u w2 = hn ? *(const v2u*)(pr + RCOLS + vc) : z;
                const f32x4 x0 = (f32x4){bflo(w0.x), bfhi(w0.x), bflo(w0.y), bfhi(w0.y)}, x1 = (f32x4){bflo(w1.x), bfhi(w1.x), bflo(w1.y), bfhi(w1.y)}, x2 = (f32x4){bflo(w2.x), bfhi(w2.x), bflo(w2.y), bfhi(w2.y)};
                const f32x4 vs = x1 + *(const f32x4*)(m0 + vc) * (x0 - x1) + *(const f32x4*)(m1 + vc) * (x2 - x1);
                const f32x4 o = (y[nt] * rstd * *(const f32x4*)(lw + col) + *(const f32x4*)(lb + col) + vs * bon) * g[nt];
                v2u w; w.x = pk2(o.x, o.y); w.y = pk2(o.z, o.w);
                *(v2u*)(YR + (size_t)m * RW + col) = w; }
        }
    }
}

__device__ __forceinline__ void attn_phase(Frame& F, int l, char* lds_generic) {
    typedef attn_body::bf16 abf;
    abf* Q = (abf*)(F.ws + WS_Q); const abf* KB = (const abf*)(F.ws + WS_KB); const abf* VB = (const abf*)(F.ws + WS_VB);
    for (int p = F.vcu; p < NB * 8; p += F.G) {
        const int b = p >> 3, hq = p & 7, kvh = hq >> 2;
        const abf* Kh = KB + (size_t)b * KVT * 128 + kvh * 64; const abf* Vh = VB + (size_t)b * KVT * 128 + kvh * 64;
        const int nu = l == 0 ? 9 : 8;
        for (int u = 0; u < nu; ++u) {
            const bool cx = u == 8;
            abf* Qu = Q + (size_t)(cx ? NL + b * TC : b * TL + u * 256) * 512 + hq * 64;
            attn_body::attn_unit<8>(Qu, cx ? Kh + (size_t)TL * 128 : Kh, cx ? Vh + (size_t)TL * 128 : Vh, Qu, cx ? TC / 64 : KVT / 64, lds_generic);
        }
    }
}

__device__ __forceinline__ int moe_tiles(Frame& F, LAS int* tile_e) {
    int nt = 0;
    for (int e = 0; e < NE; ++e) { const int cnt = (int)__hip_atomic_load(F.ctl + CW_HIST + 64 * e, RLX_AGENT); const int t = (cnt + 255) >> 8;
        for (int i = F.tid; i < t; i += 512) tile_e[nt + i] = e; nt += t; }
    __syncthreads();
    return nt;
}
__device__ __forceinline__ void moe_slots(Frame& F) {
    volatile LAS unsigned* M = F.MISC;
    const int* toke = (const int*)(F.ws + WS_MOETAB + MT_TOKE); int* toks = (int*)(F.ws + WS_MOETAB + MT_TOKS);
    const bf16* H2 = WSP(bf16, WS_H); bf16* XB = WSP(bf16, WS_XB);
    LAS int* slotl = (LAS int*)F.lds;
    for (int tb = F.vcu; tb < NL / 256; tb += F.G) {
        if (F.tid < 8) M[32 + F.tid] = 0u;
        if (F.tid == 0) { unsigned ps = 0; for (int e = 0; e < NE; ++e) { M[48 + e] = ps; const unsigned cnt = __hip_atomic_load(F.ctl + CW_HIST + 64 * e, RLX_AGENT); ps += ((cnt + 255u) >> 8) << 8; } }
        __syncthreads();
        int e_my = 0, rank = 0;
        { const int a = F.tid; e_my = toke[(size_t)tb * 512 + a]; rank = (int)__hip_atomic_fetch_add((LAS unsigned*)&M[32 + e_my], 1u, __ATOMIC_RELAXED, __HIP_MEMORY_SCOPE_WORKGROUP); }
        __syncthreads();
        if (F.tid < 8) M[40 + F.tid] = __hip_atomic_fetch_add(F.ctl + CW_CURS + 64 * F.tid, M[32 + F.tid], RLX_AGENT);
        __syncthreads();
        const int slot = (int)(M[48 + e_my] + M[40 + e_my]) + rank;
        toks[(size_t)tb * 512 + F.tid] = slot; slotl[F.tid] = slot;
        __syncthreads();
        for (int a = F.wave; a < 512; a += NWAVES) { const int tok = tb * 256 + (a >> 1); const int sl = slotl[a];
            const v4u* src = (const v4u*)(H2 + (size_t)tok * DM); v4u* dst = (v4u*)(XB + (size_t)sl * DM);
            const v4u x0 = src[F.lane], x1 = src[64 + F.lane]; dst[F.lane] = x0; dst[64 + F.lane] = x1; }
        __syncthreads();
    }
}
__device__ __forceinline__ void moe_final(Frame& F) {
    const int gw = F.vcu * NWAVES + F.wave, NGW = F.G * NWAVES;
    const int* toks = (const int*)(F.ws + WS_MOETAB + MT_TOKS); const float* tokw = (const float*)(F.ws + WS_MOETAB + MT_TOKW);
    const bf16* YM = WSP(bf16, WS_YM); const float* gt = WSP(float, WS_MOD) + (size_t)33 * 6144 + 5120;
    for (int m = gw; m < NL; m += NGW) {
        const int s0 = toks[2 * m], s1 = toks[2 * m + 1]; const float w0 = tokw[2 * m], w1 = tokw[2 * m + 1];
        const float* gv = gt + (size_t)(m >> 11) * 6144; float* xr = F.out + (size_t)m * DM;
        f32x4 v[4]; float s = 0.f;
#pragma unroll
        for (int j = 0; j < 4; ++j) { const int c = 4 * F.lane + 256 * j;
            const v2u a = *(const v2u*)(YM + (size_t)s0 * DM + c), bq = *(const v2u*)(YM + (size_t)s1 * DM + c);
            const f32x4 ya = (f32x4){bflo(a.x), bfhi(a.x), bflo(a.y), bfhi(a.y)}, yb = (f32x4){bflo(bq.x), bfhi(bq.x), bflo(bq.y), bfhi(bq.y)};
            v[j] = *(const f32x4*)(xr + c) + *(const f32x4*)(gv + c) * (ya * w0 + yb * w1);
            s += (v[j].x * v[j].x + v[j].y * v[j].y) + (v[j].z * v[j].z + v[j].w * v[j].w); }
        const float rstd = 1.0f / sqrtf(wave_sum(s) * (1.0f / DM) + 1e-6f);
#pragma unroll
        for (int j = 0; j < 4; ++j) { const int c = 4 * F.lane + 256 * j; *(f32x4*)(xr + c) = v[j] * rstd * *(const f32x4*)(INP(32) + c); }
    }
}
__global__ void __launch_bounds__(NWAVES * 64, 2) fwd_kernel(Args args) {
    extern __shared__ __attribute__((aligned(16))) unsigned char lds[];
    Frame F;
    F.lds = (LAS unsigned char*)lds;
    F.MISC = (volatile LAS unsigned*)(F.lds + MISC_OFF);
    F.tid = threadIdx.x; F.lane = F.tid & 63; F.wave = __builtin_amdgcn_readfirstlane(F.tid >> 6);
    F.G = gridDim.x; { const int bx = blockIdx.x; F.vcu = (F.G % 8 == 0) ? (bx % 8) * (F.G / 8) + bx / 8 : bx; }
    F.ws = args.ws; F.out = args.out; F.ctl = (gu32*)(args.ws + WS_CTL);
    for (int u = F.tid; u < 128; u += NWAVES * 64) ((LAS unsigned*)(F.lds + MISC_OFF))[u] = 0u;
    if (F.tid < 33) { const unsigned long long pv = (unsigned long long)args.in[F.tid]; ((LAS unsigned*)(F.lds + PTAB_OFF))[2 * F.tid] = (unsigned)pv; ((LAS unsigned*)(F.lds + PTAB_OFF))[2 * F.tid + 1] = (unsigned)(pv >> 32); }
    __syncthreads();
    const int vcu0 = F.vcu;
    const bool fused = args.mode == 0;
    XcdBarrier bar; bar.bar = (unsigned*)(F.ctl + CW_BAR); bar.x = 0; bar.st = nullptr;
    if (fused) bar = xcd_barrier_post((unsigned*)(F.ctl + CW_BAR), F.MISC + 8);
#ifndef SITE_MASK
#define SITE_MASK 0xFFFF
#endif
#define RUN(L, S) (((SITE_MASK >> (S)) & 1) && (fused || (args.l == (L) && args.site == (S))))
#define GRID_BAR() do { if (fused) xcd_barrier(bar); } while (0)
#define SITE_BEGIN() do { int t_ = threadIdx.x; asm volatile("" : "+v"(t_)); F.tid = t_; F.lane = t_ & 63; F.wave = __builtin_amdgcn_readfirstlane(t_ >> 6); int v_ = vcu0; asm volatile("" : "+s"(v_)); F.vcu = v_; unsigned long long w_ = (unsigned long long)args.ws, o_ = (unsigned long long)args.out; asm volatile("" : "+s"(w_), "+s"(o_)); F.ws = (unsigned char*)w_; F.out = (float*)o_; F.ctl = (gu32*)(F.ws + WS_CTL); } while (0)
    float* const XC = WSP(float, WS_XC);
    float* const MOD = WSP(float, WS_MOD);
    LAS int* const tile_e = (LAS int*)(F.lds + RING_BYTES);

    if (RUN(0, 0)) { SITE_BEGIN(); p0_prologue(F); GRID_BAR(); }

    for (int l = 0; l < 2; ++l) {
        const float* xlat = l == 0 ? INP(0) : (const float*)F.out;
        const float* xctx = l == 0 ? INP(2) : (const float*)XC;
        const int nM_mix = l == 0 ? MA / 256 : NL / 256;
        if (RUN(l, 1)) { SITE_BEGIN(); norm_mod_phase<false>(F, l, 0, xlat, xctx, MA, WSP(bf16, WS_H)); GRID_BAR(); }
        if (RUN(l, 2)) { SITE_BEGIN();
            pg8::StdOrder S; S.init(WSP(bf16, WS_H), WSP(bf16, WS_WIN) + (size_t)l * NIN * DM, DM, MA / 256, NIN / 256, F.G, (int)blockIdx.x);
            EpiIn E{WSP(bf16, WS_PR), WSP(bf16, WS_Q), WSP(bf16, WS_KB), WSP(bf16, WS_VB), WSP(bf16, WS_G)};
            pg8::gemm_phase<EpiIn, pg8::StdOrder, true, true>(F.lds, DM, S, E);
            GRID_BAR();
        }
        if (RUN(l, 3)) { SITE_BEGIN();
#ifndef NO_SCAN
            scan_phase(F, l);
#endif
#ifndef NO_QK
            qk_phase(F, l);
#endif
            GRID_BAR(); }
        if (RUN(l, 4)) { SITE_BEGIN(); attn_phase(F, l, (char*)lds); rwkv_out_phase(F, l, nM_mix * 256); GRID_BAR(); }
        if (RUN(l, 5)) { SITE_BEGIN();
            { pg8::StdOrder S; S.init(WSP(bf16, WS_YR), WSP(bf16, WS_WPA) + (size_t)l * DM * RW, RW, nM_mix, DM / 256, F.G, (int)blockIdx.x);
              EpiMerge<0> E{WSP(bf16, WS_G), WSP(bf16, WS_MG)};
              pg8::gemm_phase<EpiMerge<0>, pg8::StdOrder, true, true>(F.lds, RW, S, E); }
            __syncthreads();
            { pg8::StdOrder S; S.init(WSP(bf16, WS_Q), WSP(bf16, WS_WPB) + (size_t)l * DM * RW, RW, nM_mix, DM / 256, F.G, (int)blockIdx.x);
              EpiMerge<1> E{WSP(bf16, WS_G), WSP(bf16, WS_MG)};
              pg8::gemm_phase<EpiMerge<1>, pg8::StdOrder, true, true>(F.lds, RW, S, E); }
            GRID_BAR();
        }
        if (RUN(l, 6)) { SITE_BEGIN();
            pg8::StdOrder S; S.init(WSP(bf16, WS_MG), WSP(bf16, WS_WO) + (size_t)l * DM * DM, DM, nM_mix, DM / 256, F.G, (int)blockIdx.x);
            EpiRes E{xlat, xctx, F.out, XC, MOD + (size_t)l * 33 * 6144 + 2048};
            pg8::gemm_phase<EpiRes, pg8::StdOrder, true, true>(F.lds, DM, S, E);
            GRID_BAR();
        }
        if (RUN(l, 7)) { SITE_BEGIN();
            if (l == 0) norm_mod_phase<false>(F, l, 1, F.out, XC, MA, WSP(bf16, WS_H));
            else norm_mod_phase<true>(F, l, 1, F.out, XC, NL, WSP(bf16, WS_H));
            GRID_BAR();
        }
        if (l == 0) {
            if (RUN(0, 8)) { SITE_BEGIN();
                pg8::StdOrder S; S.init(WSP(bf16, WS_H), WSP(bf16, WS_WGU), DM, MA / 256, 2 * FF / 256, F.G, (int)blockIdx.x);
                EpiGU E{WSP(bf16, WS_ACT), 0};
                pg8::gemm_phase<EpiGU, pg8::StdOrder, true, true>(F.lds, DM, S, E);
                GRID_BAR();
            }
            if (RUN(0, 9)) { SITE_BEGIN();
                pg8::StdOrder S; S.init(WSP(bf16, WS_ACT), WSP(bf16, WS_WDN), FF, MA / 256, DM / 256, F.G, (int)blockIdx.x);
                EpiRes E{F.out, XC, F.out, XC, MOD + 5120};
                pg8::gemm_phase<EpiRes, pg8::StdOrder, true, true>(F.lds, FF, S, E);
                GRID_BAR();
            }
        } else {
            if (RUN(1, 10)) { SITE_BEGIN(); moe_conv(F); __syncthreads(); moe_slots(F); GRID_BAR(); }
            int ntile = 0;
            if (fused || args.site == 11 || args.site == 12) ntile = moe_tiles(F, tile_e);
            for (int ch = 0; ch < MOE_NCHUNK; ++ch) {
                if (!fused && ch != args.chunk) continue;
                const int t0 = ch * MOE_CH_TILES; if (t0 >= ntile) break;
                const int ntl = (ntile - t0) < MOE_CH_TILES ? (ntile - t0) : MOE_CH_TILES;
                if (RUN(1, 11)) { SITE_BEGIN();
                    MoeOrder S{(const char*)(F.ws + WS_XB), (const char*)(F.ws + WS_MW), (size_t)256 * DM * 2, (size_t)256 * DM * 2, (size_t)21 * MiB, t0, 0, ntl, 2 * FF / 256, F.G, (int)blockIdx.x, tile_e};
                    EpiGU E{WSP(bf16, WS_ACTC), t0};
                    pg8::gemm_phase<EpiGU, MoeOrder, true, true>(F.lds, DM, S, E);
                    GRID_BAR();
                }
                if (RUN(1, 12)) { SITE_BEGIN();
                    MoeOrder S{(const char*)(F.ws + WS_ACTC), (const char*)(F.ws + WS_MW) + (size_t)2 * FF * DM * 2, (size_t)256 * FF * 2, (size_t)256 * FF * 2, (size_t)21 * MiB, t0, t0, ntl, DM / 256, F.G, (int)blockIdx.x, tile_e};
                    EpiStore E{WSP(bf16, WS_YM)};
                    pg8::gemm_phase<EpiStore, MoeOrder, true, true>(F.lds, FF, S, E);
                    GRID_BAR();
                }
            }
            if (RUN(1, 13)) { SITE_BEGIN(); moe_final(F); }
        }
    }
#undef RUN
#undef GRID_BAR
}

extern "C" void kernel_launch(void* const* d_in, const int* in_sizes, int n_in, void* d_out, int out_size, void* d_ws, size_t ws_size, hipStream_t stream) {
    static int grid = 0;
    if (grid == 0) {
        if (n_in != 33 || in_sizes[0] != NL * DM || out_size != NL * DM || ws_size < WS_END) { fprintf(stderr, "kernel_launch: unexpected problem (n_in %d, x %d, out %d, ws %zu < %zu); nothing launched\n", n_in, n_in > 0 ? in_sizes[0] : -1, out_size, ws_size, (size_t)WS_END); grid = -1; return; }
        int dev = 0, cus = 0, per_cu = 0;
        if (hipGetDevice(&dev) != hipSuccess || hipDeviceGetAttribute(&cus, hipDeviceAttributeMultiprocessorCount, dev) != hipSuccess) { fprintf(stderr, "kernel_launch: device query failed\n"); grid = -1; return; }
        if (hipFuncSetAttribute((const void*)fwd_kernel, hipFuncAttributeMaxDynamicSharedMemorySize, LDS_BYTES) != hipSuccess) { fprintf(stderr, "kernel_launch: hipFuncSetAttribute failed\n"); grid = -1; return; }
        if (hipOccupancyMaxActiveBlocksPerMultiprocessor(&per_cu, (const void*)fwd_kernel, NWAVES * 64, LDS_BYTES) != hipSuccess || per_cu < 1) { fprintf(stderr, "kernel_launch: occupancy query reports %d workgroups per CU\n", per_cu); }
        (void)hipGetLastError();
        grid = cus;
        fprintf(stderr, "kernel_launch: grid %d, occupancy query %d\n", grid, per_cu);
    }
    if (grid < 0) return;
    if (hipMemsetAsync((char*)d_ws + WS_CTL, 0, CTL_ZERO_BYTES, stream) != hipSuccess) { fprintf(stderr, "kernel_launch: memset failed\n"); return; }
    Args a{};
    for (int i = 0; i < 33; ++i) a.in[i] = (const float*)d_in[i];
    a.out = (float*)d_out; a.ws = (unsigned char*)d_ws;
#if MK_FUSED
    a.mode = 0; a.l = 0; a.site = 0; a.chunk = 0;
    hipLaunchKernelGGL(fwd_kernel, dim3(grid), dim3(NWAVES * 64), LDS_BYTES, stream, a);
#else
    a.mode = 1;
    auto step = [&](int l, int site, int chunk) { a.l = l; a.site = site; a.chunk = chunk; hipLaunchKernelGGL(fwd_kernel, dim3(grid), dim3(NWAVES * 64), LDS_BYTES, stream, a); };
    step(0, 0, 0);
    for (int l = 0; l < 2; ++l) {
        for (int s = 1; s <= 7; ++s) step(l, s, 0);
        if (l == 0) { step(0, 8, 0); step(0, 9, 0); }
        else { step(1, 10, 0); for (int ch = 0; ch < MOE_NCHUNK; ++ch) { step(1, 11, ch); step(1, 12, ch); } step(1, 13, 0); }
    }
#endif
    const hipError_t le = hipPeekAtLastError();
    if (le != hipSuccess) fprintf(stderr, "kernel_launch: launch failed: %s\n", hipGetErrorName(le));
}
```

```cpp
#include <hip/hip_runtime.h>
#include <hip/hip_bf16.h>
#include <cstdio>
#include <cstdint>
#include <cmath>

#ifndef MK_FUSED
#define MK_FUSED 1
#endif

constexpr int DM = 1024, NB = 32, TL = 2048, TC = 256;
constexpr int NL = NB * TL;
constexpr int NC = NB * TC;
constexpr int MA = NL + NC;
constexpr int RW = 512, RCOLS = 1792, ACOLS = 768, GCOLS = 2048, NIN = 4608;
constexpr int FF = 3584, NE = 8;
constexpr int KVT = TL + TC;
constexpr int MOE_ROWS = 2 * NL + NE * 256;
constexpr int MOE_CH_TILES = 64;
constexpr int MOE_NCHUNK = (MOE_ROWS / 256 + MOE_CH_TILES - 1) / MOE_CH_TILES;

constexpr size_t MiB = 1u << 20;
constexpr size_t WS_CTL = 0, CTL_ZERO_BYTES = 1 * MiB;
constexpr size_t WS_MOD = 1 * MiB;
constexpr size_t WS_ROPE = 3 * MiB;
constexpr size_t WS_LORA = 4 * MiB;
constexpr size_t WS_BONUS = 5 * MiB;
constexpr size_t WS_MOETAB = 10 * MiB;
constexpr size_t WS_WIN = 16 * MiB;
constexpr size_t WS_WPA = 34 * MiB;
constexpr size_t WS_WPB = 36 * MiB;
constexpr size_t WS_WO = 38 * MiB;
constexpr size_t WS_WGU = 42 * MiB;
constexpr size_t WS_WDN = 56 * MiB;
constexpr size_t WS_XC = 64 * MiB;
constexpr size_t WS_H = 96 * MiB;
constexpr size_t WS_YF = 96 * MiB, WS_YB = 168 * MiB;
constexpr size_t WS_PR = 240 * MiB;
constexpr size_t WS_MG = 240 * MiB;
constexpr size_t WS_Q = 492 * MiB;
constexpr size_t WS_KB = 564 * MiB, WS_VB = 582 * MiB;
constexpr size_t WS_G = 600 * MiB;
constexpr size_t WS_YR = 888 * MiB;
constexpr size_t WS_ACT = 240 * MiB;
constexpr size_t WS_MW = 224 * MiB;
constexpr size_t WS_XB = 392 * MiB;
constexpr size_t WS_YM = 652 * MiB;
constexpr size_t WS_ACTC = 912 * MiB;
constexpr size_t WS_END = 1024 * MiB;
static_assert(WS_H + (size_t)MA * DM * 2 <= WS_PR && WS_PR + (size_t)MA * RCOLS * 2 <= WS_Q && WS_Q + (size_t)MA * 512 * 2 <= WS_KB, "ws map 1");
static_assert(WS_KB + (size_t)MA * 128 * 2 <= WS_VB && WS_VB + (size_t)MA * 128 * 2 <= WS_G && WS_G + (size_t)MA * GCOLS * 2 <= WS_YR && WS_YR + (size_t)MA * 512 * 2 <= WS_END, "ws map 2");
static_assert(WS_ACT + (size_t)MA * FF * 2 <= WS_END && WS_H + (size_t)NL * DM * 2 <= WS_MW && WS_MW + (size_t)NE * 21 * MiB <= WS_XB, "ws map 3");
static_assert(WS_XB + (size_t)MOE_ROWS * DM * 2 <= WS_YM && WS_YM + (size_t)MOE_ROWS * DM * 2 <= WS_ACTC && WS_ACTC + (size_t)MOE_CH_TILES * 256 * FF * 2 <= WS_END, "ws map 4");
static_assert(WS_WDN + (size_t)DM * FF * 2 <= WS_XC && WS_BONUS + (size_t)2 * MA * 8 * 4 <= WS_MOETAB, "ws map 5");
constexpr size_t MT_TOKE = 0;
constexpr size_t MT_TOKW = 512 * 1024;
constexpr size_t MT_TOKS = 1024 * 1024;
constexpr int CW_TMO = 0, CW_CODE = 1;
constexpr int CW_BAR = 4096;
constexpr int CW_HIST = 8192;
constexpr int CW_CURS = 8192 + 64 * 8;

constexpr int NWAVES = 8;
constexpr int LDS_BYTES = 147456;
constexpr int MISC_OFF = LDS_BYTES - 1024;
constexpr int PTAB_OFF = LDS_BYTES - 512;
constexpr int RING_BYTES = 131072;

#define GAS __attribute__((address_space(1)))
#define LAS __attribute__((address_space(3)))
typedef unsigned short bf16;
typedef unsigned v4u __attribute__((ext_vector_type(4)));
typedef unsigned v2u __attribute__((ext_vector_type(2)));
typedef float f32x4 __attribute__((ext_vector_type(4)));
typedef float f32x2 __attribute__((ext_vector_type(2)));
typedef short bf16x8 __attribute__((ext_vector_type(8)));
typedef GAS unsigned gu32;
#define RLX_AGENT __ATOMIC_RELAXED, __HIP_MEMORY_SCOPE_AGENT
#define LDS_WAIT() asm volatile("s_waitcnt lgkmcnt(0)" ::: "memory")
#define VM_WAIT() asm volatile("s_waitcnt vmcnt(0)" ::: "memory")
__device__ __forceinline__ float bf2f(unsigned b) { return __uint_as_float(b << 16); }
__device__ __forceinline__ float bflo(unsigned w) { return __uint_as_float(w << 16); }
__device__ __forceinline__ float bfhi(unsigned w) { return __uint_as_float(w & 0xffff0000u); }
typedef __bf16 bf16x2_t __attribute__((ext_vector_type(2)));
__device__ __forceinline__ unsigned pk2(float lo, float hi) { const f32x2 v = {lo, hi}; const bf16x2_t b = __builtin_convertvector(v, bf16x2_t); return __builtin_bit_cast(unsigned, b); }
__device__ __forceinline__ float sigmoidf_(float x) { return 1.0f / (1.0f + __expf(-x)); }
__device__ __forceinline__ float wave_sum(float v) {
#pragma unroll
    for (int o = 1; o < 64; o <<= 1) v += __shfl_xor(v, o);
    return v;
}
__device__ __forceinline__ int row_bi(int m) { return m < NL ? (m >> 11) : 32; }
__device__ __forceinline__ int row_kv(int m) { return m < NL ? (m >> 11) * KVT + (m & 2047) : ((m - NL) >> 8) * KVT + TL + ((m - NL) & 255); }
namespace pg8 {
#define PG8_LAS __attribute__((address_space(3)))
typedef unsigned short bf16_t;
typedef short bf16x8 __attribute__((ext_vector_type(8)));
typedef float f32x4 __attribute__((ext_vector_type(4)));
typedef unsigned u32x4 __attribute__((ext_vector_type(4)));
constexpr int BM = 256, BK = 64, HALF = 128, HTB = HALF * BK * 2  , STAGE_BYTES = 8 * HTB, NXCD = 8, WGM = 8;

__host__ __device__ __forceinline__ int lds_byte(int r, int c) { const int st = (r >> 4) * 2 + (c >> 5), rr = r & 15, cc = c & 31, ob = rr * 64 + cc * 2; return st * 1024 + (ob ^ (((ob >> 9) & 1) << 5)); }
__host__ __device__ __forceinline__ void stage_rc(int b, int& R, int& C) { const int st = b / 1024, sb = b % 1024, swz = sb ^ (((sb >> 9) & 1) << 5); R = (st >> 1) * 16 + swz / 64; C = (st & 1) * 32 + (swz % 64) / 2; }
__host__ __device__ __forceinline__ int perm32(int rho) { const int n = rho >> 4, i = rho & 15; return 8 * (i >> 2) + 4 * n + (i & 3); }

struct Unit { int pm, pn; };

struct StdOrder {
    const char* A; const char* Bt; size_t tstep; int nM, nN, nwg, G, c;
    __device__ void init(const void* A_, const void* Bt_, int K, int nM_, int nN_, int G_, int c_) { A = (const char*)A_; Bt = (const char*)Bt_; tstep = (size_t)BM * K * 2; nM = nM_; nN = nN_; nwg = nM * nN; G = G_; c = c_; }
    __device__ bool next(int i, Unit& u) const {
        const long L = (long)i * G + c; if (L >= nwg) return false;
        int wgid = (int)L; { const int q = nwg / NXCD, r = nwg % NXCD, xcd = wgid % NXCD, off = wgid / NXCD; wgid = (xcd < r ? xcd * (q + 1) : r * (q + 1) + (xcd - r) * q) + off; }
        const int nig = WGM * nN, gid = wgid / nig, fm = gid * WGM, gsz = (nM - fm) < WGM ? (nM - fm) : WGM;
        u.pm = fm + ((wgid % nig) % gsz); u.pn = (wgid % nig) / gsz; return true;
    }
    __device__ __forceinline__ const char* a_base(const Unit& u) const { return A + (size_t)u.pm * tstep; }
    __device__ __forceinline__ const char* b_base(const Unit& u) const { return Bt + (size_t)u.pn * tstep; }
    __device__ __forceinline__ void a_ready(const Unit&) const {}
    __device__ __forceinline__ void done(const Unit&) const {}
};
template <class Epi, class Sched, bool ALIGN_EPI = false, bool SP2 = false>
__device__ __forceinline__ void gemm_phase(PG8_LAS unsigned char* lds, const int K, const Sched& S, const Epi& E) {
    int tid_l = threadIdx.x; asm volatile("" : "+v"(tid_l));
    const int tid = tid_l, wid = __builtin_amdgcn_readfirstlane(tid >> 6), lane = tid & 63, wr = wid >> 2, wc = wid & 3, fr = lane & 15, fq = lane >> 4;
    const int nt = K / BK;
    unsigned voffA[2], voffB[2];
#pragma unroll
    for (int i = 0; i < 2; ++i) { int R, C; stage_rc(tid * 16 + i * 8192, R, C); const int Rb = Epi::PERM ? ((R & ~31) + perm32(R & 31)) : R;
        voffA[i] = (unsigned)(R * K + C) * 2u; voffB[i] = (unsigned)(Rb * K + C) * 2u; }
    const size_t kstep = (size_t)(BK * 2);
    const size_t hstep = (size_t)HALF * K * 2;
    const unsigned ldsw = (unsigned)wid * 1024u;
    const int aoff = lds_byte(wr * 64 + fr, fq * 8), boff = lds_byte(wc * 32 + fr, fq * 8);
#define PG8_SA(b, h) (((b) * 2 + (h)) * HTB)
#define PG8_SB(b, h) ((4 + (b) * 2 + (h)) * HTB)
#define PG8_STAGE(bufoff, gbase, voff) do { _Pragma("unroll") for (int _i = 0; _i < 2; ++_i) \
        __builtin_amdgcn_global_load_lds((const unsigned*)((const char*)(gbase) + (voff)[_i]), (PG8_LAS unsigned*)(lds + (bufoff) + ldsw + _i * 8192), 16, 0, 0); } while (0)
#define PG8_LDA(dst, b, h) do { _Pragma("unroll") for (int m = 0; m < 4; ++m) _Pragma("unroll") for (int k = 0; k < 2; ++k) dst[m][k] = *(const PG8_LAS bf16x8*)(lds + PG8_SA(b, h) + aoff + m * 2048 + k * 1024); } while (0)
#define PG8_LDB(dst, b, h) do { _Pragma("unroll") for (int n = 0; n < 2; ++n) _Pragma("unroll") for (int k = 0; k < 2; ++k) dst[n][k] = *(const PG8_LAS bf16x8*)(lds + PG8_SB(b, h) + boff + n * 2048 + k * 1024); } while (0)
#define PG8_MMA(ai, bj, At, Bt) do { __builtin_amdgcn_s_setprio(1); _Pragma("unroll") for (int m = 0; m < 4; ++m) _Pragma("unroll") for (int n = 0; n < 2; ++n) _Pragma("unroll") for (int k = 0; k < 2; ++k) \
        acc[ai][bj][m][n] = __builtin_amdgcn_mfma_f32_16x16x32_bf16(Bt[n][k], At[m][k], acc[ai][bj][m][n], 0, 0, 0); __builtin_amdgcn_s_setprio(0); } while (0)
#define PG8_WAIT_V(n) asm volatile("s_waitcnt vmcnt(" #n ")" ::: "memory")
#define PG8_WAIT_L(n) asm volatile("s_waitcnt lgkmcnt(" #n ")" ::: "memory")
#define PG8_BAR __builtin_amdgcn_s_barrier()
#define PG8_SCHED __builtin_amdgcn_sched_barrier(0)
    Unit cur, nxt; int ui = 0;
    if (!S.next(0, cur)) return;
    f32x4 acc[2][2][4][2];
#pragma unroll
    for (int a = 0; a < 2; ++a)
#pragma unroll
        for (int b = 0; b < 2; ++b)
#pragma unroll
            for (int m = 0; m < 4; ++m)
#pragma unroll
                for (int n = 0; n < 2; ++n) acc[a][b][m][n] = (f32x4){0.f, 0.f, 0.f, 0.f};
    bf16x8 At[4][2], B0[2][2], B1[2][2];
    const char* cA = S.a_base(cur); const char* cB = S.b_base(cur);
    S.a_ready(cur);
    if constexpr (SP2) {
        PG8_STAGE(PG8_SB(0, 0), cB, voffB); PG8_STAGE(PG8_SB(0, 1), cB + hstep, voffB); PG8_STAGE(PG8_SA(0, 0), cA, voffA); PG8_STAGE(PG8_SA(0, 1), cA + hstep, voffA);
        if (wr == 1) PG8_BAR;
        PG8_WAIT_V(2); PG8_BAR;
        PG8_STAGE(PG8_SB(1, 0), cB + kstep, voffB); PG8_STAGE(PG8_SA(1, 0), cA + kstep, voffA); PG8_STAGE(PG8_SB(1, 1), cB + hstep + kstep, voffB);
        PG8_WAIT_V(6); PG8_BAR;
    } else {
        PG8_STAGE(PG8_SB(0, 0), cB, voffB); PG8_STAGE(PG8_SA(0, 0), cA, voffA); PG8_STAGE(PG8_SB(0, 1), cB + hstep, voffB); PG8_STAGE(PG8_SA(0, 1), cA + hstep, voffA);
        if (wr == 1) PG8_BAR;
        PG8_WAIT_V(4); PG8_BAR;
        PG8_STAGE(PG8_SB(1, 0), cB + kstep, voffB); PG8_STAGE(PG8_SA(1, 0), cA + kstep, voffA); PG8_STAGE(PG8_SB(1, 1), cB + hstep + kstep, voffB);
        PG8_WAIT_V(6); PG8_BAR;
    }
    for (;;) {
        const bool has_next = S.next(ui + 1, nxt);
        const char* nA = has_next ? S.a_base(nxt) : cA; const char* nB = has_next ? S.b_base(nxt) : cB;
        for (int t = 0; t < nt; t += 2) {
            const bool last = (t == nt - 2);
            const char* a1 = cA + (size_t)(t + 1) * kstep;
            const char* a2 = last ? nA : cA + (size_t)(t + 2) * kstep; const char* b2 = last ? nB : cB + (size_t)(t + 2) * kstep;
            const char* a3 = a2 + kstep; const char* b3 = b2 + kstep;
            if (last && has_next) S.a_ready(nxt);
            if constexpr (SP2) {
            PG8_LDB(B0, 0, 0); PG8_LDB(B1, 0, 1); PG8_SCHED; PG8_LDA(At, 0, 0); PG8_STAGE(PG8_SA(1, 1), a1 + hstep, voffA);
            PG8_WAIT_V(8); PG8_WAIT_L(0); PG8_BAR; PG8_MMA(0, 0, At, B0); PG8_MMA(0, 1, At, B1); PG8_BAR; PG8_SCHED;
            PG8_LDA(At, 0, 1); PG8_STAGE(PG8_SB(0, 0), b2, voffB); PG8_STAGE(PG8_SB(0, 1), b2 + hstep, voffB); PG8_STAGE(PG8_SA(0, 0), a2, voffA);
            PG8_WAIT_V(8); PG8_WAIT_L(0); PG8_BAR; PG8_MMA(1, 0, At, B0); PG8_MMA(1, 1, At, B1); PG8_BAR; PG8_SCHED;
            PG8_LDB(B0, 1, 0); PG8_LDB(B1, 1, 1); PG8_SCHED; PG8_LDA(At, 1, 0); PG8_STAGE(PG8_SA(0, 1), a2 + hstep, voffA);
            PG8_WAIT_V(8); PG8_WAIT_L(0); PG8_BAR; PG8_MMA(0, 0, At, B0); PG8_MMA(0, 1, At, B1); PG8_BAR; PG8_SCHED;
            PG8_LDA(At, 1, 1); PG8_STAGE(PG8_SB(1, 0), b3, voffB); PG8_STAGE(PG8_SB(1, 1), b3 + hstep, voffB); PG8_STAGE(PG8_SA(1, 0), a3, voffA);
            PG8_WAIT_V(8); PG8_WAIT_L(0); PG8_BAR; PG8_MMA(1, 0, At, B0); PG8_MMA(1, 1, At, B1); PG8_BAR; PG8_SCHED;
            } else {
            PG8_LDB(B0, 0, 0); PG8_SCHED; PG8_LDA(At, 0, 0); PG8_STAGE(PG8_SA(1, 1), a1 + hstep, voffA);
            PG8_WAIT_L(8); PG8_BAR; PG8_WAIT_L(0); PG8_MMA(0, 0, At, B0); PG8_BAR; PG8_SCHED;
            PG8_LDB(B1, 0, 1); PG8_STAGE(PG8_SB(0, 0), b2, voffB);
            PG8_BAR; PG8_WAIT_L(0); PG8_MMA(0, 1, At, B1); PG8_BAR;
            PG8_LDA(At, 0, 1); PG8_STAGE(PG8_SA(0, 0), a2, voffA);
            PG8_BAR; PG8_WAIT_L(0); PG8_MMA(1, 0, At, B0); PG8_BAR; PG8_SCHED;
            PG8_STAGE(PG8_SB(0, 1), b2 + hstep, voffB);
            PG8_WAIT_V(6); PG8_BAR; PG8_MMA(1, 1, At, B1); PG8_BAR;
            PG8_LDB(B0, 1, 0); PG8_SCHED; PG8_LDA(At, 1, 0); PG8_STAGE(PG8_SA(0, 1), a2 + hstep, voffA);
            PG8_WAIT_L(8); PG8_BAR; PG8_WAIT_L(0); PG8_MMA(0, 0, At, B0); PG8_BAR; PG8_SCHED;
            PG8_LDB(B1, 1, 1); PG8_STAGE(PG8_SB(1, 0), b3, voffB);
            PG8_BAR; PG8_WAIT_L(0); PG8_MMA(0, 1, At, B1); PG8_BAR;
            PG8_LDA(At, 1, 1); PG8_STAGE(PG8_SA(1, 0), a3, voffA);
            PG8_BAR; PG8_WAIT_L(0); PG8_MMA(1, 0, At, B0); PG8_BAR; PG8_SCHED;
            PG8_STAGE(PG8_SB(1, 1), b3 + hstep, voffB);
            PG8_WAIT_V(6); PG8_BAR; PG8_MMA(1, 1, At, B1); PG8_BAR;
            }
        }
        if constexpr (ALIGN_EPI) { if (wr == 0) PG8_BAR; }
        if constexpr (!Epi::AFTER_DRAIN) { E(acc, cur, wr, wc, fr, fq); S.done(cur); }
        if (!has_next) break;
#pragma unroll
        for (int a = 0; a < 2; ++a)
#pragma unroll
            for (int b = 0; b < 2; ++b)
#pragma unroll
                for (int m = 0; m < 4; ++m)
#pragma unroll
                    for (int n = 0; n < 2; ++n) acc[a][b][m][n] = (f32x4){0.f, 0.f, 0.f, 0.f};
        cur = nxt; cA = nA; cB = nB; ++ui;
        if constexpr (ALIGN_EPI) { if (wr == 1) PG8_BAR; }
    }
    PG8_WAIT_V(0);
    if constexpr (!ALIGN_EPI) { if (wr == 0) PG8_BAR; }
    PG8_BAR;
    if constexpr (Epi::AFTER_DRAIN) { E.fused(acc, cur, wr, wc, fr, fq, lds, wid, lane); S.done(cur); }
#undef PG8_SA
#undef PG8_SB
#undef PG8_STAGE
#undef PG8_LDA
#undef PG8_LDB
#undef PG8_MMA
#undef PG8_WAIT_V
#undef PG8_WAIT_L
#undef PG8_BAR
#undef PG8_SCHED
}
}

#include <hip/hip_bf16.h>
#include <cmath>
namespace attn_body {
using bf16=__hip_bfloat16;
using bf16x8=__attribute__((ext_vector_type(8)))short;
using s16x4=__attribute__((ext_vector_type(4)))short;
using f32x16=__attribute__((ext_vector_type(16)))float;
using u32x4=__attribute__((ext_vector_type(4)))unsigned;
constexpr int D=64,QP=512,KP=128;
constexpr int NW=8,QBLK=32,QB=QBLK*NW,KVBLK=64;
constexpr int ATTN_UNIT_ROWS=QB;
__device__ __forceinline__ int crow(int r,int hi){return (r&3)+8*(r>>2)+4*hi;}
#define SBAR() __builtin_amdgcn_sched_barrier(0)
__device__ __forceinline__ void cmask(f32x16&p0,f32x16&p1,int jb,int qrel,int hi){
  const float NEG=-INFINITY; int kb=64*jb+4*hi;
  #pragma unroll
  for(int r=0;r<16;++r){int kv=kb+(r&3)+8*(r>>2); if(kv>qrel)p0[r]=NEG; if(kv+32>qrel)p1[r]=NEG;}
}

constexpr int NSLOT=3, SLOTB=8192;
constexpr int LDS_K=0, LDS_V=NSLOT*SLOTB, LDS_WS=2*NSLOT*SLOTB, LDS_OST=LDS_WS+NW*64*4, LDS_BYTES=LDS_OST+NW*4096;
constexpr float C2=0.125f*1.4426950408889634f;
__device__ __forceinline__ void glds16(const void*gsrc,unsigned lds_dst){unsigned keep;
  asm volatile("s_mov_b32 %0, m0\n\ts_mov_b32 m0, %2\n\ts_nop 0\n\tglobal_load_lds_dwordx4 %1, off\n\ts_mov_b32 m0, %0":"=&s"(keep):"v"(gsrc),"s"(lds_dst):"memory");}
__device__ __forceinline__ float max3f(float a,float b,float c){float r;asm("v_max3_f32 %0, %1, %2, %3":"=v"(r):"v"(a),"v"(b),"v"(c));return r;}
__device__ __forceinline__ float max2f(float a,float b){float r;asm("v_max_f32_e32 %0, %1, %2":"=v"(r):"v"(a),"v"(b));return r;}
__device__ __forceinline__ float fadd_s(float a,float b){float r;asm("v_add_f32_e32 %0, %1, %2":"=v"(r):"v"(a),"v"(b));return r;}
__device__ __forceinline__ float fsub_s(float a,float b){float r;asm("v_sub_f32_e32 %0, %1, %2":"=v"(r):"v"(a),"v"(b));return r;}
typedef float f32x2_t __attribute__((ext_vector_type(2))); typedef __bf16 bf16x2_t __attribute__((ext_vector_type(2)));
__device__ __forceinline__ unsigned cvtpk_s(float lo,float hi){f32x2_t v={lo,hi};bf16x2_t b=__builtin_convertvector(v,bf16x2_t);return __builtin_bit_cast(unsigned,b);}
#define WAIT_BAR(N) asm volatile("s_waitcnt vmcnt(" #N ") lgkmcnt(0)\n\ts_barrier":::"memory")

__device__ __forceinline__ void qkt(f32x16&p0,f32x16&p1,const char*Kslot,const bf16x8*qr,const f32x16&negm,int r32,int hi){
  const char*kb=Kslot+hi*1024+r32*16;
  #pragma unroll
  for(int d0=0;d0<4;++d0){
    const bf16x8 b0=*reinterpret_cast<const bf16x8*>(kb+d0*2048);
    const bf16x8 b1=*reinterpret_cast<const bf16x8*>(kb+d0*2048+512);
    if(d0==0){p0=__builtin_amdgcn_mfma_f32_32x32x16_bf16(b0,qr[0],negm,0,0,0);p1=__builtin_amdgcn_mfma_f32_32x32x16_bf16(b1,qr[0],negm,0,0,0);}
    else{p0=__builtin_amdgcn_mfma_f32_32x32x16_bf16(b0,qr[d0],p0,0,0,0);p1=__builtin_amdgcn_mfma_f32_32x32x16_bf16(b1,qr[d0],p1,0,0,0);}}
}
typedef __attribute__((address_space(3))) const char* lds_cptr;
typedef short v4i16_t __attribute__((ext_vector_type(4)));
__device__ __forceinline__ void kload8(bf16x8*kf,lds_cptr kp){
  kf[0]=*(const __attribute__((address_space(3))) bf16x8*)(kp);      kf[1]=*(const __attribute__((address_space(3))) bf16x8*)(kp+512);
  kf[2]=*(const __attribute__((address_space(3))) bf16x8*)(kp+2048); kf[3]=*(const __attribute__((address_space(3))) bf16x8*)(kp+2560);
  kf[4]=*(const __attribute__((address_space(3))) bf16x8*)(kp+4096); kf[5]=*(const __attribute__((address_space(3))) bf16x8*)(kp+4608);
  kf[6]=*(const __attribute__((address_space(3))) bf16x8*)(kp+6144); kf[7]=*(const __attribute__((address_space(3))) bf16x8*)(kp+6656);
}
__device__ __forceinline__ void kload2(bf16x8*kf,lds_cptr kp,int j){ kf[2*j]=*(const __attribute__((address_space(3))) bf16x8*)(kp+j*2048); kf[2*j+1]=*(const __attribute__((address_space(3))) bf16x8*)(kp+j*2048+512); }
__device__ __forceinline__ s16x4 vtr(lds_cptr p){ return __builtin_bit_cast(s16x4,__builtin_amdgcn_ds_read_tr16_b64_v4i16((__attribute__((address_space(3))) v4i16_t*)p)); }
__device__ __forceinline__ float rowmax(const f32x16&p0,const f32x16&p1){
  float a=max3f(p0[0],p0[1],p1[0]),b=max3f(p0[2],p0[3],p1[1]);a=max3f(a,p1[2],p1[3]);
  #pragma unroll
  for(int r=4;r<16;r+=4){a=max3f(a,p0[r],p0[r+1]);b=max3f(b,p0[r+2],p0[r+3]);a=max3f(a,p1[r],p1[r+1]);b=max3f(b,p1[r+2],p1[r+3]);}
  const float m=max2f(a,b);
  auto rr=__builtin_amdgcn_permlane32_swap(__float_as_uint(m),__float_as_uint(m),false,false);
  return max2f(__uint_as_float(rr[0]),__uint_as_float(rr[1]));
}
__device__ __forceinline__ void pv(f32x16*o,int vb,bf16x8 pa0,bf16x8 pa1,bf16x8 pa2,bf16x8 pa3){
  #pragma unroll
  for(int d0=0;d0<2;++d0){s16x4 lo[4],hi[4];
    #pragma unroll
    for(int ks=0;ks<4;++ks){
      asm volatile("ds_read_b64_tr_b16 %0,%1 offset:%c2":"=&v"(lo[ks]):"v"(vb),"i"(d0*4096+ks*1024):"memory");
      asm volatile("ds_read_b64_tr_b16 %0,%1 offset:%c2":"=&v"(hi[ks]):"v"(vb),"i"(d0*4096+ks*1024+512):"memory");}
    asm volatile("s_waitcnt lgkmcnt(0)":::"memory");SBAR();
    #define PK(k) (bf16x8){lo[k][0],lo[k][1],lo[k][2],lo[k][3],hi[k][0],hi[k][1],hi[k][2],hi[k][3]}
    o[d0]=__builtin_amdgcn_mfma_f32_32x32x16_bf16(pa0,PK(0),o[d0],0,0,0);
    o[d0]=__builtin_amdgcn_mfma_f32_32x32x16_bf16(pa1,PK(1),o[d0],0,0,0);
    o[d0]=__builtin_amdgcn_mfma_f32_32x32x16_bf16(pa2,PK(2),o[d0],0,0,0);
    o[d0]=__builtin_amdgcn_mfma_f32_32x32x16_bf16(pa3,PK(3),o[d0],0,0,0);
    #undef PK
  }
}

#ifndef ATTN_STORE16
#define ATTN_STORE16(p,v) (*(u32x4*)(p)=(v))
#endif
template<int THRL> __device__ __forceinline__ void attn_unit(const bf16*Qu,const bf16*__restrict__ Kh,const bf16*__restrict__ Vh,bf16*Ou,const int NT,char*shm){
  int tid_l=threadIdx.x; asm volatile("":"+v"(tid_l));
  const int tid=tid_l,lane=tid&63,r32=lane&31,hi=lane>>5; const int wid=__builtin_amdgcn_readfirstlane(tid>>6);
  const bf16*Qw=Qu+(long)(wid*QBLK)*QP;
  const unsigned lds0=(unsigned)(uintptr_t)shm;
  float*wsf=(float*)(shm+LDS_WS)+wid*64;
  const bf16*ksrc=Kh+(long)lane*KP+wid*8;
  const bf16*vsrc=Vh+(long)(16*(wid&3)+(lane>>2))*KP+(wid>>2)*32+(lane&3)*8;
  const unsigned kdst=lds0+LDS_K+wid*1024, vdst=lds0+LDS_V+wid*1024;
  #define DMA_K(t,slot) glds16(ksrc+(long)(t)*KVBLK*KP,(unsigned)__builtin_amdgcn_readfirstlane(kdst+(slot)))
  #define DMA_V(t,slot) glds16(vsrc+(long)(t)*KVBLK*KP,(unsigned)__builtin_amdgcn_readfirstlane(vdst+(slot)))
  const int vb0=(int)(lds0+LDS_V)+((lane>>4)&1)*32+(lane&3)*8+(4*hi+((lane&15)>>2))*64;
  const char*Kbase=shm+LDS_K; bf16x8 kf[8];
  const lds_cptr shm3=(lds_cptr)shm; const lds_cptr kp0=shm3+LDS_K+hi*1024+r32*16; const lds_cptr vp0=shm3+LDS_V+((lane>>4)&1)*32+(lane&3)*8+(4*hi+((lane&15)>>2))*64;
  DMA_K(0,0);DMA_V(0,0);DMA_K(1,SLOTB);
  bf16x8 qr[4];
  #pragma unroll
  for(int d0=0;d0<4;++d0)qr[d0]=*reinterpret_cast<const bf16x8*>(&Qw[(long)r32*QP+d0*16+hi*8]);
  float mhat=0.f,l_reg=0.f;f32x16 o[2];o[0]=f32x16{};o[1]=f32x16{};f32x16 negm=f32x16{};asm volatile("":"+v"(negm));
  #define CMASK(P0,P1,t) do{}while(0)
  bool resc=false;
  #define START(P0,P1) do{ const float rm=rowmax(P0,P1); resc=false; \
    { const float dl=rm; mhat=fadd_s(mhat,dl); \
      _Pragma("unroll") for(int r=0;r<16;++r){P0[r]=fsub_s(P0[r],dl);P1[r]=fsub_s(P1[r],dl);} \
      _Pragma("unroll") for(int r=0;r<16;++r)negm[r]=-mhat; asm volatile("":"+v"(negm)); } \
    _Pragma("unroll") for(int r=0;r<16;++r)P0[r]=__builtin_amdgcn_exp2f(P0[r]); }while(0)
  #define RESC() do{ if(resc){ asm volatile("s_waitcnt lgkmcnt(0)":::"memory"); \
      _Pragma("unroll") for(int d_=0;d_<2;++d_) _Pragma("unroll") for(int r=0;r<16;++r)o[d_][r]*=wsf[crow(r,hi)]; } }while(0)
  f32x16 pA0,pA1,pB0,pB1;
  int sl_prev=0,sl_cur=0,sl_next=SLOTB;
  #define ROT() do{sl_prev=sl_cur;sl_cur=sl_next;sl_next=(sl_next==(NSLOT-1)*SLOTB)?0:sl_next+SLOTB;}while(0)
  DMA_K(2,2*SLOTB);
  WAIT_BAR(3);
  qkt(pA0,pA1,Kbase,qr,negm,r32,hi);asm volatile("s_nop 15\n\ts_nop 7":"+v"(pA0),"+v"(pA1));CMASK(pA0,pA1,0);
  START(pA0,pA1);
  _Pragma("unroll") for(int r=0;r<16;++r)pA1[r]=__builtin_amdgcn_exp2f(pA1[r]);
  WAIT_BAR(0);
  DMA_K(3,0);DMA_V(1,SLOTB);
  ROT();
  kload8(kf,kp0+sl_cur);
  WAIT_BAR(2);
  s16x4 vlo[8],vhi[8]; u32x4 pw0,pw1,pw2,pw3;
  #define PKW(P,B) cvtpk_s(P[B],P[B+1])
  #define PAF(k) __builtin_bit_cast(bf16x8,pw##k)
  #define VFR(i) (bf16x8){vlo[i][0],vlo[i][1],vlo[i][2],vlo[i][3],vhi[i][0],vhi[i][1],vhi[i][2],vhi[i][3]}
  #define PIN(x) asm volatile("":"+v"(x))
  #define MX3(a,b,c) __builtin_fmaxf(__builtin_fmaxf((a),(b)),(c))
  #define GAPA(MF,A0,A1,A2,A3,W0,W1,PW) do{ MF; sacc+=A0; sacc+=A1; sacc+=A2; sacc+=A3; PIN(sacc); W0; W1; PIN(PW); SBAR(); }while(0)
  #define EX(v) __builtin_amdgcn_exp2f(v)
  #define GAPB(MF,X,B) do{ MF; X[B]=EX(X[B]); X[B+1]=EX(X[B+1]); X[B+2]=EX(X[B+2]); X[B+3]=EX(X[B+3]); PIN(X); SBAR(); }while(0)
  #define VRD(i) do{ vlo[i]=vtr(vp_+(((i)>>2)*4096+((i)&3)*1024)); vhi[i]=vtr(vp_+(((i)>>2)*4096+((i)&3)*1024+512)); }while(0)
  #define KRD(G,j) do{ if(G){ kload2(kf,kp0+sl_next,j); SBAR(); } }while(0)
  #define STEP(C0,C1,P0,P1,t,GK,GV,GL) do{ SBAR(); \
    const lds_cptr vp_=vp0+sl_prev; \
    VRD(0); SBAR(); float sacc=(P0[0]+P0[1]); \
    GAPA(C0=__builtin_amdgcn_mfma_f32_32x32x16_bf16(kf[0],qr[0],negm,0,0,0), P0[2],P0[3],P0[4],P0[5],     pw0[0]=PKW(P0,0), pw0[1]=PKW(P0,2), pw0); \
    VRD(4); SBAR(); GAPA(C1=__builtin_amdgcn_mfma_f32_32x32x16_bf16(kf[1],qr[0],negm,0,0,0), P0[6],P0[7],P0[8],P0[9],     pw0[2]=PKW(P0,4), pw0[3]=PKW(P0,6), pw0); \
    VRD(1); SBAR(); GAPA(C0=__builtin_amdgcn_mfma_f32_32x32x16_bf16(kf[2],qr[1],C0,0,0,0),   P0[10],P0[11],P0[12],P0[13], pw1[0]=PKW(P0,8), pw1[1]=PKW(P0,10), pw1); \
    VRD(5); SBAR(); GAPA(C1=__builtin_amdgcn_mfma_f32_32x32x16_bf16(kf[3],qr[1],C1,0,0,0),   P0[14],P0[15],P1[0],P1[1],   pw1[2]=PKW(P0,12),pw1[3]=PKW(P0,14), pw1); \
    VRD(2); SBAR(); GAPA(C0=__builtin_amdgcn_mfma_f32_32x32x16_bf16(kf[4],qr[2],C0,0,0,0),   P1[2],P1[3],P1[4],P1[5],     pw2[0]=PKW(P1,0), pw2[1]=PKW(P1,2), pw2); \
    VRD(6); SBAR(); GAPA(C1=__builtin_amdgcn_mfma_f32_32x32x16_bf16(kf[5],qr[2],C1,0,0,0),   P1[6],P1[7],P1[8],P1[9],     pw2[2]=PKW(P1,4), pw2[3]=PKW(P1,6), pw2); \
    VRD(3); SBAR(); GAPA(C0=__builtin_amdgcn_mfma_f32_32x32x16_bf16(kf[6],qr[3],C0,0,0,0),   P1[10],P1[11],P1[12],P1[13], pw3[0]=PKW(P1,8), pw3[1]=PKW(P1,10), pw3); \
    VRD(7); SBAR(); GAPA(C1=__builtin_amdgcn_mfma_f32_32x32x16_bf16(kf[7],qr[3],C1,0,0,0),   P1[14],P1[15],0.f,0.f,       pw3[2]=PKW(P1,12),pw3[3]=PKW(P1,14), pw3); \
    l_reg+=sacc; \
    if(GK){DMA_K((t)+3,sl_cur);} if(GV){DMA_V((t)+1,sl_next);} \
    CMASK(C0,C1,t); \
    { float a=MX3(C0[0],C0[1],C1[0]),b=MX3(C0[2],C0[3],C1[1]); a=MX3(a,C1[2],C1[3]); \
      _Pragma("unroll") for(int r=4;r<16;r+=4){a=MX3(a,C0[r],C0[r+1]);b=MX3(b,C0[r+2],C0[r+3]);a=MX3(a,C1[r],C1[r+1]);b=MX3(b,C1[r+2],C1[r+3]);} \
      float rm=__builtin_fmaxf(a,b); { auto rr=__builtin_amdgcn_permlane32_swap(__float_as_uint(rm),__float_as_uint(rm),false,false); rm=__builtin_fmaxf(__uint_as_float(rr[0]),__uint_as_float(rr[1])); } \
      resc=false; \
      if(__builtin_expect(__any(rm>(float)THRL),0)){ const float dl=__builtin_fmaxf(rm,0.f); mhat+=dl; \
        _Pragma("unroll") for(int r=0;r<16;++r){C0[r]-=dl;C1[r]-=dl;} \
        _Pragma("unroll") for(int r=0;r<16;++r)negm[r]=-mhat; asm volatile("":"+v"(negm)); \
        const float f=__builtin_amdgcn_exp2f(-dl); l_reg*=f; if(hi==0)wsf[r32]=f; resc=true; } } \
    SBAR(); \
    GAPB(o[0]=__builtin_amdgcn_mfma_f32_32x32x16_bf16(PAF(0),VFR(0),o[0],0,0,0), C0,0); \
    GAPB(o[1]=__builtin_amdgcn_mfma_f32_32x32x16_bf16(PAF(0),VFR(4),o[1],0,0,0), C0,4); \
    KRD(GL,0); GAPB(o[0]=__builtin_amdgcn_mfma_f32_32x32x16_bf16(PAF(1),VFR(1),o[0],0,0,0), C0,8); \
    KRD(GL,1); GAPB(o[1]=__builtin_amdgcn_mfma_f32_32x32x16_bf16(PAF(1),VFR(5),o[1],0,0,0), C0,12); \
    KRD(GL,2); GAPB(o[0]=__builtin_amdgcn_mfma_f32_32x32x16_bf16(PAF(2),VFR(2),o[0],0,0,0), C1,0); \
    KRD(GL,3); GAPB(o[1]=__builtin_amdgcn_mfma_f32_32x32x16_bf16(PAF(2),VFR(6),o[1],0,0,0), C1,4); \
    GAPB(o[0]=__builtin_amdgcn_mfma_f32_32x32x16_bf16(PAF(3),VFR(3),o[0],0,0,0), C1,8); \
    GAPB(o[1]=__builtin_amdgcn_mfma_f32_32x32x16_bf16(PAF(3),VFR(7),o[1],0,0,0), C1,12); \
    }while(0)
  int t=1;
  for(;t+5<NT;t+=2){
    STEP(pB0,pB1,pA0,pA1,t,true,true,true);     WAIT_BAR(2); RESC(); ROT();
    STEP(pA0,pA1,pB0,pB1,t+1,true,true,true);   WAIT_BAR(2); RESC(); ROT();
  }
  #define ENDW(tt) do{ if((tt)+3<NT){WAIT_BAR(2);} else if((tt)+2<NT){WAIT_BAR(1);} else {WAIT_BAR(0);} }while(0)
  for(;t+1<NT;t+=2){
    STEP(pB0,pB1,pA0,pA1,t,(t+3<NT),(t+1<NT),(t+1<NT));       ENDW(t);   RESC(); ROT();
    STEP(pA0,pA1,pB0,pB1,t+1,(t+4<NT),(t+2<NT),(t+2<NT));     ENDW(t+1); RESC(); ROT();
  }
  STEP(pB0,pB1,pA0,pA1,NT-1,false,false,false); RESC();
  { float sacc=pB0[0]+pB0[1]; _Pragma("unroll") for(int r=2;r<16;++r)sacc+=pB0[r]; _Pragma("unroll") for(int r=0;r<16;++r)sacc+=pB1[r]; l_reg+=sacc;
    pw0=(u32x4){PKW(pB0,0),PKW(pB0,2),PKW(pB0,4),PKW(pB0,6)};pw1=(u32x4){PKW(pB0,8),PKW(pB0,10),PKW(pB0,12),PKW(pB0,14)};pw2=(u32x4){PKW(pB1,0),PKW(pB1,2),PKW(pB1,4),PKW(pB1,6)};pw3=(u32x4){PKW(pB1,8),PKW(pB1,10),PKW(pB1,12),PKW(pB1,14)};
    SBAR(); pv(o,vb0+sl_cur,PAF(0),PAF(1),PAF(2),PAF(3)); }
  #undef PKW
  #undef PAF
  #undef VFR
  #undef PIN
  #undef MX3
  #undef GAPA
  #undef GAPB
  #undef EX
  #undef VRD
  #undef KRD
  #undef STEP
  #undef ENDW
  {auto rr=__builtin_amdgcn_permlane32_swap(__float_as_uint(l_reg),__float_as_uint(l_reg),false,false);l_reg=__uint_as_float(rr[0])+__uint_as_float(rr[1]);}
  if(hi==0)wsf[32+r32]=l_reg;asm volatile("s_waitcnt lgkmcnt(0)":::"memory");
  float rli[16];
  #pragma unroll
  for(int r=0;r<16;++r)rli[r]=__builtin_amdgcn_rcpf(wsf[32+crow(r,hi)]);
  bf16*Ow=Ou+(long)(wid*QBLK)*QP;
  { bf16*stg=(bf16*)(shm+LDS_OST)+wid*2048;
    #pragma unroll
    for(int r=0;r<16;++r){const int orow=crow(r,hi);
      #pragma unroll
      for(int d0=0;d0<2;++d0)stg[orow*64+d0*32+r32]=__float2bfloat16(o[d0][r]*rli[r]);}
    asm volatile("s_waitcnt lgkmcnt(0)":::"memory");
    #pragma unroll
    for(int i=0;i<4;++i){const int row=i*8+(lane>>3),ch=lane&7; const u32x4 v=*(const u32x4*)(stg+row*64+ch*8); ATTN_STORE16(Ow+(long)row*QP+ch*8,v);} }
  asm volatile("s_waitcnt lgkmcnt(0)\n\ts_barrier":::"memory");
  #undef DMA_K
  #undef DMA_V
  #undef CMASK
  #undef START
  #undef RESC
  #undef ROT
}
constexpr int ATTN_LDS_BYTES=LDS_BYTES;
#undef SBAR
#undef WAIT_BAR
}

#define XB_TMO      128
#define XB_XCNT(j)  (256  + 64 * (j))
#define XB_XSUB(j)  (1280 + 64 * (j))
#define XB_XGEN(j)  (2304 + 64 * (j))
#define XB_TOP      3328
#define XB_TOPGEN   3392
#define XCD_BAR_WORDS 3456
#define XB_SPIN_CAP (1u << 18)

__device__ __forceinline__ unsigned xb_ld(unsigned* p)              { return __hip_atomic_load(p, __ATOMIC_RELAXED, __HIP_MEMORY_SCOPE_AGENT); }
__device__ __forceinline__ unsigned xb_add(unsigned* p, unsigned v) { return __hip_atomic_fetch_add(p, v, __ATOMIC_RELAXED, __HIP_MEMORY_SCOPE_AGENT); }
__device__ __forceinline__ unsigned xb_xcc_id() { return (unsigned)__builtin_amdgcn_s_getreg((3 << 11) | 20) & 0xFu; }
#define XB_SPIN(cond, bar) do { unsigned _sp = 0; while (cond) { __builtin_amdgcn_s_sleep(1); \
    if ((++_sp & 255u) == 0u) { if (xb_ld(&(bar)[XB_TMO])) break; if (_sp > XB_SPIN_CAP) { atomicAdd(&(bar)[XB_TMO], 1u); break; } } } } while (0)

struct XcdBarrier {
    unsigned* bar; unsigned x;
    volatile LAS unsigned* st;
};

__device__ __forceinline__ XcdBarrier xcd_barrier_post(unsigned* bar, volatile LAS unsigned* st) {
    XcdBarrier b; b.bar = bar; b.x = xb_xcc_id(); b.st = st;
    if (threadIdx.x == 0) (void)xb_add(&bar[XB_XCNT(b.x)], 1u);
    return b;
}
__device__ __forceinline__ void xcd_barrier_complete(unsigned* bar, unsigned x, unsigned& nloc, unsigned& nx) {
    const unsigned G = gridDim.x * gridDim.y * gridDim.z;
    unsigned sum, cnt, mine, sp = 0u;
    for (;;) {
        sum = 0u; cnt = 0u; mine = 0u;
#pragma unroll
        for (unsigned j = 0; j < 16; ++j) { const unsigned c = xb_ld(&bar[XB_XCNT(j)]); sum += c; cnt += (c > 0u) ? 1u : 0u; mine = (j == x) ? c : mine; }
        if (sum == G) break;
        __builtin_amdgcn_s_sleep(1);
        if ((++sp & 255u) == 0u) { if (xb_ld(&bar[XB_TMO])) break; if (sp > XB_SPIN_CAP) { atomicAdd(&bar[XB_TMO], 1u); break; } }
    }
    nloc = mine > 0u ? mine : 1u; nx = cnt > 0u ? cnt : 1u;
}

__device__ __forceinline__ void xcd_barrier(const XcdBarrier& b) {
    asm volatile("s_waitcnt vmcnt(0)" ::: "memory");
    __syncthreads();
    if (threadIdx.x == 0) {
        unsigned* bar = b.bar;
        __builtin_amdgcn_s_waitcnt(0);
        unsigned nloc = b.st[0], nx = b.st[1];
        if (nloc == 0u) { xcd_barrier_complete(bar, b.x, nloc, nx); b.st[0] = nloc; b.st[1] = nx; }
        const unsigned old = xb_add(&bar[XB_XSUB(b.x)], 1u);
        const unsigned gen = old / nloc;
        if (old + 1u == (gen + 1u) * nloc) {
            __builtin_amdgcn_fence(__ATOMIC_RELEASE, "agent");
            asm volatile("s_waitcnt vmcnt(0)" ::: "memory");
            const unsigned og = xb_add(&bar[XB_TOP], 1u);
            const unsigned tg = og / nx;
            if (og + 1u == (tg + 1u) * nx) xb_add(&bar[XB_TOPGEN], 1u);
            else XB_SPIN(xb_ld(&bar[XB_TOPGEN]) == tg, bar);
            __builtin_amdgcn_fence(__ATOMIC_ACQUIRE, "agent");
            xb_add(&bar[XB_XGEN(b.x)], 1u);
            asm volatile("s_waitcnt vmcnt(0)" ::: "memory");
        } else {
            XB_SPIN(xb_ld(&bar[XB_XGEN(b.x)]) == gen, bar);
            __builtin_amdgcn_fence(__ATOMIC_ACQUIRE, "agent");
            asm volatile("s_waitcnt vmcnt(0)" ::: "memory");
        }
    }
    __syncthreads();
}

struct Args { const GAS float* in[33]; GAS float* out; unsigned char* ws; int mode, l, site, chunk; };
struct Frame {
    LAS unsigned char* lds; volatile LAS unsigned* MISC; gu32* ctl;
    int tid, lane, wave, vcu, G;
    unsigned char* ws; GAS float* out;
};
#define WSP(T, off) ((GAS T*)(F.ws + (off)))
#define WSGEN(T, off) ((T*)(F.ws + (off)))
__device__ __forceinline__ const GAS float* inptr(LAS unsigned char* lds, int i) { const LAS unsigned* p = (const LAS unsigned*)(lds + PTAB_OFF) + 2 * i; const unsigned lo = __builtin_amdgcn_readfirstlane(p[0]), hi = __builtin_amdgcn_readfirstlane(p[1]); return (const GAS float*)(((unsigned long long)hi << 32) | lo); }
#define INP(i) inptr(F.lds, (i))

__device__ __forceinline__ void conv_item(const GAS float* W, int Nsrc, int k0, int c0, GAS bf16* WT, int K, int drow0, LAS float* scr, int lane) {
#pragma unroll 8
    for (int i = 0; i < 32; ++i) { const int kk = 2 * i + (lane >> 5); scr[kk * 33 + (lane & 31)] = W[(size_t)(k0 + kk) * Nsrc + c0 + (lane & 31)]; }
    LDS_WAIT(); asm volatile("" ::: "memory");
    const int c = lane & 7;
#pragma unroll
    for (int j = 0; j < 4; ++j) { const int n = (lane >> 3) + 8 * j; const LAS float* s = scr + (8 * c) * 33 + n;
        v4u o; o.x = pk2(s[0 * 33], s[1 * 33]); o.y = pk2(s[2 * 33], s[3 * 33]); o.z = pk2(s[4 * 33], s[5 * 33]); o.w = pk2(s[6 * 33], s[7 * 33]);
        *(GAS v4u*)(WT + (size_t)(drow0 + n) * K + k0 + 8 * c) = o; }
    LDS_WAIT(); asm volatile("" ::: "memory");
}
__device__ __forceinline__ void conv_plain(int item, const GAS float* W, int K, int N, GAS bf16* WT, LAS float* scr, int lane) {
    const int ng = N / 32, kb = item / ng, g = item % ng; conv_item(W, N, 64 * kb, 32 * g, WT, K, 32 * g, scr, lane);
}
__device__ __forceinline__ void conv_gu(int item, const GAS float* W, GAS bf16* WT, int off, LAS float* scr, int lane) {
    const int ng = FF / 32, kb = item / ng, g = item % ng; conv_item(W, FF, 64 * kb, 32 * g, WT, DM, 256 * (g >> 2) + off + 32 * (g & 3), scr, lane);
}
__device__ __forceinline__ void mod_task(Frame& F, int task) {
    const int l = task / 96, nb = task % 96;
    LAS float* S = (LAS float*)F.lds;
    for (int i = F.tid; i < 33 * 1024; i += 512) { const int bi = i >> 10, k = i & 1023; const float c = bi < 32 ? INP(1)[bi * 1024 + k] : INP(3)[k]; S[k * 33 + bi] = c / (1.0f + __expf(-c)); }
    __syncthreads();
    const GAS float* W = INP(4) + (size_t)l * DM * 6144 + nb * 64 + F.lane;
    float acc[33];
#pragma unroll
    for (int bi = 0; bi < 33; ++bi) acc[bi] = 0.f;
    const int k0 = F.wave * 128;
    for (int k = k0; k < k0 + 128; ++k) { const float w = W[(size_t)k * 6144];
#pragma unroll
        for (int bi = 0; bi < 33; ++bi) acc[bi] = fmaf(S[k * 33 + bi], w, acc[bi]); }
    __syncthreads();
    LAS float* P = (LAS float*)F.lds;
#pragma unroll
    for (int bi = 0; bi < 33; ++bi) P[(F.wave * 33 + bi) * 64 + F.lane] = acc[bi];
    __syncthreads();
    GAS float* mod = WSP(float, WS_MOD);
    for (int o = F.tid; o < 33 * 64; o += 512) { const int bi = o >> 6, cc = o & 63; float s = 0.f;
#pragma unroll
        for (int w = 0; w < 8; ++w) s += P[(w * 33 + bi) * 64 + cc];
        const int n = nb * 64 + cc; mod[(size_t)(l * 33 + bi) * 6144 + n] = s + INP(5)[l * 6144 + n]; }
    __syncthreads();
}
__device__ __forceinline__ void p0_prologue(Frame& F) {
    for (int t = F.vcu; t < 192; t += F.G) mod_task(F, t);
    if (F.vcu == F.G - 1) { GAS float* rt = WSP(float, WS_ROPE);
        for (int i = F.tid; i < 1024; i += 512) { const int pos = i >> 4, f = i & 15; const float inv = powf(10000.0f, -(float)f / 16.0f); const float a = (float)pos * inv; rt[i] = cosf(a); rt[1024 + i] = sinf(a); } }
    LAS float* scr = (LAS float*)(F.lds + F.wave * 8448);
    const int gw = F.vcu * NWAVES + F.wave, NGW = F.G * NWAVES;
    constexpr int I_IN = 16 * 144, I_P = 8 * 32, I_O = 16 * 32, I_GU = 16 * 112, I_DN = 56 * 32, I_L = 16, I_G2 = 32;
    constexpr int NITEMS = 2 * I_IN + 4 * I_P + 2 * I_O + 2 * I_GU + I_DN + 8 * I_L + 2 * I_G2;
    GAS bf16* lora = WSP(bf16, WS_LORA);
    for (int it = gw; it < NITEMS; it += NGW) {
        int r = it;
        if (r < 2 * I_IN) { const int l = r / I_IN; conv_plain(r % I_IN, INP(8) + (size_t)l * DM * NIN, DM, NIN, WSP(bf16, WS_WIN) + (size_t)l * NIN * DM, scr, F.lane); continue; } r -= 2 * I_IN;
        if (r < 2 * I_P) { const int l = r / I_P; conv_plain(r % I_P, INP(22) + (size_t)l * RW * DM, RW, DM, WSP(bf16, WS_WPA) + (size_t)l * DM * RW, scr, F.lane); continue; } r -= 2 * I_P;
        if (r < 2 * I_P) { const int l = r / I_P; conv_plain(r % I_P, INP(23) + (size_t)l * RW * DM, RW, DM, WSP(bf16, WS_WPB) + (size_t)l * DM * RW, scr, F.lane); continue; } r -= 2 * I_P;
        if (r < 2 * I_O) { const int l = r / I_O; conv_plain(r % I_O, INP(24) + (size_t)l * DM * DM, DM, DM, WSP(bf16, WS_WO) + (size_t)l * DM * DM, scr, F.lane); continue; } r -= 2 * I_O;
        if (r < I_GU) { conv_gu(r, INP(25), WSP(bf16, WS_WGU), 0, scr, F.lane); continue; } r -= I_GU;
        if (r < I_GU) { conv_gu(r, INP(26), WSP(bf16, WS_WGU), 128, scr, F.lane); continue; } r -= I_GU;
        if (r < I_DN) { conv_plain(r, INP(27), FF, DM, WSP(bf16, WS_WDN), scr, F.lane); continue; } r -= I_DN;
        if (r < 4 * I_L) { const int ld = r / I_L; conv_plain(r % I_L, INP(11) + (size_t)ld * 64 * RW, 64, RW, lora + (size_t)ld * RW * 64, scr, F.lane); continue; } r -= 4 * I_L;
        if (r < 4 * I_L) { const int ld = r / I_L; conv_plain(r % I_L, INP(13) + (size_t)ld * 64 * RW, 64, RW, lora + (size_t)(4 + ld) * RW * 64, scr, F.lane); continue; } r -= 4 * I_L;
        { const int l = r / I_G2; conv_plain(r % I_G2, INP(14) + (size_t)l * 128 * RW, 128, RW, lora + (size_t)8 * RW * 64 + (size_t)l * RW * 128, scr, F.lane); }
    }
}
__device__ __forceinline__ void moe_conv(Frame& F) {
    LAS float* scr = (LAS float*)(F.lds + F.wave * 8448);
    const int gw = F.vcu * NWAVES + F.wave, NGW = F.G * NWAVES;
    constexpr int I_GU = 16 * 112, I_DN = 56 * 32, I_E = 2 * I_GU + I_DN;
    for (int it = gw; it < NE * I_E; it += NGW) {
        const int e = it / I_E; int r = it % I_E; GAS bf16* base = WSP(bf16, WS_MW) + (size_t)e * (21 * MiB / 2);
        if (r < I_GU) { conv_gu(r, INP(29) + (size_t)e * DM * FF, base, 0, scr, F.lane); continue; } r -= I_GU;
        if (r < I_GU) { conv_gu(r, INP(30) + (size_t)e * DM * FF, base, 128, scr, F.lane); continue; } r -= I_GU;
        conv_plain(r, INP(31) + (size_t)e * FF * DM, FF, DM, base + (size_t)2 * FF * DM, scr, F.lane);
    }
}

template <bool ROUTER>
__device__ __forceinline__ void norm_mod_phase(Frame& F, int l, int which, const GAS float* xlat, const GAS float* xctx, int nrows, GAS bf16* H) {
    const int gw = F.vcu * NWAVES + F.wave, NGW = F.G * NWAVES;
    const GAS float* gain = INP(which ? 7 : 6) + l * DM;
    const GAS float* modl = WSP(float, WS_MOD) + (size_t)l * 33 * 6144 + (which ? 3072 : 0);
    for (int m = gw; m < nrows; m += NGW) {
        const GAS float* xr = m < NL ? xlat + (size_t)m * DM : xctx + (size_t)(m - NL) * DM;
        const GAS float* mv = modl + (size_t)row_bi(m) * 6144;
        f32x4 v[4]; float s = 0.f;
#pragma unroll
        for (int j = 0; j < 4; ++j) { v[j] = *(const GAS f32x4*)(xr + 4 * F.lane + 256 * j); s += (v[j].x * v[j].x + v[j].y * v[j].y) + (v[j].z * v[j].z + v[j].w * v[j].w); }
        const float rstd = 1.0f / sqrtf(wave_sum(s) * (1.0f / DM) + 1e-6f);
        float lg[8];
        if (ROUTER) {
#pragma unroll
            for (int e = 0; e < 8; ++e) lg[e] = 0.f; }
#pragma unroll
        for (int j = 0; j < 4; ++j) { const int c = 4 * F.lane + 256 * j;
            const f32x4 g = *(const GAS f32x4*)(gain + c), sh = *(const GAS f32x4*)(mv + c), sc = *(const GAS f32x4*)(mv + 1024 + c);
            const f32x4 hv = v[j] * rstd * g * (sc + 1.0f) + sh;
            v2u o; o.x = pk2(hv.x, hv.y); o.y = pk2(hv.z, hv.w);
            *(GAS v2u*)(H + (size_t)m * DM + c) = o;
            if (ROUTER) { const GAS float* rw = INP(28) + (size_t)c * 8;
#pragma unroll
                for (int q = 0; q < 4; ++q) { const f32x4 r0 = *(const GAS f32x4*)(rw + q * 8), r1 = *(const GAS f32x4*)(rw + q * 8 + 4); const float hq = hv[q];
                    lg[0] = fmaf(hq, r0.x, lg[0]); lg[1] = fmaf(hq, r0.y, lg[1]); lg[2] = fmaf(hq, r0.z, lg[2]); lg[3] = fmaf(hq, r0.w, lg[3]);
                    lg[4] = fmaf(hq, r1.x, lg[4]); lg[5] = fmaf(hq, r1.y, lg[5]); lg[6] = fmaf(hq, r1.z, lg[6]); lg[7] = fmaf(hq, r1.w, lg[7]); } }
        }
        if (ROUTER) {
#pragma unroll
            for (int e = 0; e < 8; ++e) lg[e] = wave_sum(lg[e]);
            int e0 = 0; float l0 = lg[0];
#pragma unroll
            for (int e = 1; e < 8; ++e) if (lg[e] > l0) { l0 = lg[e]; e0 = e; }
            int e1 = -1; float l1 = -INFINITY;
#pragma unroll
            for (int e = 0; e < 8; ++e) if (e != e0 && lg[e] > l1) { l1 = lg[e]; e1 = e; }
            const float w1 = 1.0f / (1.0f + __expf(l0 - l1)), w0 = 1.0f - w1;
            if (F.lane == 0) {
                GAS int* te = (GAS int*)(F.ws + WS_MOETAB + MT_TOKE) + 2 * m; GAS float* tw = (GAS float*)(F.ws + WS_MOETAB + MT_TOKW) + 2 * m;
                te[0] = e0; te[1] = e1; tw[0] = w0; tw[1] = w1;
                __hip_atomic_fetch_add((LAS unsigned*)&F.MISC[16 + e0], 1u, __ATOMIC_RELAXED, __HIP_MEMORY_SCOPE_WORKGROUP); __hip_atomic_fetch_add((LAS unsigned*)&F.MISC[16 + e1], 1u, __ATOMIC_RELAXED, __HIP_MEMORY_SCOPE_WORKGROUP);
            }
        }
    }
    if (ROUTER) { __syncthreads(); if (F.tid < 8) { const unsigned c = F.MISC[16 + F.tid]; if (c) __hip_atomic_fetch_add(F.ctl + CW_HIST + 64 * F.tid, c, RLX_AGENT); } __syncthreads(); }
}

using pg8::Unit;
struct EpiIn {
    static constexpr bool PERM = true, AFTER_DRAIN = false;
    GAS bf16 *PR, *Q, *KB, *VB, *G;
    __device__ __forceinline__ void operator()(const f32x4 (&acc)[2][2][4][2], const Unit& u, int wr, int wc, int fr, int fq) const {
        const int row0 = u.pm * 256 + wr * 64 + fr, cb = wc * 32 + 8 * fq, pn = u.pn;
#pragma unroll
        for (int ai = 0; ai < 2; ++ai)
#pragma unroll
            for (int m = 0; m < 4; ++m) { const int r = row0 + ai * 128 + m * 16;
#pragma unroll
                for (int bj = 0; bj < 2; ++bj) { f32x4 v0 = acc[ai][bj][m][0], v1 = acc[ai][bj][m][1]; GAS bf16* dst;
                    if (pn < 7) dst = PR + (size_t)r * RCOLS + pn * 256 + bj * 128 + cb;
                    else if (pn < 9) dst = Q + (size_t)r * 512 + (pn - 7) * 256 + bj * 128 + cb;
                    else if (pn == 9) dst = (bj == 0 ? KB : VB) + (size_t)row_kv(r) * 128 + cb;
                    else { dst = G + (size_t)r * GCOLS + (pn - 10) * 256 + bj * 128 + cb;
#pragma unroll
                        for (int q = 0; q < 4; ++q) { v0[q] = sigmoidf_(v0[q]); v1[q] = sigmoidf_(v1[q]); } }
                    v4u w; w.x = pk2(v0[0], v0[1]); w.y = pk2(v0[2], v0[3]); w.z = pk2(v1[0], v1[1]); w.w = pk2(v1[2], v1[3]);
                    *(GAS v4u*)dst = w; } }
    }
};
template <int MODE> struct EpiMerge {
    static constexpr bool PERM = true, AFTER_DRAIN = false;
    const GAS bf16* G; GAS bf16* MG;
    __device__ __forceinline__ void operator()(const f32x4 (&acc)[2][2][4][2], const Unit& u, int wr, int wc, int fr, int fq) const {
        const int row0 = u.pm * 256 + wr * 64 + fr, col0 = u.pn * 256 + wc * 32 + 8 * fq;
#pragma unroll
        for (int ai = 0; ai < 2; ++ai)
#pragma unroll
            for (int m = 0; m < 4; ++m) { const int r = row0 + ai * 128 + m * 16;
#pragma unroll
                for (int bj = 0; bj < 2; ++bj) { const int c = col0 + bj * 128;
                    const v4u g = *(const GAS v4u*)(G + (size_t)r * GCOLS + MODE * DM + c);
                    const f32x4 a0 = acc[ai][bj][m][0], a1 = acc[ai][bj][m][1];
                    float o[8] = { bflo(g.x) * a0[0], bfhi(g.x) * a0[1], bflo(g.y) * a0[2], bfhi(g.y) * a0[3], bflo(g.z) * a1[0], bfhi(g.z) * a1[1], bflo(g.w) * a1[2], bfhi(g.w) * a1[3] };
                    GAS bf16* dst = MG + (size_t)r * DM + c;
                    if (MODE == 1) { const v4u p = *(const GAS v4u*)dst; o[0] += bflo(p.x); o[1] += bfhi(p.x); o[2] += bflo(p.y); o[3] += bfhi(p.y); o[4] += bflo(p.z); o[5] += bfhi(p.z); o[6] += bflo(p.w); o[7] += bfhi(p.w); }
                    v4u w; w.x = pk2(o[0], o[1]); w.y = pk2(o[2], o[3]); w.z = pk2(o[4], o[5]); w.w = pk2(o[6], o[7]);
                    *(GAS v4u*)dst = w; } }
    }
};
struct EpiRes {
    static constexpr bool PERM = false, AFTER_DRAIN = false;
    const GAS float *base_lat, *base_ctx; GAS float *out_lat, *out_ctx; const GAS float* gt;
    __device__ __forceinline__ void operator()(const f32x4 (&acc)[2][2][4][2], const Unit& u, int wr, int wc, int fr, int fq) const {
        const bool lat = u.pm < NL / 256; const int bi = lat ? (u.pm >> 3) : 32;
        const int rr0 = (lat ? u.pm * 256 : u.pm * 256 - NL) + wr * 64 + fr, col0 = u.pn * 256 + wc * 32 + 4 * fq;
        const GAS float* bp = lat ? base_lat : base_ctx; GAS float* op = lat ? out_lat : out_ctx; const GAS float* gv = gt + (size_t)bi * 6144 + col0;
        f32x4 g[2][2];
#pragma unroll
        for (int bj = 0; bj < 2; ++bj)
#pragma unroll
            for (int n = 0; n < 2; ++n) g[bj][n] = *(const GAS f32x4*)(gv + bj * 128 + n * 16);
#pragma unroll
        for (int ai = 0; ai < 2; ++ai)
#pragma unroll
            for (int m = 0; m < 4; ++m) { const size_t off = (size_t)(rr0 + ai * 128 + m * 16) * DM + col0;
#pragma unroll
                for (int bj = 0; bj < 2; ++bj)
#pragma unroll
                    for (int n = 0; n < 2; ++n) { const f32x4 b = *(const GAS f32x4*)(bp + off + bj * 128 + n * 16); *(GAS f32x4*)(op + off + bj * 128 + n * 16) = b + g[bj][n] * acc[ai][bj][m][n]; }
                asm volatile("" ::: "memory"); }
    }
};
struct EpiGU {
    static constexpr bool PERM = true, AFTER_DRAIN = false;
    GAS bf16* ACT; int pm0;
    __device__ __forceinline__ void operator()(const f32x4 (&acc)[2][2][4][2], const Unit& u, int wr, int wc, int fr, int fq) const {
        const int row0 = (u.pm - pm0) * 256 + wr * 64 + fr, col0 = u.pn * 128 + wc * 32 + 8 * fq;
#pragma unroll
        for (int ai = 0; ai < 2; ++ai)
#pragma unroll
            for (int m = 0; m < 4; ++m) { const int r = row0 + ai * 128 + m * 16; float o[8];
#pragma unroll
                for (int n = 0; n < 2; ++n)
#pragma unroll
                    for (int q = 0; q < 4; ++q) { const float gte = acc[ai][0][m][n][q], up = acc[ai][1][m][n][q]; o[4 * n + q] = gte * sigmoidf_(gte) * up; }
                v4u w; w.x = pk2(o[0], o[1]); w.y = pk2(o[2], o[3]); w.z = pk2(o[4], o[5]); w.w = pk2(o[6], o[7]);
                *(GAS v4u*)(ACT + (size_t)r * FF + col0) = w; }
    }
};
struct EpiStore {
    static constexpr bool PERM = true, AFTER_DRAIN = false;
    GAS bf16* O;
    __device__ __forceinline__ void operator()(const f32x4 (&acc)[2][2][4][2], const Unit& u, int wr, int wc, int fr, int fq) const {
        const int row0 = u.pm * 256 + wr * 64 + fr, col0 = u.pn * 256 + wc * 32 + 8 * fq;
#pragma unroll
        for (int ai = 0; ai < 2; ++ai)
#pragma unroll
            for (int m = 0; m < 4; ++m) { const int r = row0 + ai * 128 + m * 16;
#pragma unroll
                for (int bj = 0; bj < 2; ++bj) { const f32x4 v0 = acc[ai][bj][m][0], v1 = acc[ai][bj][m][1];
                    v4u w; w.x = pk2(v0[0], v0[1]); w.y = pk2(v0[2], v0[3]); w.z = pk2(v1[0], v1[1]); w.w = pk2(v1[2], v1[3]);
                    *(GAS v4u*)(O + (size_t)r * DM + col0 + bj * 128) = w; } }
    }
};
struct MoeOrder {
    const char* A; const char* W; size_t a_tstep, b_tstep, w_estep; int tile0, a_tile0, ntl, nN, G, c; const LAS int* tile_e;
    __device__ bool next(int i, Unit& u) const { const long L = (long)i * G + c; if (L >= (long)ntl * nN) return false; u.pn = (int)(L / ntl); u.pm = tile0 + (int)(L % ntl); return true; }
    __device__ __forceinline__ const char* a_base(const Unit& u) const { return A + (size_t)(u.pm - a_tile0) * a_tstep; }
    __device__ __forceinline__ const char* b_base(const Unit& u) const { return W + (size_t)tile_e[u.pm] * w_estep + (size_t)u.pn * b_tstep; }
    __device__ __forceinline__ void a_ready(const Unit&) const {}
    __device__ __forceinline__ void done(const Unit&) const {}
};

__device__ __forceinline__ void qk_phase(Frame& F, int l) {
    const int gw = F.vcu * NWAVES + F.wave, NGW = F.G * NWAVES, lane = F.lane, d0 = 8 * (lane & 7);
    const GAS float* rt = WSP(float, WS_ROPE);
    GAS bf16* Q = WSP(bf16, WS_Q); GAS bf16* KB = WSP(bf16, WS_KB);
    float gq[8], gk[8];
#pragma unroll
    for (int e = 0; e < 8; ++e) { gq[e] = INP(20)[l * 64 + d0 + e]; gk[e] = INP(21)[l * 64 + d0 + e]; }
    for (int m = gw; m < MA; m += NGW) {
        const bool lat = m < NL; const int t = m & 2047, pr = t >> 6, pc = t & 63;
        float cs[4], sn[4];
        if (lat) {
#pragma unroll
            for (int pi = 0; pi < 4; ++pi) { const int i = 4 * (lane & 7) + pi, pos = i < 16 ? pr : pc, f = i & 15; cs[pi] = rt[pos * 16 + f]; sn[pi] = rt[1024 + pos * 16 + f]; } }
        { GAS bf16* p = Q + (size_t)m * 512 + 8 * lane; const v4u w = *(const GAS v4u*)p;
          float x[8] = { bflo(w.x), bfhi(w.x), bflo(w.y), bfhi(w.y), bflo(w.z), bfhi(w.z), bflo(w.w), bfhi(w.w) };
          float ss = 0.f;
#pragma unroll
          for (int e = 0; e < 8; ++e) ss += x[e] * x[e];
          ss += __shfl_xor(ss, 1); ss += __shfl_xor(ss, 2); ss += __shfl_xor(ss, 4);
          const float r = 1.0f / sqrtf(ss * (1.0f / 64.0f) + 1e-6f);
#pragma unroll
          for (int e = 0; e < 8; ++e) x[e] = x[e] * r * gq[e];
          if (lat) {
#pragma unroll
              for (int pi = 0; pi < 4; ++pi) { const float x0 = x[2 * pi], x1 = x[2 * pi + 1]; x[2 * pi] = x0 * cs[pi] - x1 * sn[pi]; x[2 * pi + 1] = x0 * sn[pi] + x1 * cs[pi]; } }
          const float C2 = attn_body::C2;
          v4u o; o.x = pk2(x[0] * C2, x[1] * C2); o.y = pk2(x[2] * C2, x[3] * C2); o.z = pk2(x[4] * C2, x[5] * C2); o.w = pk2(x[6] * C2, x[7] * C2);
          *(GAS v4u*)p = o; }
        { GAS bf16* p = KB + (size_t)row_kv(m) * 128 + 8 * (lane & 15); v4u w = (v4u){0u, 0u, 0u, 0u}; if (lane < 16) w = *(const GAS v4u*)p;
          float x[8] = { bflo(w.x), bfhi(w.x), bflo(w.y), bfhi(w.y), bflo(w.z), bfhi(w.z), bflo(w.w), bfhi(w.w) };
          float ss = 0.f;
#pragma unroll
          for (int e = 0; e < 8; ++e) ss += x[e] * x[e];
          ss += __shfl_xor(ss, 1); ss += __shfl_xor(ss, 2); ss += __shfl_xor(ss, 4);
          const float r = 1.0f / sqrtf(ss * (1.0f / 64.0f) + 1e-6f);
#pragma unroll
          for (int e = 0; e < 8; ++e) x[e] = x[e] * r * gk[e];
          if (lat) {
#pragma unroll
              for (int pi = 0; pi < 4; ++pi) { const float x0 = x[2 * pi], x1 = x[2 * pi + 1]; x[2 * pi] = x0 * cs[pi] - x1 * sn[pi]; x[2 * pi + 1] = x0 * sn[pi] + x1 * cs[pi]; } }
          v4u o; o.x = pk2(x[0], x[1]); o.y = pk2(x[2], x[3]); o.z = pk2(x[4], x[5]); o.w = pk2(x[6], x[7]);
          if (lane < 16) *(GAS v4u*)p = o; }
    }
}

constexpr int SC_RAW = 0, SC_SV = 11520, SC_KT = SC_SV + 24576, SC_KK = SC_KT + 4096, SC_TWA = SC_KK + 4096, SC_ADA = SC_TWA + 2304, SC_YO = SC_ADA + 2304, SC_BON = SC_YO + 4096, SC_DIR = SC_BON + 256;
static_assert(2 * SC_DIR <= RING_BYTES, "scan LDS");
__device__ __forceinline__ float dpp_quad_sum(float v) {
    v += __builtin_bit_cast(float, __builtin_amdgcn_mov_dpp(__builtin_bit_cast(int, v), 0xB1, 0xF, 0xF, true));
    v += __builtin_bit_cast(float, __builtin_amdgcn_mov_dpp(__builtin_bit_cast(int, v), 0x4E, 0xF, 0xF, true));
    return v;
}
__device__ __forceinline__ void scan_phase(Frame& F, int l) {
    const int d = F.tid >> 8, dt = F.tid & 255, w4 = F.wave & 3, lane = F.lane;
    LAS unsigned char* L = F.lds + d * SC_DIR;
    LAS float* SV = (LAS float*)(L + SC_SV); LAS float* KT = (LAS float*)(L + SC_KT); LAS float* KK = (LAS float*)(L + SC_KK);
    LAS float* YO = (LAS float*)(L + SC_YO); LAS float* BON = (LAS float*)(L + SC_BON);
    const GAS bf16* PR = WSP(bf16, WS_PR);
    GAS bf16* Yd = WSP(bf16, d == 0 ? WS_YF : WS_YB);
    GAS float* bonus = WSP(float, WS_BONUS) + (size_t)d * MA * 8;
    const int j = dt >> 4, cg = dt & 15;
    const int st_j = d == 0 ? j : 15 - j;
    for (int p = F.vcu; p < NB * 8; p += F.G) {
        const int b = p >> 3, h = p & 7;
        const GAS bf16* w2t = WSP(bf16, WS_LORA) + (size_t)((l * 2 + d) * RW + h * 64 + 16 * w4 + (lane & 15)) * 64 + 8 * (lane >> 4);
        const GAS bf16* a2t = w2t + (size_t)4 * RW * 64;
        const int ccol = h * 64 + 16 * w4 + (lane & 15);
        const float w0c = INP(10)[(l * 2 + d) * RW + ccol], a0c = INP(12)[(l * 2 + d) * RW + ccol], kac = INP(16)[l * RW + ccol], rkc = INP(17)[l * RW + ccol];
        const GAS float* mup = INP(9) + (size_t)(l * 2) * RCOLS + 4 * cg; const GAS float* kkp = INP(15) + l * RW + h * 64 + 4 * cg;
        float S[16];
#pragma unroll
        for (int i = 0; i < 16; ++i) S[i] = 0.f;
        v4u raw[3];
#define SC_GEOM(c) const int s0_ = 16 * (c); const bool isctx_ = s0_ < TC; const int pos0_ = isctx_ ? s0_ : s0_ - TC; const int len_ = isctx_ ? TC : TL; \
        const int rowbase_ = isctx_ ? NL + b * TC : b * TL; const int toklo_ = d == 0 ? pos0_ : len_ - 16 - pos0_;
#define SC_LOAD(c) do { SC_GEOM(c) _Pragma("unroll") for (int i = 0; i < 3; ++i) { const int pp = dt + 256 * i; raw[i] = (v4u){0u, 0u, 0u, 0u}; \
            if (pp < 720) { const int row = pp / 40, rem = pp % 40, grp = rem >> 3, c8 = rem & 7; const int tr = toklo_ - 1 + row; \
                const int gc = grp == 0 ? h * 64 : grp == 1 ? 512 + h * 64 : grp == 2 ? 1024 + h * 64 : grp == 3 ? 1536 : 1600; \
                if (tr >= 0 && tr < len_) raw[i] = *(const GAS v4u*)(PR + (size_t)(rowbase_ + tr) * RCOLS + gc + 8 * c8); } } } while (0)
        SC_LOAD(0);
        for (int c = 0; c < KVT / 16; ++c) {
            SC_GEOM(c)
#pragma unroll
            for (int i = 0; i < 3; ++i) { const int pp = dt + 256 * i; if (pp < 720) { const int row = pp / 40, rem = pp % 40; *(LAS v4u*)(L + SC_RAW + (row * 320 + rem * 8) * 2) = raw[i]; } }
            __syncthreads();
            if (c + 1 < KVT / 16) SC_LOAD(c + 1);
            {
                f32x4 xs[5];
#pragma unroll
                for (int g = 0; g < 5; ++g) {
                    const v2u a0 = *(const LAS v2u*)(L + SC_RAW + ((j + 0) * 320 + g * 64 + 4 * cg) * 2), a1 = *(const LAS v2u*)(L + SC_RAW + ((j + 1) * 320 + g * 64 + 4 * cg) * 2), a2 = *(const LAS v2u*)(L + SC_RAW + ((j + 2) * 320 + g * 64 + 4 * cg) * 2);
                    const f32x4 x0 = (f32x4){bflo(a0.x), bfhi(a0.x), bflo(a0.y), bfhi(a0.y)}, x1 = (f32x4){bflo(a1.x), bfhi(a1.x), bflo(a1.y), bfhi(a1.y)}, x2 = (f32x4){bflo(a2.x), bfhi(a2.x), bflo(a2.y), bfhi(a2.y)};
                    const int gc = g == 0 ? h * 64 : g == 1 ? 512 + h * 64 : g == 2 ? 1024 + h * 64 : g == 3 ? 1536 : 1600;
                    const f32x4 mu0 = *(const GAS f32x4*)(mup + gc), mu1 = *(const GAS f32x4*)(mup + RCOLS + gc);
                    xs[g] = x1 + mu0 * (x0 - x1) + mu1 * (x2 - x1);
                }
                *(LAS f32x4*)(SV + (0 * 16 + st_j) * 64 + 4 * cg) = xs[0];
                *(LAS f32x4*)(SV + (3 * 16 + st_j) * 64 + 4 * cg) = xs[2];
                *(LAS f32x4*)(KT + j * 64 + 4 * cg) = xs[1];
                const f32x4 kkf = xs[1] * *(const GAS f32x4*)kkp; float ss = (kkf.x * kkf.x + kkf.y * kkf.y) + (kkf.z * kkf.z + kkf.w * kkf.w);
                ss += __shfl_xor(ss, 1); ss += __shfl_xor(ss, 2); ss += __shfl_xor(ss, 4); ss += __shfl_xor(ss, 8);
                const float inv = 1.0f / fmaxf(sqrtf(ss), 1e-12f); const f32x4 kk = kkf * inv;
                *(LAS f32x4*)(KK + j * 64 + 4 * cg) = kk;
                *(LAS f32x4*)(SV + (4 * 16 + st_j) * 64 + 4 * cg) = -kk;
                v2u tw; tw.x = pk2(tanhf(xs[3].x), tanhf(xs[3].y)); tw.y = pk2(tanhf(xs[3].z), tanhf(xs[3].w));
                *(LAS v2u*)(L + SC_TWA + (j * 72 + 4 * cg) * 2) = tw;
                v2u ad; ad.x = pk2(xs[4].x, xs[4].y); ad.y = pk2(xs[4].z, xs[4].w);
                *(LAS v2u*)(L + SC_ADA + (j * 72 + 4 * cg) * 2) = ad;
            }
            __syncthreads();
            {
                const int ao = ((lane & 15) * 72 + 8 * (lane >> 4)) * 2;
                const bf16x8 At0 = *(const LAS bf16x8*)(L + SC_TWA + ao), At1 = *(const LAS bf16x8*)(L + SC_TWA + ao + 64), Aa0 = *(const LAS bf16x8*)(L + SC_ADA + ao), Aa1 = *(const LAS bf16x8*)(L + SC_ADA + ao + 64);
                const bf16x8 Bw0 = *(const GAS bf16x8*)w2t, Bw1 = *(const GAS bf16x8*)(w2t + 32), Ba0 = *(const GAS bf16x8*)a2t, Ba1 = *(const GAS bf16x8*)(a2t + 32);
                f32x4 zw = (f32x4){0.f, 0.f, 0.f, 0.f}, za = (f32x4){0.f, 0.f, 0.f, 0.f};
                zw = __builtin_amdgcn_mfma_f32_16x16x32_bf16(At0, Bw0, zw, 0, 0, 0); zw = __builtin_amdgcn_mfma_f32_16x16x32_bf16(At1, Bw1, zw, 0, 0, 0);
                za = __builtin_amdgcn_mfma_f32_16x16x32_bf16(Aa0, Ba0, za, 0, 0, 0); za = __builtin_amdgcn_mfma_f32_16x16x32_bf16(Aa1, Ba1, za, 0, 0, 0);
                const int cl = 16 * w4 + (lane & 15);
#pragma unroll
                for (int i = 0; i < 4; ++i) { const int jj = 4 * (lane >> 4) + i, st = d == 0 ? jj : 15 - jj;
                    const float sg = sigmoidf_(w0c + zw[i]); SV[(1 * 16 + st) * 64 + cl] = __expf(-0.6065306597f * sg);
                    const float al = sigmoidf_(a0c + za[i]);
                    const float kv = KT[jj * 64 + cl] * (1.0f + (al - 1.0f) * kac); SV[(2 * 16 + st) * 64 + cl] = kv;
                    SV[(5 * 16 + st) * 64 + cl] = KK[jj * 64 + cl] * al;
                    float bp = SV[(0 * 16 + st) * 64 + cl] * kv * rkc;
                    bp += __shfl_xor(bp, 1); bp += __shfl_xor(bp, 2); bp += __shfl_xor(bp, 4); bp += __shfl_xor(bp, 8);
                    if ((lane & 15) == 0) BON[w4 * 16 + jj] = bp; }
            }
            __syncthreads();
            {
                const int ri = 16 * w4 + (lane >> 2), q = lane & 3;
#pragma unroll 1
                for (int s = 0; s < 16; ++s) {
                    const LAS float* base = SV + s * 64 + 16 * q;
                    f32x4 na[4], wv[4], bv[4], kv[4], rv[4];
#pragma unroll
                    for (int i = 0; i < 4; ++i) { na[i] = *(const LAS f32x4*)(base + 4 * 16 * 64 + 4 * i); wv[i] = *(const LAS f32x4*)(base + 1 * 16 * 64 + 4 * i); bv[i] = *(const LAS f32x4*)(base + 5 * 16 * 64 + 4 * i);
                        kv[i] = *(const LAS f32x4*)(base + 2 * 16 * 64 + 4 * i); rv[i] = *(const LAS f32x4*)(base + 4 * i); }
                    const float vi = SV[(3 * 16 + s) * 64 + ri];
                    float d0 = 0.f, d1 = 0.f, d2 = 0.f, d3 = 0.f;
#pragma unroll
                    for (int i = 0; i < 4; ++i) { d0 = fmaf(S[4 * i], na[i].x, d0); d1 = fmaf(S[4 * i + 1], na[i].y, d1); d2 = fmaf(S[4 * i + 2], na[i].z, d2); d3 = fmaf(S[4 * i + 3], na[i].w, d3); }
                    const float sa = dpp_quad_sum((d0 + d1) + (d2 + d3));
                    float y0 = 0.f, y1 = 0.f, y2 = 0.f, y3 = 0.f;
#pragma unroll
                    for (int i = 0; i < 4; ++i) {
                        S[4 * i] = fmaf(vi, kv[i].x, fmaf(sa, bv[i].x, S[4 * i] * wv[i].x)); S[4 * i + 1] = fmaf(vi, kv[i].y, fmaf(sa, bv[i].y, S[4 * i + 1] * wv[i].y));
                        S[4 * i + 2] = fmaf(vi, kv[i].z, fmaf(sa, bv[i].z, S[4 * i + 2] * wv[i].z)); S[4 * i + 3] = fmaf(vi, kv[i].w, fmaf(sa, bv[i].w, S[4 * i + 3] * wv[i].w));
                        y0 = fmaf(S[4 * i], rv[i].x, y0); y1 = fmaf(S[4 * i + 1], rv[i].y, y1); y2 = fmaf(S[4 * i + 2], rv[i].z, y2); y3 = fmaf(S[4 * i + 3], rv[i].w, y3); }
                    const float y = dpp_quad_sum((y0 + y1) + (y2 + y3));
                    if (q == 0) YO[s * 64 + ri] = y;
                }
            }
            __syncthreads();
            if (dt < 128) { const int s = dt >> 3, c8 = dt & 7; const int tok = d == 0 ? pos0_ + s : len_ - 1 - (pos0_ + s);
                const f32x4 a = *(const LAS f32x4*)(YO + s * 64 + 8 * c8), bq = *(const LAS f32x4*)(YO + s * 64 + 8 * c8 + 4);
                v4u w; w.x = pk2(a.x, a.y); w.y = pk2(a.z, a.w); w.z = pk2(bq.x, bq.y); w.w = pk2(bq.z, bq.w);
                *(GAS v4u*)(Yd + (size_t)(rowbase_ + tok) * RW + h * 64 + 8 * c8) = w; }
            else if (dt < 144) { const int jj = dt - 128; bonus[(size_t)(rowbase_ + toklo_ + jj) * 8 + h] = (BON[jj] + BON[16 + jj]) + (BON[32 + jj] + BON[48 + jj]); }
        }
        __syncthreads();
#undef SC_LOAD
#undef SC_GEOM
    }
}

__device__ __forceinline__ void rwkv_out_phase(Frame& F, int l, int nrows) {
    const int gw = F.vcu * NWAVES + F.wave, NGW = F.G * NWAVES, lane = F.lane, jr = lane & 15, fq = lane >> 4;
    const GAS bf16* PR = WSP(bf16, WS_PR); const GAS bf16* YF = WSP(bf16, WS_YF); const GAS bf16* YB = WSP(bf16, WS_YB); GAS bf16* YR = WSP(bf16, WS_YR);
    const GAS float* bon0 = WSP(float, WS_BONUS); const GAS float* bon1 = bon0 + (size_t)MA * 8;
    const GAS bf16* g2t = WSP(bf16, WS_LORA) + (size_t)8 * RW * 64 + (size_t)l * RW * 128;
    const GAS float* m0 = INP(9) + (size_t)(l * 2) * RCOLS; const GAS float* m1 = m0 + RCOLS;
    const GAS float* lw = INP(18) + l * RW; const GAS float* lb = INP(19) + l * RW;
    for (int unit = gw; unit < nrows / 16; unit += NGW) {
        const int m = unit * 16 + jr;
        const int pos = m < NL ? (m & 2047) : ((m - NL) & 255), len = m < NL ? TL : TC;
        const bool hp = pos > 0, hn = pos < len - 1;
        const GAS bf16* pr = PR + (size_t)m * RCOLS;
        bf16x8 Af[4];
#pragma unroll
        for (int ks = 0; ks < 4; ++ks) { const int col = 1664 + 8 * fq + 32 * ks;
            const v4u z = (v4u){0u, 0u, 0u, 0u}; const v4u w1 = *(const GAS v4u*)(pr + col); const v4u w0 = hp ? *(const GAS v4u*)(pr - RCOLS + col) : z; const v4u w2 = hn ? *(const GAS v4u*)(pr + RCOLS + col) : z;
            const unsigned u0[4] = {w0.x, w0.y, w0.z, w0.w}, u1[4] = {w1.x, w1.y, w1.z, w1.w}, u2[4] = {w2.x, w2.y, w2.z, w2.w}; unsigned o[4];
#pragma unroll
            for (int e = 0; e < 4; ++e) { const f32x2 a = *(const GAS f32x2*)(m0 + col + 2 * e), bq = *(const GAS f32x2*)(m1 + col + 2 * e);
                const float xl = bflo(u1[e]), xh = bfhi(u1[e]);
                const float vl = xl + a.x * (bflo(u0[e]) - xl) + bq.x * (bflo(u2[e]) - xl), vh = xh + a.y * (bfhi(u0[e]) - xh) + bq.y * (bfhi(u2[e]) - xh);
                o[e] = pk2(sigmoidf_(vl), sigmoidf_(vh)); }
            Af[ks] = __builtin_bit_cast(bf16x8, (v4u){o[0], o[1], o[2], o[3]}); }
        for (int hh = 0; hh < 8; ++hh) {
            const float bon = 0.5f * (bon0[(size_t)m * 8 + hh] + bon1[(size_t)m * 8 + hh]);
            f32x4 y[4], g[4];
#pragma unroll
            for (int nt = 0; nt < 4; ++nt) { const int c0 = hh * 64 + 16 * nt;
                f32x4 acc = (f32x4){0.f, 0.f, 0.f, 0.f};
#pragma unroll
                for (int ks = 0; ks < 4; ++ks) { const bf16x8 Bf = *(const GAS bf16x8*)(g2t + (size_t)(c0 + jr) * 128 + 8 * fq + 32 * ks); acc = __builtin_amdgcn_mfma_f32_16x16x32_bf16(Bf, Af[ks], acc, 0, 0, 0); }
                g[nt] = acc;
                const int col = c0 + 4 * fq; const v2u a = *(const GAS v2u*)(YF + (size_t)m * RW + col), bq = *(const GAS v2u*)(YB + (size_t)m * RW + col);
                y[nt] = (f32x4){bflo(a.x) + bflo(bq.x), bfhi(a.x) + bfhi(bq.x), bflo(a.y) + bflo(bq.y), bfhi(a.y) + bfhi(bq.y)}; }
            float s = 0.f;
#pragma unroll
            for (int nt = 0; nt < 4; ++nt) s += (y[nt].x + y[nt].y) + (y[nt].z + y[nt].w);
            s += __shfl_xor(s, 16); s += __shfl_xor(s, 32);
            const float mean = s * (1.0f / 64.0f); float qv = 0.f;
#pragma unroll
            for (int nt = 0; nt < 4; ++nt) { y[nt] = y[nt] - mean; qv += (y[nt].x * y[nt].x + y[nt].y * y[nt].y) + (y[nt].z * y[nt].z + y[nt].w * y[nt].w); }
            qv += __shfl_xor(qv, 16); qv += __shfl_xor(qv, 32);
            const float rstd = 1.0f / sqrtf(qv * (1.0f / 64.0f) + 64e-5f);
#pragma unroll
            for (int nt = 0; nt < 4; ++nt) { const int col = hh * 64 + 16 * nt + 4 * fq, vc = 1024 + col;
                const v2u z = (v2u){0u, 0u}; const v2u w1 = *(const GAS v2u*)(pr + vc); const v2u w0 = hp ? *(const GAS v2u*)(pr - RCOLS + vc) : z; const v2u w2 = hn ? *(const GAS v2u*)(pr + RCOLS + vc) : z;
                const f32x4 x0 = (f32x4){bflo(w0.x), bfhi(w0.x), bflo(w0.y), bfhi(w0.y)}, x1 = (f32x4){bflo(w1.x), bfhi(w1.x), bflo(w1.y), bfhi(w1.y)}, x2 = (f32x4){bflo(w2.x), bfhi(w2.x), bflo(w2.y), bfhi(w2.y)};
                const f32x4 vs = x1 + *(const GAS f32x4*)(m0 + vc) * (x0 - x1) + *(const GAS f32x4*)(m1 + vc) * (x2 - x1);
                const f32x4 o = (y[nt] * rstd * *(const GAS f32x4*)(lw + col) + *(const GAS f32x4*)(lb + col) + vs * bon) * g[nt];
                v2u w; w.x = pk2(o.x, o.y); w.y = pk2(o.z, o.w);
                *(GAS v2u*)(YR + (size_t)m * RW + col) = w; }
        }
    }
}

__device__ __forceinline__ void attn_phase(Frame& F, int l, char* lds_generic, size_t q_off) {
    typedef attn_body::bf16 abf;
    abf* Q = (abf*)(F.ws + q_off); const abf* KB = (const abf*)(F.ws + WS_KB); const abf* VB = (const abf*)(F.ws + WS_VB);
    for (int p = F.vcu; p < NB * 8; p += F.G) {
        const int b = p >> 3, hq = p & 7, kvh = hq >> 2;
        const abf* Kh = KB + (size_t)b * KVT * 128 + kvh * 64; const abf* Vh = VB + (size_t)b * KVT * 128 + kvh * 64;
        const int nu = l == 0 ? 9 : 8;
        for (int u = 0; u < nu; ++u) {
            const bool cx = u == 8;
            abf* Qu = Q + (size_t)(cx ? NL + b * TC : b * TL + u * 256) * 512 + hq * 64;
            attn_body::attn_unit<8>(Qu, cx ? Kh + (size_t)TL * 128 : Kh, cx ? Vh + (size_t)TL * 128 : Vh, Qu, cx ? TC / 64 : KVT / 64, lds_generic);
        }
    }
}

__device__ __forceinline__ int moe_tiles(Frame& F, LAS int* tile_e) {
    int nt = 0;
    for (int e = 0; e < NE; ++e) { const int cnt = (int)__hip_atomic_load(F.ctl + CW_HIST + 64 * e, RLX_AGENT); const int t = (cnt + 255) >> 8;
        for (int i = F.tid; i < t; i += 512) tile_e[nt + i] = e; nt += t; }
    __syncthreads();
    return nt;
}
__device__ __forceinline__ void moe_slots(Frame& F) {
    volatile LAS unsigned* M = F.MISC;
    const GAS int* toke = (const GAS int*)(F.ws + WS_MOETAB + MT_TOKE); GAS int* toks = (GAS int*)(F.ws + WS_MOETAB + MT_TOKS);
    const GAS bf16* H2 = WSP(bf16, WS_H); GAS bf16* XB = WSP(bf16, WS_XB);
    LAS int* slotl = (LAS int*)F.lds;
    for (int tb = F.vcu; tb < NL / 256; tb += F.G) {
        if (F.tid < 8) M[32 + F.tid] = 0u;
        if (F.tid == 0) { unsigned ps = 0; for (int e = 0; e < NE; ++e) { M[48 + e] = ps; const unsigned cnt = __hip_atomic_load(F.ctl + CW_HIST + 64 * e, RLX_AGENT); ps += ((cnt + 255u) >> 8) << 8; } }
        __syncthreads();
        int e_my = 0, rank = 0;
        { const int a = F.tid; e_my = toke[(size_t)tb * 512 + a]; rank = (int)__hip_atomic_fetch_add((LAS unsigned*)&M[32 + e_my], 1u, __ATOMIC_RELAXED, __HIP_MEMORY_SCOPE_WORKGROUP); }
        __syncthreads();
        if (F.tid < 8) M[40 + F.tid] = __hip_atomic_fetch_add(F.ctl + CW_CURS + 64 * F.tid, M[32 + F.tid], RLX_AGENT);
        __syncthreads();
        const int slot = (int)(M[48 + e_my] + M[40 + e_my]) + rank;
        toks[(size_t)tb * 512 + F.tid] = slot; slotl[F.tid] = slot;
        __syncthreads();
        for (int a = F.wave; a < 512; a += NWAVES) { const int tok = tb * 256 + (a >> 1); const int sl = slotl[a];
            const GAS v4u* src = (const GAS v4u*)(H2 + (size_t)tok * DM); GAS v4u* dst = (GAS v4u*)(XB + (size_t)sl * DM);
            const v4u x0 = src[F.lane], x1 = src[64 + F.lane]; dst[F.lane] = x0; dst[64 + F.lane] = x1; }
        __syncthreads();
    }
}
__device__ __forceinline__ void moe_final(Frame& F) {
    const int gw = F.vcu * NWAVES + F.wave, NGW = F.G * NWAVES;
    const GAS int* toks = (const GAS int*)(F.ws + WS_MOETAB + MT_TOKS); const GAS float* tokw = (const GAS float*)(F.ws + WS_MOETAB + MT_TOKW);
    const GAS bf16* YM = WSP(bf16, WS_YM); const GAS float* gt = WSP(float, WS_MOD) + (size_t)33 * 6144 + 5120;
    for (int m = gw; m < NL; m += NGW) {
        const int s0 = toks[2 * m], s1 = toks[2 * m + 1]; const float w0 = tokw[2 * m], w1 = tokw[2 * m + 1];
        const GAS float* gv = gt + (size_t)(m >> 11) * 6144; GAS float* xr = F.out + (size_t)m * DM;
        f32x4 v[4]; float s = 0.f;
#pragma unroll
        for (int j = 0; j < 4; ++j) { const int c = 4 * F.lane + 256 * j;
            const v2u a = *(const GAS v2u*)(YM + (size_t)s0 * DM + c), bq = *(const GAS v2u*)(YM + (size_t)s1 * DM + c);
            const f32x4 ya = (f32x4){bflo(a.x), bfhi(a.x), bflo(a.y), bfhi(a.y)}, yb = (f32x4){bflo(bq.x), bfhi(bq.x), bflo(bq.y), bfhi(bq.y)};
            v[j] = *(const GAS f32x4*)(xr + c) + *(const GAS f32x4*)(gv + c) * (ya * w0 + yb * w1);
            s += (v[j].x * v[j].x + v[j].y * v[j].y) + (v[j].z * v[j].z + v[j].w * v[j].w); }
        const float rstd = 1.0f / sqrtf(wave_sum(s) * (1.0f / DM) + 1e-6f);
#pragma unroll
        for (int j = 0; j < 4; ++j) { const int c = 4 * F.lane + 256 * j; *(GAS f32x4*)(xr + c) = v[j] * rstd * *(const GAS f32x4*)(INP(32) + c); }
    }
}
constexpr int S2_RS = 0, S2_VS = 4096, S2_KS = 8192, S2_KK = 12288, S2_W = 16384, S2_KT = 20480, S2_BB = 24576, S2_RAW = 16384;
constexpr int S2_RQT = 0, S2_S16 = 11520, S2_D1T = 20736, S2_D2T = 24576;
constexpr int S2_C0 = 28672, S2_TWA = S2_C0, S2_ADA = S2_C0 + 2304, S2_GA = S2_C0, S2_GBT = S2_C0 + 4608, S2_RTF = S2_C0 + 9216, S2_BCT = S2_C0 + 13312, S2_KCF = S2_C0 + 16384,
              S2_G15 = S2_C0 + 20480, S2_ATT = S2_C0 + 20736, S2_VT = S2_C0 + 23808;
constexpr int S2_M0 = S2_C0 + 26880, S2_MAB = S2_M0, S2_MAK = S2_M0 + 1088, S2_MBRT = S2_M0 + 1856, S2_MKR = S2_M0 + 2624, S2_TA = S2_M0 + 3648, S2_TT = S2_M0 + 4416, S2_C1A = S2_M0 + 5184;
constexpr int S2_YO = S2_M0 + 5952, S2_BON = S2_YO + 4096, S2_DIR = S2_BON + 256;
static_assert(2 * S2_DIR <= MISC_OFF && S2_D2T + 3840 <= S2_C0 && S2_RAW + 11520 <= S2_C0, "scan LDS map");
__device__ __forceinline__ bf16x8 lds_frag(const LAS unsigned char* p) { return *(const LAS bf16x8*)p; }
__device__ __forceinline__ bf16x8 lds_frag16(const LAS unsigned char* row, int lane) { bf16x8 z = (bf16x8){0, 0, 0, 0, 0, 0, 0, 0}; if (lane < 32) z = *(const LAS bf16x8*)(row + 16 * (lane >> 4)); return z; }
__device__ __forceinline__ float tanh_fast(float x) { const float e = __expf(2.0f * x); return 1.0f - 2.0f / (e + 1.0f); }
__device__ __forceinline__ void st_bf(LAS unsigned char* p, float v) { *(LAS unsigned short*)p = (unsigned short)(pk2(v, 0.f) & 0xffffu); }

#define S2_IDS() int tl_ = F.tid; asm volatile("" : "+v"(tl_)); const int dt = tl_ & 255, lane = tl_ & 63, lr = lane & 15, lq = lane >> 4; const int wv_ = __builtin_amdgcn_readfirstlane(tl_ >> 6); const int w4 = wv_ & 3, d = wv_ >> 2; \
    LAS unsigned char* const L = F.lds + d * S2_DIR; (void)dt; (void)lr; (void)lq; (void)w4; (void)lane
#define S2_F32(name, off) LAS float* const name = (LAS float*)(L + (off))
#define S2_BAR() asm volatile("s_waitcnt lgkmcnt(0)\n\ts_barrier" ::: "memory")
__device__ __forceinline__ void scan_phase2(Frame& F, int l) {
    const GAS bf16* PR = WSP(bf16, WS_PR);
    for (int p = F.vcu; p < NB * 8; p += F.G) {
        const int b = p >> 3, h = p & 7;
        f32x4 S[4];
#pragma unroll
        for (int i = 0; i < 4; ++i) S[i] = (f32x4){0.f, 0.f, 0.f, 0.f};
        v4u raw[3];
        int prow[3], pcol[3], plds[3];
        f32x4 mu0[5], mu1[5], kkc; bf16x8 Bw0, Bw1, Ba0, Ba1; float w0c, a0c, kac, rkc;
        { S2_IDS();
#pragma unroll
          for (int i = 0; i < 3; ++i) { const int pp = dt + 256 * i, row = pp / 40, rem = pp % 40, grp = rem >> 3, c8 = rem & 7;
              prow[i] = pp < 720 ? row : -100000; pcol[i] = (grp == 0 ? h * 64 : grp == 1 ? 512 + h * 64 : grp == 2 ? 1024 + h * 64 : grp == 3 ? 1536 : 1600) + 8 * c8; plds[i] = (row * 320 + rem * 8) * 2; }
          const int cg = dt & 15; const GAS float* mup = INP(9) + (size_t)(l * 2) * RCOLS + 4 * cg;
#pragma unroll
          for (int g = 0; g < 5; ++g) { const int gc = g == 0 ? h * 64 : g == 1 ? 512 + h * 64 : g == 2 ? 1024 + h * 64 : g == 3 ? 1536 : 1600; mu0[g] = *(const GAS f32x4*)(mup + gc); mu1[g] = *(const GAS f32x4*)(mup + RCOLS + gc); }
          kkc = *(const GAS f32x4*)(INP(15) + l * RW + h * 64 + 4 * cg);
          const GAS bf16* w2t = WSP(bf16, WS_LORA) + (size_t)((l * 2 + d) * RW + h * 64 + 16 * w4 + lr) * 64 + 8 * lq; const GAS bf16* a2t = w2t + (size_t)4 * RW * 64;
          Bw0 = *(const GAS bf16x8*)w2t; Bw1 = *(const GAS bf16x8*)(w2t + 32); Ba0 = *(const GAS bf16x8*)a2t; Ba1 = *(const GAS bf16x8*)(a2t + 32);
          const int ccol = h * 64 + 16 * w4 + lr;
          w0c = INP(10)[(l * 2 + d) * RW + ccol]; a0c = INP(12)[(l * 2 + d) * RW + ccol]; kac = INP(16)[l * RW + ccol]; rkc = INP(17)[l * RW + ccol]; }
#define SC_GEOM(c) const int s0_ = 16 * (c); const bool isctx_ = s0_ < TC; const int pos0_ = isctx_ ? s0_ : s0_ - TC; const int len_ = isctx_ ? TC : TL; \
        const int rowbase_ = isctx_ ? NL + b * TC : b * TL; const int toklo_ = d == 0 ? pos0_ : len_ - 16 - pos0_;
#define SC_LOAD(c) do { SC_GEOM(c) _Pragma("unroll") for (int i = 0; i < 3; ++i) { const int tr = toklo_ - 1 + prow[i]; raw[i] = (v4u){0u, 0u, 0u, 0u}; \
            if (tr >= 0 && tr < len_) raw[i] = *(const GAS v4u*)(PR + (size_t)(rowbase_ + tr) * RCOLS + pcol[i]); } } while (0)
        { S2_IDS(); SC_LOAD(0); }
        for (int c = 0; c < KVT / 16; ++c) {
            { S2_IDS();
#pragma unroll
              for (int i = 0; i < 3; ++i) { if (prow[i] >= 0) *(LAS v4u*)(L + S2_RAW + plds[i]) = raw[i]; }
              S2_BAR();
              if (c + 1 < KVT / 16) SC_LOAD(c + 1); }
            { S2_IDS(); S2_F32(RS, S2_RS); S2_F32(VS, S2_VS); S2_F32(KS, S2_KS); S2_F32(KK, S2_KK);
              const int j = dt >> 4, cg = dt & 15, st_j = d == 0 ? j : 15 - j;
              f32x4 xs[5];
#pragma unroll
              for (int g = 0; g < 5; ++g) {
                  const v2u a0 = *(const LAS v2u*)(L + S2_RAW + ((j + 0) * 320 + g * 64 + 4 * cg) * 2), a1 = *(const LAS v2u*)(L + S2_RAW + ((j + 1) * 320 + g * 64 + 4 * cg) * 2), a2 = *(const LAS v2u*)(L + S2_RAW + ((j + 2) * 320 + g * 64 + 4 * cg) * 2);
                  const f32x4 x0 = (f32x4){bflo(a0.x), bfhi(a0.x), bflo(a0.y), bfhi(a0.y)}, x1 = (f32x4){bflo(a1.x), bfhi(a1.x), bflo(a1.y), bfhi(a1.y)}, x2 = (f32x4){bflo(a2.x), bfhi(a2.x), bflo(a2.y), bfhi(a2.y)};
                  xs[g] = x1 + mu0[g] * (x0 - x1) + mu1[g] * (x2 - x1);
              }
              *(LAS f32x4*)(RS + st_j * 64 + 4 * cg) = xs[0];
              *(LAS f32x4*)(VS + st_j * 64 + 4 * cg) = xs[2];
              *(LAS f32x4*)(KS + j * 64 + 4 * cg) = xs[1];
              const f32x4 kkf = xs[1] * kkc; float ss = (kkf.x * kkf.x + kkf.y * kkf.y) + (kkf.z * kkf.z + kkf.w * kkf.w);
              ss += __shfl_xor(ss, 1); ss += __shfl_xor(ss, 2); ss += __shfl_xor(ss, 4); ss += __shfl_xor(ss, 8);
              const float inv = 1.0f / fmaxf(sqrtf(ss), 1e-12f);
              *(LAS f32x4*)(KK + j * 64 + 4 * cg) = kkf * inv;
              v2u tw; tw.x = pk2(tanh_fast(xs[3].x), tanh_fast(xs[3].y)); tw.y = pk2(tanh_fast(xs[3].z), tanh_fast(xs[3].w));
              *(LAS v2u*)(L + S2_TWA + (j * 72 + 4 * cg) * 2) = tw;
              v2u ad; ad.x = pk2(xs[4].x, xs[4].y); ad.y = pk2(xs[4].z, xs[4].w);
              *(LAS v2u*)(L + S2_ADA + (j * 72 + 4 * cg) * 2) = ad;
            }
            S2_BAR();
            { S2_IDS(); S2_F32(RS, S2_RS); S2_F32(KS, S2_KS); S2_F32(KK, S2_KK); S2_F32(Wd, S2_W); S2_F32(KT, S2_KT); S2_F32(BB, S2_BB); S2_F32(BON, S2_BON);
              const int ao = (lr * 72 + 8 * lq) * 2;
              const bf16x8 At0 = lds_frag(L + S2_TWA + ao), At1 = lds_frag(L + S2_TWA + ao + 64), Aa0 = lds_frag(L + S2_ADA + ao), Aa1 = lds_frag(L + S2_ADA + ao + 64);
              f32x4 zw = (f32x4){0.f, 0.f, 0.f, 0.f}, za = (f32x4){0.f, 0.f, 0.f, 0.f};
              zw = __builtin_amdgcn_mfma_f32_16x16x32_bf16(At0, Bw0, zw, 0, 0, 0); zw = __builtin_amdgcn_mfma_f32_16x16x32_bf16(At1, Bw1, zw, 0, 0, 0);
              za = __builtin_amdgcn_mfma_f32_16x16x32_bf16(Aa0, Ba0, za, 0, 0, 0); za = __builtin_amdgcn_mfma_f32_16x16x32_bf16(Aa1, Ba1, za, 0, 0, 0);
              const int cl = 16 * w4 + lr;
#pragma unroll
              for (int i = 0; i < 4; ++i) { const int jj = 4 * lq + i, st = d == 0 ? jj : 15 - jj;
                  const float sg = sigmoidf_(w0c + zw[i]); Wd[st * 64 + cl] = __expf(-0.6065306597f * sg);
                  const float al = sigmoidf_(a0c + za[i]);
                  const float kv = KS[jj * 64 + cl] * (1.0f + (al - 1.0f) * kac); KT[st * 64 + cl] = kv;
                  BB[st * 64 + cl] = KK[jj * 64 + cl] * al;
                  float bp = RS[st * 64 + cl] * kv * rkc;
                  bp += __shfl_xor(bp, 1); bp += __shfl_xor(bp, 2); bp += __shfl_xor(bp, 4); bp += __shfl_xor(bp, 8);
                  if (lr == 0) BON[w4 * 16 + jj] = bp; }
            }
            S2_BAR();
            { S2_IDS(); S2_F32(RS, S2_RS); S2_F32(VS, S2_VS); S2_F32(KK, S2_KK); S2_F32(Wd, S2_W); S2_F32(KT, S2_KT); S2_F32(BB, S2_BB); S2_F32(RTF, S2_RTF); S2_F32(KCF, S2_KCF); S2_F32(G15, S2_G15);
              const int cc = lane; float g = 1.f, gp[4], gt[4];
#pragma unroll
              for (int t = 0; t < 16; ++t) { const float wt = Wd[t * 64 + cc]; if ((t >> 2) == w4) gp[t & 3] = g; g *= wt; if ((t >> 2) == w4) gt[t & 3] = g; }
              if (w4 == 0) G15[cc] = g;
              unsigned pa[2], pb[2], pv[2];
#pragma unroll
              for (int i = 0; i < 4; ++i) { const int t = 4 * w4 + i, jm = d == 0 ? t : 15 - t;
                  const float ig = 1.0f / gt[i], sc = g * ig;
                  const float av = -KK[jm * 64 + cc] * gp[i], rv = RS[t * 64 + cc] * gt[i], bv = BB[t * 64 + cc], kv = KT[t * 64 + cc];
                  st_bf(L + S2_GA + (t * 72 + cc) * 2, bv * ig); st_bf(L + S2_GA + ((16 + t) * 72 + cc) * 2, kv * ig);
                  st_bf(L + S2_GBT + (t * 72 + cc) * 2, av); st_bf(L + S2_GBT + ((16 + t) * 72 + cc) * 2, rv);
                  RTF[t * 64 + cc] = rv; KCF[t * 64 + cc] = kv * sc;
                  const float bc = bv * sc, vv = VS[t * 64 + cc];
                  if (i & 1) { pa[i >> 1] = pk2(__uint_as_float(pa[i >> 1]), av); pb[i >> 1] = pk2(__uint_as_float(pb[i >> 1]), bc); pv[i >> 1] = pk2(__uint_as_float(pv[i >> 1]), vv); }
                  else { pa[i >> 1] = __float_as_uint(av); pb[i >> 1] = __float_as_uint(bc); pv[i >> 1] = __float_as_uint(vv); } }
              *(LAS v2u*)(L + S2_ATT + (cc * 24 + 4 * w4) * 2) = (v2u){pa[0], pa[1]};
              *(LAS v2u*)(L + S2_BCT + (cc * 24 + 4 * w4) * 2) = (v2u){pb[0], pb[1]};
              *(LAS v2u*)(L + S2_VT + (cc * 24 + 4 * w4) * 2) = (v2u){pv[0], pv[1]};
            }
            S2_BAR();
            { S2_IDS(); S2_F32(MAB, S2_MAB); S2_F32(MKR, S2_MKR);
              const int mt = w4 >> 1, nt = w4 & 1, ao = ((16 * mt + lr) * 72 + 8 * lq) * 2, bo = ((16 * nt + lr) * 72 + 8 * lq) * 2;
              f32x4 acc = (f32x4){0.f, 0.f, 0.f, 0.f};
              acc = __builtin_amdgcn_mfma_f32_16x16x32_bf16(lds_frag(L + S2_GA + ao), lds_frag(L + S2_GBT + bo), acc, 0, 0, 0);
              acc = __builtin_amdgcn_mfma_f32_16x16x32_bf16(lds_frag(L + S2_GA + ao + 64), lds_frag(L + S2_GBT + bo + 64), acc, 0, 0, 0);
#pragma unroll
              for (int i = 0; i < 4; ++i) { const int s = 4 * lq + i, t = lr; const bool keep = nt == 0 ? (s < t) : (s <= t); const float v = keep ? acc[i] : 0.f;
                  if (w4 == 0) MAB[s * 16 + t] = v;
                  else if (w4 == 2) st_bf(L + S2_MAK + (s * 24 + t) * 2, v);
                  else if (w4 == 1) st_bf(L + S2_MBRT + (t * 24 + s) * 2, v);
                  else MKR[s * 16 + t] = v; }
            }
            S2_BAR();
            { S2_IDS(); S2_F32(MAB, S2_MAB);
              if (dt < 16) { const int t = dt; float Tc[16];
#pragma unroll
                for (int s = 15; s >= 0; --s) { float a = (s == t) ? 1.f : 0.f; asm volatile("" ::: "memory");
                    float mr[16];
#pragma unroll
                    for (int q4 = (s + 1) / 4; q4 < 4; ++q4) { const f32x4 mv = *(const LAS f32x4*)(MAB + s * 16 + 4 * q4); mr[4 * q4] = mv.x; mr[4 * q4 + 1] = mv.y; mr[4 * q4 + 2] = mv.z; mr[4 * q4 + 3] = mv.w; }
#pragma unroll
                    for (int jx = s + 1; jx < 16; ++jx) a = fmaf(mr[jx], Tc[jx], a);
                    Tc[s] = a; }
                unsigned tt[8];
#pragma unroll
                for (int s = 0; s < 16; ++s) st_bf(L + S2_TA + (s * 24 + t) * 2, Tc[s]);
#pragma unroll
                for (int s = 0; s < 8; ++s) tt[s] = pk2(Tc[2 * s], Tc[2 * s + 1]);
                *(LAS v4u*)(L + S2_TT + (t * 24) * 2) = (v4u){tt[0], tt[1], tt[2], tt[3]}; *(LAS v4u*)(L + S2_TT + (t * 24 + 8) * 2) = (v4u){tt[4], tt[5], tt[6], tt[7]}; }
            }
            S2_BAR();
            { S2_IDS();
#pragma unroll
              for (int rep = 0; rep < 2; ++rep) { const int task = w4 + 4 * rep; if (task < 6) {
                  const bf16x8 Af = lds_frag16(L + (task == 0 ? S2_MAK : S2_TA) + lr * 48, lane);
                  const bf16x8 Bf = task == 0 ? lds_frag16(L + S2_TT + lr * 48, lane) : task == 1 ? lds_frag16(L + S2_MBRT + lr * 48, lane) : lds_frag16(L + S2_BCT + (16 * (task - 2) + lr) * 48, lane);
                  const f32x4 acc = __builtin_amdgcn_mfma_f32_16x16x32_bf16(Af, Bf, (f32x4){0.f, 0.f, 0.f, 0.f}, 0, 0, 0);
                  if (task == 0) {
#pragma unroll
                      for (int i = 0; i < 4; ++i) st_bf(L + S2_C1A + ((4 * lq + i) * 24 + lr) * 2, acc[i]); }
                  else { const int n = 16 * (task - 1) + lr; *(LAS v2u*)(L + S2_D1T + (n * 24 + 4 * lq) * 2) = (v2u){pk2(acc[0], acc[1]), pk2(acc[2], acc[3])}; } } }
            }
            S2_BAR();
            { S2_IDS(); S2_F32(MKR, S2_MKR); S2_F32(KCF, S2_KCF);
#pragma unroll
              for (int rep = 0; rep < 2; ++rep) { const int nt = w4 + 4 * rep; if (nt < 5) {
                  const bf16x8 Af = lds_frag16(L + S2_C1A + lr * 48, lane);
                  const bf16x8 Bf = nt == 0 ? lds_frag16(L + S2_MBRT + lr * 48, lane) : lds_frag16(L + S2_BCT + (16 * (nt - 1) + lr) * 48, lane);
                  f32x4 acc;
#pragma unroll
                  for (int i = 0; i < 4; ++i) acc[i] = nt == 0 ? MKR[(4 * lq + i) * 16 + lr] : KCF[(4 * lq + i) * 64 + 16 * (nt - 1) + lr];
                  acc = __builtin_amdgcn_mfma_f32_16x16x32_bf16(Af, Bf, acc, 0, 0, 0);
                  const int n = 16 * nt + lr; *(LAS v2u*)(L + S2_D2T + (n * 24 + 4 * lq) * 2) = (v2u){pk2(acc[0], acc[1]), pk2(acc[2], acc[3])}; } }
            }
            S2_BAR();
            f32x4 accP[5];
            { S2_IDS(); S2_F32(RTF, S2_RTF);
              const bf16x8 Aa = lds_frag16(L + S2_ATT + (16 * w4 + lr) * 48, lane), Av = lds_frag16(L + S2_VT + (16 * w4 + lr) * 48, lane);
#pragma unroll
              for (int nt = 0; nt < 5; ++nt) {
                  const bf16x8 B1 = lds_frag16(L + S2_D1T + (16 * nt + lr) * 48, lane), B2 = lds_frag16(L + S2_D2T + (16 * nt + lr) * 48, lane);
                  f32x4 a1 = (f32x4){0.f, 0.f, 0.f, 0.f};
                  if (nt == 0) {
#pragma unroll
                      for (int i = 0; i < 4; ++i) a1[i] = RTF[lr * 64 + 16 * w4 + 4 * lq + i]; }
                  a1 = __builtin_amdgcn_mfma_f32_16x16x32_bf16(Aa, B1, a1, 0, 0, 0);
                  accP[nt] = __builtin_amdgcn_mfma_f32_16x16x32_bf16(Av, B2, (f32x4){0.f, 0.f, 0.f, 0.f}, 0, 0, 0);
                  *(LAS v2u*)(L + S2_RQT + ((16 * nt + lr) * 72 + 16 * w4 + 4 * lq) * 2) = (v2u){pk2(a1[0], a1[1]), pk2(a1[2], a1[3])};
              }
              LAS unsigned char* Sw = L + S2_S16 + w4 * 2304;
#pragma unroll
              for (int nt = 0; nt < 4; ++nt)
#pragma unroll
                  for (int i = 0; i < 4; ++i) st_bf(Sw + ((4 * lq + i) * 72 + 16 * nt + lr) * 2, S[nt][i]);
            }
            S2_BAR();
            { S2_IDS(); S2_F32(G15, S2_G15); S2_F32(YO, S2_YO);
              const LAS unsigned char* Sw = L + S2_S16 + w4 * 2304;
              const bf16x8 As0 = lds_frag(Sw + (lr * 72 + 8 * lq) * 2), As1 = lds_frag(Sw + (lr * 72 + 8 * lq) * 2 + 64);
#pragma unroll
              for (int nt = 0; nt < 5; ++nt) { const int bo = ((16 * nt + lr) * 72 + 8 * lq) * 2;
                  accP[nt] = __builtin_amdgcn_mfma_f32_16x16x32_bf16(As0, lds_frag(L + S2_RQT + bo), accP[nt], 0, 0, 0);
                  accP[nt] = __builtin_amdgcn_mfma_f32_16x16x32_bf16(As1, lds_frag(L + S2_RQT + bo + 64), accP[nt], 0, 0, 0); }
#pragma unroll
              for (int i = 0; i < 4; ++i) YO[lr * 64 + 16 * w4 + 4 * lq + i] = accP[0][i];
#pragma unroll
              for (int nt = 0; nt < 4; ++nt) { const float g = G15[16 * nt + lr]; S[nt] = S[nt] * g + accP[1 + nt]; }
            }
            S2_BAR();
            { S2_IDS(); S2_F32(YO, S2_YO); S2_F32(BON, S2_BON); SC_GEOM(c)
              if (dt < 128) { const int s = dt >> 3, c8 = dt & 7; const int tok = d == 0 ? pos0_ + s : len_ - 1 - (pos0_ + s);
                  GAS bf16* Yd = WSP(bf16, d == 0 ? WS_YF : WS_YB);
                  const f32x4 a = *(const LAS f32x4*)(YO + s * 64 + 8 * c8), bq = *(const LAS f32x4*)(YO + s * 64 + 8 * c8 + 4);
                  v4u w; w.x = pk2(a.x, a.y); w.y = pk2(a.z, a.w); w.z = pk2(bq.x, bq.y); w.w = pk2(bq.z, bq.w);
                  *(GAS v4u*)(Yd + (size_t)(rowbase_ + tok) * RW + h * 64 + 8 * c8) = w; }
              else if (dt < 144) { const int jj = dt - 128; GAS float* bonus = WSP(float, WS_BONUS) + (size_t)d * MA * 8;
                  bonus[(size_t)(rowbase_ + toklo_ + jj) * 8 + h] = (BON[jj] + BON[16 + jj]) + (BON[32 + jj] + BON[48 + jj]); }
            }
        }
        __syncthreads();
#undef SC_LOAD
#undef SC_GEOM
    }
}
__global__ void __launch_bounds__(NWAVES * 64, 2) fwd_kernel(Args args) {
    extern __shared__ __attribute__((aligned(16))) unsigned char lds[];
    Frame F;
    F.lds = (LAS unsigned char*)lds;
    F.MISC = (volatile LAS unsigned*)(F.lds + MISC_OFF);
    F.tid = threadIdx.x; F.lane = F.tid & 63; F.wave = __builtin_amdgcn_readfirstlane(F.tid >> 6);
    F.G = gridDim.x; { const int bx = blockIdx.x; F.vcu = (F.G % 8 == 0) ? (bx % 8) * (F.G / 8) + bx / 8 : bx; }
    F.ws = args.ws; F.out = args.out; F.ctl = (gu32*)(args.ws + WS_CTL);
    for (int u = F.tid; u < 128; u += NWAVES * 64) ((LAS unsigned*)(F.lds + MISC_OFF))[u] = 0u;
    if (F.tid < 33) { const unsigned long long pv = (unsigned long long)args.in[F.tid]; ((LAS unsigned*)(F.lds + PTAB_OFF))[2 * F.tid] = (unsigned)pv; ((LAS unsigned*)(F.lds + PTAB_OFF))[2 * F.tid + 1] = (unsigned)(pv >> 32); }
    __syncthreads();
    const int vcu0 = F.vcu;
    const bool fused = args.mode == 0;
    XcdBarrier bar; bar.bar = (unsigned*)(F.ctl + CW_BAR); bar.x = 0; bar.st = nullptr;
    if (fused) bar = xcd_barrier_post((unsigned*)(F.ctl + CW_BAR), F.MISC + 8);
#ifndef REP_PRO
#define REP_PRO 1
#endif
#ifndef REP_NORM
#define REP_NORM 1
#endif
#ifndef REP_GEMM1
#define REP_GEMM1 1
#endif
#ifndef REP_SCAN
#define REP_SCAN 1
#endif
#ifndef REP_ROUT
#define REP_ROUT 1
#endif
#ifndef REP_ATTN_DUMMY
#define REP_ATTN_DUMMY 0
#endif
#ifndef REP_MERGEA
#define REP_MERGEA 1
#endif
#ifndef REP_GU
#define REP_GU 1
#endif
#ifndef REP_DOWN_DUMMY
#define REP_DOWN_DUMMY 0
#endif
#ifndef REP_MOECONV
#define REP_MOECONV 1
#endif
#ifndef REP_MOEGEMM
#define REP_MOEGEMM 1
#endif
#define REPEAT(n) for (int rep_ = 0; rep_ < (n); ++rep_)
#ifndef SITE_MASK
#define SITE_MASK 0xFFFF
#endif
#define RUN(L, S) (((SITE_MASK >> (S)) & 1) && (fused || (args.l == (L) && args.site == (S))))
#define GRID_BAR() do { if (fused) xcd_barrier(bar); } while (0)
#define SITE_BEGIN() do { int t_ = threadIdx.x; asm volatile("" : "+v"(t_)); F.tid = t_; F.lane = t_ & 63; F.wave = __builtin_amdgcn_readfirstlane(t_ >> 6); int v_ = vcu0; asm volatile("" : "+s"(v_)); F.vcu = v_; unsigned long long w_ = (unsigned long long)args.ws, o_ = (unsigned long long)args.out; asm volatile("" : "+s"(w_), "+s"(o_)); F.ws = (unsigned char*)w_; F.out = (GAS float*)o_; F.ctl = (gu32*)(F.ws + WS_CTL); } while (0)
    GAS float* const XC = WSP(float, WS_XC);
    GAS float* const MOD = WSP(float, WS_MOD);
    LAS int* const tile_e = (LAS int*)(F.lds + RING_BYTES);

    if (RUN(0, 0)) { SITE_BEGIN(); REPEAT(REP_PRO) p0_prologue(F); GRID_BAR(); }

    for (int l = 0; l < 2; ++l) {
        const GAS float* xlat = l == 0 ? INP(0) : (const GAS float*)F.out;
        const GAS float* xctx = l == 0 ? INP(2) : (const GAS float*)XC;
        const int nM_mix = l == 0 ? MA / 256 : NL / 256;
        if (RUN(l, 1)) { SITE_BEGIN(); REPEAT(REP_NORM) norm_mod_phase<false>(F, l, 0, xlat, xctx, MA, WSP(bf16, WS_H)); GRID_BAR(); }
        if (RUN(l, 2)) { SITE_BEGIN();
            pg8::StdOrder S; S.init(WSGEN(bf16, WS_H), WSGEN(bf16, WS_WIN) + (size_t)l * NIN * DM, DM, MA / 256, NIN / 256, F.G, (int)blockIdx.x);
            EpiIn E{WSP(bf16, WS_PR), WSP(bf16, WS_Q), WSP(bf16, WS_KB), WSP(bf16, WS_VB), WSP(bf16, WS_G)};
            REPEAT(REP_GEMM1) pg8::gemm_phase<EpiIn, pg8::StdOrder, true, true>(F.lds, DM, S, E);
            GRID_BAR();
        }
        if (RUN(l, 3)) { SITE_BEGIN();
#ifndef NO_SCAN
            REPEAT(REP_SCAN) scan_phase2(F, l);
#endif
#ifndef NO_QK
            qk_phase(F, l);
#endif
            GRID_BAR(); }
        if (RUN(l, 4)) { SITE_BEGIN(); REPEAT(REP_ROUT) rwkv_out_phase(F, l, nM_mix * 256); REPEAT(REP_ATTN_DUMMY) attn_phase(F, l, (char*)lds, WS_YF); attn_phase(F, l, (char*)lds, WS_Q); GRID_BAR(); }
        if (RUN(l, 5)) { SITE_BEGIN();
            { pg8::StdOrder S; S.init(WSGEN(bf16, WS_YR), WSGEN(bf16, WS_WPA) + (size_t)l * DM * RW, RW, nM_mix, DM / 256, F.G, (int)blockIdx.x);
              EpiMerge<0> E{WSP(bf16, WS_G), WSP(bf16, WS_MG)};
              REPEAT(REP_MERGEA) pg8::gemm_phase<EpiMerge<0>, pg8::StdOrder, true, true>(F.lds, RW, S, E); }
            __syncthreads();
            { pg8::StdOrder S; S.init(WSGEN(bf16, WS_Q), WSGEN(bf16, WS_WPB) + (size_t)l * DM * RW, RW, nM_mix, DM / 256, F.G, (int)blockIdx.x);
              EpiMerge<1> E{WSP(bf16, WS_G), WSP(bf16, WS_MG)};
              pg8::gemm_phase<EpiMerge<1>, pg8::StdOrder, true, true>(F.lds, RW, S, E); }
            GRID_BAR();
        }
        if (RUN(l, 6)) { SITE_BEGIN();
            pg8::StdOrder S; S.init(WSGEN(bf16, WS_MG), WSGEN(bf16, WS_WO) + (size_t)l * DM * DM, DM, nM_mix, DM / 256, F.G, (int)blockIdx.x);
            EpiRes E{xlat, xctx, F.out, XC, MOD + (size_t)l * 33 * 6144 + 2048};
            pg8::gemm_phase<EpiRes, pg8::StdOrder, true, true>(F.lds, DM, S, E);
            GRID_BAR();
        }
        if (RUN(l, 7)) { SITE_BEGIN();
            if (l == 0) norm_mod_phase<false>(F, l, 1, F.out, XC, MA, WSP(bf16, WS_H));
            else norm_mod_phase<true>(F, l, 1, F.out, XC, NL, WSP(bf16, WS_H));
            GRID_BAR();
        }
        if (l == 0) {
            if (RUN(0, 8)) { SITE_BEGIN();
                pg8::StdOrder S; S.init(WSGEN(bf16, WS_H), WSGEN(bf16, WS_WGU), DM, MA / 256, 2 * FF / 256, F.G, (int)blockIdx.x);
                EpiGU E{WSP(bf16, WS_ACT), 0};
                REPEAT(REP_GU) pg8::gemm_phase<EpiGU, pg8::StdOrder, true, true>(F.lds, DM, S, E);
                GRID_BAR();
            }
            if (RUN(0, 9)) { SITE_BEGIN();
                pg8::StdOrder S; S.init(WSGEN(bf16, WS_ACT), WSGEN(bf16, WS_WDN), FF, MA / 256, DM / 256, F.G, (int)blockIdx.x);
                EpiRes E{F.out, XC, F.out, XC, MOD + 5120};
                REPEAT(REP_DOWN_DUMMY) { EpiStore ED{WSP(bf16, WS_H)}; pg8::gemm_phase<EpiStore, pg8::StdOrder, true, true>(F.lds, FF, S, ED); __syncthreads(); }
                pg8::gemm_phase<EpiRes, pg8::StdOrder, true, true>(F.lds, FF, S, E);
                GRID_BAR();
            }
        } else {
            if (RUN(1, 10)) { SITE_BEGIN(); REPEAT(REP_MOECONV) moe_conv(F); __syncthreads(); moe_slots(F); GRID_BAR(); }
            int ntile = 0;
            if (fused || args.site == 11 || args.site == 12) ntile = moe_tiles(F, tile_e);
            for (int ch = 0; ch < MOE_NCHUNK; ++ch) {
                if (!fused && ch != args.chunk) continue;
                const int t0 = ch * MOE_CH_TILES; if (t0 >= ntile) break;
                const int ntl = (ntile - t0) < MOE_CH_TILES ? (ntile - t0) : MOE_CH_TILES;
                if (RUN(1, 11)) { SITE_BEGIN();
                    MoeOrder S{(const char*)(F.ws + WS_XB), (const char*)(F.ws + WS_MW), (size_t)256 * DM * 2, (size_t)256 * DM * 2, (size_t)21 * MiB, t0, 0, ntl, 2 * FF / 256, F.G, (int)blockIdx.x, tile_e};
                    EpiGU E{WSP(bf16, WS_ACTC), t0};
                    REPEAT(REP_MOEGEMM) pg8::gemm_phase<EpiGU, MoeOrder, true, true>(F.lds, DM, S, E);
                    GRID_BAR();
                }
                if (RUN(1, 12)) { SITE_BEGIN();
                    MoeOrder S{(const char*)(F.ws + WS_ACTC), (const char*)(F.ws + WS_MW) + (size_t)2 * FF * DM * 2, (size_t)256 * FF * 2, (size_t)256 * FF * 2, (size_t)21 * MiB, t0, t0, ntl, DM / 256, F.G, (int)blockIdx.x, tile_e};
                    EpiStore E{WSP(bf16, WS_YM)};
                    REPEAT(REP_MOEGEMM) pg8::gemm_phase<EpiStore, MoeOrder, true, true>(F.lds, FF, S, E);
                    GRID_BAR();
                }
            }
            if (RUN(1, 13)) { SITE_BEGIN(); moe_final(F); }
        }
    }
#undef RUN
#undef GRID_BAR
}

extern "C" void kernel_launch(void* const* d_in, const GAS int* in_sizes, int n_in, void* d_out, int out_size, void* d_ws, size_t ws_size, hipStream_t stream) {
    static int grid = 0;
    if (grid == 0) {
        if (n_in != 33 || in_sizes[0] != NL * DM || out_size != NL * DM || ws_size < WS_END) { fprintf(stderr, "kernel_launch: unexpected problem (n_in %d, x %d, out %d, ws %zu < %zu); nothing launched\n", n_in, n_in > 0 ? in_sizes[0] : -1, out_size, ws_size, (size_t)WS_END); grid = -1; return; }
        int dev = 0, cus = 0, per_cu = 0;
        if (hipGetDevice(&dev) != hipSuccess || hipDeviceGetAttribute(&cus, hipDeviceAttributeMultiprocessorCount, dev) != hipSuccess) { fprintf(stderr, "kernel_launch: device query failed\n"); grid = -1; return; }
        if (hipFuncSetAttribute((const void*)fwd_kernel, hipFuncAttributeMaxDynamicSharedMemorySize, LDS_BYTES) != hipSuccess) { fprintf(stderr, "kernel_launch: hipFuncSetAttribute failed\n"); grid = -1; return; }
        if (hipOccupancyMaxActiveBlocksPerMultiprocessor(&per_cu, (const void*)fwd_kernel, NWAVES * 64, LDS_BYTES) != hipSuccess || per_cu < 1) { fprintf(stderr, "kernel_launch: occupancy query reports %d workgroups per CU\n", per_cu); }
        (void)hipGetLastError();
        grid = cus;
        fprintf(stderr, "kernel_launch: grid %d, occupancy query %d\n", grid, per_cu);
    }
    if (grid < 0) return;
    if (hipMemsetAsync((char*)d_ws + WS_CTL, 0, CTL_ZERO_BYTES, stream) != hipSuccess) { fprintf(stderr, "kernel_launch: memset failed\n"); return; }
    Args a{};
    for (int i = 0; i < 33; ++i) a.in[i] = (const GAS float*)d_in[i];
    a.out = (GAS float*)d_out; a.ws = (unsigned char*)d_ws;
#if MK_FUSED
    a.mode = 0; a.l = 0; a.site = 0; a.chunk = 0;
    hipLaunchKernelGGL(fwd_kernel, dim3(grid), dim3(NWAVES * 64), LDS_BYTES, stream, a);
#else
    a.mode = 1;
    auto step = [&](int l, int site, int chunk) { a.l = l; a.site = site; a.chunk = chunk; hipLaunchKernelGGL(fwd_kernel, dim3(grid), dim3(NWAVES * 64), LDS_BYTES, stream, a); };
    step(0, 0, 0);
    for (int l = 0; l < 2; ++l) {
        for (int s = 1; s <= 7; ++s) step(l, s, 0);
        if (l == 0) { step(0, 8, 0); step(0, 9, 0); }
        else { step(1, 10, 0); for (int ch = 0; ch < MOE_NCHUNK; ++ch) { step(1, 11, ch); step(1, 12, ch); } step(1, 13, 0); }
    }
#endif
    const hipError_t le = hipPeekAtLastError();
    if (le != hipSuccess) fprintf(stderr, "kernel_launch: launch failed: %s\n", hipGetErrorName(le));
}
```

```cpp
#include <hip/hip_runtime.h>
#include <hip/hip_bf16.h>
#include <cstdio>
#include <cstdint>
#include <cmath>

#ifndef MK_FUSED
#define MK_FUSED 1
#endif

constexpr int DM = 1024, NB = 32, TL = 2048, TC = 256;
constexpr int NL = NB * TL;
constexpr int NC = NB * TC;
constexpr int MA = NL + NC;
constexpr int RW = 512, RCOLS = 1792, ACOLS = 768, GCOLS = 2048, NIN = 4608;
constexpr int FF = 3584, NE = 8;
constexpr int KVT = TL + TC;
constexpr int MOE_ROWS = 2 * NL + NE * 256;
constexpr int MOE_CH_TILES = 64;
constexpr int MOE_NCHUNK = (MOE_ROWS / 256 + MOE_CH_TILES - 1) / MOE_CH_TILES;

constexpr size_t MiB = 1u << 20;
constexpr size_t WS_CTL = 0, CTL_ZERO_BYTES = 1 * MiB;
constexpr size_t WS_MOD = 1 * MiB;
constexpr size_t WS_ROPE = 3 * MiB;
constexpr size_t WS_LORA = 4 * MiB;
constexpr size_t WS_BONUS = 5 * MiB;
constexpr size_t WS_MOETAB = 10 * MiB;
constexpr size_t WS_WIN = 16 * MiB;
constexpr size_t WS_WPA = 34 * MiB;
constexpr size_t WS_WPB = 36 * MiB;
constexpr size_t WS_WO = 38 * MiB;
constexpr size_t WS_WGU = 42 * MiB;
constexpr size_t WS_WDN = 56 * MiB;
constexpr size_t WS_XC = 64 * MiB;
constexpr size_t WS_H = 96 * MiB;
constexpr size_t WS_YF = 96 * MiB, WS_YB = 168 * MiB;
constexpr size_t WS_PR = 240 * MiB;
constexpr size_t WS_MG = 240 * MiB;
constexpr size_t WS_Q = 492 * MiB;
constexpr size_t WS_KB = 564 * MiB, WS_VB = 582 * MiB;
constexpr size_t WS_G = 600 * MiB;
constexpr size_t WS_YR = 888 * MiB;
constexpr size_t WS_ACT = 240 * MiB;
constexpr size_t WS_MW = 224 * MiB;
constexpr size_t WS_XB = 392 * MiB;
constexpr size_t WS_YM = 652 * MiB;
constexpr size_t WS_ACTC = 912 * MiB;
constexpr size_t WS_END = 1024 * MiB;
static_assert(WS_H + (size_t)MA * DM * 2 <= WS_PR && WS_PR + (size_t)MA * RCOLS * 2 <= WS_Q && WS_Q + (size_t)MA * 512 * 2 <= WS_KB, "ws map 1");
static_assert(WS_KB + (size_t)MA * 128 * 2 <= WS_VB && WS_VB + (size_t)MA * 128 * 2 <= WS_G && WS_G + (size_t)MA * GCOLS * 2 <= WS_YR && WS_YR + (size_t)MA * 512 * 2 <= WS_END, "ws map 2");
static_assert(WS_ACT + (size_t)MA * FF * 2 <= WS_END && WS_H + (size_t)NL * DM * 2 <= WS_MW && WS_MW + (size_t)NE * 21 * MiB <= WS_XB, "ws map 3");
static_assert(WS_XB + (size_t)MOE_ROWS * DM * 2 <= WS_YM && WS_YM + (size_t)MOE_ROWS * DM * 2 <= WS_ACTC && WS_ACTC + (size_t)MOE_CH_TILES * 256 * FF * 2 <= WS_END, "ws map 4");
static_assert(WS_WDN + (size_t)DM * FF * 2 <= WS_XC && WS_BONUS + (size_t)2 * MA * 8 * 4 <= WS_MOETAB, "ws map 5");
constexpr size_t MT_TOKE = 0;
constexpr size_t MT_TOKW = 512 * 1024;
constexpr size_t MT_TOKS = 1024 * 1024;
constexpr int CW_TMO = 0, CW_CODE = 1;
constexpr int CW_BAR = 4096;
constexpr int CW_HIST = 8192;
constexpr int CW_CURS = 8192 + 64 * 8;

constexpr int NWAVES = 8;
constexpr int LDS_BYTES = 147456;
constexpr int MISC_OFF = LDS_BYTES - 1024;
constexpr int PTAB_OFF = LDS_BYTES - 512;
constexpr int RING_BYTES = 131072;

#define GAS __attribute__((address_space(1)))
#define LAS __attribute__((address_space(3)))
typedef unsigned short bf16;
typedef unsigned v4u __attribute__((ext_vector_type(4)));
typedef unsigned v2u __attribute__((ext_vector_type(2)));
typedef float f32x4 __attribute__((ext_vector_type(4)));
typedef float f32x2 __attribute__((ext_vector_type(2)));
typedef short bf16x8 __attribute__((ext_vector_type(8)));
typedef GAS unsigned gu32;
#define RLX_AGENT __ATOMIC_RELAXED, __HIP_MEMORY_SCOPE_AGENT
#define LDS_WAIT() asm volatile("s_waitcnt lgkmcnt(0)" ::: "memory")
#define VM_WAIT() asm volatile("s_waitcnt vmcnt(0)" ::: "memory")
__device__ __forceinline__ float bf2f(unsigned b) { return __uint_as_float(b << 16); }
__device__ __forceinline__ float bflo(unsigned w) { return __uint_as_float(w << 16); }
__device__ __forceinline__ float bfhi(unsigned w) { return __uint_as_float(w & 0xffff0000u); }
typedef __bf16 bf16x2_t __attribute__((ext_vector_type(2)));
__device__ __forceinline__ unsigned pk2(float lo, float hi) { const f32x2 v = {lo, hi}; const bf16x2_t b = __builtin_convertvector(v, bf16x2_t); return __builtin_bit_cast(unsigned, b); }
__device__ __forceinline__ float sigmoidf_(float x) { return 1.0f / (1.0f + __expf(-x)); }
__device__ __forceinline__ float wave_sum(float v) {
#pragma unroll
    for (int o = 1; o < 64; o <<= 1) v += __shfl_xor(v, o);
    return v;
}
__device__ __forceinline__ int row_bi(int m) { return m < NL ? (m >> 11) : 32; }
__device__ __forceinline__ int row_kv(int m) { return m < NL ? (m >> 11) * KVT + (m & 2047) : ((m - NL) >> 8) * KVT + TL + ((m - NL) & 255); }
namespace pg8 {
#define PG8_LAS __attribute__((address_space(3)))
typedef unsigned short bf16_t;
typedef short bf16x8 __attribute__((ext_vector_type(8)));
typedef float f32x4 __attribute__((ext_vector_type(4)));
typedef unsigned u32x4 __attribute__((ext_vector_type(4)));
constexpr int BM = 256, BK = 64, HALF = 128, HTB = HALF * BK * 2  , STAGE_BYTES = 8 * HTB, NXCD = 8, WGM = 8;

__host__ __device__ __forceinline__ int lds_byte(int r, int c) { const int st = (r >> 4) * 2 + (c >> 5), rr = r & 15, cc = c & 31, ob = rr * 64 + cc * 2; return st * 1024 + (ob ^ (((ob >> 9) & 1) << 5)); }
__host__ __device__ __forceinline__ void stage_rc(int b, int& R, int& C) { const int st = b / 1024, sb = b % 1024, swz = sb ^ (((sb >> 9) & 1) << 5); R = (st >> 1) * 16 + swz / 64; C = (st & 1) * 32 + (swz % 64) / 2; }
__host__ __device__ __forceinline__ int perm32(int rho) { const int n = rho >> 4, i = rho & 15; return 8 * (i >> 2) + 4 * n + (i & 3); }

struct Unit { int pm, pn; };

struct StdOrder {
    const char* A; const char* Bt; size_t tstep; int nM, nN, nwg, G, c;
    __device__ void init(const void* A_, const void* Bt_, int K, int nM_, int nN_, int G_, int c_) { A = (const char*)A_; Bt = (const char*)Bt_; tstep = (size_t)BM * K * 2; nM = nM_; nN = nN_; nwg = nM * nN; G = G_; c = c_; }
    __device__ bool next(int i, Unit& u) const {
        const long L = (long)i * G + c; if (L >= nwg) return false;
        int wgid = (int)L; { const int q = nwg / NXCD, r = nwg % NXCD, xcd = wgid % NXCD, off = wgid / NXCD; wgid = (xcd < r ? xcd * (q + 1) : r * (q + 1) + (xcd - r) * q) + off; }
        const int nig = WGM * nN, gid = wgid / nig, fm = gid * WGM, gsz = (nM - fm) < WGM ? (nM - fm) : WGM;
        u.pm = fm + ((wgid % nig) % gsz); u.pn = (wgid % nig) / gsz; return true;
    }
    __device__ __forceinline__ const char* a_base(const Unit& u) const { return A + (size_t)u.pm * tstep; }
    __device__ __forceinline__ const char* b_base(const Unit& u) const { return Bt + (size_t)u.pn * tstep; }
    __device__ __forceinline__ void a_ready(const Unit&) const {}
    __device__ __forceinline__ void done(const Unit&) const {}
};
template <class Epi, class Sched, bool ALIGN_EPI = false, bool SP2 = false>
__device__ __forceinline__ void gemm_phase(PG8_LAS unsigned char* lds, const int K, const Sched& S, const Epi& E) {
    int tid_l = threadIdx.x; asm volatile("" : "+v"(tid_l));
    const int tid = tid_l, wid = __builtin_amdgcn_readfirstlane(tid >> 6), lane = tid & 63, wr = wid >> 2, wc = wid & 3, fr = lane & 15, fq = lane >> 4;
    const int nt = K / BK;
    unsigned voffA[2], voffB[2];
#pragma unroll
    for (int i = 0; i < 2; ++i) { int R, C; stage_rc(tid * 16 + i * 8192, R, C); const int Rb = Epi::PERM ? ((R & ~31) + perm32(R & 31)) : R;
        voffA[i] = (unsigned)(R * K + C) * 2u; voffB[i] = (unsigned)(Rb * K + C) * 2u; }
    const size_t kstep = (size_t)(BK * 2);
    const size_t hstep = (size_t)HALF * K * 2;
    const unsigned ldsw = (unsigned)wid * 1024u;
    const int aoff = lds_byte(wr * 64 + fr, fq * 8), boff = lds_byte(wc * 32 + fr, fq * 8);
#define PG8_SA(b, h) (((b) * 2 + (h)) * HTB)
#define PG8_SB(b, h) ((4 + (b) * 2 + (h)) * HTB)
#define PG8_STAGE(bufoff, gbase, voff) do { _Pragma("unroll") for (int _i = 0; _i < 2; ++_i) \
        __builtin_amdgcn_global_load_lds((const unsigned*)((const char*)(gbase) + (voff)[_i]), (PG8_LAS unsigned*)(lds + (bufoff) + ldsw + _i * 8192), 16, 0, 0); } while (0)
#define PG8_LDA(dst, b, h) do { _Pragma("unroll") for (int m = 0; m < 4; ++m) _Pragma("unroll") for (int k = 0; k < 2; ++k) dst[m][k] = *(const PG8_LAS bf16x8*)(lds + PG8_SA(b, h) + aoff + m * 2048 + k * 1024); } while (0)
#define PG8_LDB(dst, b, h) do { _Pragma("unroll") for (int n = 0; n < 2; ++n) _Pragma("unroll") for (int k = 0; k < 2; ++k) dst[n][k] = *(const PG8_LAS bf16x8*)(lds + PG8_SB(b, h) + boff + n * 2048 + k * 1024); } while (0)
#define PG8_MMA(ai, bj, At, Bt) do { __builtin_amdgcn_s_setprio(1); _Pragma("unroll") for (int m = 0; m < 4; ++m) _Pragma("unroll") for (int n = 0; n < 2; ++n) _Pragma("unroll") for (int k = 0; k < 2; ++k) \
        acc[ai][bj][m][n] = __builtin_amdgcn_mfma_f32_16x16x32_bf16(Bt[n][k], At[m][k], acc[ai][bj][m][n], 0, 0, 0); __builtin_amdgcn_s_setprio(0); } while (0)
#define PG8_WAIT_V(n) asm volatile("s_waitcnt vmcnt(" #n ")" ::: "memory")
#define PG8_WAIT_L(n) asm volatile("s_waitcnt lgkmcnt(" #n ")" ::: "memory")
#define PG8_BAR __builtin_amdgcn_s_barrier()
#define PG8_SCHED __builtin_amdgcn_sched_barrier(0)
    Unit cur, nxt; int ui = 0;
    if (!S.next(0, cur)) return;
    f32x4 acc[2][2][4][2];
#pragma unroll
    for (int a = 0; a < 2; ++a)
#pragma unroll
        for (int b = 0; b < 2; ++b)
#pragma unroll
            for (int m = 0; m < 4; ++m)
#pragma unroll
                for (int n = 0; n < 2; ++n) acc[a][b][m][n] = (f32x4){0.f, 0.f, 0.f, 0.f};
    bf16x8 At[4][2], B0[2][2], B1[2][2];
    const char* cA = S.a_base(cur); const char* cB = S.b_base(cur);
    S.a_ready(cur);
    if constexpr (SP2) {
        PG8_STAGE(PG8_SB(0, 0), cB, voffB); PG8_STAGE(PG8_SB(0, 1), cB + hstep, voffB); PG8_STAGE(PG8_SA(0, 0), cA, voffA); PG8_STAGE(PG8_SA(0, 1), cA + hstep, voffA);
        if (wr == 1) PG8_BAR;
        PG8_WAIT_V(2); PG8_BAR;
        PG8_STAGE(PG8_SB(1, 0), cB + kstep, voffB); PG8_STAGE(PG8_SA(1, 0), cA + kstep, voffA); PG8_STAGE(PG8_SB(1, 1), cB + hstep + kstep, voffB);
        PG8_WAIT_V(6); PG8_BAR;
    } else {
        PG8_STAGE(PG8_SB(0, 0), cB, voffB); PG8_STAGE(PG8_SA(0, 0), cA, voffA); PG8_STAGE(PG8_SB(0, 1), cB + hstep, voffB); PG8_STAGE(PG8_SA(0, 1), cA + hstep, voffA);
        if (wr == 1) PG8_BAR;
        PG8_WAIT_V(4); PG8_BAR;
        PG8_STAGE(PG8_SB(1, 0), cB + kstep, voffB); PG8_STAGE(PG8_SA(1, 0), cA + kstep, voffA); PG8_STAGE(PG8_SB(1, 1), cB + hstep + kstep, voffB);
        PG8_WAIT_V(6); PG8_BAR;
    }
    for (;;) {
        const bool has_next = S.next(ui + 1, nxt);
        const char* nA = has_next ? S.a_base(nxt) : cA; const char* nB = has_next ? S.b_base(nxt) : cB;
        for (int t = 0; t < nt; t += 2) {
            const bool last = (t == nt - 2);
            const char* a1 = cA + (size_t)(t + 1) * kstep;
            const char* a2 = last ? nA : cA + (size_t)(t + 2) * kstep; const char* b2 = last ? nB : cB + (size_t)(t + 2) * kstep;
            const char* a3 = a2 + kstep; const char* b3 = b2 + kstep;
            if (last && has_next) S.a_ready(nxt);
            if constexpr (SP2) {
            PG8_LDB(B0, 0, 0); PG8_LDB(B1, 0, 1); PG8_SCHED; PG8_LDA(At, 0, 0); PG8_STAGE(PG8_SA(1, 1), a1 + hstep, voffA);
            PG8_WAIT_V(8); PG8_WAIT_L(0); PG8_BAR; PG8_MMA(0, 0, At, B0); PG8_MMA(0, 1, At, B1); PG8_BAR; PG8_SCHED;
            PG8_LDA(At, 0, 1); PG8_STAGE(PG8_SB(0, 0), b2, voffB); PG8_STAGE(PG8_SB(0, 1), b2 + hstep, voffB); PG8_STAGE(PG8_SA(0, 0), a2, voffA);
            PG8_WAIT_V(8); PG8_WAIT_L(0); PG8_BAR; PG8_MMA(1, 0, At, B0); PG8_MMA(1, 1, At, B1); PG8_BAR; PG8_SCHED;
            PG8_LDB(B0, 1, 0); PG8_LDB(B1, 1, 1); PG8_SCHED; PG8_LDA(At, 1, 0); PG8_STAGE(PG8_SA(0, 1), a2 + hstep, voffA);
            PG8_WAIT_V(8); PG8_WAIT_L(0); PG8_BAR; PG8_MMA(0, 0, At, B0); PG8_MMA(0, 1, At, B1); PG8_BAR; PG8_SCHED;
            PG8_LDA(At, 1, 1); PG8_STAGE(PG8_SB(1, 0), b3, voffB); PG8_STAGE(PG8_SB(1, 1), b3 + hstep, voffB); PG8_STAGE(PG8_SA(1, 0), a3, voffA);
            PG8_WAIT_V(8); PG8_WAIT_L(0); PG8_BAR; PG8_MMA(1, 0, At, B0); PG8_MMA(1, 1, At, B1); PG8_BAR; PG8_SCHED;
            } else {
            PG8_LDB(B0, 0, 0); PG8_SCHED; PG8_LDA(At, 0, 0); PG8_STAGE(PG8_SA(1, 1), a1 + hstep, voffA);
            PG8_WAIT_L(8); PG8_BAR; PG8_WAIT_L(0); PG8_MMA(0, 0, At, B0); PG8_BAR; PG8_SCHED;
            PG8_LDB(B1, 0, 1); PG8_STAGE(PG8_SB(0, 0), b2, voffB);
            PG8_BAR; PG8_WAIT_L(0); PG8_MMA(0, 1, At, B1); PG8_BAR;
            PG8_LDA(At, 0, 1); PG8_STAGE(PG8_SA(0, 0), a2, voffA);
            PG8_BAR; PG8_WAIT_L(0); PG8_MMA(1, 0, At, B0); PG8_BAR; PG8_SCHED;
            PG8_STAGE(PG8_SB(0, 1), b2 + hstep, voffB);
            PG8_WAIT_V(6); PG8_BAR; PG8_MMA(1, 1, At, B1); PG8_BAR;
            PG8_LDB(B0, 1, 0); PG8_SCHED; PG8_LDA(At, 1, 0); PG8_STAGE(PG8_SA(0, 1), a2 + hstep, voffA);
            PG8_WAIT_L(8); PG8_BAR; PG8_WAIT_L(0); PG8_MMA(0, 0, At, B0); PG8_BAR; PG8_SCHED;
            PG8_LDB(B1, 1, 1); PG8_STAGE(PG8_SB(1, 0), b3, voffB);
            PG8_BAR; PG8_WAIT_L(0); PG8_MMA(0, 1, At, B1); PG8_BAR;
            PG8_LDA(At, 1, 1); PG8_STAGE(PG8_SA(1, 0), a3, voffA);
            PG8_BAR; PG8_WAIT_L(0); PG8_MMA(1, 0, At, B0); PG8_BAR; PG8_SCHED;
            PG8_STAGE(PG8_SB(1, 1), b3 + hstep, voffB);
            PG8_WAIT_V(6); PG8_BAR; PG8_MMA(1, 1, At, B1); PG8_BAR;
            }
        }
        if constexpr (ALIGN_EPI) { if (wr == 0) PG8_BAR; }
        if constexpr (!Epi::AFTER_DRAIN) { E(acc, cur, wr, wc, fr, fq); S.done(cur); }
        if (!has_next) break;
#pragma unroll
        for (int a = 0; a < 2; ++a)
#pragma unroll
            for (int b = 0; b < 2; ++b)
#pragma unroll
                for (int m = 0; m < 4; ++m)
#pragma unroll
                    for (int n = 0; n < 2; ++n) acc[a][b][m][n] = (f32x4){0.f, 0.f, 0.f, 0.f};
        cur = nxt; cA = nA; cB = nB; ++ui;
        if constexpr (ALIGN_EPI) { if (wr == 1) PG8_BAR; }
    }
    PG8_WAIT_V(0);
    if constexpr (!ALIGN_EPI) { if (wr == 0) PG8_BAR; }
    PG8_BAR;
    if constexpr (Epi::AFTER_DRAIN) { E.fused(acc, cur, wr, wc, fr, fq, lds, wid, lane); S.done(cur); }
#undef PG8_SA
#undef PG8_SB
#undef PG8_STAGE
#undef PG8_LDA
#undef PG8_LDB
#undef PG8_MMA
#undef PG8_WAIT_V
#undef PG8_WAIT_L
#undef PG8_BAR
#undef PG8_SCHED
}
}

#include <hip/hip_bf16.h>
#include <cmath>
namespace attn_body {
using bf16=__hip_bfloat16;
using bf16x8=__attribute__((ext_vector_type(8)))short;
using s16x4=__attribute__((ext_vector_type(4)))short;
using f32x16=__attribute__((ext_vector_type(16)))float;
using u32x4=__attribute__((ext_vector_type(4)))unsigned;
constexpr int D=64,QP=512,KP=128;
constexpr int NW=8,QBLK=32,QB=QBLK*NW,KVBLK=64;
constexpr int ATTN_UNIT_ROWS=QB;
__device__ __forceinline__ int crow(int r,int hi){return (r&3)+8*(r>>2)+4*hi;}
#define SBAR() __builtin_amdgcn_sched_barrier(0)
__device__ __forceinline__ void cmask(f32x16&p0,f32x16&p1,int jb,int qrel,int hi){
  const float NEG=-INFINITY; int kb=64*jb+4*hi;
  #pragma unroll
  for(int r=0;r<16;++r){int kv=kb+(r&3)+8*(r>>2); if(kv>qrel)p0[r]=NEG; if(kv+32>qrel)p1[r]=NEG;}
}

constexpr int NSLOT=3, SLOTB=8192;
constexpr int LDS_K=0, LDS_V=NSLOT*SLOTB, LDS_WS=2*NSLOT*SLOTB, LDS_OST=LDS_WS+NW*64*4, LDS_BYTES=LDS_OST+NW*4096;
constexpr float C2=0.125f*1.4426950408889634f;
__device__ __forceinline__ void glds16(const void*gsrc,unsigned lds_dst){unsigned keep;
  asm volatile("s_mov_b32 %0, m0\n\ts_mov_b32 m0, %2\n\ts_nop 0\n\tglobal_load_lds_dwordx4 %1, off\n\ts_mov_b32 m0, %0":"=&s"(keep):"v"(gsrc),"s"(lds_dst):"memory");}
__device__ __forceinline__ float max3f(float a,float b,float c){float r;asm("v_max3_f32 %0, %1, %2, %3":"=v"(r):"v"(a),"v"(b),"v"(c));return r;}
__device__ __forceinline__ float max2f(float a,float b){float r;asm("v_max_f32_e32 %0, %1, %2":"=v"(r):"v"(a),"v"(b));return r;}
__device__ __forceinline__ float fadd_s(float a,float b){float r;asm("v_add_f32_e32 %0, %1, %2":"=v"(r):"v"(a),"v"(b));return r;}
__device__ __forceinline__ float fsub_s(float a,float b){float r;asm("v_sub_f32_e32 %0, %1, %2":"=v"(r):"v"(a),"v"(b));return r;}
typedef float f32x2_t __attribute__((ext_vector_type(2))); typedef __bf16 bf16x2_t __attribute__((ext_vector_type(2)));
__device__ __forceinline__ unsigned cvtpk_s(float lo,float hi){f32x2_t v={lo,hi};bf16x2_t b=__builtin_convertvector(v,bf16x2_t);return __builtin_bit_cast(unsigned,b);}
#define WAIT_BAR(N) asm volatile("s_waitcnt vmcnt(" #N ") lgkmcnt(0)\n\ts_barrier":::"memory")

__device__ __forceinline__ void qkt(f32x16&p0,f32x16&p1,const char*Kslot,const bf16x8*qr,const f32x16&negm,int r32,int hi){
  const char*kb=Kslot+hi*1024+r32*16;
  #pragma unroll
  for(int d0=0;d0<4;++d0){
    const bf16x8 b0=*reinterpret_cast<const bf16x8*>(kb+d0*2048);
    const bf16x8 b1=*reinterpret_cast<const bf16x8*>(kb+d0*2048+512);
    if(d0==0){p0=__builtin_amdgcn_mfma_f32_32x32x16_bf16(b0,qr[0],negm,0,0,0);p1=__builtin_amdgcn_mfma_f32_32x32x16_bf16(b1,qr[0],negm,0,0,0);}
    else{p0=__builtin_amdgcn_mfma_f32_32x32x16_bf16(b0,qr[d0],p0,0,0,0);p1=__builtin_amdgcn_mfma_f32_32x32x16_bf16(b1,qr[d0],p1,0,0,0);}}
}
typedef __attribute__((address_space(3))) const char* lds_cptr;
typedef short v4i16_t __attribute__((ext_vector_type(4)));
__device__ __forceinline__ void kload8(bf16x8*kf,lds_cptr kp){
  kf[0]=*(const __attribute__((address_space(3))) bf16x8*)(kp);      kf[1]=*(const __attribute__((address_space(3))) bf16x8*)(kp+512);
  kf[2]=*(const __attribute__((address_space(3))) bf16x8*)(kp+2048); kf[3]=*(const __attribute__((address_space(3))) bf16x8*)(kp+2560);
  kf[4]=*(const __attribute__((address_space(3))) bf16x8*)(kp+4096); kf[5]=*(const __attribute__((address_space(3))) bf16x8*)(kp+4608);
  kf[6]=*(const __attribute__((address_space(3))) bf16x8*)(kp+6144); kf[7]=*(const __attribute__((address_space(3))) bf16x8*)(kp+6656);
}
__device__ __forceinline__ void kload2(bf16x8*kf,lds_cptr kp,int j){ kf[2*j]=*(const __attribute__((address_space(3))) bf16x8*)(kp+j*2048); kf[2*j+1]=*(const __attribute__((address_space(3))) bf16x8*)(kp+j*2048+512); }
__device__ __forceinline__ s16x4 vtr(lds_cptr p){ return __builtin_bit_cast(s16x4,__builtin_amdgcn_ds_read_tr16_b64_v4i16((__attribute__((address_space(3))) v4i16_t*)p)); }
__device__ __forceinline__ float rowmax(const f32x16&p0,const f32x16&p1){
  float a=max3f(p0[0],p0[1],p1[0]),b=max3f(p0[2],p0[3],p1[1]);a=max3f(a,p1[2],p1[3]);
  #pragma unroll
  for(int r=4;r<16;r+=4){a=max3f(a,p0[r],p0[r+1]);b=max3f(b,p0[r+2],p0[r+3]);a=max3f(a,p1[r],p1[r+1]);b=max3f(b,p1[r+2],p1[r+3]);}
  const float m=max2f(a,b);
  auto rr=__builtin_amdgcn_permlane32_swap(__float_as_uint(m),__float_as_uint(m),false,false);
  return max2f(__uint_as_float(rr[0]),__uint_as_float(rr[1]));
}
__device__ __forceinline__ void pv(f32x16*o,int vb,bf16x8 pa0,bf16x8 pa1,bf16x8 pa2,bf16x8 pa3){
  #pragma unroll
  for(int d0=0;d0<2;++d0){s16x4 lo[4],hi[4];
    #pragma unroll
    for(int ks=0;ks<4;++ks){
      asm volatile("ds_read_b64_tr_b16 %0,%1 offset:%c2":"=&v"(lo[ks]):"v"(vb),"i"(d0*4096+ks*1024):"memory");
      asm volatile("ds_read_b64_tr_b16 %0,%1 offset:%c2":"=&v"(hi[ks]):"v"(vb),"i"(d0*4096+ks*1024+512):"memory");}
    asm volatile("s_waitcnt lgkmcnt(0)":::"memory");SBAR();
    #define PK(k) (bf16x8){lo[k][0],lo[k][1],lo[k][2],lo[k][3],hi[k][0],hi[k][1],hi[k][2],hi[k][3]}
    o[d0]=__builtin_amdgcn_mfma_f32_32x32x16_bf16(pa0,PK(0),o[d0],0,0,0);
    o[d0]=__builtin_amdgcn_mfma_f32_32x32x16_bf16(pa1,PK(1),o[d0],0,0,0);
    o[d0]=__builtin_amdgcn_mfma_f32_32x32x16_bf16(pa2,PK(2),o[d0],0,0,0);
    o[d0]=__builtin_amdgcn_mfma_f32_32x32x16_bf16(pa3,PK(3),o[d0],0,0,0);
    #undef PK
  }
}

#ifndef ATTN_STORE16
#define ATTN_STORE16(p,v) (*(u32x4*)(p)=(v))
#endif
template<int THRL> __device__ __forceinline__ void attn_unit(const bf16*Qu,const bf16*__restrict__ Kh,const bf16*__restrict__ Vh,bf16*Ou,const int NT,char*shm){
  int tid_l=threadIdx.x; asm volatile("":"+v"(tid_l));
  const int tid=tid_l,lane=tid&63,r32=lane&31,hi=lane>>5; const int wid=__builtin_amdgcn_readfirstlane(tid>>6);
  const bf16*Qw=Qu+(long)(wid*QBLK)*QP;
  const unsigned lds0=(unsigned)(uintptr_t)shm;
  float*wsf=(float*)(shm+LDS_WS)+wid*64;
  const bf16*ksrc=Kh+(long)lane*KP+wid*8;
  const bf16*vsrc=Vh+(long)(16*(wid&3)+(lane>>2))*KP+(wid>>2)*32+(lane&3)*8;
  const unsigned kdst=lds0+LDS_K+wid*1024, vdst=lds0+LDS_V+wid*1024;
  #define DMA_K(t,slot) glds16(ksrc+(long)(t)*KVBLK*KP,(unsigned)__builtin_amdgcn_readfirstlane(kdst+(slot)))
  #define DMA_V(t,slot) glds16(vsrc+(long)(t)*KVBLK*KP,(unsigned)__builtin_amdgcn_readfirstlane(vdst+(slot)))
  const int vb0=(int)(lds0+LDS_V)+((lane>>4)&1)*32+(lane&3)*8+(4*hi+((lane&15)>>2))*64;
  const char*Kbase=shm+LDS_K; bf16x8 kf[8];
  const lds_cptr shm3=(lds_cptr)shm; const lds_cptr kp0=shm3+LDS_K+hi*1024+r32*16; const lds_cptr vp0=shm3+LDS_V+((lane>>4)&1)*32+(lane&3)*8+(4*hi+((lane&15)>>2))*64;
  DMA_K(0,0);DMA_V(0,0);DMA_K(1,SLOTB);
  bf16x8 qr[4];
  #pragma unroll
  for(int d0=0;d0<4;++d0)qr[d0]=*reinterpret_cast<const bf16x8*>(&Qw[(long)r32*QP+d0*16+hi*8]);
  float mhat=0.f,l_reg=0.f;f32x16 o[2];o[0]=f32x16{};o[1]=f32x16{};f32x16 negm=f32x16{};asm volatile("":"+v"(negm));
  #define CMASK(P0,P1,t) do{}while(0)
  bool resc=false;
  #define START(P0,P1) do{ const float rm=rowmax(P0,P1); resc=false; \
    { const float dl=rm; mhat=fadd_s(mhat,dl); \
      _Pragma("unroll") for(int r=0;r<16;++r){P0[r]=fsub_s(P0[r],dl);P1[r]=fsub_s(P1[r],dl);} \
      _Pragma("unroll") for(int r=0;r<16;++r)negm[r]=-mhat; asm volatile("":"+v"(negm)); } \
    _Pragma("unroll") for(int r=0;r<16;++r)P0[r]=__builtin_amdgcn_exp2f(P0[r]); }while(0)
  #define RESC() do{ if(resc){ asm volatile("s_waitcnt lgkmcnt(0)":::"memory"); \
      _Pragma("unroll") for(int d_=0;d_<2;++d_) _Pragma("unroll") for(int r=0;r<16;++r)o[d_][r]*=wsf[crow(r,hi)]; } }while(0)
  f32x16 pA0,pA1,pB0,pB1;
  int sl_prev=0,sl_cur=0,sl_next=SLOTB;
  #define ROT() do{sl_prev=sl_cur;sl_cur=sl_next;sl_next=(sl_next==(NSLOT-1)*SLOTB)?0:sl_next+SLOTB;}while(0)
  DMA_K(2,2*SLOTB);
  WAIT_BAR(3);
  qkt(pA0,pA1,Kbase,qr,negm,r32,hi);asm volatile("s_nop 15\n\ts_nop 7":"+v"(pA0),"+v"(pA1));CMASK(pA0,pA1,0);
  START(pA0,pA1);
  _Pragma("unroll") for(int r=0;r<16;++r)pA1[r]=__builtin_amdgcn_exp2f(pA1[r]);
  WAIT_BAR(0);
  DMA_K(3,0);DMA_V(1,SLOTB);
  ROT();
  kload8(kf,kp0+sl_cur);
  WAIT_BAR(2);
  s16x4 vlo[8],vhi[8]; u32x4 pw0,pw1,pw2,pw3;
  #define PKW(P,B) cvtpk_s(P[B],P[B+1])
  #define PAF(k) __builtin_bit_cast(bf16x8,pw##k)
  #define VFR(i) (bf16x8){vlo[i][0],vlo[i][1],vlo[i][2],vlo[i][3],vhi[i][0],vhi[i][1],vhi[i][2],vhi[i][3]}
  #define PIN(x) asm volatile("":"+v"(x))
  #define MX3(a,b,c) __builtin_fmaxf(__builtin_fmaxf((a),(b)),(c))
  #define GAPA(MF,A0,A1,A2,A3,W0,W1,PW) do{ MF; sacc+=A0; sacc+=A1; sacc+=A2; sacc+=A3; PIN(sacc); W0; W1; PIN(PW); SBAR(); }while(0)
  #define EX(v) __builtin_amdgcn_exp2f(v)
  #define GAPB(MF,X,B) do{ MF; X[B]=EX(X[B]); X[B+1]=EX(X[B+1]); X[B+2]=EX(X[B+2]); X[B+3]=EX(X[B+3]); PIN(X); SBAR(); }while(0)
  #define VRD(i) do{ vlo[i]=vtr(vp_+(((i)>>2)*4096+((i)&3)*1024)); vhi[i]=vtr(vp_+(((i)>>2)*4096+((i)&3)*1024+512)); }while(0)
  #define KRD(G,j) do{ if(G){ kload2(kf,kp0+sl_next,j); SBAR(); } }while(0)
  #define STEP(C0,C1,P0,P1,t,GK,GV,GL) do{ SBAR(); \
    const lds_cptr vp_=vp0+sl_prev; \
    VRD(0); SBAR(); float sacc=(P0[0]+P0[1]); \
    GAPA(C0=__builtin_amdgcn_mfma_f32_32x32x16_bf16(kf[0],qr[0],negm,0,0,0), P0[2],P0[3],P0[4],P0[5],     pw0[0]=PKW(P0,0), pw0[1]=PKW(P0,2), pw0); \
    VRD(4); SBAR(); GAPA(C1=__builtin_amdgcn_mfma_f32_32x32x16_bf16(kf[1],qr[0],negm,0,0,0), P0[6],P0[7],P0[8],P0[9],     pw0[2]=PKW(P0,4), pw0[3]=PKW(P0,6), pw0); \
    VRD(1); SBAR(); GAPA(C0=__builtin_amdgcn_mfma_f32_32x32x16_bf16(kf[2],qr[1],C0,0,0,0),   P0[10],P0[11],P0[12],P0[13], pw1[0]=PKW(P0,8), pw1[1]=PKW(P0,10), pw1); \
    VRD(5); SBAR(); GAPA(C1=__builtin_amdgcn_mfma_f32_32x32x16_bf16(kf[3],qr[1],C1,0,0,0),   P0[14],P0[15],P1[0],P1[1],   pw1[2]=PKW(P0,12),pw1[3]=PKW(P0,14), pw1); \
    VRD(2); SBAR(); GAPA(C0=__builtin_amdgcn_mfma_f32_32x32x16_bf16(kf[4],qr[2],C0,0,0,0),   P1[2],P1[3],P1[4],P1[5],     pw2[0]=PKW(P1,0), pw2[1]=PKW(P1,2), pw2); \
    VRD(6); SBAR(); GAPA(C1=__builtin_amdgcn_mfma_f32_32x32x16_bf16(kf[5],qr[2],C1,0,0,0),   P1[6],P1[7],P1[8],P1[9],     pw2[2]=PKW(P1,4), pw2[3]=PKW(P1,6), pw2); \
    VRD(3); SBAR(); GAPA(C0=__builtin_amdgcn_mfma_f32_32x32x16_bf16(kf[6],qr[3],C0,0,0,0),   P1[10],P1[11],P1[12],P1[13], pw3[0]=PKW(P1,8), pw3[1]=PKW(P1,10), pw3); \
    VRD(7); SBAR(); GAPA(C1=__builtin_amdgcn_mfma_f32_32x32x16_bf16(kf[7],qr[3],C1,0,0,0),   P1[14],P1[15],0.f,0.f,       pw3[2]=PKW(P1,12),pw3[3]=PKW(P1,14), pw3); \
    l_reg+=sacc; \
    if(GK){DMA_K((t)+3,sl_cur);} if(GV){DMA_V((t)+1,sl_next);} \
    CMASK(C0,C1,t); \
    { float a=MX3(C0[0],C0[1],C1[0]),b=MX3(C0[2],C0[3],C1[1]); a=MX3(a,C1[2],C1[3]); \
      _Pragma("unroll") for(int r=4;r<16;r+=4){a=MX3(a,C0[r],C0[r+1]);b=MX3(b,C0[r+2],C0[r+3]);a=MX3(a,C1[r],C1[r+1]);b=MX3(b,C1[r+2],C1[r+3]);} \
      float rm=__builtin_fmaxf(a,b); { auto rr=__builtin_amdgcn_permlane32_swap(__float_as_uint(rm),__float_as_uint(rm),false,false); rm=__builtin_fmaxf(__uint_as_float(rr[0]),__uint_as_float(rr[1])); } \
      resc=false; \
      if(__builtin_expect(__any(rm>(float)THRL),0)){ const float dl=__builtin_fmaxf(rm,0.f); mhat+=dl; \
        _Pragma("unroll") for(int r=0;r<16;++r){C0[r]-=dl;C1[r]-=dl;} \
        _Pragma("unroll") for(int r=0;r<16;++r)negm[r]=-mhat; asm volatile("":"+v"(negm)); \
        const float f=__builtin_amdgcn_exp2f(-dl); l_reg*=f; if(hi==0)wsf[r32]=f; resc=true; } } \
    SBAR(); \
    GAPB(o[0]=__builtin_amdgcn_mfma_f32_32x32x16_bf16(PAF(0),VFR(0),o[0],0,0,0), C0,0); \
    GAPB(o[1]=__builtin_amdgcn_mfma_f32_32x32x16_bf16(PAF(0),VFR(4),o[1],0,0,0), C0,4); \
    KRD(GL,0); GAPB(o[0]=__builtin_amdgcn_mfma_f32_32x32x16_bf16(PAF(1),VFR(1),o[0],0,0,0), C0,8); \
    KRD(GL,1); GAPB(o[1]=__builtin_amdgcn_mfma_f32_32x32x16_bf16(PAF(1),VFR(5),o[1],0,0,0), C0,12); \
    KRD(GL,2); GAPB(o[0]=__builtin_amdgcn_mfma_f32_32x32x16_bf16(PAF(2),VFR(2),o[0],0,0,0), C1,0); \
    KRD(GL,3); GAPB(o[1]=__builtin_amdgcn_mfma_f32_32x32x16_bf16(PAF(2),VFR(6),o[1],0,0,0), C1,4); \
    GAPB(o[0]=__builtin_amdgcn_mfma_f32_32x32x16_bf16(PAF(3),VFR(3),o[0],0,0,0), C1,8); \
    GAPB(o[1]=__builtin_amdgcn_mfma_f32_32x32x16_bf16(PAF(3),VFR(7),o[1],0,0,0), C1,12); \
    }while(0)
  int t=1;
  for(;t+5<NT;t+=2){
    STEP(pB0,pB1,pA0,pA1,t,true,true,true);     WAIT_BAR(2); RESC(); ROT();
    STEP(pA0,pA1,pB0,pB1,t+1,true,true,true);   WAIT_BAR(2); RESC(); ROT();
  }
  #define ENDW(tt) do{ if((tt)+3<NT){WAIT_BAR(2);} else if((tt)+2<NT){WAIT_BAR(1);} else {WAIT_BAR(0);} }while(0)
  for(;t+1<NT;t+=2){
    STEP(pB0,pB1,pA0,pA1,t,(t+3<NT),(t+1<NT),(t+1<NT));       ENDW(t);   RESC(); ROT();
    STEP(pA0,pA1,pB0,pB1,t+1,(t+4<NT),(t+2<NT),(t+2<NT));     ENDW(t+1); RESC(); ROT();
  }
  STEP(pB0,pB1,pA0,pA1,NT-1,false,false,false); RESC();
  { float sacc=pB0[0]+pB0[1]; _Pragma("unroll") for(int r=2;r<16;++r)sacc+=pB0[r]; _Pragma("unroll") for(int r=0;r<16;++r)sacc+=pB1[r]; l_reg+=sacc;
    pw0=(u32x4){PKW(pB0,0),PKW(pB0,2),PKW(pB0,4),PKW(pB0,6)};pw1=(u32x4){PKW(pB0,8),PKW(pB0,10),PKW(pB0,12),PKW(pB0,14)};pw2=(u32x4){PKW(pB1,0),PKW(pB1,2),PKW(pB1,4),PKW(pB1,6)};pw3=(u32x4){PKW(pB1,8),PKW(pB1,10),PKW(pB1,12),PKW(pB1,14)};
    SBAR(); pv(o,vb0+sl_cur,PAF(0),PAF(1),PAF(2),PAF(3)); }
  #undef PKW
  #undef PAF
  #undef VFR
  #undef PIN
  #undef MX3
  #undef GAPA
  #undef GAPB
  #undef EX
  #undef VRD
  #undef KRD
  #undef STEP
  #undef ENDW
  {auto rr=__builtin_amdgcn_permlane32_swap(__float_as_uint(l_reg),__float_as_uint(l_reg),false,false);l_reg=__uint_as_float(rr[0])+__uint_as_float(rr[1]);}
  if(hi==0)wsf[32+r32]=l_reg;asm volatile("s_waitcnt lgkmcnt(0)":::"memory");
  float rli[16];
  #pragma unroll
  for(int r=0;r<16;++r)rli[r]=__builtin_amdgcn_rcpf(wsf[32+crow(r,hi)]);
  bf16*Ow=Ou+(long)(wid*QBLK)*QP;
  { bf16*stg=(bf16*)(shm+LDS_OST)+wid*2048;
    #pragma unroll
    for(int r=0;r<16;++r){const int orow=crow(r,hi);
      #pragma unroll
      for(int d0=0;d0<2;++d0)stg[orow*64+d0*32+r32]=__float2bfloat16(o[d0][r]*rli[r]);}
    asm volatile("s_waitcnt lgkmcnt(0)":::"memory");
    #pragma unroll
    for(int i=0;i<4;++i){const int row=i*8+(lane>>3),ch=lane&7; const u32x4 v=*(const u32x4*)(stg+row*64+ch*8); ATTN_STORE16(Ow+(long)row*QP+ch*8,v);} }
  asm volatile("s_waitcnt lgkmcnt(0)\n\ts_barrier":::"memory");
  #undef DMA_K
  #undef DMA_V
  #undef CMASK
  #undef START
  #undef RESC
  #undef ROT
}
constexpr int ATTN_LDS_BYTES=LDS_BYTES;
#undef SBAR
#undef WAIT_BAR
}

#define XB_TMO      128
#define XB_XCNT(j)  (256  + 64 * (j))
#define XB_XSUB(j)  (1280 + 64 * (j))
#define XB_XGEN(j)  (2304 + 64 * (j))
#define XB_TOP      3328
#define XB_TOPGEN   3392
#define XCD_BAR_WORDS 3456
#define XB_SPIN_CAP (1u << 18)

__device__ __forceinline__ unsigned xb_ld(unsigned* p)              { return __hip_atomic_load(p, __ATOMIC_RELAXED, __HIP_MEMORY_SCOPE_AGENT); }
__device__ __forceinline__ unsigned xb_add(unsigned* p, unsigned v) { return __hip_atomic_fetch_add(p, v, __ATOMIC_RELAXED, __HIP_MEMORY_SCOPE_AGENT); }
__device__ __forceinline__ unsigned xb_xcc_id() { return (unsigned)__builtin_amdgcn_s_getreg((3 << 11) | 20) & 0xFu; }
#define XB_SPIN(cond, bar) do { unsigned _sp = 0; while (cond) { __builtin_amdgcn_s_sleep(1); \
    if ((++_sp & 255u) == 0u) { if (xb_ld(&(bar)[XB_TMO])) break; if (_sp > XB_SPIN_CAP) { atomicAdd(&(bar)[XB_TMO], 1u); break; } } } } while (0)

struct XcdBarrier {
    unsigned* bar; unsigned x;
    volatile LAS unsigned* st;
};

__device__ __forceinline__ XcdBarrier xcd_barrier_post(unsigned* bar, volatile LAS unsigned* st) {
    XcdBarrier b; b.bar = bar; b.x = xb_xcc_id(); b.st = st;
    if (threadIdx.x == 0) (void)xb_add(&bar[XB_XCNT(b.x)], 1u);
    return b;
}
__device__ __forceinline__ void xcd_barrier_complete(unsigned* bar, unsigned x, unsigned& nloc, unsigned& nx) {
    const unsigned G = gridDim.x * gridDim.y * gridDim.z;
    unsigned sum, cnt, mine, sp = 0u;
    for (;;) {
        sum = 0u; cnt = 0u; mine = 0u;
#pragma unroll
        for (unsigned j = 0; j < 16; ++j) { const unsigned c = xb_ld(&bar[XB_XCNT(j)]); sum += c; cnt += (c > 0u) ? 1u : 0u; mine = (j == x) ? c : mine; }
        if (sum == G) break;
        __builtin_amdgcn_s_sleep(1);
        if ((++sp & 255u) == 0u) { if (xb_ld(&bar[XB_TMO])) break; if (sp > XB_SPIN_CAP) { atomicAdd(&bar[XB_TMO], 1u); break; } }
    }
    nloc = mine > 0u ? mine : 1u; nx = cnt > 0u ? cnt : 1u;
}

__device__ __forceinline__ void xcd_barrier(const XcdBarrier& b) {
    asm volatile("s_waitcnt vmcnt(0)" ::: "memory");
    __syncthreads();
    if (threadIdx.x == 0) {
        unsigned* bar = b.bar;
        __builtin_amdgcn_s_waitcnt(0);
        unsigned nloc = b.st[0], nx = b.st[1];
        if (nloc == 0u) { xcd_barrier_complete(bar, b.x, nloc, nx); b.st[0] = nloc; b.st[1] = nx; }
        const unsigned old = xb_add(&bar[XB_XSUB(b.x)], 1u);
        const unsigned gen = old / nloc;
        if (old + 1u == (gen + 1u) * nloc) {
            __builtin_amdgcn_fence(__ATOMIC_RELEASE, "agent");
            asm volatile("s_waitcnt vmcnt(0)" ::: "memory");
            const unsigned og = xb_add(&bar[XB_TOP], 1u);
            const unsigned tg = og / nx;
            if (og + 1u == (tg + 1u) * nx) xb_add(&bar[XB_TOPGEN], 1u);
            else XB_SPIN(xb_ld(&bar[XB_TOPGEN]) == tg, bar);
            __builtin_amdgcn_fence(__ATOMIC_ACQUIRE, "agent");
            xb_add(&bar[XB_XGEN(b.x)], 1u);
            asm volatile("s_waitcnt vmcnt(0)" ::: "memory");
        } else {
            XB_SPIN(xb_ld(&bar[XB_XGEN(b.x)]) == gen, bar);
            __builtin_amdgcn_fence(__ATOMIC_ACQUIRE, "agent");
            asm volatile("s_waitcnt vmcnt(0)" ::: "memory");
        }
    }
    __syncthreads();
}

struct Args { const GAS float* in[33]; GAS float* out; unsigned char* ws; int mode, l, site, chunk; };
struct Frame {
    LAS unsigned char* lds; volatile LAS unsigned* MISC; gu32* ctl;
    int tid, lane, wave, vcu, G;
    unsigned char* ws; GAS float* out;
};
#define WSP(T, off) ((GAS T*)(F.ws + (off)))
#define WSGEN(T, off) ((T*)(F.ws + (off)))
__device__ __forceinline__ const GAS float* inptr(LAS unsigned char* lds, int i) { const LAS unsigned* p = (const LAS unsigned*)(lds + PTAB_OFF) + 2 * i; const unsigned lo = __builtin_amdgcn_readfirstlane(p[0]), hi = __builtin_amdgcn_readfirstlane(p[1]); return (const GAS float*)(((unsigned long long)hi << 32) | lo); }
#define INP(i) inptr(F.lds, (i))

__device__ __forceinline__ void conv_item(const GAS float* W, int Nsrc, int k0, int c0, GAS bf16* WT, int K, int drow0, LAS float* scr, int lane) {
#pragma unroll 8
    for (int i = 0; i < 32; ++i) { const int kk = 2 * i + (lane >> 5); scr[kk * 33 + (lane & 31)] = W[(size_t)(k0 + kk) * Nsrc + c0 + (lane & 31)]; }
    LDS_WAIT(); asm volatile("" ::: "memory");
    const int c = lane & 7;
#pragma unroll
    for (int j = 0; j < 4; ++j) { const int n = (lane >> 3) + 8 * j; const LAS float* s = scr + (8 * c) * 33 + n;
        v4u o; o.x = pk2(s[0 * 33], s[1 * 33]); o.y = pk2(s[2 * 33], s[3 * 33]); o.z = pk2(s[4 * 33], s[5 * 33]); o.w = pk2(s[6 * 33], s[7 * 33]);
        *(GAS v4u*)(WT + (size_t)(drow0 + n) * K + k0 + 8 * c) = o; }
    LDS_WAIT(); asm volatile("" ::: "memory");
}
__device__ __forceinline__ void conv_plain(int item, const GAS float* W, int K, int N, GAS bf16* WT, LAS float* scr, int lane) {
    const int ng = N / 32, kb = item / ng, g = item % ng; conv_item(W, N, 64 * kb, 32 * g, WT, K, 32 * g, scr, lane);
}
__device__ __forceinline__ void conv_gu(int item, const GAS float* W, GAS bf16* WT, int off, LAS float* scr, int lane) {
    const int ng = FF / 32, kb = item / ng, g = item % ng; conv_item(W, FF, 64 * kb, 32 * g, WT, DM, 256 * (g >> 2) + off + 32 * (g & 3), scr, lane);
}
__device__ __forceinline__ void mod_task(Frame& F, int task) {
    const int l = task / 96, nb = task % 96;
    LAS float* S = (LAS float*)F.lds;
    for (int i = F.tid; i < 33 * 1024; i += 512) { const int bi = i >> 10, k = i & 1023; const float c = bi < 32 ? INP(1)[bi * 1024 + k] : INP(3)[k]; S[k * 33 + bi] = c / (1.0f + __expf(-c)); }
    __syncthreads();
    const GAS float* W = INP(4) + (size_t)l * DM * 6144 + nb * 64 + F.lane;
    float acc[33];
#pragma unroll
    for (int bi = 0; bi < 33; ++bi) acc[bi] = 0.f;
    const int k0 = F.wave * 128;
    for (int k = k0; k < k0 + 128; ++k) { const float w = W[(size_t)k * 6144];
#pragma unroll
        for (int bi = 0; bi < 33; ++bi) acc[bi] = fmaf(S[k * 33 + bi], w, acc[bi]); }
    __syncthreads();
    LAS float* P = (LAS float*)F.lds;
#pragma unroll
    for (int bi = 0; bi < 33; ++bi) P[(F.wave * 33 + bi) * 64 + F.lane] = acc[bi];
    __syncthreads();
    GAS float* mod = WSP(float, WS_MOD);
    for (int o = F.tid; o < 33 * 64; o += 512) { const int bi = o >> 6, cc = o & 63; float s = 0.f;
#pragma unroll
        for (int w = 0; w < 8; ++w) s += P[(w * 33 + bi) * 64 + cc];
        const int n = nb * 64 + cc; mod[(size_t)(l * 33 + bi) * 6144 + n] = s + INP(5)[l * 6144 + n]; }
    __syncthreads();
}
__device__ __forceinline__ void p0_prologue(Frame& F) {
    for (int t = F.vcu; t < 192; t += F.G) mod_task(F, t);
    if (F.vcu == F.G - 1) { GAS float* rt = WSP(float, WS_ROPE);
        for (int i = F.tid; i < 1024; i += 512) { const int pos = i >> 4, f = i & 15; const float inv = powf(10000.0f, -(float)f / 16.0f); const float a = (float)pos * inv; rt[i] = cosf(a); rt[1024 + i] = sinf(a); } }
    LAS float* scr = (LAS float*)(F.lds + F.wave * 8448);
    const int gw = F.vcu * NWAVES + F.wave, NGW = F.G * NWAVES;
    constexpr int I_IN = 16 * 144, I_P = 8 * 32, I_O = 16 * 32, I_GU = 16 * 112, I_DN = 56 * 32, I_L = 16, I_G2 = 32;
    constexpr int NITEMS = 2 * I_IN + 4 * I_P + 2 * I_O + 2 * I_GU + I_DN + 8 * I_L + 2 * I_G2;
    GAS bf16* lora = WSP(bf16, WS_LORA);
    for (int it = gw; it < NITEMS; it += NGW) {
        int r = it;
        if (r < 2 * I_IN) { const int l = r / I_IN; conv_plain(r % I_IN, INP(8) + (size_t)l * DM * NIN, DM, NIN, WSP(bf16, WS_WIN) + (size_t)l * NIN * DM, scr, F.lane); continue; } r -= 2 * I_IN;
        if (r < 2 * I_P) { const int l = r / I_P; conv_plain(r % I_P, INP(22) + (size_t)l * RW * DM, RW, DM, WSP(bf16, WS_WPA) + (size_t)l * DM * RW, scr, F.lane); continue; } r -= 2 * I_P;
        if (r < 2 * I_P) { const int l = r / I_P; conv_plain(r % I_P, INP(23) + (size_t)l * RW * DM, RW, DM, WSP(bf16, WS_WPB) + (size_t)l * DM * RW, scr, F.lane); continue; } r -= 2 * I_P;
        if (r < 2 * I_O) { const int l = r / I_O; conv_plain(r % I_O, INP(24) + (size_t)l * DM * DM, DM, DM, WSP(bf16, WS_WO) + (size_t)l * DM * DM, scr, F.lane); continue; } r -= 2 * I_O;
        if (r < I_GU) { conv_gu(r, INP(25), WSP(bf16, WS_WGU), 0, scr, F.lane); continue; } r -= I_GU;
        if (r < I_GU) { conv_gu(r, INP(26), WSP(bf16, WS_WGU), 128, scr, F.lane); continue; } r -= I_GU;
        if (r < I_DN) { conv_plain(r, INP(27), FF, DM, WSP(bf16, WS_WDN), scr, F.lane); continue; } r -= I_DN;
        if (r < 4 * I_L) { const int ld = r / I_L; conv_plain(r % I_L, INP(11) + (size_t)ld * 64 * RW, 64, RW, lora + (size_t)ld * RW * 64, scr, F.lane); continue; } r -= 4 * I_L;
        if (r < 4 * I_L) { const int ld = r / I_L; conv_plain(r % I_L, INP(13) + (size_t)ld * 64 * RW, 64, RW, lora + (size_t)(4 + ld) * RW * 64, scr, F.lane); continue; } r -= 4 * I_L;
        { const int l = r / I_G2; conv_plain(r % I_G2, INP(14) + (size_t)l * 128 * RW, 128, RW, lora + (size_t)8 * RW * 64 + (size_t)l * RW * 128, scr, F.lane); }
    }
}
__device__ __forceinline__ void moe_conv(Frame& F) {
    LAS float* scr = (LAS float*)(F.lds + F.wave * 8448);
    const int gw = F.vcu * NWAVES + F.wave, NGW = F.G * NWAVES;
    constexpr int I_GU = 16 * 112, I_DN = 56 * 32, I_E = 2 * I_GU + I_DN;
    for (int it = gw; it < NE * I_E; it += NGW) {
        const int e = it / I_E; int r = it % I_E; GAS bf16* base = WSP(bf16, WS_MW) + (size_t)e * (21 * MiB / 2);
        if (r < I_GU) { conv_gu(r, INP(29) + (size_t)e * DM * FF, base, 0, scr, F.lane); continue; } r -= I_GU;
        if (r < I_GU) { conv_gu(r, INP(30) + (size_t)e * DM * FF, base, 128, scr, F.lane); continue; } r -= I_GU;
        conv_plain(r, INP(31) + (size_t)e * FF * DM, FF, DM, base + (size_t)2 * FF * DM, scr, F.lane);
    }
}

template <bool ROUTER>
__device__ __forceinline__ void norm_mod_phase(Frame& F, int l, int which, const GAS float* xlat, const GAS float* xctx, int nrows, GAS bf16* H) {
    const int gw = F.vcu * NWAVES + F.wave, NGW = F.G * NWAVES;
    const GAS float* gain = INP(which ? 7 : 6) + l * DM;
    const GAS float* modl = WSP(float, WS_MOD) + (size_t)l * 33 * 6144 + (which ? 3072 : 0);
    for (int m = gw; m < nrows; m += NGW) {
        const GAS float* xr = m < NL ? xlat + (size_t)m * DM : xctx + (size_t)(m - NL) * DM;
        const GAS float* mv = modl + (size_t)row_bi(m) * 6144;
        f32x4 v[4]; float s = 0.f;
#pragma unroll
        for (int j = 0; j < 4; ++j) { v[j] = *(const GAS f32x4*)(xr + 4 * F.lane + 256 * j); s += (v[j].x * v[j].x + v[j].y * v[j].y) + (v[j].z * v[j].z + v[j].w * v[j].w); }
        const float rstd = 1.0f / sqrtf(wave_sum(s) * (1.0f / DM) + 1e-6f);
        float lg[8];
        if (ROUTER) {
#pragma unroll
            for (int e = 0; e < 8; ++e) lg[e] = 0.f; }
#pragma unroll
        for (int j = 0; j < 4; ++j) { const int c = 4 * F.lane + 256 * j;
            const f32x4 g = *(const GAS f32x4*)(gain + c), sh = *(const GAS f32x4*)(mv + c), sc = *(const GAS f32x4*)(mv + 1024 + c);
            const f32x4 hv = v[j] * rstd * g * (sc + 1.0f) + sh;
            v2u o; o.x = pk2(hv.x, hv.y); o.y = pk2(hv.z, hv.w);
            *(GAS v2u*)(H + (size_t)m * DM + c) = o;
            if (ROUTER) { const GAS float* rw = INP(28) + (size_t)c * 8;
#pragma unroll
                for (int q = 0; q < 4; ++q) { const f32x4 r0 = *(const GAS f32x4*)(rw + q * 8), r1 = *(const GAS f32x4*)(rw + q * 8 + 4); const float hq = hv[q];
                    lg[0] = fmaf(hq, r0.x, lg[0]); lg[1] = fmaf(hq, r0.y, lg[1]); lg[2] = fmaf(hq, r0.z, lg[2]); lg[3] = fmaf(hq, r0.w, lg[3]);
                    lg[4] = fmaf(hq, r1.x, lg[4]); lg[5] = fmaf(hq, r1.y, lg[5]); lg[6] = fmaf(hq, r1.z, lg[6]); lg[7] = fmaf(hq, r1.w, lg[7]); } }
        }
        if (ROUTER) {
#pragma unroll
            for (int e = 0; e < 8; ++e) lg[e] = wave_sum(lg[e]);
            int e0 = 0; float l0 = lg[0];
#pragma unroll
            for (int e = 1; e < 8; ++e) if (lg[e] > l0) { l0 = lg[e]; e0 = e; }
            int e1 = -1; float l1 = -INFINITY;
#pragma unroll
            for (int e = 0; e < 8; ++e) if (e != e0 && lg[e] > l1) { l1 = lg[e]; e1 = e; }
            const float w1 = 1.0f / (1.0f + __expf(l0 - l1)), w0 = 1.0f - w1;
            if (F.lane == 0) {
                GAS int* te = (GAS int*)(F.ws + WS_MOETAB + MT_TOKE) + 2 * m; GAS float* tw = (GAS float*)(F.ws + WS_MOETAB + MT_TOKW) + 2 * m;
                te[0] = e0; te[1] = e1; tw[0] = w0; tw[1] = w1;
                __hip_atomic_fetch_add((LAS unsigned*)&F.MISC[16 + e0], 1u, __ATOMIC_RELAXED, __HIP_MEMORY_SCOPE_WORKGROUP); __hip_atomic_fetch_add((LAS unsigned*)&F.MISC[16 + e1], 1u, __ATOMIC_RELAXED, __HIP_MEMORY_SCOPE_WORKGROUP);
            }
        }
    }
    if (ROUTER) { __syncthreads(); if (F.tid < 8) { const unsigned c = F.MISC[16 + F.tid]; if (c) __hip_atomic_fetch_add(F.ctl + CW_HIST + 64 * F.tid, c, RLX_AGENT); } __syncthreads(); }
}

using pg8::Unit;
struct EpiIn {
    static constexpr bool PERM = true, AFTER_DRAIN = false;
    GAS bf16 *PR, *Q, *KB, *VB, *G;
    __device__ __forceinline__ void operator()(const f32x4 (&acc)[2][2][4][2], const Unit& u, int wr, int wc, int fr, int fq) const {
        const int row0 = u.pm * 256 + wr * 64 + fr, cb = wc * 32 + 8 * fq, pn = u.pn;
#pragma unroll
        for (int ai = 0; ai < 2; ++ai)
#pragma unroll
            for (int m = 0; m < 4; ++m) { const int r = row0 + ai * 128 + m * 16;
#pragma unroll
                for (int bj = 0; bj < 2; ++bj) { f32x4 v0 = acc[ai][bj][m][0], v1 = acc[ai][bj][m][1]; GAS bf16* dst;
                    if (pn < 7) dst = PR + (size_t)r * RCOLS + pn * 256 + bj * 128 + cb;
                    else if (pn < 9) dst = Q + (size_t)r * 512 + (pn - 7) * 256 + bj * 128 + cb;
                    else if (pn == 9) dst = (bj == 0 ? KB : VB) + (size_t)row_kv(r) * 128 + cb;
                    else { dst = G + (size_t)r * GCOLS + (pn - 10) * 256 + bj * 128 + cb;
#pragma unroll
                        for (int q = 0; q < 4; ++q) { v0[q] = sigmoidf_(v0[q]); v1[q] = sigmoidf_(v1[q]); } }
                    v4u w; w.x = pk2(v0[0], v0[1]); w.y = pk2(v0[2], v0[3]); w.z = pk2(v1[0], v1[1]); w.w = pk2(v1[2], v1[3]);
                    *(GAS v4u*)dst = w; } }
    }
};
template <int MODE> struct EpiMerge {
    static constexpr bool PERM = true, AFTER_DRAIN = false;
    const GAS bf16* G; GAS bf16* MG;
    __device__ __forceinline__ void operator()(const f32x4 (&acc)[2][2][4][2], const Unit& u, int wr, int wc, int fr, int fq) const {
        const int row0 = u.pm * 256 + wr * 64 + fr, col0 = u.pn * 256 + wc * 32 + 8 * fq;
#pragma unroll
        for (int ai = 0; ai < 2; ++ai)
#pragma unroll
            for (int m = 0; m < 4; ++m) { const int r = row0 + ai * 128 + m * 16;
#pragma unroll
                for (int bj = 0; bj < 2; ++bj) { const int c = col0 + bj * 128;
                    const v4u g = *(const GAS v4u*)(G + (size_t)r * GCOLS + MODE * DM + c);
                    const f32x4 a0 = acc[ai][bj][m][0], a1 = acc[ai][bj][m][1];
                    float o[8] = { bflo(g.x) * a0[0], bfhi(g.x) * a0[1], bflo(g.y) * a0[2], bfhi(g.y) * a0[3], bflo(g.z) * a1[0], bfhi(g.z) * a1[1], bflo(g.w) * a1[2], bfhi(g.w) * a1[3] };
                    GAS bf16* dst = MG + (size_t)r * DM + c;
                    if (MODE == 1) { const v4u p = *(const GAS v4u*)dst; o[0] += bflo(p.x); o[1] += bfhi(p.x); o[2] += bflo(p.y); o[3] += bfhi(p.y); o[4] += bflo(p.z); o[5] += bfhi(p.z); o[6] += bflo(p.w); o[7] += bfhi(p.w); }
                    v4u w; w.x = pk2(o[0], o[1]); w.y = pk2(o[2], o[3]); w.z = pk2(o[4], o[5]); w.w = pk2(o[6], o[7]);
                    *(GAS v4u*)dst = w; } }
    }
};
struct EpiRes {
    static constexpr bool PERM = false, AFTER_DRAIN = false;
    const GAS float *base_lat, *base_ctx; GAS float *out_lat, *out_ctx; const GAS float* gt;
    __device__ __forceinline__ void operator()(const f32x4 (&acc)[2][2][4][2], const Unit& u, int wr, int wc, int fr, int fq) const {
        const bool lat = u.pm < NL / 256; const int bi = lat ? (u.pm >> 3) : 32;
        const int rr0 = (lat ? u.pm * 256 : u.pm * 256 - NL) + wr * 64 + fr, col0 = u.pn * 256 + wc * 32 + 4 * fq;
        const GAS float* bp = lat ? base_lat : base_ctx; GAS float* op = lat ? out_lat : out_ctx; const GAS float* gv = gt + (size_t)bi * 6144 + col0;
        f32x4 g[2][2];
#pragma unroll
        for (int bj = 0; bj < 2; ++bj)
#pragma unroll
            for (int n = 0; n < 2; ++n) g[bj][n] = *(const GAS f32x4*)(gv + bj * 128 + n * 16);
#pragma unroll
        for (int ai = 0; ai < 2; ++ai)
#pragma unroll
            for (int m = 0; m < 4; ++m) { const size_t off = (size_t)(rr0 + ai * 128 + m * 16) * DM + col0;
#pragma unroll
                for (int bj = 0; bj < 2; ++bj)
#pragma unroll
                    for (int n = 0; n < 2; ++n) { const f32x4 b = *(const GAS f32x4*)(bp + off + bj * 128 + n * 16); *(GAS f32x4*)(op + off + bj * 128 + n * 16) = b + g[bj][n] * acc[ai][bj][m][n]; }
                asm volatile("" ::: "memory"); }
    }
};
struct EpiGU {
    static constexpr bool PERM = true, AFTER_DRAIN = false;
    GAS bf16* ACT; int pm0;
    __device__ __forceinline__ void operator()(const f32x4 (&acc)[2][2][4][2], const Unit& u, int wr, int wc, int fr, int fq) const {
        const int row0 = (u.pm - pm0) * 256 + wr * 64 + fr, col0 = u.pn * 128 + wc * 32 + 8 * fq;
#pragma unroll
        for (int ai = 0; ai < 2; ++ai)
#pragma unroll
            for (int m = 0; m < 4; ++m) { const int r = row0 + ai * 128 + m * 16; float o[8];
#pragma unroll
                for (int n = 0; n < 2; ++n)
#pragma unroll
                    for (int q = 0; q < 4; ++q) { const float gte = acc[ai][0][m][n][q], up = acc[ai][1][m][n][q]; o[4 * n + q] = gte * sigmoidf_(gte) * up; }
                v4u w; w.x = pk2(o[0], o[1]); w.y = pk2(o[2], o[3]); w.z = pk2(o[4], o[5]); w.w = pk2(o[6], o[7]);
                *(GAS v4u*)(ACT + (size_t)r * FF + col0) = w; }
    }
};
struct EpiStore {
    static constexpr bool PERM = true, AFTER_DRAIN = false;
    GAS bf16* O;
    __device__ __forceinline__ void operator()(const f32x4 (&acc)[2][2][4][2], const Unit& u, int wr, int wc, int fr, int fq) const {
        const int row0 = u.pm * 256 + wr * 64 + fr, col0 = u.pn * 256 + wc * 32 + 8 * fq;
#pragma unroll
        for (int ai = 0; ai < 2; ++ai)
#pragma unroll
            for (int m = 0; m < 4; ++m) { const int r = row0 + ai * 128 + m * 16;
#pragma unroll
                for (int bj = 0; bj < 2; ++bj) { const f32x4 v0 = acc[ai][bj][m][0], v1 = acc[ai][bj][m][1];
                    v4u w; w.x = pk2(v0[0], v0[1]); w.y = pk2(v0[2], v0[3]); w.z = pk2(v1[0], v1[1]); w.w = pk2(v1[2], v1[3]);
                    *(GAS v4u*)(O + (size_t)r * DM + col0 + bj * 128) = w; } }
    }
};
struct MoeOrder {
    const char* A; const char* W; size_t a_tstep, b_tstep, w_estep; int tile0, a_tile0, ntl, nN, G, c; const LAS int* tile_e;
    __device__ bool next(int i, Unit& u) const { const long L = (long)i * G + c; if (L >= (long)ntl * nN) return false; u.pn = (int)(L / ntl); u.pm = tile0 + (int)(L % ntl); return true; }
    __device__ __forceinline__ const char* a_base(const Unit& u) const { return A + (size_t)(u.pm - a_tile0) * a_tstep; }
    __device__ __forceinline__ const char* b_base(const Unit& u) const { return W + (size_t)tile_e[u.pm] * w_estep + (size_t)u.pn * b_tstep; }
    __device__ __forceinline__ void a_ready(const Unit&) const {}
    __device__ __forceinline__ void done(const Unit&) const {}
};

__device__ __forceinline__ void qk_phase(Frame& F, int l) {
    const int gw = F.vcu * NWAVES + F.wave, NGW = F.G * NWAVES, lane = F.lane, d0 = 8 * (lane & 7);
    const GAS float* rt = WSP(float, WS_ROPE);
    GAS bf16* Q = WSP(bf16, WS_Q); GAS bf16* KB = WSP(bf16, WS_KB);
    float gq[8], gk[8];
#pragma unroll
    for (int e = 0; e < 8; ++e) { gq[e] = INP(20)[l * 64 + d0 + e]; gk[e] = INP(21)[l * 64 + d0 + e]; }
    for (int m = gw; m < MA; m += NGW) {
        const bool lat = m < NL; const int t = m & 2047, pr = t >> 6, pc = t & 63;
        float cs[4], sn[4];
        if (lat) {
#pragma unroll
            for (int pi = 0; pi < 4; ++pi) { const int i = 4 * (lane & 7) + pi, pos = i < 16 ? pr : pc, f = i & 15; cs[pi] = rt[pos * 16 + f]; sn[pi] = rt[1024 + pos * 16 + f]; } }
        { GAS bf16* p = Q + (size_t)m * 512 + 8 * lane; const v4u w = *(const GAS v4u*)p;
          float x[8] = { bflo(w.x), bfhi(w.x), bflo(w.y), bfhi(w.y), bflo(w.z), bfhi(w.z), bflo(w.w), bfhi(w.w) };
          float ss = 0.f;
#pragma unroll
          for (int e = 0; e < 8; ++e) ss += x[e] * x[e];
          ss += __shfl_xor(ss, 1); ss += __shfl_xor(ss, 2); ss += __shfl_xor(ss, 4);
          const float r = 1.0f / sqrtf(ss * (1.0f / 64.0f) + 1e-6f);
#pragma unroll
          for (int e = 0; e < 8; ++e) x[e] = x[e] * r * gq[e];
          if (lat) {
#pragma unroll
              for (int pi = 0; pi < 4; ++pi) { const float x0 = x[2 * pi], x1 = x[2 * pi + 1]; x[2 * pi] = x0 * cs[pi] - x1 * sn[pi]; x[2 * pi + 1] = x0 * sn[pi] + x1 * cs[pi]; } }
          const float C2 = attn_body::C2;
          v4u o; o.x = pk2(x[0] * C2, x[1] * C2); o.y = pk2(x[2] * C2, x[3] * C2); o.z = pk2(x[4] * C2, x[5] * C2); o.w = pk2(x[6] * C2, x[7] * C2);
          *(GAS v4u*)p = o; }
        { GAS bf16* p = KB + (size_t)row_kv(m) * 128 + 8 * (lane & 15); v4u w = (v4u){0u, 0u, 0u, 0u}; if (lane < 16) w = *(const GAS v4u*)p;
          float x[8] = { bflo(w.x), bfhi(w.x), bflo(w.y), bfhi(w.y), bflo(w.z), bfhi(w.z), bflo(w.w), bfhi(w.w) };
          float ss = 0.f;
#pragma unroll
          for (int e = 0; e < 8; ++e) ss += x[e] * x[e];
          ss += __shfl_xor(ss, 1); ss += __shfl_xor(ss, 2); ss += __shfl_xor(ss, 4);
          const float r = 1.0f / sqrtf(ss * (1.0f / 64.0f) + 1e-6f);
#pragma unroll
          for (int e = 0; e < 8; ++e) x[e] = x[e] * r * gk[e];
          if (lat) {
#pragma unroll
              for (int pi = 0; pi < 4; ++pi) { const float x0 = x[2 * pi], x1 = x[2 * pi + 1]; x[2 * pi] = x0 * cs[pi] - x1 * sn[pi]; x[2 * pi + 1] = x0 * sn[pi] + x1 * cs[pi]; } }
          v4u o; o.x = pk2(x[0], x[1]); o.y = pk2(x[2], x[3]); o.z = pk2(x[4], x[5]); o.w = pk2(x[6], x[7]);
          if (lane < 16) *(GAS v4u*)p = o; }
    }
}

constexpr int SC_RAW = 0, SC_SV = 11520, SC_KT = SC_SV + 24576, SC_KK = SC_KT + 4096, SC_TWA = SC_KK + 4096, SC_ADA = SC_TWA + 2304, SC_YO = SC_ADA + 2304, SC_BON = SC_YO + 4096, SC_DIR = SC_BON + 256;
static_assert(2 * SC_DIR <= RING_BYTES, "scan LDS");
__device__ __forceinline__ float dpp_quad_sum(float v) {
    v += __builtin_bit_cast(float, __builtin_amdgcn_mov_dpp(__builtin_bit_cast(int, v), 0xB1, 0xF, 0xF, true));
    v += __builtin_bit_cast(float, __builtin_amdgcn_mov_dpp(__builtin_bit_cast(int, v), 0x4E, 0xF, 0xF, true));
    return v;
}
__device__ __forceinline__ void scan_phase(Frame& F, int l) {
    const int d = F.tid >> 8, dt = F.tid & 255, w4 = F.wave & 3, lane = F.lane;
    LAS unsigned char* L = F.lds + d * SC_DIR;
    LAS float* SV = (LAS float*)(L + SC_SV); LAS float* KT = (LAS float*)(L + SC_KT); LAS float* KK = (LAS float*)(L + SC_KK);
    LAS float* YO = (LAS float*)(L + SC_YO); LAS float* BON = (LAS float*)(L + SC_BON);
    const GAS bf16* PR = WSP(bf16, WS_PR);
    GAS bf16* Yd = WSP(bf16, d == 0 ? WS_YF : WS_YB);
    GAS float* bonus = WSP(float, WS_BONUS) + (size_t)d * MA * 8;
    const int j = dt >> 4, cg = dt & 15;
    const int st_j = d == 0 ? j : 15 - j;
    for (int p = F.vcu; p < NB * 8; p += F.G) {
        const int b = p >> 3, h = p & 7;
        const GAS bf16* w2t = WSP(bf16, WS_LORA) + (size_t)((l * 2 + d) * RW + h * 64 + 16 * w4 + (lane & 15)) * 64 + 8 * (lane >> 4);
        const GAS bf16* a2t = w2t + (size_t)4 * RW * 64;
        const int ccol = h * 64 + 16 * w4 + (lane & 15);
        const float w0c = INP(10)[(l * 2 + d) * RW + ccol], a0c = INP(12)[(l * 2 + d) * RW + ccol], kac = INP(16)[l * RW + ccol], rkc = INP(17)[l * RW + ccol];
        const GAS float* mup = INP(9) + (size_t)(l * 2) * RCOLS + 4 * cg; const GAS float* kkp = INP(15) + l * RW + h * 64 + 4 * cg;
        float S[16];
#pragma unroll
        for (int i = 0; i < 16; ++i) S[i] = 0.f;
        v4u raw[3];
#define SC_GEOM(c) const int s0_ = 16 * (c); const bool isctx_ = s0_ < TC; const int pos0_ = isctx_ ? s0_ : s0_ - TC; const int len_ = isctx_ ? TC : TL; \
        const int rowbase_ = isctx_ ? NL + b * TC : b * TL; const int toklo_ = d == 0 ? pos0_ : len_ - 16 - pos0_;
#define SC_LOAD(c) do { SC_GEOM(c) _Pragma("unroll") for (int i = 0; i < 3; ++i) { const int pp = dt + 256 * i; raw[i] = (v4u){0u, 0u, 0u, 0u}; \
            if (pp < 720) { const int row = pp / 40, rem = pp % 40, grp = rem >> 3, c8 = rem & 7; const int tr = toklo_ - 1 + row; \
                const int gc = grp == 0 ? h * 64 : grp == 1 ? 512 + h * 64 : grp == 2 ? 1024 + h * 64 : grp == 3 ? 1536 : 1600; \
                if (tr >= 0 && tr < len_) raw[i] = *(const GAS v4u*)(PR + (size_t)(rowbase_ + tr) * RCOLS + gc + 8 * c8); } } } while (0)
        SC_LOAD(0);
        for (int c = 0; c < KVT / 16; ++c) {
            SC_GEOM(c)
#pragma unroll
            for (int i = 0; i < 3; ++i) { const int pp = dt + 256 * i; if (pp < 720) { const int row = pp / 40, rem = pp % 40; *(LAS v4u*)(L + SC_RAW + (row * 320 + rem * 8) * 2) = raw[i]; } }
            __syncthreads();
            if (c + 1 < KVT / 16) SC_LOAD(c + 1);
            {
                f32x4 xs[5];
#pragma unroll
                for (int g = 0; g < 5; ++g) {
                    const v2u a0 = *(const LAS v2u*)(L + SC_RAW + ((j + 0) * 320 + g * 64 + 4 * cg) * 2), a1 = *(const LAS v2u*)(L + SC_RAW + ((j + 1) * 320 + g * 64 + 4 * cg) * 2), a2 = *(const LAS v2u*)(L + SC_RAW + ((j + 2) * 320 + g * 64 + 4 * cg) * 2);
                    const f32x4 x0 = (f32x4){bflo(a0.x), bfhi(a0.x), bflo(a0.y), bfhi(a0.y)}, x1 = (f32x4){bflo(a1.x), bfhi(a1.x), bflo(a1.y), bfhi(a1.y)}, x2 = (f32x4){bflo(a2.x), bfhi(a2.x), bflo(a2.y), bfhi(a2.y)};
                    const int gc = g == 0 ? h * 64 : g == 1 ? 512 + h * 64 : g == 2 ? 1024 + h * 64 : g == 3 ? 1536 : 1600;
                    const f32x4 mu0 = *(const GAS f32x4*)(mup + gc), mu1 = *(const GAS f32x4*)(mup + RCOLS + gc);
                    xs[g] = x1 + mu0 * (x0 - x1) + mu1 * (x2 - x1);
                }
                *(LAS f32x4*)(SV + (0 * 16 + st_j) * 64 + 4 * cg) = xs[0];
                *(LAS f32x4*)(SV + (3 * 16 + st_j) * 64 + 4 * cg) = xs[2];
                *(LAS f32x4*)(KT + j * 64 + 4 * cg) = xs[1];
                const f32x4 kkf = xs[1] * *(const GAS f32x4*)kkp; float ss = (kkf.x * kkf.x + kkf.y * kkf.y) + (kkf.z * kkf.z + kkf.w * kkf.w);
                ss += __shfl_xor(ss, 1); ss += __shfl_xor(ss, 2); ss += __shfl_xor(ss, 4); ss += __shfl_xor(ss, 8);
                const float inv = 1.0f / fmaxf(sqrtf(ss), 1e-12f); const f32x4 kk = kkf * inv;
                *(LAS f32x4*)(KK + j * 64 + 4 * cg) = kk;
                *(LAS f32x4*)(SV + (4 * 16 + st_j) * 64 + 4 * cg) = -kk;
                v2u tw; tw.x = pk2(tanhf(xs[3].x), tanhf(xs[3].y)); tw.y = pk2(tanhf(xs[3].z), tanhf(xs[3].w));
                *(LAS v2u*)(L + SC_TWA + (j * 72 + 4 * cg) * 2) = tw;
                v2u ad; ad.x = pk2(xs[4].x, xs[4].y); ad.y = pk2(xs[4].z, xs[4].w);
                *(LAS v2u*)(L + SC_ADA + (j * 72 + 4 * cg) * 2) = ad;
            }
            __syncthreads();
            {
                const int ao = ((lane & 15) * 72 + 8 * (lane >> 4)) * 2;
                const bf16x8 At0 = *(const LAS bf16x8*)(L + SC_TWA + ao), At1 = *(const LAS bf16x8*)(L + SC_TWA + ao + 64), Aa0 = *(const LAS bf16x8*)(L + SC_ADA + ao), Aa1 = *(const LAS bf16x8*)(L + SC_ADA + ao + 64);
                const bf16x8 Bw0 = *(const GAS bf16x8*)w2t, Bw1 = *(const GAS bf16x8*)(w2t + 32), Ba0 = *(const GAS bf16x8*)a2t, Ba1 = *(const GAS bf16x8*)(a2t + 32);
                f32x4 zw = (f32x4){0.f, 0.f, 0.f, 0.f}, za = (f32x4){0.f, 0.f, 0.f, 0.f};
                zw = __builtin_amdgcn_mfma_f32_16x16x32_bf16(At0, Bw0, zw, 0, 0, 0); zw = __builtin_amdgcn_mfma_f32_16x16x32_bf16(At1, Bw1, zw, 0, 0, 0);
                za = __builtin_amdgcn_mfma_f32_16x16x32_bf16(Aa0, Ba0, za, 0, 0, 0); za = __builtin_amdgcn_mfma_f32_16x16x32_bf16(Aa1, Ba1, za, 0, 0, 0);
                const int cl = 16 * w4 + (lane & 15);
#pragma unroll
                for (int i = 0; i < 4; ++i) { const int jj = 4 * (lane >> 4) + i, st = d == 0 ? jj : 15 - jj;
                    const float sg = sigmoidf_(w0c + zw[i]); SV[(1 * 16 + st) * 64 + cl] = __expf(-0.6065306597f * sg);
                    const float al = sigmoidf_(a0c + za[i]);
                    const float kv = KT[jj * 64 + cl] * (1.0f + (al - 1.0f) * kac); SV[(2 * 16 + st) * 64 + cl] = kv;
                    SV[(5 * 16 + st) * 64 + cl] = KK[jj * 64 + cl] * al;
                    float bp = SV[(0 * 16 + st) * 64 + cl] * kv * rkc;
                    bp += __shfl_xor(bp, 1); bp += __shfl_xor(bp, 2); bp += __shfl_xor(bp, 4); bp += __shfl_xor(bp, 8);
                    if ((lane & 15) == 0) BON[w4 * 16 + jj] = bp; }
            }
            __syncthreads();
            {
                const int ri = 16 * w4 + (lane >> 2), q = lane & 3;
#pragma unroll 1
                for (int s = 0; s < 16; ++s) {
                    const LAS float* base = SV + s * 64 + 16 * q;
                    f32x4 na[4], wv[4], bv[4], kv[4], rv[4];
#pragma unroll
                    for (int i = 0; i < 4; ++i) { na[i] = *(const LAS f32x4*)(base + 4 * 16 * 64 + 4 * i); wv[i] = *(const LAS f32x4*)(base + 1 * 16 * 64 + 4 * i); bv[i] = *(const LAS f32x4*)(base + 5 * 16 * 64 + 4 * i);
                        kv[i] = *(const LAS f32x4*)(base + 2 * 16 * 64 + 4 * i); rv[i] = *(const LAS f32x4*)(base + 4 * i); }
                    const float vi = SV[(3 * 16 + s) * 64 + ri];
                    float d0 = 0.f, d1 = 0.f, d2 = 0.f, d3 = 0.f;
#pragma unroll
                    for (int i = 0; i < 4; ++i) { d0 = fmaf(S[4 * i], na[i].x, d0); d1 = fmaf(S[4 * i + 1], na[i].y, d1); d2 = fmaf(S[4 * i + 2], na[i].z, d2); d3 = fmaf(S[4 * i + 3], na[i].w, d3); }
                    const float sa = dpp_quad_sum((d0 + d1) + (d2 + d3));
                    float y0 = 0.f, y1 = 0.f, y2 = 0.f, y3 = 0.f;
#pragma unroll
                    for (int i = 0; i < 4; ++i) {
                        S[4 * i] = fmaf(vi, kv[i].x, fmaf(sa, bv[i].x, S[4 * i] * wv[i].x)); S[4 * i + 1] = fmaf(vi, kv[i].y, fmaf(sa, bv[i].y, S[4 * i + 1] * wv[i].y));
                        S[4 * i + 2] = fmaf(vi, kv[i].z, fmaf(sa, bv[i].z, S[4 * i + 2] * wv[i].z)); S[4 * i + 3] = fmaf(vi, kv[i].w, fmaf(sa, bv[i].w, S[4 * i + 3] * wv[i].w));
                        y0 = fmaf(S[4 * i], rv[i].x, y0); y1 = fmaf(S[4 * i + 1], rv[i].y, y1); y2 = fmaf(S[4 * i + 2], rv[i].z, y2); y3 = fmaf(S[4 * i + 3], rv[i].w, y3); }
                    const float y = dpp_quad_sum((y0 + y1) + (y2 + y3));
                    if (q == 0) YO[s * 64 + ri] = y;
                }
            }
            __syncthreads();
            if (dt < 128) { const int s = dt >> 3, c8 = dt & 7; const int tok = d == 0 ? pos0_ + s : len_ - 1 - (pos0_ + s);
                const f32x4 a = *(const LAS f32x4*)(YO + s * 64 + 8 * c8), bq = *(const LAS f32x4*)(YO + s * 64 + 8 * c8 + 4);
                v4u w; w.x = pk2(a.x, a.y); w.y = pk2(a.z, a.w); w.z = pk2(bq.x, bq.y); w.w = pk2(bq.z, bq.w);
                *(GAS v4u*)(Yd + (size_t)(rowbase_ + tok) * RW + h * 64 + 8 * c8) = w; }
            else if (dt < 144) { const int jj = dt - 128; bonus[(size_t)(rowbase_ + toklo_ + jj) * 8 + h] = (BON[jj] + BON[16 + jj]) + (BON[32 + jj] + BON[48 + jj]); }
        }
        __syncthreads();
#undef SC_LOAD
#undef SC_GEOM
    }
}

__device__ __forceinline__ void rwkv_out_phase(Frame& F, int l, int nrows) {
    const int gw = F.vcu * NWAVES + F.wave, NGW = F.G * NWAVES, lane = F.lane, jr = lane & 15, fq = lane >> 4;
    const GAS bf16* PR = WSP(bf16, WS_PR); const GAS bf16* YF = WSP(bf16, WS_YF); const GAS bf16* YB = WSP(bf16, WS_YB); GAS bf16* YR = WSP(bf16, WS_YR);
    const GAS float* bon0 = WSP(float, WS_BONUS); const GAS float* bon1 = bon0 + (size_t)MA * 8;
    const GAS bf16* g2t = WSP(bf16, WS_LORA) + (size_t)8 * RW * 64 + (size_t)l * RW * 128;
    const GAS float* m0 = INP(9) + (size_t)(l * 2) * RCOLS; const GAS float* m1 = m0 + RCOLS;
    const GAS float* lw = INP(18) + l * RW; const GAS float* lb = INP(19) + l * RW;
    for (int unit = gw; unit < nrows / 16; unit += NGW) {
        const int m = unit * 16 + jr;
        const int pos = m < NL ? (m & 2047) : ((m - NL) & 255), len = m < NL ? TL : TC;
        const bool hp = pos > 0, hn = pos < len - 1;
        const GAS bf16* pr = PR + (size_t)m * RCOLS;
        bf16x8 Af[4];
#pragma unroll
        for (int ks = 0; ks < 4; ++ks) { const int col = 1664 + 8 * fq + 32 * ks;
            const v4u z = (v4u){0u, 0u, 0u, 0u}; const v4u w1 = *(const GAS v4u*)(pr + col); const v4u w0 = hp ? *(const GAS v4u*)(pr - RCOLS + col) : z; const v4u w2 = hn ? *(const GAS v4u*)(pr + RCOLS + col) : z;
            const unsigned u0[4] = {w0.x, w0.y, w0.z, w0.w}, u1[4] = {w1.x, w1.y, w1.z, w1.w}, u2[4] = {w2.x, w2.y, w2.z, w2.w}; unsigned o[4];
#pragma unroll
            for (int e = 0; e < 4; ++e) { const f32x2 a = *(const GAS f32x2*)(m0 + col + 2 * e), bq = *(const GAS f32x2*)(m1 + col + 2 * e);
                const float xl = bflo(u1[e]), xh = bfhi(u1[e]);
                const float vl = xl + a.x * (bflo(u0[e]) - xl) + bq.x * (bflo(u2[e]) - xl), vh = xh + a.y * (bfhi(u0[e]) - xh) + bq.y * (bfhi(u2[e]) - xh);
                o[e] = pk2(sigmoidf_(vl), sigmoidf_(vh)); }
            Af[ks] = __builtin_bit_cast(bf16x8, (v4u){o[0], o[1], o[2], o[3]}); }
        for (int hh = 0; hh < 8; ++hh) {
            const float bon = 0.5f * (bon0[(size_t)m * 8 + hh] + bon1[(size_t)m * 8 + hh]);
            f32x4 y[4], g[4];
#pragma unroll
            for (int nt = 0; nt < 4; ++nt) { const int c0 = hh * 64 + 16 * nt;
                f32x4 acc = (f32x4){0.f, 0.f, 0.f, 0.f};
#pragma unroll
                for (int ks = 0; ks < 4; ++ks) { const bf16x8 Bf = *(const GAS bf16x8*)(g2t + (size_t)(c0 + jr) * 128 + 8 * fq + 32 * ks); acc = __builtin_amdgcn_mfma_f32_16x16x32_bf16(Bf, Af[ks], acc, 0, 0, 0); }
                g[nt] = acc;
                const int col = c0 + 4 * fq; const v2u a = *(const GAS v2u*)(YF + (size_t)m * RW + col), bq = *(const GAS v2u*)(YB + (size_t)m * RW + col);
                y[nt] = (f32x4){bflo(a.x) + bflo(bq.x), bfhi(a.x) + bfhi(bq.x), bflo(a.y) + bflo(bq.y), bfhi(a.y) + bfhi(bq.y)}; }
            float s = 0.f;
#pragma unroll
            for (int nt = 0; nt < 4; ++nt) s += (y[nt].x + y[nt].y) + (y[nt].z + y[nt].w);
            s += __shfl_xor(s, 16); s += __shfl_xor(s, 32);
            const float mean = s * (1.0f / 64.0f); float qv = 0.f;
#pragma unroll
            for (int nt = 0; nt < 4; ++nt) { y[nt] = y[nt] - mean; qv += (y[nt].x * y[nt].x + y[nt].y * y[nt].y) + (y[nt].z * y[nt].z + y[nt].w * y[nt].w); }
            qv += __shfl_xor(qv, 16); qv += __shfl_xor(qv, 32);
            const float rstd = 1.0f / sqrtf(qv * (1.0f / 64.0f) + 64e-5f);
#pragma unroll
            for (int nt = 0; nt < 4; ++nt) { const int col = hh * 64 + 16 * nt + 4 * fq, vc = 1024 + col;
                const v2u z = (v2u){0u, 0u}; const v2u w1 = *(const GAS v2u*)(pr + vc); const v2u w0 = hp ? *(const GAS v2u*)(pr - RCOLS + vc) : z; const v2u w2 = hn ? *(const GAS v2u*)(pr + RCOLS + vc) : z;
                const f32x4 x0 = (f32x4){bflo(w0.x), bfhi(w0.x), bflo(w0.y), bfhi(w0.y)}, x1 = (f32x4){bflo(w1.x), bfhi(w1.x), bflo(w1.y), bfhi(w1.y)}, x2 = (f32x4){bflo(w2.x), bfhi(w2.x), bflo(w2.y), bfhi(w2.y)};
                const f32x4 vs = x1 + *(const GAS f32x4*)(m0 + vc) * (x0 - x1) + *(const GAS f32x4*)(m1 + vc) * (x2 - x1);
                const f32x4 o = (y[nt] * rstd * *(const GAS f32x4*)(lw + col) + *(const GAS f32x4*)(lb + col) + vs * bon) * g[nt];
                v2u w; w.x = pk2(o.x, o.y); w.y = pk2(o.z, o.w);
                *(GAS v2u*)(YR + (size_t)m * RW + col) = w; }
        }
    }
}

__device__ __forceinline__ void attn_phase(Frame& F, int l, char* lds_generic, size_t q_off) {
    typedef attn_body::bf16 abf;
    abf* Q = (abf*)(F.ws + q_off); const abf* KB = (const abf*)(F.ws + WS_KB); const abf* VB = (const abf*)(F.ws + WS_VB);
    for (int p = F.vcu; p < NB * 8; p += F.G) {
        const int b = p >> 3, hq = p & 7, kvh = hq >> 2;
        const abf* Kh = KB + (size_t)b * KVT * 128 + kvh * 64; const abf* Vh = VB + (size_t)b * KVT * 128 + kvh * 64;
        const int nu = l == 0 ? 9 : 8;
        for (int u = 0; u < nu; ++u) {
            const bool cx = u == 8;
            abf* Qu = Q + (size_t)(cx ? NL + b * TC : b * TL + u * 256) * 512 + hq * 64;
            attn_body::attn_unit<8>(Qu, cx ? Kh + (size_t)TL * 128 : Kh, cx ? Vh + (size_t)TL * 128 : Vh, Qu, cx ? TC / 64 : KVT / 64, lds_generic);
        }
    }
}

__device__ __forceinline__ int moe_tiles(Frame& F, LAS int* tile_e) {
    int nt = 0;
    for (int e = 0; e < NE; ++e) { const int cnt = (int)__hip_atomic_load(F.ctl + CW_HIST + 64 * e, RLX_AGENT); const int t = (cnt + 255) >> 8;
        for (int i = F.tid; i < t; i += 512) tile_e[nt + i] = e; nt += t; }
    __syncthreads();
    return nt;
}
__device__ __forceinline__ void moe_slots(Frame& F) {
    volatile LAS unsigned* M = F.MISC;
    const GAS int* toke = (const GAS int*)(F.ws + WS_MOETAB + MT_TOKE); GAS int* toks = (GAS int*)(F.ws + WS_MOETAB + MT_TOKS);
    const GAS bf16* H2 = WSP(bf16, WS_H); GAS bf16* XB = WSP(bf16, WS_XB);
    LAS int* slotl = (LAS int*)F.lds;
    for (int tb = F.vcu; tb < NL / 256; tb += F.G) {
        if (F.tid < 8) M[32 + F.tid] = 0u;
        if (F.tid == 0) { unsigned ps = 0; for (int e = 0; e < NE; ++e) { M[48 + e] = ps; const unsigned cnt = __hip_atomic_load(F.ctl + CW_HIST + 64 * e, RLX_AGENT); ps += ((cnt + 255u) >> 8) << 8; } }
        __syncthreads();
        int e_my = 0, rank = 0;
        { const int a = F.tid; e_my = toke[(size_t)tb * 512 + a]; rank = (int)__hip_atomic_fetch_add((LAS unsigned*)&M[32 + e_my], 1u, __ATOMIC_RELAXED, __HIP_MEMORY_SCOPE_WORKGROUP); }
        __syncthreads();
        if (F.tid < 8) M[40 + F.tid] = __hip_atomic_fetch_add(F.ctl + CW_CURS + 64 * F.tid, M[32 + F.tid], RLX_AGENT);
        __syncthreads();
        const int slot = (int)(M[48 + e_my] + M[40 + e_my]) + rank;
        toks[(size_t)tb * 512 + F.tid] = slot; slotl[F.tid] = slot;
        __syncthreads();
        for (int a = F.wave; a < 512; a += NWAVES) { const int tok = tb * 256 + (a >> 1); const int sl = slotl[a];
            const GAS v4u* src = (const GAS v4u*)(H2 + (size_t)tok * DM); GAS v4u* dst = (GAS v4u*)(XB + (size_t)sl * DM);
            const v4u x0 = src[F.lane], x1 = src[64 + F.lane]; dst[F.lane] = x0; dst[64 + F.lane] = x1; }
        __syncthreads();
    }
}
__device__ __forceinline__ void moe_final(Frame& F) {
    const int gw = F.vcu * NWAVES + F.wave, NGW = F.G * NWAVES;
    const GAS int* toks = (const GAS int*)(F.ws + WS_MOETAB + MT_TOKS); const GAS float* tokw = (const GAS float*)(F.ws + WS_MOETAB + MT_TOKW);
    const GAS bf16* YM = WSP(bf16, WS_YM); const GAS float* gt = WSP(float, WS_MOD) + (size_t)33 * 6144 + 5120;
    for (int m = gw; m < NL; m += NGW) {
        const int s0 = toks[2 * m], s1 = toks[2 * m + 1]; const float w0 = tokw[2 * m], w1 = tokw[2 * m + 1];
        const GAS float* gv = gt + (size_t)(m >> 11) * 6144; GAS float* xr = F.out + (size_t)m * DM;
        f32x4 v[4]; float s = 0.f;
#pragma unroll
        for (int j = 0; j < 4; ++j) { const int c = 4 * F.lane + 256 * j;
            const v2u a = *(const GAS v2u*)(YM + (size_t)s0 * DM + c), bq = *(const GAS v2u*)(YM + (size_t)s1 * DM + c);
            const f32x4 ya = (f32x4){bflo(a.x), bfhi(a.x), bflo(a.y), bfhi(a.y)}, yb = (f32x4){bflo(bq.x), bfhi(bq.x), bflo(bq.y), bfhi(bq.y)};
            v[j] = *(const GAS f32x4*)(xr + c) + *(const GAS f32x4*)(gv + c) * (ya * w0 + yb * w1);
            s += (v[j].x * v[j].x + v[j].y * v[j].y) + (v[j].z * v[j].z + v[j].w * v[j].w); }
        const float rstd = 1.0f / sqrtf(wave_sum(s) * (1.0f / DM) + 1e-6f);
#pragma unroll
        for (int j = 0; j < 4; ++j) { const int c = 4 * F.lane + 256 * j; *(GAS f32x4*)(xr + c) = v[j] * rstd * *(const GAS f32x4*)(INP(32) + c); }
    }
}
constexpr int S2_RS = 0, S2_VS = 4096, S2_KS = 8192, S2_KK = 12288, S2_W = 16384, S2_KT = 20480, S2_BB = 24576, S2_RAW = 16384;
constexpr int S2_RQT = 0, S2_S16 = 11520, S2_D1T = 20736, S2_D2T = 24576;
constexpr int S2_C0 = 28672, S2_TWA = S2_C0, S2_ADA = S2_C0 + 2304, S2_GA = S2_C0, S2_GBT = S2_C0 + 4608, S2_RTF = S2_C0 + 9216, S2_BCT = S2_C0 + 13312, S2_KCF = S2_C0 + 16384,
              S2_G15 = S2_C0 + 20480, S2_ATT = S2_C0 + 20736, S2_VT = S2_C0 + 23808;
constexpr int S2_M0 = S2_C0 + 26880, S2_MAB = S2_M0, S2_MAK = S2_M0 + 1088, S2_MBRT = S2_M0 + 1856, S2_MKR = S2_M0 + 2624, S2_TA = S2_M0 + 3648, S2_TT = S2_M0 + 4416, S2_C1A = S2_M0 + 5184;
constexpr int S2_YO = S2_M0 + 5952, S2_BON = S2_YO + 4096, S2_DIR = S2_BON + 256;
static_assert(2 * S2_DIR <= MISC_OFF && S2_D2T + 3840 <= S2_C0 && S2_RAW + 11520 <= S2_C0, "scan LDS map");
__device__ __forceinline__ bf16x8 lds_frag(const LAS unsigned char* p) { return *(const LAS bf16x8*)p; }
__device__ __forceinline__ bf16x8 lds_frag16(const LAS unsigned char* row, int lane) { bf16x8 z = (bf16x8){0, 0, 0, 0, 0, 0, 0, 0}; if (lane < 32) z = *(const LAS bf16x8*)(row + 16 * (lane >> 4)); return z; }
__device__ __forceinline__ float tanh_fast(float x) { const float e = __expf(2.0f * x); return 1.0f - 2.0f / (e + 1.0f); }
__device__ __forceinline__ void st_bf(LAS unsigned char* p, float v) { *(LAS unsigned short*)p = (unsigned short)(pk2(v, 0.f) & 0xffffu); }

#define S2_IDS() int tl_ = F.tid; asm volatile("" : "+v"(tl_)); const int dt = tl_ & 255, lane = tl_ & 63, lr = lane & 15, lq = lane >> 4; const int wv_ = __builtin_amdgcn_readfirstlane(tl_ >> 6); const int w4 = wv_ & 3, d = wv_ >> 2; \
    LAS unsigned char* const L = F.lds + d * S2_DIR; (void)dt; (void)lr; (void)lq; (void)w4; (void)lane
#define S2_F32(name, off) LAS float* const name = (LAS float*)(L + (off))
#define S2_BAR() asm volatile("s_waitcnt lgkmcnt(0)\n\ts_barrier" ::: "memory")
__device__ __forceinline__ void scan_phase2(Frame& F, int l) {
    const GAS bf16* PR = WSP(bf16, WS_PR);
    for (int p = F.vcu; p < NB * 8; p += F.G) {
        const int b = p >> 3, h = p & 7;
        f32x4 S[4];
#pragma unroll
        for (int i = 0; i < 4; ++i) S[i] = (f32x4){0.f, 0.f, 0.f, 0.f};
        v4u raw[3];
        int prow[3], pcol[3], plds[3];
        f32x4 mu0[5], mu1[5], kkc; bf16x8 Bw0, Bw1, Ba0, Ba1; float w0c, a0c, kac, rkc;
        { S2_IDS();
#pragma unroll
          for (int i = 0; i < 3; ++i) { const int pp = dt + 256 * i, row = pp / 40, rem = pp % 40, grp = rem >> 3, c8 = rem & 7;
              prow[i] = pp < 720 ? row : -100000; pcol[i] = (grp == 0 ? h * 64 : grp == 1 ? 512 + h * 64 : grp == 2 ? 1024 + h * 64 : grp == 3 ? 1536 : 1600) + 8 * c8; plds[i] = (row * 320 + rem * 8) * 2; }
          const int cg = dt & 15; const GAS float* mup = INP(9) + (size_t)(l * 2) * RCOLS + 4 * cg;
#pragma unroll
          for (int g = 0; g < 5; ++g) { const int gc = g == 0 ? h * 64 : g == 1 ? 512 + h * 64 : g == 2 ? 1024 + h * 64 : g == 3 ? 1536 : 1600; mu0[g] = *(const GAS f32x4*)(mup + gc); mu1[g] = *(const GAS f32x4*)(mup + RCOLS + gc); }
          kkc = *(const GAS f32x4*)(INP(15) + l * RW + h * 64 + 4 * cg);
          const GAS bf16* w2t = WSP(bf16, WS_LORA) + (size_t)((l * 2 + d) * RW + h * 64 + 16 * w4 + lr) * 64 + 8 * lq; const GAS bf16* a2t = w2t + (size_t)4 * RW * 64;
          Bw0 = *(const GAS bf16x8*)w2t; Bw1 = *(const GAS bf16x8*)(w2t + 32); Ba0 = *(const GAS bf16x8*)a2t; Ba1 = *(const GAS bf16x8*)(a2t + 32);
          const int ccol = h * 64 + 16 * w4 + lr;
          w0c = INP(10)[(l * 2 + d) * RW + ccol]; a0c = INP(12)[(l * 2 + d) * RW + ccol]; kac = INP(16)[l * RW + ccol]; rkc = INP(17)[l * RW + ccol]; }
#define SC_GEOM(c) const int s0_ = 16 * (c); const bool isctx_ = s0_ < TC; const int pos0_ = isctx_ ? s0_ : s0_ - TC; const int len_ = isctx_ ? TC : TL; \
        const int rowbase_ = isctx_ ? NL + b * TC : b * TL; const int toklo_ = d == 0 ? pos0_ : len_ - 16 - pos0_;
#define SC_LOAD(c) do { SC_GEOM(c) _Pragma("unroll") for (int i = 0; i < 3; ++i) { const int tr = toklo_ - 1 + prow[i]; raw[i] = (v4u){0u, 0u, 0u, 0u}; \
            if (tr >= 0 && tr < len_) raw[i] = *(const GAS v4u*)(PR + (size_t)(rowbase_ + tr) * RCOLS + pcol[i]); } } while (0)
        { S2_IDS(); SC_LOAD(0); }
        for (int c = 0; c < KVT / 16; ++c) {
            { S2_IDS();
#pragma unroll
              for (int i = 0; i < 3; ++i) { if (prow[i] >= 0) *(LAS v4u*)(L + S2_RAW + plds[i]) = raw[i]; }
              S2_BAR();
              if (c + 1 < KVT / 16) SC_LOAD(c + 1); }
            { S2_IDS(); S2_F32(RS, S2_RS); S2_F32(VS, S2_VS); S2_F32(KS, S2_KS); S2_F32(KK, S2_KK);
              const int j = dt >> 4, cg = dt & 15, st_j = d == 0 ? j : 15 - j;
              f32x4 xs[5];
#pragma unroll
              for (int g = 0; g < 5; ++g) {
                  const v2u a0 = *(const LAS v2u*)(L + S2_RAW + ((j + 0) * 320 + g * 64 + 4 * cg) * 2), a1 = *(const LAS v2u*)(L + S2_RAW + ((j + 1) * 320 + g * 64 + 4 * cg) * 2), a2 = *(const LAS v2u*)(L + S2_RAW + ((j + 2) * 320 + g * 64 + 4 * cg) * 2);
                  const f32x4 x0 = (f32x4){bflo(a0.x), bfhi(a0.x), bflo(a0.y), bfhi(a0.y)}, x1 = (f32x4){bflo(a1.x), bfhi(a1.x), bflo(a1.y), bfhi(a1.y)}, x2 = (f32x4){bflo(a2.x), bfhi(a2.x), bflo(a2.y), bfhi(a2.y)};
                  xs[g] = x1 + mu0[g] * (x0 - x1) + mu1[g] * (x2 - x1);
              }
              *(LAS f32x4*)(RS + st_j * 64 + 4 * cg) = xs[0];
              *(LAS f32x4*)(VS + st_j * 64 + 4 * cg) = xs[2];
              *(LAS f32x4*)(KS + j * 64 + 4 * cg) = xs[1];
              const f32x4 kkf = xs[1] * kkc; float ss = (kkf.x * kkf.x + kkf.y * kkf.y) + (kkf.z * kkf.z + kkf.w * kkf.w);
              ss += __shfl_xor(ss, 1); ss += __shfl_xor(ss, 2); ss += __shfl_xor(ss, 4); ss += __shfl_xor(ss, 8);
              const float inv = 1.0f / fmaxf(sqrtf(ss), 1e-12f);
              *(LAS f32x4*)(KK + j * 64 + 4 * cg) = kkf * inv;
              v2u tw; tw.x = pk2(tanh_fast(xs[3].x), tanh_fast(xs[3].y)); tw.y = pk2(tanh_fast(xs[3].z), tanh_fast(xs[3].w));
              *(LAS v2u*)(L + S2_TWA + (j * 72 + 4 * cg) * 2) = tw;
              v2u ad; ad.x = pk2(xs[4].x, xs[4].y); ad.y = pk2(xs[4].z, xs[4].w);
              *(LAS v2u*)(L + S2_ADA + (j * 72 + 4 * cg) * 2) = ad;
            }
            S2_BAR();
            { S2_IDS(); S2_F32(RS, S2_RS); S2_F32(KS, S2_KS); S2_F32(KK, S2_KK); S2_F32(Wd, S2_W); S2_F32(KT, S2_KT); S2_F32(BB, S2_BB); S2_F32(BON, S2_BON);
              const int ao = (lr * 72 + 8 * lq) * 2;
              const bf16x8 At0 = lds_frag(L + S2_TWA + ao), At1 = lds_frag(L + S2_TWA + ao + 64), Aa0 = lds_frag(L + S2_ADA + ao), Aa1 = lds_frag(L + S2_ADA + ao + 64);
              f32x4 zw = (f32x4){0.f, 0.f, 0.f, 0.f}, za = (f32x4){0.f, 0.f, 0.f, 0.f};
              zw = __builtin_amdgcn_mfma_f32_16x16x32_bf16(At0, Bw0, zw, 0, 0, 0); zw = __builtin_amdgcn_mfma_f32_16x16x32_bf16(At1, Bw1, zw, 0, 0, 0);
              za = __builtin_amdgcn_mfma_f32_16x16x32_bf16(Aa0, Ba0, za, 0, 0, 0); za = __builtin_amdgcn_mfma_f32_16x16x32_bf16(Aa1, Ba1, za, 0, 0, 0);
              const int cl = 16 * w4 + lr;
#pragma unroll
              for (int i = 0; i < 4; ++i) { const int jj = 4 * lq + i, st = d == 0 ? jj : 15 - jj;
                  const float sg = sigmoidf_(w0c + zw[i]); Wd[st * 64 + cl] = __expf(-0.6065306597f * sg);
                  const float al = sigmoidf_(a0c + za[i]);
                  const float kv = KS[jj * 64 + cl] * (1.0f + (al - 1.0f) * kac); KT[st * 64 + cl] = kv;
                  BB[st * 64 + cl] = KK[jj * 64 + cl] * al;
                  float bp = RS[st * 64 + cl] * kv * rkc;
                  bp += __shfl_xor(bp, 1); bp += __shfl_xor(bp, 2); bp += __shfl_xor(bp, 4); bp += __shfl_xor(bp, 8);
                  if (lr == 0) BON[w4 * 16 + jj] = bp; }
            }
            S2_BAR();
            { S2_IDS(); S2_F32(RS, S2_RS); S2_F32(VS, S2_VS); S2_F32(KK, S2_KK); S2_F32(Wd, S2_W); S2_F32(KT, S2_KT); S2_F32(BB, S2_BB); S2_F32(RTF, S2_RTF); S2_F32(KCF, S2_KCF); S2_F32(G15, S2_G15);
              const int cc = lane; float g = 1.f, gp[4], gt[4];
#pragma unroll
              for (int t = 0; t < 16; ++t) { const float wt = Wd[t * 64 + cc]; if ((t >> 2) == w4) gp[t & 3] = g; g *= wt; if ((t >> 2) == w4) gt[t & 3] = g; }
              if (w4 == 0) G15[cc] = g;
              unsigned pa[2], pb[2], pv[2];
#pragma unroll
              for (int i = 0; i < 4; ++i) { const int t = 4 * w4 + i, jm = d == 0 ? t : 15 - t;
                  const float ig = 1.0f / gt[i], sc = g * ig;
                  const float av = -KK[jm * 64 + cc] * gp[i], rv = RS[t * 64 + cc] * gt[i], bv = BB[t * 64 + cc], kv = KT[t * 64 + cc];
                  st_bf(L + S2_GA + (t * 72 + cc) * 2, bv * ig); st_bf(L + S2_GA + ((16 + t) * 72 + cc) * 2, kv * ig);
                  st_bf(L + S2_GBT + (t * 72 + cc) * 2, av); st_bf(L + S2_GBT + ((16 + t) * 72 + cc) * 2, rv);
                  RTF[t * 64 + cc] = rv; KCF[t * 64 + cc] = kv * sc;
                  const float bc = bv * sc, vv = VS[t * 64 + cc];
                  if (i & 1) { pa[i >> 1] = pk2(__uint_as_float(pa[i >> 1]), av); pb[i >> 1] = pk2(__uint_as_float(pb[i >> 1]), bc); pv[i >> 1] = pk2(__uint_as_float(pv[i >> 1]), vv); }
                  else { pa[i >> 1] = __float_as_uint(av); pb[i >> 1] = __float_as_uint(bc); pv[i >> 1] = __float_as_uint(vv); } }
              *(LAS v2u*)(L + S2_ATT + (cc * 24 + 4 * w4) * 2) = (v2u){pa[0], pa[1]};
              *(LAS v2u*)(L + S2_BCT + (cc * 24 + 4 * w4) * 2) = (v2u){pb[0], pb[1]};
              *(LAS v2u*)(L + S2_VT + (cc * 24 + 4 * w4) * 2) = (v2u){pv[0], pv[1]};
            }
            S2_BAR();
            { S2_IDS(); S2_F32(MAB, S2_MAB); S2_F32(MKR, S2_MKR);
              const int mt = w4 >> 1, nt = w4 & 1, ao = ((16 * mt + lr) * 72 + 8 * lq) * 2, bo = ((16 * nt + lr) * 72 + 8 * lq) * 2;
              f32x4 acc = (f32x4){0.f, 0.f, 0.f, 0.f};
              acc = __builtin_amdgcn_mfma_f32_16x16x32_bf16(lds_frag(L + S2_GA + ao), lds_frag(L + S2_GBT + bo), acc, 0, 0, 0);
              acc = __builtin_amdgcn_mfma_f32_16x16x32_bf16(lds_frag(L + S2_GA + ao + 64), lds_frag(L + S2_GBT + bo + 64), acc, 0, 0, 0);
#pragma unroll
              for (int i = 0; i < 4; ++i) { const int s = 4 * lq + i, t = lr; const bool keep = nt == 0 ? (s < t) : (s <= t); const float v = keep ? acc[i] : 0.f;
                  if (w4 == 0) MAB[s * 16 + t] = v;
                  else if (w4 == 2) st_bf(L + S2_MAK + (s * 24 + t) * 2, v);
                  else if (w4 == 1) st_bf(L + S2_MBRT + (t * 24 + s) * 2, v);
                  else MKR[s * 16 + t] = v; }
            }
            S2_BAR();
            { S2_IDS(); S2_F32(MAB, S2_MAB);
              if (dt < 16) { const int t = dt; float Tc[16];
#pragma unroll
                for (int s = 15; s >= 0; --s) { float a = (s == t) ? 1.f : 0.f; asm volatile("" ::: "memory");
                    float mr[16];
#pragma unroll
                    for (int q4 = (s + 1) / 4; q4 < 4; ++q4) { const f32x4 mv = *(const LAS f32x4*)(MAB + s * 16 + 4 * q4); mr[4 * q4] = mv.x; mr[4 * q4 + 1] = mv.y; mr[4 * q4 + 2] = mv.z; mr[4 * q4 + 3] = mv.w; }
#pragma unroll
                    for (int jx = s + 1; jx < 16; ++jx) a = fmaf(mr[jx], Tc[jx], a);
                    Tc[s] = a; }
                unsigned tt[8];
#pragma unroll
                for (int s = 0; s < 16; ++s) st_bf(L + S2_TA + (s * 24 + t) * 2, Tc[s]);
#pragma unroll
                for (int s = 0; s < 8; ++s) tt[s] = pk2(Tc[2 * s], Tc[2 * s + 1]);
                *(LAS v4u*)(L + S2_TT + (t * 24) * 2) = (v4u){tt[0], tt[1], tt[2], tt[3]}; *(LAS v4u*)(L + S2_TT + (t * 24 + 8) * 2) = (v4u){tt[4], tt[5], tt[6], tt[7]}; }
            }
            S2_BAR();
            { S2_IDS();
#pragma unroll
              for (int rep = 0; rep < 2; ++rep) { const int task = w4 + 4 * rep; if (task < 6) {
                  const bf16x8 Af = lds_frag16(L + (task == 0 ? S2_MAK : S2_TA) + lr * 48, lane);
                  const bf16x8 Bf = task == 0 ? lds_frag16(L + S2_TT + lr * 48, lane) : task == 1 ? lds_frag16(L + S2_MBRT + lr * 48, lane) : lds_frag16(L + S2_BCT + (16 * (task - 2) + lr) * 48, lane);
                  const f32x4 acc = __builtin_amdgcn_mfma_f32_16x16x32_bf16(Af, Bf, (f32x4){0.f, 0.f, 0.f, 0.f}, 0, 0, 0);
                  if (task == 0) {
#pragma unroll
                      for (int i = 0; i < 4; ++i) st_bf(L + S2_C1A + ((4 * lq + i) * 24 + lr) * 2, acc[i]); }
                  else { const int n = 16 * (task - 1) + lr; *(LAS v2u*)(L + S2_D1T + (n * 24 + 4 * lq) * 2) = (v2u){pk2(acc[0], acc[1]), pk2(acc[2], acc[3])}; } } }
            }
            S2_BAR();
            { S2_IDS(); S2_F32(MKR, S2_MKR); S2_F32(KCF, S2_KCF);
#pragma unroll
              for (int rep = 0; rep < 2; ++rep) { const int nt = w4 + 4 * rep; if (nt < 5) {
                  const bf16x8 Af = lds_frag16(L + S2_C1A + lr * 48, lane);
                  const bf16x8 Bf = nt == 0 ? lds_frag16(L + S2_MBRT + lr * 48, lane) : lds_frag16(L + S2_BCT + (16 * (nt - 1) + lr) * 48, lane);
                  f32x4 acc;
#pragma unroll
                  for (int i = 0; i < 4; ++i) acc[i] = nt == 0 ? MKR[(4 * lq + i) * 16 + lr] : KCF[(4 * lq + i) * 64 + 16 * (nt - 1) + lr];
                  acc = __builtin_amdgcn_mfma_f32_16x16x32_bf16(Af, Bf, acc, 0, 0, 0);
                  const int n = 16 * nt + lr; *(LAS v2u*)(L + S2_D2T + (n * 24 + 4 * lq) * 2) = (v2u){pk2(acc[0], acc[1]), pk2(acc[2], acc[3])}; } }
            }
            S2_BAR();
            f32x4 accP[5];
            { S2_IDS(); S2_F32(RTF, S2_RTF);
              const bf16x8 Aa = lds_frag16(L + S2_ATT + (16 * w4 + lr) * 48, lane), Av = lds_frag16(L + S2_VT + (16 * w4 + lr) * 48, lane);
#pragma unroll
              for (int nt = 0; nt < 5; ++nt) {
                  const bf16x8 B1 = lds_frag16(L + S2_D1T + (16 * nt + lr) * 48, lane), B2 = lds_frag16(L + S2_D2T + (16 * nt + lr) * 48, lane);
                  f32x4 a1 = (f32x4){0.f, 0.f, 0.f, 0.f};
                  if (nt == 0) {
#pragma unroll
                      for (int i = 0; i < 4; ++i) a1[i] = RTF[lr * 64 + 16 * w4 + 4 * lq + i]; }
                  a1 = __builtin_amdgcn_mfma_f32_16x16x32_bf16(Aa, B1, a1, 0, 0, 0);
                  accP[nt] = __builtin_amdgcn_mfma_f32_16x16x32_bf16(Av, B2, (f32x4){0.f, 0.f, 0.f, 0.f}, 0, 0, 0);
                  *(LAS v2u*)(L + S2_RQT + ((16 * nt + lr) * 72 + 16 * w4 + 4 * lq) * 2) = (v2u){pk2(a1[0], a1[1]), pk2(a1[2], a1[3])};
              }
              LAS unsigned char* Sw = L + S2_S16 + w4 * 2304;
#pragma unroll
              for (int nt = 0; nt < 4; ++nt)
#pragma unroll
                  for (int i = 0; i < 4; ++i) st_bf(Sw + ((4 * lq + i) * 72 + 16 * nt + lr) * 2, S[nt][i]);
            }
            S2_BAR();
            { S2_IDS(); S2_F32(G15, S2_G15); S2_F32(YO, S2_YO);
              const LAS unsigned char* Sw = L + S2_S16 + w4 * 2304;
              const bf16x8 As0 = lds_frag(Sw + (lr * 72 + 8 * lq) * 2), As1 = lds_frag(Sw + (lr * 72 + 8 * lq) * 2 + 64);
#pragma unroll
              for (int nt = 0; nt < 5; ++nt) { const int bo = ((16 * nt + lr) * 72 + 8 * lq) * 2;
                  accP[nt] = __builtin_amdgcn_mfma_f32_16x16x32_bf16(As0, lds_frag(L + S2_RQT + bo), accP[nt], 0, 0, 0);
                  accP[nt] = __builtin_amdgcn_mfma_f32_16x16x32_bf16(As1, lds_frag(L + S2_RQT + bo + 64), accP[nt], 0, 0, 0); }
#pragma unroll
              for (int i = 0; i < 4; ++i) YO[lr * 64 + 16 * w4 + 4 * lq + i] = accP[0][i];
#pragma unroll
              for (int nt = 0; nt < 4; ++nt) { const float g = G15[16 * nt + lr]; S[nt] = S[nt] * g + accP[1 + nt]; }
            }
            S2_BAR();
            { S2_IDS(); S2_F32(YO, S2_YO); S2_F32(BON, S2_BON); SC_GEOM(c)
              if (dt < 128) { const int s = dt >> 3, c8 = dt & 7; const int tok = d == 0 ? pos0_ + s : len_ - 1 - (pos0_ + s);
                  GAS bf16* Yd = WSP(bf16, d == 0 ? WS_YF : WS_YB);
                  const f32x4 a = *(const LAS f32x4*)(YO + s * 64 + 8 * c8), bq = *(const LAS f32x4*)(YO + s * 64 + 8 * c8 + 4);
                  v4u w; w.x = pk2(a.x, a.y); w.y = pk2(a.z, a.w); w.z = pk2(bq.x, bq.y); w.w = pk2(bq.z, bq.w);
                  *(GAS v4u*)(Yd + (size_t)(rowbase_ + tok) * RW + h * 64 + 8 * c8) = w; }
              else if (dt < 144) { const int jj = dt - 128; GAS float* bonus = WSP(float, WS_BONUS) + (size_t)d * MA * 8;
                  bonus[(size_t)(rowbase_ + toklo_ + jj) * 8 + h] = (BON[jj] + BON[16 + jj]) + (BON[32 + jj] + BON[48 + jj]); }
            }
        }
        __syncthreads();
#undef SC_LOAD
#undef SC_GEOM
    }
}
constexpr int S3_RAW = 0, S3_KS = 11520, S3_KK = 15616, S3_RS = 19712, S3_VS = 23808, S3_TWA = 27904, S3_ADA = 30208, S3_R1END = 32512;
constexpr int S3_GA = 0, S3_GBT = 4608;
constexpr int S3_MAK = 11520, S3_MBRT = 12288, S3_TA = 13056, S3_TT = 13824, S3_MKR = 14592, S3_MAB = 15616;
constexpr int S3_RQ0 = 0;
constexpr int S3_WSC = 16640, S3_WSC_STRIDE = 6144;
constexpr int S3_BCREST = S3_WSC + 4 * S3_WSC_STRIDE;
constexpr int S3_RTF = S3_BCREST, S3_KCF = S3_RTF + 4096, S3_G15 = S3_KCF + 4096, S3_ATT = S3_G15 + 256, S3_BCT = S3_ATT + 3072, S3_VT = S3_BCT + 3072;
constexpr int S3_S16 = S3_VT + 3072, S3_YO = S3_S16 + 9216, S3_BON = S3_YO + 4096, S3_DIR = S3_BON + 256;
static_assert(S3_MAB + 1024 <= S3_WSC && S3_WSC >= S3_KK && 2 * S3_DIR <= MISC_OFF && S3_RQ0 + 4 * 2304 <= S3_MAK, "scan3 LDS map");
#define S3_BAR() asm volatile("s_waitcnt lgkmcnt(0)\n\ts_barrier" ::: "memory")
#define S3_WAVE_SYNC() asm volatile("s_waitcnt lgkmcnt(0)" ::: "memory")
#define S3_IDS() int tl_ = F.tid; asm volatile("" : "+v"(tl_)); const int dt = tl_ & 255, lane = tl_ & 63, lr = lane & 15, lq = lane >> 4; const int wv_ = __builtin_amdgcn_readfirstlane(tl_ >> 6); const int w4 = wv_ & 3, d = wv_ >> 2; \
    LAS unsigned char* const L = F.lds + d * S3_DIR; (void)dt; (void)lr; (void)lq; (void)w4; (void)lane
#define S3_F32(name, off) LAS float* const name = (LAS float*)(L + (off))
__device__ __forceinline__ f32x4 mfma16(bf16x8 a, bf16x8 b, f32x4 c) { return __builtin_amdgcn_mfma_f32_16x16x32_bf16(a, b, c, 0, 0, 0); }

__device__ __forceinline__ void scan_phase3(Frame& F, int l) {
    const GAS bf16* PR = WSP(bf16, WS_PR);
    for (int p = F.vcu; p < NB * 8; p += F.G) {
        const int b = p >> 3, h = p & 7;
        f32x4 S[4];
#pragma unroll
        for (int i = 0; i < 4; ++i) S[i] = (f32x4){0.f, 0.f, 0.f, 0.f};
        v4u raw[3];
        int prow[3], pcol[3], plds[3];
        f32x4 mu0[5], mu1[5], kkc; bf16x8 Bw0, Bw1, Ba0, Ba1; float w0c, a0c, kac, rkc;
        { S3_IDS();
#pragma unroll
          for (int i = 0; i < 3; ++i) { const int pp = dt + 256 * i, row = pp / 40, rem = pp % 40, grp = rem >> 3, c8 = rem & 7;
              prow[i] = pp < 720 ? row : -100000; pcol[i] = (grp == 0 ? h * 64 : grp == 1 ? 512 + h * 64 : grp == 2 ? 1024 + h * 64 : grp == 3 ? 1536 : 1600) + 8 * c8; plds[i] = (row * 320 + rem * 8) * 2; }
          const int cg = dt & 15; const GAS float* mup = INP(9) + (size_t)(l * 2) * RCOLS + 4 * cg;
#pragma unroll
          for (int g = 0; g < 5; ++g) { const int gc = g == 0 ? h * 64 : g == 1 ? 512 + h * 64 : g == 2 ? 1024 + h * 64 : g == 3 ? 1536 : 1600; mu0[g] = *(const GAS f32x4*)(mup + gc); mu1[g] = *(const GAS f32x4*)(mup + RCOLS + gc); }
          kkc = *(const GAS f32x4*)(INP(15) + l * RW + h * 64 + 4 * cg);
          const GAS bf16* w2t = WSP(bf16, WS_LORA) + (size_t)((l * 2 + d) * RW + h * 64 + 16 * w4 + lr) * 64 + 8 * lq; const GAS bf16* a2t = w2t + (size_t)4 * RW * 64;
          Bw0 = *(const GAS bf16x8*)w2t; Bw1 = *(const GAS bf16x8*)(w2t + 32); Ba0 = *(const GAS bf16x8*)a2t; Ba1 = *(const GAS bf16x8*)(a2t + 32);
          const int ccol = h * 64 + 16 * w4 + lr;
          w0c = INP(10)[(l * 2 + d) * RW + ccol]; a0c = INP(12)[(l * 2 + d) * RW + ccol]; kac = INP(16)[l * RW + ccol]; rkc = INP(17)[l * RW + ccol];
          for (int i = dt; i < 9216 / 16; i += 256) *(LAS v4u*)(L + S3_S16 + 16 * i) = (v4u){0u, 0u, 0u, 0u}; }
#define SC_GEOM(c) const int s0_ = 16 * (c); const bool isctx_ = s0_ < TC; const int pos0_ = isctx_ ? s0_ : s0_ - TC; const int len_ = isctx_ ? TC : TL; \
        const int rowbase_ = isctx_ ? NL + b * TC : b * TL; const int toklo_ = d == 0 ? pos0_ : len_ - 16 - pos0_;
#define SC_LOAD(c) do { SC_GEOM(c) _Pragma("unroll") for (int i = 0; i < 3; ++i) { const int tr = toklo_ - 1 + prow[i]; raw[i] = (v4u){0u, 0u, 0u, 0u}; \
            if (tr >= 0 && tr < len_) raw[i] = *(const GAS v4u*)(PR + (size_t)(rowbase_ + tr) * RCOLS + pcol[i]); } } while (0)
        { S3_IDS(); SC_LOAD(0); }
        for (int c = 0; c < KVT / 16; ++c) {
            { S3_IDS();
#pragma unroll
              for (int i = 0; i < 3; ++i) { if (prow[i] >= 0) *(LAS v4u*)(L + S3_RAW + plds[i]) = raw[i]; }
              S3_BAR();
              if (c + 1 < KVT / 16) SC_LOAD(c + 1); }
            { S3_IDS(); S3_F32(RS, S3_RS); S3_F32(VS, S3_VS); S3_F32(KS, S3_KS); S3_F32(KK, S3_KK);
              const int j = dt >> 4, cg = dt & 15;
              f32x4 xs[5];
#pragma unroll
              for (int g = 0; g < 5; ++g) {
                  const v2u a0 = *(const LAS v2u*)(L + S3_RAW + ((j + 0) * 320 + g * 64 + 4 * cg) * 2), a1 = *(const LAS v2u*)(L + S3_RAW + ((j + 1) * 320 + g * 64 + 4 * cg) * 2), a2 = *(const LAS v2u*)(L + S3_RAW + ((j + 2) * 320 + g * 64 + 4 * cg) * 2);
                  const f32x4 x0 = (f32x4){bflo(a0.x), bfhi(a0.x), bflo(a0.y), bfhi(a0.y)}, x1 = (f32x4){bflo(a1.x), bfhi(a1.x), bflo(a1.y), bfhi(a1.y)}, x2 = (f32x4){bflo(a2.x), bfhi(a2.x), bflo(a2.y), bfhi(a2.y)};
                  xs[g] = x1 + mu0[g] * (x0 - x1) + mu1[g] * (x2 - x1);
              }
              *(LAS f32x4*)(RS + j * 64 + 4 * cg) = xs[0];
              *(LAS f32x4*)(VS + j * 64 + 4 * cg) = xs[2];
              *(LAS f32x4*)(KS + j * 64 + 4 * cg) = xs[1];
              const f32x4 kkf = xs[1] * kkc; float ss = (kkf.x * kkf.x + kkf.y * kkf.y) + (kkf.z * kkf.z + kkf.w * kkf.w);
              ss += __shfl_xor(ss, 1); ss += __shfl_xor(ss, 2); ss += __shfl_xor(ss, 4); ss += __shfl_xor(ss, 8);
              const float inv = 1.0f / fmaxf(sqrtf(ss), 1e-12f);
              *(LAS f32x4*)(KK + j * 64 + 4 * cg) = kkf * inv;
              v2u tw; tw.x = pk2(tanh_fast(xs[3].x), tanh_fast(xs[3].y)); tw.y = pk2(tanh_fast(xs[3].z), tanh_fast(xs[3].w));
              *(LAS v2u*)(L + S3_TWA + (j * 72 + 4 * cg) * 2) = tw;
              v2u ad; ad.x = pk2(xs[4].x, xs[4].y); ad.y = pk2(xs[4].z, xs[4].w);
              *(LAS v2u*)(L + S3_ADA + (j * 72 + 4 * cg) * 2) = ad;
            }
            S3_BAR();
            { S3_IDS(); S3_F32(RS, S3_RS); S3_F32(VS, S3_VS); S3_F32(KS, S3_KS); S3_F32(KK, S3_KK); S3_F32(RTF, S3_RTF); S3_F32(KCF, S3_KCF); S3_F32(G15, S3_G15); S3_F32(BON, S3_BON);
              const int ao = (lr * 72 + 8 * lq) * 2;
              const bf16x8 At0 = lds_frag(L + S3_TWA + ao), At1 = lds_frag(L + S3_TWA + ao + 64), Aa0 = lds_frag(L + S3_ADA + ao), Aa1 = lds_frag(L + S3_ADA + ao + 64);
              f32x4 zw = mfma16(At0, Bw0, (f32x4){0.f, 0.f, 0.f, 0.f}); zw = mfma16(At1, Bw1, zw);
              f32x4 za = mfma16(Aa0, Ba0, (f32x4){0.f, 0.f, 0.f, 0.f}); za = mfma16(Aa1, Ba1, za);
              const int cl = 16 * w4 + lr;
              float wv[4], kt[4], bb[4], kkv[4], rsv[4], vsv[4];
#pragma unroll
              for (int i = 0; i < 4; ++i) { const int jj = 4 * lq + i;
                  wv[i] = __expf(-0.6065306597f * sigmoidf_(w0c + zw[i]));
                  const float al = sigmoidf_(a0c + za[i]);
                  kkv[i] = KK[jj * 64 + cl]; rsv[i] = RS[jj * 64 + cl]; vsv[i] = VS[jj * 64 + cl];
                  kt[i] = KS[jj * 64 + cl] * (1.0f + (al - 1.0f) * kac); bb[i] = kkv[i] * al;
                  float bp = rsv[i] * kt[i] * rkc;
                  bp += __shfl_xor(bp, 1); bp += __shfl_xor(bp, 2); bp += __shfl_xor(bp, 4); bp += __shfl_xor(bp, 8);
                  if (lr == 0) BON[w4 * 16 + jj] = bp; }
              const int gq = d == 0 ? lq : 3 - lq;
              float e0 = d == 0 ? wv[0] : wv[3], e1 = d == 0 ? wv[1] : wv[2], e2 = d == 0 ? wv[2] : wv[1], e3 = d == 0 ? wv[3] : wv[0];
              const float c0 = e0, c1 = c0 * e1, c2 = c1 * e2, c3 = c2 * e3;
              const float t0 = __shfl(c3, (d == 0 ? 0 : 48) + lr), t1 = __shfl(c3, (d == 0 ? 16 : 32) + lr), t2 = __shfl(c3, (d == 0 ? 32 : 16) + lr), t3 = __shfl(c3, (d == 0 ? 48 : 0) + lr);
              const float pre = gq == 0 ? 1.0f : gq == 1 ? t0 : gq == 2 ? t0 * t1 : t0 * t1 * t2;
              const float g15 = (t0 * t1) * (t2 * t3);
              const float gin[4] = { pre * c0, pre * c1, pre * c2, pre * c3 }, gex[4] = { pre, pre * c0, pre * c1, pre * c2 };
              if (lq == 0) G15[cl] = g15;
              float avs[4], bcs[4], vvs[4];
#pragma unroll
              for (int k = 0; k < 4; ++k) { const int i = d == 0 ? k : 3 - k, t = 4 * gq + k;
                  const float ig = 1.0f / gin[k], sc = g15 * ig;
                  const float av = -kkv[i] * gex[k], rv = rsv[i] * gin[k];
                  st_bf(L + S3_GA + (t * 72 + cl) * 2, bb[i] * ig); st_bf(L + S3_GA + ((16 + t) * 72 + cl) * 2, kt[i] * ig);
                  st_bf(L + S3_GBT + (t * 72 + cl) * 2, av); st_bf(L + S3_GBT + ((16 + t) * 72 + cl) * 2, rv);
                  RTF[t * 64 + cl] = rv; KCF[t * 64 + cl] = kt[i] * sc;
                  avs[k] = av; bcs[k] = bb[i] * sc; vvs[k] = vsv[i]; }
              *(LAS v2u*)(L + S3_ATT + (cl * 24 + 4 * gq) * 2) = (v2u){pk2(avs[0], avs[1]), pk2(avs[2], avs[3])};
              *(LAS v2u*)(L + S3_BCT + (cl * 24 + 4 * gq) * 2) = (v2u){pk2(bcs[0], bcs[1]), pk2(bcs[2], bcs[3])};
              *(LAS v2u*)(L + S3_VT + (cl * 24 + 4 * gq) * 2) = (v2u){pk2(vvs[0], vvs[1]), pk2(vvs[2], vvs[3])};
            }
            S3_BAR();
            { S3_IDS(); S3_F32(MAB, S3_MAB); S3_F32(MKR, S3_MKR);
              const int mt = w4 >> 1, nt = w4 & 1, ao = ((16 * mt + lr) * 72 + 8 * lq) * 2, bo = ((16 * nt + lr) * 72 + 8 * lq) * 2;
              f32x4 acc = mfma16(lds_frag(L + S3_GA + ao), lds_frag(L + S3_GBT + bo), (f32x4){0.f, 0.f, 0.f, 0.f});
              acc = mfma16(lds_frag(L + S3_GA + ao + 64), lds_frag(L + S3_GBT + bo + 64), acc);
#pragma unroll
              for (int i = 0; i < 4; ++i) { const int s = 4 * lq + i, t = lr; const bool keep = nt == 0 ? (s < t) : (s <= t); const float v = keep ? acc[i] : 0.f;
                  if (w4 == 0) MAB[s * 16 + t] = v;
                  else if (w4 == 2) st_bf(L + S3_MAK + (s * 24 + t) * 2, v);
                  else if (w4 == 1) st_bf(L + S3_MBRT + (t * 24 + s) * 2, v);
                  else MKR[s * 16 + t] = v; }
              if (w4 == 0) { S3_WAVE_SYNC();
                  if (lane < 16) { const int t = lane; float Tc[16];
#pragma unroll
                    for (int s = 15; s >= 0; --s) { float a = (s == t) ? 1.f : 0.f; asm volatile("" ::: "memory");
                        float mr[16];
#pragma unroll
                        for (int q4 = (s + 1) / 4; q4 < 4; ++q4) { const f32x4 mv = *(const LAS f32x4*)(MAB + s * 16 + 4 * q4); mr[4 * q4] = mv.x; mr[4 * q4 + 1] = mv.y; mr[4 * q4 + 2] = mv.z; mr[4 * q4 + 3] = mv.w; }
#pragma unroll
                        for (int jx = s + 1; jx < 16; ++jx) a = fmaf(mr[jx], Tc[jx], a);
                        Tc[s] = a; }
                    unsigned tt[8];
#pragma unroll
                    for (int s = 0; s < 16; ++s) st_bf(L + S3_TA + (s * 24 + t) * 2, Tc[s]);
#pragma unroll
                    for (int s = 0; s < 8; ++s) tt[s] = pk2(Tc[2 * s], Tc[2 * s + 1]);
                    *(LAS v4u*)(L + S3_TT + (t * 24) * 2) = (v4u){tt[0], tt[1], tt[2], tt[3]}; *(LAS v4u*)(L + S3_TT + (t * 24 + 8) * 2) = (v4u){tt[4], tt[5], tt[6], tt[7]}; } }
            }
            S3_BAR();
            { S3_IDS(); S3_F32(MKR, S3_MKR); S3_F32(KCF, S3_KCF); S3_F32(RTF, S3_RTF); S3_F32(G15, S3_G15); S3_F32(YO, S3_YO);
              const int cb = (w4 + 3) & 3;
              LAS unsigned char* const Wsc = L + S3_WSC + w4 * S3_WSC_STRIDE;
              LAS unsigned char* const Rq0 = L + S3_RQ0 + w4 * 2304;
              const bf16x8 Ata = lds_frag16(L + S3_TA + lr * 48, lane);
              { const f32x4 c1 = mfma16(lds_frag16(L + S3_MAK + lr * 48, lane), lds_frag16(L + S3_TT + lr * 48, lane), (f32x4){0.f, 0.f, 0.f, 0.f});
#pragma unroll
                for (int i = 0; i < 4; ++i) st_bf(Wsc + ((4 * lq + i) * 24 + lr) * 2, c1[i]); }
              S3_WAVE_SYNC();
              const bf16x8 Ac1 = lds_frag16(Wsc + lr * 48, lane);
              { const bf16x8 B0 = lds_frag16(L + S3_MBRT + lr * 48, lane), BE = lds_frag16(L + S3_BCT + (16 * cb + lr) * 48, lane);
                f32x4 i0, iE;
#pragma unroll
                for (int i = 0; i < 4; ++i) { i0[i] = MKR[(4 * lq + i) * 16 + lr]; iE[i] = KCF[(4 * lq + i) * 64 + 16 * cb + lr]; }
                const f32x4 d10 = mfma16(Ata, B0, (f32x4){0.f, 0.f, 0.f, 0.f}), d20 = mfma16(Ac1, B0, i0), d1E = mfma16(Ata, BE, (f32x4){0.f, 0.f, 0.f, 0.f}), d2E = mfma16(Ac1, BE, iE);
                *(LAS v2u*)(Wsc + 768 + (lr * 24 + 4 * lq) * 2) = (v2u){pk2(d10[0], d10[1]), pk2(d10[2], d10[3])};
                *(LAS v2u*)(Wsc + 1536 + (lr * 24 + 4 * lq) * 2) = (v2u){pk2(d20[0], d20[1]), pk2(d20[2], d20[3])};
                *(LAS v2u*)(Wsc + 2304 + (lr * 24 + 4 * lq) * 2) = (v2u){pk2(d1E[0], d1E[1]), pk2(d1E[2], d1E[3])};
                *(LAS v2u*)(Wsc + 3072 + (lr * 24 + 4 * lq) * 2) = (v2u){pk2(d2E[0], d2E[1]), pk2(d2E[2], d2E[3])}; }
              S3_WAVE_SYNC();
              const bf16x8 Bd10 = lds_frag16(Wsc + 768 + lr * 48, lane), Bd20 = lds_frag16(Wsc + 1536 + lr * 48, lane), Bd1E = lds_frag16(Wsc + 2304 + lr * 48, lane), Bd2E = lds_frag16(Wsc + 3072 + lr * 48, lane);
              f32x4 accY, accS[4];
#pragma unroll
              for (int mt = 0; mt < 4; ++mt) {
                  const bf16x8 Aa = lds_frag16(L + S3_ATT + (16 * mt + lr) * 48, lane), Av = lds_frag16(L + S3_VT + (16 * mt + lr) * 48, lane);
                  f32x4 r0;
#pragma unroll
                  for (int i = 0; i < 4; ++i) r0[i] = RTF[lr * 64 + 16 * mt + 4 * lq + i];
                  r0 = mfma16(Aa, Bd10, r0);
                  const f32x4 q1 = mfma16(Aa, Bd1E, (f32x4){0.f, 0.f, 0.f, 0.f});
                  *(LAS v2u*)(Rq0 + (lr * 72 + 16 * mt + 4 * lq) * 2) = (v2u){pk2(r0[0], r0[1]), pk2(r0[2], r0[3])};
                  *(LAS v2u*)(Wsc + 3840 + (lr * 72 + 16 * mt + 4 * lq) * 2) = (v2u){pk2(q1[0], q1[1]), pk2(q1[2], q1[3])};
                  accS[mt] = mfma16(Av, Bd2E, (f32x4){0.f, 0.f, 0.f, 0.f});
                  if (mt == w4) accY = mfma16(Av, Bd20, (f32x4){0.f, 0.f, 0.f, 0.f});
              }
              S3_WAVE_SYNC();
#pragma unroll
              for (int ks = 0; ks < 2; ++ks) {
                  const bf16x8 Bq0 = lds_frag(Rq0 + (lr * 72 + 8 * lq + 32 * ks) * 2), Bq1 = lds_frag(Wsc + 3840 + (lr * 72 + 8 * lq + 32 * ks) * 2);
#pragma unroll
                  for (int mt = 0; mt < 4; ++mt) { const bf16x8 As = lds_frag(L + S3_S16 + ((16 * mt + lr) * 72 + 8 * lq + 32 * ks) * 2);
                      accS[mt] = mfma16(As, Bq1, accS[mt]);
                      if (mt == w4) accY = mfma16(As, Bq0, accY); } }
#pragma unroll
              for (int i = 0; i < 4; ++i) YO[lr * 64 + 16 * w4 + 4 * lq + i] = accY[i];
              const float g = G15[16 * cb + lr];
#pragma unroll
              for (int mt = 0; mt < 4; ++mt) S[mt] = S[mt] * g + accS[mt];
            }
            S3_BAR();
            { S3_IDS(); const int cb = (w4 + 3) & 3;
#pragma unroll
              for (int mt = 0; mt < 4; ++mt)
#pragma unroll
                  for (int i = 0; i < 4; ++i) st_bf(L + S3_S16 + ((16 * mt + 4 * lq + i) * 72 + 16 * cb + lr) * 2, S[mt][i]);
            }
            { S3_IDS(); S3_F32(YO, S3_YO); S3_F32(BON, S3_BON); SC_GEOM(c)
              if (dt < 128) { const int s = dt >> 3, c8 = dt & 7; const int tok = d == 0 ? pos0_ + s : len_ - 1 - (pos0_ + s);
                  GAS bf16* Yd = WSP(bf16, d == 0 ? WS_YF : WS_YB);
                  const f32x4 a = *(const LAS f32x4*)(YO + s * 64 + 8 * c8), bq = *(const LAS f32x4*)(YO + s * 64 + 8 * c8 + 4);
                  v4u w; w.x = pk2(a.x, a.y); w.y = pk2(a.z, a.w); w.z = pk2(bq.x, bq.y); w.w = pk2(bq.z, bq.w);
                  *(GAS v4u*)(Yd + (size_t)(rowbase_ + tok) * RW + h * 64 + 8 * c8) = w; }
              else if (dt < 144) { const int jj = dt - 128; GAS float* bonus = WSP(float, WS_BONUS) + (size_t)d * MA * 8;
                  bonus[(size_t)(rowbase_ + toklo_ + jj) * 8 + h] = (BON[jj] + BON[16 + jj]) + (BON[32 + jj] + BON[48 + jj]); }
            }
        }
        __syncthreads();
#undef SC_LOAD
#undef SC_GEOM
    }
}
__global__ void __launch_bounds__(NWAVES * 64, 2) fwd_kernel(Args args) {
    extern __shared__ __attribute__((aligned(16))) unsigned char lds[];
    Frame F;
    F.lds = (LAS unsigned char*)lds;
    F.MISC = (volatile LAS unsigned*)(F.lds + MISC_OFF);
    F.tid = threadIdx.x; F.lane = F.tid & 63; F.wave = __builtin_amdgcn_readfirstlane(F.tid >> 6);
    F.G = gridDim.x; { const int bx = blockIdx.x; F.vcu = (F.G % 8 == 0) ? (bx % 8) * (F.G / 8) + bx / 8 : bx; }
    F.ws = args.ws; F.out = args.out; F.ctl = (gu32*)(args.ws + WS_CTL);
    for (int u = F.tid; u < 128; u += NWAVES * 64) ((LAS unsigned*)(F.lds + MISC_OFF))[u] = 0u;
    if (F.tid < 33) { const unsigned long long pv = (unsigned long long)args.in[F.tid]; ((LAS unsigned*)(F.lds + PTAB_OFF))[2 * F.tid] = (unsigned)pv; ((LAS unsigned*)(F.lds + PTAB_OFF))[2 * F.tid + 1] = (unsigned)(pv >> 32); }
    __syncthreads();
    const int vcu0 = F.vcu;
    const bool fused = args.mode == 0;
    XcdBarrier bar; bar.bar = (unsigned*)(F.ctl + CW_BAR); bar.x = 0; bar.st = nullptr;
    if (fused) bar = xcd_barrier_post((unsigned*)(F.ctl + CW_BAR), F.MISC + 8);
#ifndef REP_PRO
#define REP_PRO 1
#endif
#ifndef REP_NORM
#define REP_NORM 1
#endif
#ifndef REP_GEMM1
#define REP_GEMM1 1
#endif
#ifndef REP_SCAN
#define REP_SCAN 1
#endif
#ifndef REP_ROUT
#define REP_ROUT 1
#endif
#ifndef REP_ATTN_DUMMY
#define REP_ATTN_DUMMY 0
#endif
#ifndef REP_MERGEA
#define REP_MERGEA 1
#endif
#ifndef REP_GU
#define REP_GU 1
#endif
#ifndef REP_DOWN_DUMMY
#define REP_DOWN_DUMMY 0
#endif
#ifndef REP_MOECONV
#define REP_MOECONV 1
#endif
#ifndef REP_MOEGEMM
#define REP_MOEGEMM 1
#endif
#define REPEAT(n) for (int rep_ = 0; rep_ < (n); ++rep_)
#ifndef SITE_MASK
#define SITE_MASK 0xFFFF
#endif
#define RUN(L, S) (((SITE_MASK >> (S)) & 1) && (fused || (args.l == (L) && args.site == (S))))
#define GRID_BAR() do { if (fused) xcd_barrier(bar); } while (0)
#define SITE_BEGIN() do { int t_ = threadIdx.x; asm volatile("" : "+v"(t_)); F.tid = t_; F.lane = t_ & 63; F.wave = __builtin_amdgcn_readfirstlane(t_ >> 6); int v_ = vcu0; asm volatile("" : "+s"(v_)); F.vcu = v_; unsigned long long w_ = (unsigned long long)args.ws, o_ = (unsigned long long)args.out; asm volatile("" : "+s"(w_), "+s"(o_)); F.ws = (unsigned char*)w_; F.out = (GAS float*)o_; F.ctl = (gu32*)(F.ws + WS_CTL); } while (0)
    GAS float* const XC = WSP(float, WS_XC);
    GAS float* const MOD = WSP(float, WS_MOD);
    LAS int* const tile_e = (LAS int*)(F.lds + RING_BYTES);

    if (RUN(0, 0)) { SITE_BEGIN(); REPEAT(REP_PRO) p0_prologue(F); GRID_BAR(); }

    for (int l = 0; l < 2; ++l) {
        const GAS float* xlat = l == 0 ? INP(0) : (const GAS float*)F.out;
        const GAS float* xctx = l == 0 ? INP(2) : (const GAS float*)XC;
        const int nM_mix = l == 0 ? MA / 256 : NL / 256;
        if (RUN(l, 1)) { SITE_BEGIN(); REPEAT(REP_NORM) norm_mod_phase<false>(F, l, 0, xlat, xctx, MA, WSP(bf16, WS_H)); GRID_BAR(); }
        if (RUN(l, 2)) { SITE_BEGIN();
            pg8::StdOrder S; S.init(WSGEN(bf16, WS_H), WSGEN(bf16, WS_WIN) + (size_t)l * NIN * DM, DM, MA / 256, NIN / 256, F.G, (int)blockIdx.x);
            EpiIn E{WSP(bf16, WS_PR), WSP(bf16, WS_Q), WSP(bf16, WS_KB), WSP(bf16, WS_VB), WSP(bf16, WS_G)};
            REPEAT(REP_GEMM1) pg8::gemm_phase<EpiIn, pg8::StdOrder, true, true>(F.lds, DM, S, E);
            GRID_BAR();
        }
        if (RUN(l, 3)) { SITE_BEGIN();
#ifndef NO_SCAN
            REPEAT(REP_SCAN) scan_phase3(F, l);
#endif
#ifndef NO_QK
            qk_phase(F, l);
#endif
            GRID_BAR(); }
        if (RUN(l, 4)) { SITE_BEGIN(); REPEAT(REP_ROUT) rwkv_out_phase(F, l, nM_mix * 256); REPEAT(REP_ATTN_DUMMY) attn_phase(F, l, (char*)lds, WS_YF); attn_phase(F, l, (char*)lds, WS_Q); GRID_BAR(); }
        if (RUN(l, 5)) { SITE_BEGIN();
            { pg8::StdOrder S; S.init(WSGEN(bf16, WS_YR), WSGEN(bf16, WS_WPA) + (size_t)l * DM * RW, RW, nM_mix, DM / 256, F.G, (int)blockIdx.x);
              EpiMerge<0> E{WSP(bf16, WS_G), WSP(bf16, WS_MG)};
              REPEAT(REP_MERGEA) pg8::gemm_phase<EpiMerge<0>, pg8::StdOrder, true, true>(F.lds, RW, S, E); }
            __syncthreads();
            { pg8::StdOrder S; S.init(WSGEN(bf16, WS_Q), WSGEN(bf16, WS_WPB) + (size_t)l * DM * RW, RW, nM_mix, DM / 256, F.G, (int)blockIdx.x);
              EpiMerge<1> E{WSP(bf16, WS_G), WSP(bf16, WS_MG)};
              pg8::gemm_phase<EpiMerge<1>, pg8::StdOrder, true, true>(F.lds, RW, S, E); }
            GRID_BAR();
        }
        if (RUN(l, 6)) { SITE_BEGIN();
            pg8::StdOrder S; S.init(WSGEN(bf16, WS_MG), WSGEN(bf16, WS_WO) + (size_t)l * DM * DM, DM, nM_mix, DM / 256, F.G, (int)blockIdx.x);
            EpiRes E{xlat, xctx, F.out, XC, MOD + (size_t)l * 33 * 6144 + 2048};
            pg8::gemm_phase<EpiRes, pg8::StdOrder, true, true>(F.lds, DM, S, E);
            GRID_BAR();
        }
        if (RUN(l, 7)) { SITE_BEGIN();
            if (l == 0) norm_mod_phase<false>(F, l, 1, F.out, XC, MA, WSP(bf16, WS_H));
            else norm_mod_phase<true>(F, l, 1, F.out, XC, NL, WSP(bf16, WS_H));
            GRID_BAR();
        }
        if (l == 0) {
            if (RUN(0, 8)) { SITE_BEGIN();
                pg8::StdOrder S; S.init(WSGEN(bf16, WS_H), WSGEN(bf16, WS_WGU), DM, MA / 256, 2 * FF / 256, F.G, (int)blockIdx.x);
                EpiGU E{WSP(bf16, WS_ACT), 0};
                REPEAT(REP_GU) pg8::gemm_phase<EpiGU, pg8::StdOrder, true, true>(F.lds, DM, S, E);
                GRID_BAR();
            }
            if (RUN(0, 9)) { SITE_BEGIN();
                pg8::StdOrder S; S.init(WSGEN(bf16, WS_ACT), WSGEN(bf16, WS_WDN), FF, MA / 256, DM / 256, F.G, (int)blockIdx.x);
                EpiRes E{F.out, XC, F.out, XC, MOD + 5120};
                REPEAT(REP_DOWN_DUMMY) { EpiStore ED{WSP(bf16, WS_H)}; pg8::gemm_phase<EpiStore, pg8::StdOrder, true, true>(F.lds, FF, S, ED); __syncthreads(); }
                pg8::gemm_phase<EpiRes, pg8::StdOrder, true, true>(F.lds, FF, S, E);
                GRID_BAR();
            }
        } else {
            if (RUN(1, 10)) { SITE_BEGIN(); REPEAT(REP_MOECONV) moe_conv(F); __syncthreads(); moe_slots(F); GRID_BAR(); }
            int ntile = 0;
            if (fused || args.site == 11 || args.site == 12) ntile = moe_tiles(F, tile_e);
            for (int ch = 0; ch < MOE_NCHUNK; ++ch) {
                if (!fused && ch != args.chunk) continue;
                const int t0 = ch * MOE_CH_TILES; if (t0 >= ntile) break;
                const int ntl = (ntile - t0) < MOE_CH_TILES ? (ntile - t0) : MOE_CH_TILES;
                if (RUN(1, 11)) { SITE_BEGIN();
                    MoeOrder S{(const char*)(F.ws + WS_XB), (const char*)(F.ws + WS_MW), (size_t)256 * DM * 2, (size_t)256 * DM * 2, (size_t)21 * MiB, t0, 0, ntl, 2 * FF / 256, F.G, (int)blockIdx.x, tile_e};
                    EpiGU E{WSP(bf16, WS_ACTC), t0};
                    REPEAT(REP_MOEGEMM) pg8::gemm_phase<EpiGU, MoeOrder, true, true>(F.lds, DM, S, E);
                    GRID_BAR();
                }
                if (RUN(1, 12)) { SITE_BEGIN();
                    MoeOrder S{(const char*)(F.ws + WS_ACTC), (const char*)(F.ws + WS_MW) + (size_t)2 * FF * DM * 2, (size_t)256 * FF * 2, (size_t)256 * FF * 2, (size_t)21 * MiB, t0, t0, ntl, DM / 256, F.G, (int)blockIdx.x, tile_e};
                    EpiStore E{WSP(bf16, WS_YM)};
                    REPEAT(REP_MOEGEMM) pg8::gemm_phase<EpiStore, MoeOrder, true, true>(F.lds, FF, S, E);
                    GRID_BAR();
                }
            }
            if (RUN(1, 13)) { SITE_BEGIN(); moe_final(F); }
        }
    }
#undef RUN
#undef GRID_BAR
}

extern "C" void kernel_launch(void* const* d_in, const GAS int* in_sizes, int n_in, void* d_out, int out_size, void* d_ws, size_t ws_size, hipStream_t stream) {
    static int grid = 0;
    if (grid == 0) {
        if (n_in != 33 || in_sizes[0] != NL * DM || out_size != NL * DM || ws_size < WS_END) { fprintf(stderr, "kernel_launch: unexpected problem (n_in %d, x %d, out %d, ws %zu < %zu); nothing launched\n", n_in, n_in > 0 ? in_sizes[0] : -1, out_size, ws_size, (size_t)WS_END); grid = -1; return; }
        int dev = 0, cus = 0, per_cu = 0;
        if (hipGetDevice(&dev) != hipSuccess || hipDeviceGetAttribute(&cus, hipDeviceAttributeMultiprocessorCount, dev) != hipSuccess) { fprintf(stderr, "kernel_launch: device query failed\n"); grid = -1; return; }
        if (hipFuncSetAttribute((const void*)fwd_kernel, hipFuncAttributeMaxDynamicSharedMemorySize, LDS_BYTES) != hipSuccess) { fprintf(stderr, "kernel_launch: hipFuncSetAttribute failed\n"); grid = -1; return; }
        if (hipOccupancyMaxActiveBlocksPerMultiprocessor(&per_cu, (const void*)fwd_kernel, NWAVES * 64, LDS_BYTES) != hipSuccess || per_cu < 1) { fprintf(stderr, "kernel_launch: occupancy query reports %d workgroups per CU\n", per_cu); }
        (void)hipGetLastError();
        grid = cus;
        fprintf(stderr, "kernel_launch: grid %d, occupancy query %d\n", grid, per_cu);
    }
    if (grid < 0) return;
    if (hipMemsetAsync((char*)d_ws + WS_CTL, 0, CTL_ZERO_BYTES, stream) != hipSuccess) { fprintf(stderr, "kernel_launch: memset failed\n"); return; }
    Args a{};
    for (int i = 0; i < 33; ++i) a.in[i] = (const GAS float*)d_in[i];
    a.out = (GAS float*)d_out; a.ws = (unsigned char*)d_ws;
#if MK_FUSED
    a.mode = 0; a.l = 0; a.site = 0; a.chunk = 0;
    hipLaunchKernelGGL(fwd_kernel, dim3(grid), dim3(NWAVES * 64), LDS_BYTES, stream, a);
#else
    a.mode = 1;
    auto step = [&](int l, int site, int chunk) { a.l = l; a.site = site; a.chunk = chunk; hipLaunchKernelGGL(fwd_kernel, dim3(grid), dim3(NWAVES * 64), LDS_BYTES, stream, a); };
    step(0, 0, 0);
    for (int l = 0; l < 2; ++l) {
        for (int s = 1; s <= 7; ++s) step(l, s, 0);
        if (l == 0) { step(0, 8, 0); step(0, 9, 0); }
        else { step(1, 10, 0); for (int ch = 0; ch < MOE_NCHUNK; ++ch) { step(1, 11, ch); step(1, 12, ch); } step(1, 13, 0); }
    }
#endif
    const hipError_t le = hipPeekAtLastError();
    if (le != hipSuccess) fprintf(stderr, "kernel_launch: launch failed: %s\n", hipGetErrorName(le));
}
```

```cpp
#include <hip/hip_runtime.h>
#include <hip/hip_bf16.h>
#include <cstdio>
#include <cstdint>
#include <cmath>

#ifndef MK_FUSED
#define MK_FUSED 1
#endif

constexpr int DM = 1024, NB = 32, TL = 2048, TC = 256;
constexpr int NL = NB * TL;
constexpr int NC = NB * TC;
constexpr int MA = NL + NC;
constexpr int RW = 512, RCOLS = 1792, ACOLS = 768, GCOLS = 2048, NIN = 4608;
constexpr int FF = 3584, NE = 8;
constexpr int KVT = TL + TC;
constexpr int MOE_ROWS = 2 * NL + NE * 256;
constexpr int MOE_CH_TILES = 64;
constexpr int MOE_NCHUNK = 8;
constexpr int MOE_LAST_TILES = 72;

constexpr size_t MiB = 1u << 20;
constexpr size_t WS_CTL = 0, CTL_ZERO_BYTES = 1 * MiB;
constexpr size_t WS_MOD = 1 * MiB;
constexpr size_t WS_ROPE = 3 * MiB;
constexpr size_t WS_LORA = 4 * MiB;
constexpr size_t WS_BONUS = 5 * MiB;
constexpr size_t WS_MOETAB = 10 * MiB;
constexpr size_t WS_WIN = 16 * MiB;
constexpr size_t WS_WPA = 34 * MiB;
constexpr size_t WS_WPB = 36 * MiB;
constexpr size_t WS_WO = 38 * MiB;
constexpr size_t WS_WGU = 42 * MiB;
constexpr size_t WS_WDN = 56 * MiB;
constexpr size_t WS_XC = 64 * MiB;
constexpr size_t WS_H = 96 * MiB;
constexpr size_t WS_YF = 96 * MiB, WS_YB = 168 * MiB;
constexpr size_t WS_PR = 240 * MiB;
constexpr size_t WS_MG = 240 * MiB;
constexpr size_t WS_Q = 492 * MiB;
constexpr size_t WS_KB = 564 * MiB, WS_VB = 582 * MiB;
constexpr size_t WS_G = 600 * MiB;
constexpr size_t WS_YR = 888 * MiB;
constexpr size_t WS_ACT = 240 * MiB;
constexpr size_t WS_H2M = 80 * MiB;
constexpr size_t WS_MW = 208 * MiB;
constexpr size_t WS_XB = 376 * MiB;
constexpr size_t WS_YM = 636 * MiB;
constexpr size_t WS_ACTC = 896 * MiB;
constexpr size_t WS_END = 1024 * MiB;
static_assert(WS_H + (size_t)MA * DM * 2 <= WS_PR && WS_PR + (size_t)MA * RCOLS * 2 <= WS_Q && WS_Q + (size_t)MA * 512 * 2 <= WS_KB, "ws map 1");
static_assert(WS_KB + (size_t)MA * 128 * 2 <= WS_VB && WS_VB + (size_t)MA * 128 * 2 <= WS_G && WS_G + (size_t)MA * GCOLS * 2 <= WS_YR && WS_YR + (size_t)MA * 512 * 2 <= WS_END, "ws map 2");
static_assert(WS_ACT + (size_t)MA * FF * 2 <= WS_END && WS_H2M + (size_t)NL * DM * 2 <= WS_MW && WS_MW + (size_t)NE * 21 * MiB <= WS_XB && WS_H2M >= WS_XC, "ws map 3");
static_assert(WS_XB + (size_t)MOE_ROWS * DM * 2 <= WS_YM && WS_YM + (size_t)MOE_ROWS * DM * 2 <= WS_ACTC && WS_ACTC + (size_t)MOE_LAST_TILES * 256 * FF * 2 <= WS_END, "ws map 4");
static_assert(WS_WDN + (size_t)DM * FF * 2 <= WS_XC && WS_BONUS + (size_t)2 * MA * 8 * 4 <= WS_MOETAB, "ws map 5");
constexpr size_t MT_TOKE = 0;
constexpr size_t MT_TOKW = 512 * 1024;
constexpr size_t MT_TOKS = 1024 * 1024;
constexpr int CW_TMO = 0, CW_CODE = 1;
constexpr int CW_BAR = 4096;
constexpr int CW_HIST = 8192;
constexpr int CW_CURS = 8192 + 64 * 8;

constexpr int NWAVES = 8;
constexpr int LDS_BYTES = 147456;
constexpr int MISC_OFF = LDS_BYTES - 1024;
constexpr int PTAB_OFF = LDS_BYTES - 512;
constexpr int RING_BYTES = 131072;

#define GAS __attribute__((address_space(1)))
#define LAS __attribute__((address_space(3)))
typedef unsigned short bf16;
typedef unsigned v4u __attribute__((ext_vector_type(4)));
typedef unsigned v2u __attribute__((ext_vector_type(2)));
typedef float f32x4 __attribute__((ext_vector_type(4)));
typedef float f32x2 __attribute__((ext_vector_type(2)));
typedef short bf16x8 __attribute__((ext_vector_type(8)));
typedef GAS unsigned gu32;
#define RLX_AGENT __ATOMIC_RELAXED, __HIP_MEMORY_SCOPE_AGENT
#define LDS_WAIT() asm volatile("s_waitcnt lgkmcnt(0)" ::: "memory")
#define VM_WAIT() asm volatile("s_waitcnt vmcnt(0)" ::: "memory")
__device__ __forceinline__ float bf2f(unsigned b) { return __uint_as_float(b << 16); }
__device__ __forceinline__ float bflo(unsigned w) { return __uint_as_float(w << 16); }
__device__ __forceinline__ float bfhi(unsigned w) { return __uint_as_float(w & 0xffff0000u); }
typedef __bf16 bf16x2_t __attribute__((ext_vector_type(2)));
__device__ __forceinline__ unsigned pk2(float lo, float hi) { const f32x2 v = {lo, hi}; const bf16x2_t b = __builtin_convertvector(v, bf16x2_t); return __builtin_bit_cast(unsigned, b); }
__device__ __forceinline__ float rcp_(float x) { return __builtin_amdgcn_rcpf(x); }
__device__ __forceinline__ float rsq_(float x) { return __builtin_amdgcn_rsqf(x); }
__device__ __forceinline__ float sigmoidf_(float x) { return rcp_(1.0f + __expf(-x)); }
__device__ __forceinline__ float wave_sum(float v) {
#pragma unroll
    for (int o = 1; o < 64; o <<= 1) v += __shfl_xor(v, o);
    return v;
}
__device__ __forceinline__ int row_bi(int m) { return m < NL ? (m >> 11) : 32; }
__device__ __forceinline__ int row_kv(int m) { return m < NL ? (m >> 11) * KVT + (m & 2047) : ((m - NL) >> 8) * KVT + TL + ((m - NL) & 255); }
namespace pg8 {
#define PG8_LAS __attribute__((address_space(3)))
typedef unsigned short bf16_t;
typedef short bf16x8 __attribute__((ext_vector_type(8)));
typedef float f32x4 __attribute__((ext_vector_type(4)));
typedef unsigned u32x4 __attribute__((ext_vector_type(4)));
constexpr int BM = 256, BK = 64, HALF = 128, HTB = HALF * BK * 2  , STAGE_BYTES = 8 * HTB, NXCD = 8, WGM = 8;

__host__ __device__ __forceinline__ int lds_byte(int r, int c) { const int st = (r >> 4) * 2 + (c >> 5), rr = r & 15, cc = c & 31, ob = rr * 64 + cc * 2; return st * 1024 + (ob ^ (((ob >> 9) & 1) << 5)); }
__host__ __device__ __forceinline__ void stage_rc(int b, int& R, int& C) { const int st = b / 1024, sb = b % 1024, swz = sb ^ (((sb >> 9) & 1) << 5); R = (st >> 1) * 16 + swz / 64; C = (st & 1) * 32 + (swz % 64) / 2; }
__host__ __device__ __forceinline__ int perm32(int rho) { const int n = rho >> 4, i = rho & 15; return 8 * (i >> 2) + 4 * n + (i & 3); }

struct Unit { int pm, pn; };

struct StdOrder {
    const char* A; const char* Bt; size_t tstep; int nM, nN, nwg, G, c;
    __device__ void init(const void* A_, const void* Bt_, int K, int nM_, int nN_, int G_, int c_) { A = (const char*)A_; Bt = (const char*)Bt_; tstep = (size_t)BM * K * 2; nM = nM_; nN = nN_; nwg = nM * nN; G = G_; c = c_; }
    __device__ bool next(int i, Unit& u) const {
        const long L = (long)i * G + c; if (L >= nwg) return false;
        int wgid = (int)L; { const int q = nwg / NXCD, r = nwg % NXCD, xcd = wgid % NXCD, off = wgid / NXCD; wgid = (xcd < r ? xcd * (q + 1) : r * (q + 1) + (xcd - r) * q) + off; }
        const int nig = WGM * nN, gid = wgid / nig, fm = gid * WGM, gsz = (nM - fm) < WGM ? (nM - fm) : WGM;
        u.pm = fm + ((wgid % nig) % gsz); u.pn = (wgid % nig) / gsz; return true;
    }
    __device__ __forceinline__ const char* a_base(const Unit& u) const { return A + (size_t)u.pm * tstep; }
    __device__ __forceinline__ const char* b_base(const Unit& u) const { return Bt + (size_t)u.pn * tstep; }
    __device__ __forceinline__ void a_ready(const Unit&) const {}
    __device__ __forceinline__ void done(const Unit&) const {}
};
template <class Epi, class Sched, bool ALIGN_EPI = false, bool SP2 = false>
__device__ __forceinline__ void gemm_phase(PG8_LAS unsigned char* lds, const int K, const Sched& S, const Epi& E) {
    int tid_l = threadIdx.x; asm volatile("" : "+v"(tid_l));
    const int tid = tid_l, wid = __builtin_amdgcn_readfirstlane(tid >> 6), lane = tid & 63, wr = wid >> 2, wc = wid & 3, fr = lane & 15, fq = lane >> 4;
    const int nt = K / BK;
    unsigned voffA[2], voffB[2];
#pragma unroll
    for (int i = 0; i < 2; ++i) { int R, C; stage_rc(tid * 16 + i * 8192, R, C); const int Rb = Epi::PERM ? ((R & ~31) + perm32(R & 31)) : R;
        voffA[i] = (unsigned)(R * K + C) * 2u; voffB[i] = (unsigned)(Rb * K + C) * 2u; }
    const size_t kstep = (size_t)(BK * 2);
    const size_t hstep = (size_t)HALF * K * 2;
    const unsigned ldsw = (unsigned)wid * 1024u;
    const int aoff = lds_byte(wr * 64 + fr, fq * 8), boff = lds_byte(wc * 32 + fr, fq * 8);
#define PG8_SA(b, h) (((b) * 2 + (h)) * HTB)
#define PG8_SB(b, h) ((4 + (b) * 2 + (h)) * HTB)
#define PG8_STAGE(bufoff, gbase, voff) do { _Pragma("unroll") for (int _i = 0; _i < 2; ++_i) \
        __builtin_amdgcn_global_load_lds((const unsigned*)((const char*)(gbase) + (voff)[_i]), (PG8_LAS unsigned*)(lds + (bufoff) + ldsw + _i * 8192), 16, 0, 0); } while (0)
#define PG8_LDA(dst, b, h) do { _Pragma("unroll") for (int m = 0; m < 4; ++m) _Pragma("unroll") for (int k = 0; k < 2; ++k) dst[m][k] = *(const PG8_LAS bf16x8*)(lds + PG8_SA(b, h) + aoff + m * 2048 + k * 1024); } while (0)
#define PG8_LDB(dst, b, h) do { _Pragma("unroll") for (int n = 0; n < 2; ++n) _Pragma("unroll") for (int k = 0; k < 2; ++k) dst[n][k] = *(const PG8_LAS bf16x8*)(lds + PG8_SB(b, h) + boff + n * 2048 + k * 1024); } while (0)
#define PG8_MMA(ai, bj, At, Bt) do { __builtin_amdgcn_s_setprio(1); _Pragma("unroll") for (int m = 0; m < 4; ++m) _Pragma("unroll") for (int n = 0; n < 2; ++n) _Pragma("unroll") for (int k = 0; k < 2; ++k) \
        acc[ai][bj][m][n] = __builtin_amdgcn_mfma_f32_16x16x32_bf16(Bt[n][k], At[m][k], acc[ai][bj][m][n], 0, 0, 0); __builtin_amdgcn_s_setprio(0); } while (0)
#define PG8_WAIT_V(n) asm volatile("s_waitcnt vmcnt(" #n ")" ::: "memory")
#define PG8_WAIT_L(n) asm volatile("s_waitcnt lgkmcnt(" #n ")" ::: "memory")
#define PG8_BAR __builtin_amdgcn_s_barrier()
#define PG8_SCHED __builtin_amdgcn_sched_barrier(0)
    Unit cur, nxt; int ui = 0;
    if (!S.next(0, cur)) return;
    f32x4 acc[2][2][4][2];
#pragma unroll
    for (int a = 0; a < 2; ++a)
#pragma unroll
        for (int b = 0; b < 2; ++b)
#pragma unroll
            for (int m = 0; m < 4; ++m)
#pragma unroll
                for (int n = 0; n < 2; ++n) acc[a][b][m][n] = (f32x4){0.f, 0.f, 0.f, 0.f};
    bf16x8 At[4][2], B0[2][2], B1[2][2];
    const char* cA = S.a_base(cur); const char* cB = S.b_base(cur);
    S.a_ready(cur);
    if constexpr (SP2) {
        PG8_STAGE(PG8_SB(0, 0), cB, voffB); PG8_STAGE(PG8_SB(0, 1), cB + hstep, voffB); PG8_STAGE(PG8_SA(0, 0), cA, voffA); PG8_STAGE(PG8_SA(0, 1), cA + hstep, voffA);
        if (wr == 1) PG8_BAR;
        PG8_WAIT_V(2); PG8_BAR;
        PG8_STAGE(PG8_SB(1, 0), cB + kstep, voffB); PG8_STAGE(PG8_SA(1, 0), cA + kstep, voffA); PG8_STAGE(PG8_SB(1, 1), cB + hstep + kstep, voffB);
        PG8_WAIT_V(6); PG8_BAR;
    } else {
        PG8_STAGE(PG8_SB(0, 0), cB, voffB); PG8_STAGE(PG8_SA(0, 0), cA, voffA); PG8_STAGE(PG8_SB(0, 1), cB + hstep, voffB); PG8_STAGE(PG8_SA(0, 1), cA + hstep, voffA);
        if (wr == 1) PG8_BAR;
        PG8_WAIT_V(4); PG8_BAR;
        PG8_STAGE(PG8_SB(1, 0), cB + kstep, voffB); PG8_STAGE(PG8_SA(1, 0), cA + kstep, voffA); PG8_STAGE(PG8_SB(1, 1), cB + hstep + kstep, voffB);
        PG8_WAIT_V(6); PG8_BAR;
    }
    for (;;) {
        const bool has_next = S.next(ui + 1, nxt);
        const char* nA = has_next ? S.a_base(nxt) : cA; const char* nB = has_next ? S.b_base(nxt) : cB;
        for (int t = 0; t < nt; t += 2) {
            const bool last = (t == nt - 2);
            const char* a1 = cA + (size_t)(t + 1) * kstep;
            const char* a2 = last ? nA : cA + (size_t)(t + 2) * kstep; const char* b2 = last ? nB : cB + (size_t)(t + 2) * kstep;
            const char* a3 = a2 + kstep; const char* b3 = b2 + kstep;
            if (last && has_next) S.a_ready(nxt);
            if constexpr (SP2) {
            PG8_LDB(B0, 0, 0); PG8_LDB(B1, 0, 1); PG8_SCHED; PG8_LDA(At, 0, 0); PG8_STAGE(PG8_SA(1, 1), a1 + hstep, voffA);
            PG8_WAIT_V(8); PG8_WAIT_L(0); PG8_BAR; PG8_MMA(0, 0, At, B0); PG8_MMA(0, 1, At, B1); PG8_BAR; PG8_SCHED;
            PG8_LDA(At, 0, 1); PG8_STAGE(PG8_SB(0, 0), b2, voffB); PG8_STAGE(PG8_SB(0, 1), b2 + hstep, voffB); PG8_STAGE(PG8_SA(0, 0), a2, voffA);
            PG8_WAIT_V(8); PG8_WAIT_L(0); PG8_BAR; PG8_MMA(1, 0, At, B0); PG8_MMA(1, 1, At, B1); PG8_BAR; PG8_SCHED;
            PG8_LDB(B0, 1, 0); PG8_LDB(B1, 1, 1); PG8_SCHED; PG8_LDA(At, 1, 0); PG8_STAGE(PG8_SA(0, 1), a2 + hstep, voffA);
            PG8_WAIT_V(8); PG8_WAIT_L(0); PG8_BAR; PG8_MMA(0, 0, At, B0); PG8_MMA(0, 1, At, B1); PG8_BAR; PG8_SCHED;
            PG8_LDA(At, 1, 1); PG8_STAGE(PG8_SB(1, 0), b3, voffB); PG8_STAGE(PG8_SB(1, 1), b3 + hstep, voffB); PG8_STAGE(PG8_SA(1, 0), a3, voffA);
            PG8_WAIT_V(8); PG8_WAIT_L(0); PG8_BAR; PG8_MMA(1, 0, At, B0); PG8_MMA(1, 1, At, B1); PG8_BAR; PG8_SCHED;
            } else {
            PG8_LDB(B0, 0, 0); PG8_SCHED; PG8_LDA(At, 0, 0); PG8_STAGE(PG8_SA(1, 1), a1 + hstep, voffA);
            PG8_WAIT_L(8); PG8_BAR; PG8_WAIT_L(0); PG8_MMA(0, 0, At, B0); PG8_BAR; PG8_SCHED;
            PG8_LDB(B1, 0, 1); PG8_STAGE(PG8_SB(0, 0), b2, voffB);
            PG8_BAR; PG8_WAIT_L(0); PG8_MMA(0, 1, At, B1); PG8_BAR;
            PG8_LDA(At, 0, 1); PG8_STAGE(PG8_SA(0, 0), a2, voffA);
            PG8_BAR; PG8_WAIT_L(0); PG8_MMA(1, 0, At, B0); PG8_BAR; PG8_SCHED;
            PG8_STAGE(PG8_SB(0, 1), b2 + hstep, voffB);
            PG8_WAIT_V(6); PG8_BAR; PG8_MMA(1, 1, At, B1); PG8_BAR;
            PG8_LDB(B0, 1, 0); PG8_SCHED; PG8_LDA(At, 1, 0); PG8_STAGE(PG8_SA(0, 1), a2 + hstep, voffA);
            PG8_WAIT_L(8); PG8_BAR; PG8_WAIT_L(0); PG8_MMA(0, 0, At, B0); PG8_BAR; PG8_SCHED;
            PG8_LDB(B1, 1, 1); PG8_STAGE(PG8_SB(1, 0), b3, voffB);
            PG8_BAR; PG8_WAIT_L(0); PG8_MMA(0, 1, At, B1); PG8_BAR;
            PG8_LDA(At, 1, 1); PG8_STAGE(PG8_SA(1, 0), a3, voffA);
            PG8_BAR; PG8_WAIT_L(0); PG8_MMA(1, 0, At, B0); PG8_BAR; PG8_SCHED;
            PG8_STAGE(PG8_SB(1, 1), b3 + hstep, voffB);
            PG8_WAIT_V(6); PG8_BAR; PG8_MMA(1, 1, At, B1); PG8_BAR;
            }
        }
        if constexpr (ALIGN_EPI) { if (wr == 0) PG8_BAR; }
        if constexpr (!Epi::AFTER_DRAIN) { E(acc, cur, wr, wc, fr, fq); S.done(cur); }
        if (!has_next) break;
#pragma unroll
        for (int a = 0; a < 2; ++a)
#pragma unroll
            for (int b = 0; b < 2; ++b)
#pragma unroll
                for (int m = 0; m < 4; ++m)
#pragma unroll
                    for (int n = 0; n < 2; ++n) acc[a][b][m][n] = (f32x4){0.f, 0.f, 0.f, 0.f};
        cur = nxt; cA = nA; cB = nB; ++ui;
        if constexpr (ALIGN_EPI) { if (wr == 1) PG8_BAR; }
    }
    PG8_WAIT_V(0);
    if constexpr (!ALIGN_EPI) { if (wr == 0) PG8_BAR; }
    PG8_BAR;
    if constexpr (Epi::AFTER_DRAIN) { E.fused(acc, cur, wr, wc, fr, fq, lds, wid, lane); S.done(cur); }
#undef PG8_SA
#undef PG8_SB
#undef PG8_STAGE
#undef PG8_LDA
#undef PG8_LDB
#undef PG8_MMA
#undef PG8_WAIT_V
#undef PG8_WAIT_L
#undef PG8_BAR
#undef PG8_SCHED
}
}

#include <hip/hip_bf16.h>
#include <cmath>
namespace attn_body {
using bf16=__hip_bfloat16;
using bf16x8=__attribute__((ext_vector_type(8)))short;
using s16x4=__attribute__((ext_vector_type(4)))short;
using f32x16=__attribute__((ext_vector_type(16)))float;
using u32x4=__attribute__((ext_vector_type(4)))unsigned;
constexpr int D=64,QP=512,KP=128;
constexpr int NW=8,QBLK=32,QB=QBLK*NW,KVBLK=64;
constexpr int ATTN_UNIT_ROWS=QB;
__device__ __forceinline__ int crow(int r,int hi){return (r&3)+8*(r>>2)+4*hi;}
#define SBAR() __builtin_amdgcn_sched_barrier(0)
__device__ __forceinline__ void cmask(f32x16&p0,f32x16&p1,int jb,int qrel,int hi){
  const float NEG=-INFINITY; int kb=64*jb+4*hi;
  #pragma unroll
  for(int r=0;r<16;++r){int kv=kb+(r&3)+8*(r>>2); if(kv>qrel)p0[r]=NEG; if(kv+32>qrel)p1[r]=NEG;}
}

constexpr int NSLOT=3, SLOTB=8192;
constexpr int LDS_K=0, LDS_V=NSLOT*SLOTB, LDS_WS=2*NSLOT*SLOTB, LDS_OST=LDS_WS+NW*64*4, LDS_BYTES=LDS_OST+NW*4096;
constexpr float C2=0.125f*1.4426950408889634f;
__device__ __forceinline__ void glds16(const void*gsrc,unsigned lds_dst){unsigned keep;
  asm volatile("s_mov_b32 %0, m0\n\ts_mov_b32 m0, %2\n\ts_nop 0\n\tglobal_load_lds_dwordx4 %1, off\n\ts_mov_b32 m0, %0":"=&s"(keep):"v"(gsrc),"s"(lds_dst):"memory");}
__device__ __forceinline__ float max3f(float a,float b,float c){float r;asm("v_max3_f32 %0, %1, %2, %3":"=v"(r):"v"(a),"v"(b),"v"(c));return r;}
__device__ __forceinline__ float max2f(float a,float b){float r;asm("v_max_f32_e32 %0, %1, %2":"=v"(r):"v"(a),"v"(b));return r;}
__device__ __forceinline__ float fadd_s(float a,float b){float r;asm("v_add_f32_e32 %0, %1, %2":"=v"(r):"v"(a),"v"(b));return r;}
__device__ __forceinline__ float fsub_s(float a,float b){float r;asm("v_sub_f32_e32 %0, %1, %2":"=v"(r):"v"(a),"v"(b));return r;}
typedef float f32x2_t __attribute__((ext_vector_type(2))); typedef __bf16 bf16x2_t __attribute__((ext_vector_type(2)));
__device__ __forceinline__ unsigned cvtpk_s(float lo,float hi){f32x2_t v={lo,hi};bf16x2_t b=__builtin_convertvector(v,bf16x2_t);return __builtin_bit_cast(unsigned,b);}
#define WAIT_BAR(N) asm volatile("s_waitcnt vmcnt(" #N ") lgkmcnt(0)\n\ts_barrier":::"memory")

__device__ __forceinline__ void qkt(f32x16&p0,f32x16&p1,const char*Kslot,const bf16x8*qr,const f32x16&negm,int r32,int hi){
  const char*kb=Kslot+hi*1024+r32*16;
  #pragma unroll
  for(int d0=0;d0<4;++d0){
    const bf16x8 b0=*reinterpret_cast<const bf16x8*>(kb+d0*2048);
    const bf16x8 b1=*reinterpret_cast<const bf16x8*>(kb+d0*2048+512);
    if(d0==0){p0=__builtin_amdgcn_mfma_f32_32x32x16_bf16(b0,qr[0],negm,0,0,0);p1=__builtin_amdgcn_mfma_f32_32x32x16_bf16(b1,qr[0],negm,0,0,0);}
    else{p0=__builtin_amdgcn_mfma_f32_32x32x16_bf16(b0,qr[d0],p0,0,0,0);p1=__builtin_amdgcn_mfma_f32_32x32x16_bf16(b1,qr[d0],p1,0,0,0);}}
}
typedef __attribute__((address_space(3))) const char* lds_cptr;
typedef short v4i16_t __attribute__((ext_vector_type(4)));
__device__ __forceinline__ void kload8(bf16x8*kf,lds_cptr kp){
  kf[0]=*(const __attribute__((address_space(3))) bf16x8*)(kp);      kf[1]=*(const __attribute__((address_space(3))) bf16x8*)(kp+512);
  kf[2]=*(const __attribute__((address_space(3))) bf16x8*)(kp+2048); kf[3]=*(const __attribute__((address_space(3))) bf16x8*)(kp+2560);
  kf[4]=*(const __attribute__((address_space(3))) bf16x8*)(kp+4096); kf[5]=*(const __attribute__((address_space(3))) bf16x8*)(kp+4608);
  kf[6]=*(const __attribute__((address_space(3))) bf16x8*)(kp+6144); kf[7]=*(const __attribute__((address_space(3))) bf16x8*)(kp+6656);
}
__device__ __forceinline__ void kload2(bf16x8*kf,lds_cptr kp,int j){ kf[2*j]=*(const __attribute__((address_space(3))) bf16x8*)(kp+j*2048); kf[2*j+1]=*(const __attribute__((address_space(3))) bf16x8*)(kp+j*2048+512); }
__device__ __forceinline__ s16x4 vtr(lds_cptr p){ return __builtin_bit_cast(s16x4,__builtin_amdgcn_ds_read_tr16_b64_v4i16((__attribute__((address_space(3))) v4i16_t*)p)); }
__device__ __forceinline__ float rowmax(const f32x16&p0,const f32x16&p1){
  float a=max3f(p0[0],p0[1],p1[0]),b=max3f(p0[2],p0[3],p1[1]);a=max3f(a,p1[2],p1[3]);
  #pragma unroll
  for(int r=4;r<16;r+=4){a=max3f(a,p0[r],p0[r+1]);b=max3f(b,p0[r+2],p0[r+3]);a=max3f(a,p1[r],p1[r+1]);b=max3f(b,p1[r+2],p1[r+3]);}
  const float m=max2f(a,b);
  auto rr=__builtin_amdgcn_permlane32_swap(__float_as_uint(m),__float_as_uint(m),false,false);
  return max2f(__uint_as_float(rr[0]),__uint_as_float(rr[1]));
}
__device__ __forceinline__ void pv(f32x16*o,int vb,bf16x8 pa0,bf16x8 pa1,bf16x8 pa2,bf16x8 pa3){
  #pragma unroll
  for(int d0=0;d0<2;++d0){s16x4 lo[4],hi[4];
    #pragma unroll
    for(int ks=0;ks<4;++ks){
      asm volatile("ds_read_b64_tr_b16 %0,%1 offset:%c2":"=&v"(lo[ks]):"v"(vb),"i"(d0*4096+ks*1024):"memory");
      asm volatile("ds_read_b64_tr_b16 %0,%1 offset:%c2":"=&v"(hi[ks]):"v"(vb),"i"(d0*4096+ks*1024+512):"memory");}
    asm volatile("s_waitcnt lgkmcnt(0)":::"memory");SBAR();
    #define PK(k) (bf16x8){lo[k][0],lo[k][1],lo[k][2],lo[k][3],hi[k][0],hi[k][1],hi[k][2],hi[k][3]}
    o[d0]=__builtin_amdgcn_mfma_f32_32x32x16_bf16(pa0,PK(0),o[d0],0,0,0);
    o[d0]=__builtin_amdgcn_mfma_f32_32x32x16_bf16(pa1,PK(1),o[d0],0,0,0);
    o[d0]=__builtin_amdgcn_mfma_f32_32x32x16_bf16(pa2,PK(2),o[d0],0,0,0);
    o[d0]=__builtin_amdgcn_mfma_f32_32x32x16_bf16(pa3,PK(3),o[d0],0,0,0);
    #undef PK
  }
}

#ifndef ATTN_STORE16
#define ATTN_STORE16(p,v) (*(u32x4*)(p)=(v))
#endif
template<int THRL> __device__ __forceinline__ void attn_unit(const bf16*Qu,const bf16*__restrict__ Kh,const bf16*__restrict__ Vh,bf16*Ou,const int NT,char*shm){
  int tid_l=threadIdx.x; asm volatile("":"+v"(tid_l));
  const int tid=tid_l,lane=tid&63,r32=lane&31,hi=lane>>5; const int wid=__builtin_amdgcn_readfirstlane(tid>>6);
  const bf16*Qw=Qu+(long)(wid*QBLK)*QP;
  const unsigned lds0=(unsigned)(uintptr_t)shm;
  float*wsf=(float*)(shm+LDS_WS)+wid*64;
  const bf16*ksrc=Kh+(long)lane*KP+wid*8;
  const bf16*vsrc=Vh+(long)(16*(wid&3)+(lane>>2))*KP+(wid>>2)*32+(lane&3)*8;
  const unsigned kdst=lds0+LDS_K+wid*1024, vdst=lds0+LDS_V+wid*1024;
  #define DMA_K(t,slot) glds16(ksrc+(long)(t)*KVBLK*KP,(unsigned)__builtin_amdgcn_readfirstlane(kdst+(slot)))
  #define DMA_V(t,slot) glds16(vsrc+(long)(t)*KVBLK*KP,(unsigned)__builtin_amdgcn_readfirstlane(vdst+(slot)))
  const int vb0=(int)(lds0+LDS_V)+((lane>>4)&1)*32+(lane&3)*8+(4*hi+((lane&15)>>2))*64;
  const char*Kbase=shm+LDS_K; bf16x8 kf[8];
  const lds_cptr shm3=(lds_cptr)shm; const lds_cptr kp0=shm3+LDS_K+hi*1024+r32*16; const lds_cptr vp0=shm3+LDS_V+((lane>>4)&1)*32+(lane&3)*8+(4*hi+((lane&15)>>2))*64;
  DMA_K(0,0);DMA_V(0,0);DMA_K(1,SLOTB);
  bf16x8 qr[4];
  #pragma unroll
  for(int d0=0;d0<4;++d0)qr[d0]=*reinterpret_cast<const bf16x8*>(&Qw[(long)r32*QP+d0*16+hi*8]);
  float mhat=0.f,l_reg=0.f;f32x16 o[2];o[0]=f32x16{};o[1]=f32x16{};f32x16 negm=f32x16{};asm volatile("":"+v"(negm));
  #define CMASK(P0,P1,t) do{}while(0)
  bool resc=false;
  #define START(P0,P1) do{ const float rm=rowmax(P0,P1); resc=false; \
    { const float dl=rm; mhat=fadd_s(mhat,dl); \
      _Pragma("unroll") for(int r=0;r<16;++r){P0[r]=fsub_s(P0[r],dl);P1[r]=fsub_s(P1[r],dl);} \
      _Pragma("unroll") for(int r=0;r<16;++r)negm[r]=-mhat; asm volatile("":"+v"(negm)); } \
    _Pragma("unroll") for(int r=0;r<16;++r)P0[r]=__builtin_amdgcn_exp2f(P0[r]); }while(0)
  #define RESC() do{ if(resc){ asm volatile("s_waitcnt lgkmcnt(0)":::"memory"); \
      _Pragma("unroll") for(int d_=0;d_<2;++d_) _Pragma("unroll") for(int r=0;r<16;++r)o[d_][r]*=wsf[crow(r,hi)]; } }while(0)
  f32x16 pA0,pA1,pB0,pB1;
  int sl_prev=0,sl_cur=0,sl_next=SLOTB;
  #define ROT() do{sl_prev=sl_cur;sl_cur=sl_next;sl_next=(sl_next==(NSLOT-1)*SLOTB)?0:sl_next+SLOTB;}while(0)
  DMA_K(2,2*SLOTB);
  WAIT_BAR(3);
  qkt(pA0,pA1,Kbase,qr,negm,r32,hi);asm volatile("s_nop 15\n\ts_nop 7":"+v"(pA0),"+v"(pA1));CMASK(pA0,pA1,0);
  START(pA0,pA1);
  _Pragma("unroll") for(int r=0;r<16;++r)pA1[r]=__builtin_amdgcn_exp2f(pA1[r]);
  WAIT_BAR(0);
  DMA_K(3,0);DMA_V(1,SLOTB);
  ROT();
  kload8(kf,kp0+sl_cur);
  WAIT_BAR(2);
  s16x4 vlo[8],vhi[8]; u32x4 pw0,pw1,pw2,pw3;
  #define PKW(P,B) cvtpk_s(P[B],P[B+1])
  #define PAF(k) __builtin_bit_cast(bf16x8,pw##k)
  #define VFR(i) (bf16x8){vlo[i][0],vlo[i][1],vlo[i][2],vlo[i][3],vhi[i][0],vhi[i][1],vhi[i][2],vhi[i][3]}
  #define PIN(x) asm volatile("":"+v"(x))
  #define MX3(a,b,c) __builtin_fmaxf(__builtin_fmaxf((a),(b)),(c))
  #define GAPA(MF,A0,A1,A2,A3,W0,W1,PW) do{ MF; sacc+=A0; sacc+=A1; sacc+=A2; sacc+=A3; PIN(sacc); W0; W1; PIN(PW); SBAR(); }while(0)
  #define EX(v) __builtin_amdgcn_exp2f(v)
  #define GAPB(MF,X,B) do{ MF; X[B]=EX(X[B]); X[B+1]=EX(X[B+1]); X[B+2]=EX(X[B+2]); X[B+3]=EX(X[B+3]); PIN(X); SBAR(); }while(0)
  #define VRD(i) do{ vlo[i]=vtr(vp_+(((i)>>2)*4096+((i)&3)*1024)); vhi[i]=vtr(vp_+(((i)>>2)*4096+((i)&3)*1024+512)); }while(0)
  #define KRD(G,j) do{ if(G){ kload2(kf,kp0+sl_next,j); SBAR(); } }while(0)
  #define STEP(C0,C1,P0,P1,t,GK,GV,GL) do{ SBAR(); \
    const lds_cptr vp_=vp0+sl_prev; \
    VRD(0); SBAR(); float sacc=(P0[0]+P0[1]); \
    GAPA(C0=__builtin_amdgcn_mfma_f32_32x32x16_bf16(kf[0],qr[0],negm,0,0,0), P0[2],P0[3],P0[4],P0[5],     pw0[0]=PKW(P0,0), pw0[1]=PKW(P0,2), pw0); \
    VRD(4); SBAR(); GAPA(C1=__builtin_amdgcn_mfma_f32_32x32x16_bf16(kf[1],qr[0],negm,0,0,0), P0[6],P0[7],P0[8],P0[9],     pw0[2]=PKW(P0,4), pw0[3]=PKW(P0,6), pw0); \
    VRD(1); SBAR(); GAPA(C0=__builtin_amdgcn_mfma_f32_32x32x16_bf16(kf[2],qr[1],C0,0,0,0),   P0[10],P0[11],P0[12],P0[13], pw1[0]=PKW(P0,8), pw1[1]=PKW(P0,10), pw1); \
    VRD(5); SBAR(); GAPA(C1=__builtin_amdgcn_mfma_f32_32x32x16_bf16(kf[3],qr[1],C1,0,0,0),   P0[14],P0[15],P1[0],P1[1],   pw1[2]=PKW(P0,12),pw1[3]=PKW(P0,14), pw1); \
    VRD(2); SBAR(); GAPA(C0=__builtin_amdgcn_mfma_f32_32x32x16_bf16(kf[4],qr[2],C0,0,0,0),   P1[2],P1[3],P1[4],P1[5],     pw2[0]=PKW(P1,0), pw2[1]=PKW(P1,2), pw2); \
    VRD(6); SBAR(); GAPA(C1=__builtin_amdgcn_mfma_f32_32x32x16_bf16(kf[5],qr[2],C1,0,0,0),   P1[6],P1[7],P1[8],P1[9],     pw2[2]=PKW(P1,4), pw2[3]=PKW(P1,6), pw2); \
    VRD(3); SBAR(); GAPA(C0=__builtin_amdgcn_mfma_f32_32x32x16_bf16(kf[6],qr[3],C0,0,0,0),   P1[10],P1[11],P1[12],P1[13], pw3[0]=PKW(P1,8), pw3[1]=PKW(P1,10), pw3); \
    VRD(7); SBAR(); GAPA(C1=__builtin_amdgcn_mfma_f32_32x32x16_bf16(kf[7],qr[3],C1,0,0,0),   P1[14],P1[15],0.f,0.f,       pw3[2]=PKW(P1,12),pw3[3]=PKW(P1,14), pw3); \
    l_reg+=sacc; \
    if(GK){DMA_K((t)+3,sl_cur);} if(GV){DMA_V((t)+1,sl_next);} \
    CMASK(C0,C1,t); \
    { float a=MX3(C0[0],C0[1],C1[0]),b=MX3(C0[2],C0[3],C1[1]); a=MX3(a,C1[2],C1[3]); \
      _Pragma("unroll") for(int r=4;r<16;r+=4){a=MX3(a,C0[r],C0[r+1]);b=MX3(b,C0[r+2],C0[r+3]);a=MX3(a,C1[r],C1[r+1]);b=MX3(b,C1[r+2],C1[r+3]);} \
      float rm=__builtin_fmaxf(a,b); { auto rr=__builtin_amdgcn_permlane32_swap(__float_as_uint(rm),__float_as_uint(rm),false,false); rm=__builtin_fmaxf(__uint_as_float(rr[0]),__uint_as_float(rr[1])); } \
      resc=false; \
      if(__builtin_expect(__any(rm>(float)THRL),0)){ const float dl=__builtin_fmaxf(rm,0.f); mhat+=dl; \
        _Pragma("unroll") for(int r=0;r<16;++r){C0[r]-=dl;C1[r]-=dl;} \
        _Pragma("unroll") for(int r=0;r<16;++r)negm[r]=-mhat; asm volatile("":"+v"(negm)); \
        const float f=__builtin_amdgcn_exp2f(-dl); l_reg*=f; if(hi==0)wsf[r32]=f; resc=true; } } \
    SBAR(); \
    GAPB(o[0]=__builtin_amdgcn_mfma_f32_32x32x16_bf16(PAF(0),VFR(0),o[0],0,0,0), C0,0); \
    GAPB(o[1]=__builtin_amdgcn_mfma_f32_32x32x16_bf16(PAF(0),VFR(4),o[1],0,0,0), C0,4); \
    KRD(GL,0); GAPB(o[0]=__builtin_amdgcn_mfma_f32_32x32x16_bf16(PAF(1),VFR(1),o[0],0,0,0), C0,8); \
    KRD(GL,1); GAPB(o[1]=__builtin_amdgcn_mfma_f32_32x32x16_bf16(PAF(1),VFR(5),o[1],0,0,0), C0,12); \
    KRD(GL,2); GAPB(o[0]=__builtin_amdgcn_mfma_f32_32x32x16_bf16(PAF(2),VFR(2),o[0],0,0,0), C1,0); \
    KRD(GL,3); GAPB(o[1]=__builtin_amdgcn_mfma_f32_32x32x16_bf16(PAF(2),VFR(6),o[1],0,0,0), C1,4); \
    GAPB(o[0]=__builtin_amdgcn_mfma_f32_32x32x16_bf16(PAF(3),VFR(3),o[0],0,0,0), C1,8); \
    GAPB(o[1]=__builtin_amdgcn_mfma_f32_32x32x16_bf16(PAF(3),VFR(7),o[1],0,0,0), C1,12); \
    }while(0)
  int t=1;
  for(;t+5<NT;t+=2){
    STEP(pB0,pB1,pA0,pA1,t,true,true,true);     WAIT_BAR(2); RESC(); ROT();
    STEP(pA0,pA1,pB0,pB1,t+1,true,true,true);   WAIT_BAR(2); RESC(); ROT();
  }
  #define ENDW(tt) do{ if((tt)+3<NT){WAIT_BAR(2);} else if((tt)+2<NT){WAIT_BAR(1);} else {WAIT_BAR(0);} }while(0)
  for(;t+1<NT;t+=2){
    STEP(pB0,pB1,pA0,pA1,t,(t+3<NT),(t+1<NT),(t+1<NT));       ENDW(t);   RESC(); ROT();
    STEP(pA0,pA1,pB0,pB1,t+1,(t+4<NT),(t+2<NT),(t+2<NT));     ENDW(t+1); RESC(); ROT();
  }
  STEP(pB0,pB1,pA0,pA1,NT-1,false,false,false); RESC();
  { float sacc=pB0[0]+pB0[1]; _Pragma("unroll") for(int r=2;r<16;++r)sacc+=pB0[r]; _Pragma("unroll") for(int r=0;r<16;++r)sacc+=pB1[r]; l_reg+=sacc;
    pw0=(u32x4){PKW(pB0,0),PKW(pB0,2),PKW(pB0,4),PKW(pB0,6)};pw1=(u32x4){PKW(pB0,8),PKW(pB0,10),PKW(pB0,12),PKW(pB0,14)};pw2=(u32x4){PKW(pB1,0),PKW(pB1,2),PKW(pB1,4),PKW(pB1,6)};pw3=(u32x4){PKW(pB1,8),PKW(pB1,10),PKW(pB1,12),PKW(pB1,14)};
    SBAR(); pv(o,vb0+sl_cur,PAF(0),PAF(1),PAF(2),PAF(3)); }
  #undef PKW
  #undef PAF
  #undef VFR
  #undef PIN
  #undef MX3
  #undef GAPA
  #undef GAPB
  #undef EX
  #undef VRD
  #undef KRD
  #undef STEP
  #undef ENDW
  {auto rr=__builtin_amdgcn_permlane32_swap(__float_as_uint(l_reg),__float_as_uint(l_reg),false,false);l_reg=__uint_as_float(rr[0])+__uint_as_float(rr[1]);}
  if(hi==0)wsf[32+r32]=l_reg;asm volatile("s_waitcnt lgkmcnt(0)":::"memory");
  float rli[16];
  #pragma unroll
  for(int r=0;r<16;++r)rli[r]=__builtin_amdgcn_rcpf(wsf[32+crow(r,hi)]);
  bf16*Ow=Ou+(long)(wid*QBLK)*QP;
  { bf16*stg=(bf16*)(shm+LDS_OST)+wid*2048;
    #pragma unroll
    for(int r=0;r<16;++r){const int orow=crow(r,hi);
      #pragma unroll
      for(int d0=0;d0<2;++d0)stg[orow*64+d0*32+r32]=__float2bfloat16(o[d0][r]*rli[r]);}
    asm volatile("s_waitcnt lgkmcnt(0)":::"memory");
    #pragma unroll
    for(int i=0;i<4;++i){const int row=i*8+(lane>>3),ch=lane&7; const u32x4 v=*(const u32x4*)(stg+row*64+ch*8); ATTN_STORE16(Ow+(long)row*QP+ch*8,v);} }
  asm volatile("s_waitcnt lgkmcnt(0)\n\ts_barrier":::"memory");
  #undef DMA_K
  #undef DMA_V
  #undef CMASK
  #undef START
  #undef RESC
  #undef ROT
}
constexpr int ATTN_LDS_BYTES=LDS_BYTES;
#undef SBAR
#undef WAIT_BAR
}

#define XB_TMO      128
#define XB_XCNT(j)  (256  + 64 * (j))
#define XB_XSUB(j)  (1280 + 64 * (j))
#define XB_XGEN(j)  (2304 + 64 * (j))
#define XB_TOP      3328
#define XB_TOPGEN   3392
#define XCD_BAR_WORDS 3456
#define XB_SPIN_CAP (1u << 18)

__device__ __forceinline__ unsigned xb_ld(unsigned* p)              { return __hip_atomic_load(p, __ATOMIC_RELAXED, __HIP_MEMORY_SCOPE_AGENT); }
__device__ __forceinline__ unsigned xb_add(unsigned* p, unsigned v) { return __hip_atomic_fetch_add(p, v, __ATOMIC_RELAXED, __HIP_MEMORY_SCOPE_AGENT); }
__device__ __forceinline__ unsigned xb_xcc_id() { return (unsigned)__builtin_amdgcn_s_getreg((3 << 11) | 20) & 0xFu; }
#define XB_SPIN(cond, bar) do { unsigned _sp = 0; while (cond) { __builtin_amdgcn_s_sleep(1); \
    if ((++_sp & 255u) == 0u) { if (xb_ld(&(bar)[XB_TMO])) break; if (_sp > XB_SPIN_CAP) { atomicAdd(&(bar)[XB_TMO], 1u); break; } } } } while (0)

struct XcdBarrier {
    unsigned* bar; unsigned x;
    volatile LAS unsigned* st;
};

__device__ __forceinline__ XcdBarrier xcd_barrier_post(unsigned* bar, volatile LAS unsigned* st) {
    XcdBarrier b; b.bar = bar; b.x = xb_xcc_id(); b.st = st;
    if (threadIdx.x == 0) (void)xb_add(&bar[XB_XCNT(b.x)], 1u);
    return b;
}
__device__ __forceinline__ void xcd_barrier_complete(unsigned* bar, unsigned x, unsigned& nloc, unsigned& nx) {
    const unsigned G = gridDim.x * gridDim.y * gridDim.z;
    unsigned sum, cnt, mine, sp = 0u;
    for (;;) {
        sum = 0u; cnt = 0u; mine = 0u;
#pragma unroll
        for (unsigned j = 0; j < 16; ++j) { const unsigned c = xb_ld(&bar[XB_XCNT(j)]); sum += c; cnt += (c > 0u) ? 1u : 0u; mine = (j == x) ? c : mine; }
        if (sum == G) break;
        __builtin_amdgcn_s_sleep(1);
        if ((++sp & 255u) == 0u) { if (xb_ld(&bar[XB_TMO])) break; if (sp > XB_SPIN_CAP) { atomicAdd(&bar[XB_TMO], 1u); break; } }
    }
    nloc = mine > 0u ? mine : 1u; nx = cnt > 0u ? cnt : 1u;
}

__device__ __forceinline__ void xcd_barrier(const XcdBarrier& b) {
    asm volatile("s_waitcnt vmcnt(0)" ::: "memory");
    __syncthreads();
    if (threadIdx.x == 0) {
        unsigned* bar = b.bar;
        __builtin_amdgcn_s_waitcnt(0);
        unsigned nloc = b.st[0], nx = b.st[1];
        if (nloc == 0u) { xcd_barrier_complete(bar, b.x, nloc, nx); b.st[0] = nloc; b.st[1] = nx; }
        const unsigned old = xb_add(&bar[XB_XSUB(b.x)], 1u);
        const unsigned gen = old / nloc;
        if (old + 1u == (gen + 1u) * nloc) {
            __builtin_amdgcn_fence(__ATOMIC_RELEASE, "agent");
            asm volatile("s_waitcnt vmcnt(0)" ::: "memory");
            const unsigned og = xb_add(&bar[XB_TOP], 1u);
            const unsigned tg = og / nx;
            if (og + 1u == (tg + 1u) * nx) xb_add(&bar[XB_TOPGEN], 1u);
            else XB_SPIN(xb_ld(&bar[XB_TOPGEN]) == tg, bar);
            __builtin_amdgcn_fence(__ATOMIC_ACQUIRE, "agent");
            xb_add(&bar[XB_XGEN(b.x)], 1u);
            asm volatile("s_waitcnt vmcnt(0)" ::: "memory");
        } else {
            XB_SPIN(xb_ld(&bar[XB_XGEN(b.x)]) == gen, bar);
            __builtin_amdgcn_fence(__ATOMIC_ACQUIRE, "agent");
            asm volatile("s_waitcnt vmcnt(0)" ::: "memory");
        }
    }
    __syncthreads();
}

struct Args { const GAS float* in[33]; GAS float* out; unsigned char* ws; int mode, l, site, chunk; };
struct Frame {
    LAS unsigned char* lds; volatile LAS unsigned* MISC; gu32* ctl;
    int tid, lane, wave, vcu, G;
    unsigned char* ws; GAS float* out;
};
#define WSP(T, off) ((GAS T*)(F.ws + (off)))
#define WSGEN(T, off) ((T*)(F.ws + (off)))
__device__ __forceinline__ const GAS float* inptr(LAS unsigned char* lds, int i) { const LAS unsigned* p = (const LAS unsigned*)(lds + PTAB_OFF) + 2 * i; const unsigned lo = __builtin_amdgcn_readfirstlane(p[0]), hi = __builtin_amdgcn_readfirstlane(p[1]); return (const GAS float*)(((unsigned long long)hi << 32) | lo); }
#define INP(i) inptr(F.lds, (i))

__device__ __forceinline__ void conv_item(const GAS float* W, int Nsrc, int k0, int c0, GAS bf16* WT, int K, int drow0, LAS float* scr, int lane) {
#pragma unroll
    for (int i = 0; i < 8; ++i) { const int kk = 8 * i + (lane >> 3), nn = 4 * (lane & 7); const f32x4 v = *(const GAS f32x4*)(W + (size_t)(k0 + kk) * Nsrc + c0 + nn);
        scr[kk * 33 + nn] = v.x; scr[kk * 33 + nn + 1] = v.y; scr[kk * 33 + nn + 2] = v.z; scr[kk * 33 + nn + 3] = v.w; }
    LDS_WAIT(); asm volatile("" ::: "memory");
    const int c = lane & 7;
#pragma unroll
    for (int j = 0; j < 4; ++j) { const int n = (lane >> 3) + 8 * j; const LAS float* s = scr + (8 * c) * 33 + n;
        v4u o; o.x = pk2(s[0 * 33], s[1 * 33]); o.y = pk2(s[2 * 33], s[3 * 33]); o.z = pk2(s[4 * 33], s[5 * 33]); o.w = pk2(s[6 * 33], s[7 * 33]);
        *(GAS v4u*)(WT + (size_t)(drow0 + n) * K + k0 + 8 * c) = o; }
    LDS_WAIT(); asm volatile("" ::: "memory");
}
__device__ __forceinline__ void conv_plain(int item, const GAS float* W, int K, int N, GAS bf16* WT, LAS float* scr, int lane) {
    const int ng = N / 32, kb = item / ng, g = item % ng; conv_item(W, N, 64 * kb, 32 * g, WT, K, 32 * g, scr, lane);
}
__device__ __forceinline__ void conv_gu(int item, const GAS float* W, GAS bf16* WT, int off, LAS float* scr, int lane) {
    const int ng = FF / 32, kb = item / ng, g = item % ng; conv_item(W, FF, 64 * kb, 32 * g, WT, DM, 256 * (g >> 2) + off + 32 * (g & 3), scr, lane);
}
__device__ __forceinline__ void mod_task(Frame& F, int task) {
    const int l = task / 96, nb = task % 96;
    LAS float* S = (LAS float*)F.lds;
    for (int i = F.tid; i < 33 * 1024; i += 512) { const int bi = i >> 10, k = i & 1023; const float c = bi < 32 ? INP(1)[bi * 1024 + k] : INP(3)[k]; S[k * 33 + bi] = c / (1.0f + __expf(-c)); }
    __syncthreads();
    const GAS float* W = INP(4) + (size_t)l * DM * 6144 + nb * 64 + F.lane;
    float acc[33];
#pragma unroll
    for (int bi = 0; bi < 33; ++bi) acc[bi] = 0.f;
    const int k0 = F.wave * 128;
    for (int k = k0; k < k0 + 128; ++k) { const float w = W[(size_t)k * 6144];
#pragma unroll
        for (int bi = 0; bi < 33; ++bi) acc[bi] = fmaf(S[k * 33 + bi], w, acc[bi]); }
    __syncthreads();
    LAS float* P = (LAS float*)F.lds;
#pragma unroll
    for (int bi = 0; bi < 33; ++bi) P[(F.wave * 33 + bi) * 64 + F.lane] = acc[bi];
    __syncthreads();
    GAS float* mod = WSP(float, WS_MOD);
    for (int o = F.tid; o < 33 * 64; o += 512) { const int bi = o >> 6, cc = o & 63; float s = 0.f;
#pragma unroll
        for (int w = 0; w < 8; ++w) s += P[(w * 33 + bi) * 64 + cc];
        const int n = nb * 64 + cc; mod[(size_t)(l * 33 + bi) * 6144 + n] = s + INP(5)[l * 6144 + n]; }
    __syncthreads();
}
__device__ __forceinline__ void p0_prologue(Frame& F) {
    for (int t = F.vcu; t < 192; t += F.G) mod_task(F, t);
    if (F.vcu == F.G - 1) { GAS float* rt = WSP(float, WS_ROPE);
        for (int i = F.tid; i < 1024; i += 512) { const int pos = i >> 4, f = i & 15; const float inv = powf(10000.0f, -(float)f / 16.0f); const float a = (float)pos * inv; rt[i] = cosf(a); rt[1024 + i] = sinf(a); } }
    LAS float* scr = (LAS float*)(F.lds + F.wave * 8448);
    const int gw = F.vcu * NWAVES + F.wave, NGW = F.G * NWAVES;
    constexpr int I_IN = 16 * 144, I_P = 8 * 32, I_O = 16 * 32, I_GU = 16 * 112, I_DN = 56 * 32, I_L = 16, I_G2 = 32;
    constexpr int NITEMS = 2 * I_IN + 4 * I_P + 2 * I_O + 2 * I_GU + I_DN + 8 * I_L + 2 * I_G2;
    GAS bf16* lora = WSP(bf16, WS_LORA);
    for (int it = gw; it < NITEMS; it += NGW) {
        int r = it;
        if (r < 2 * I_IN) { const int l = r / I_IN; conv_plain(r % I_IN, INP(8) + (size_t)l * DM * NIN, DM, NIN, WSP(bf16, WS_WIN) + (size_t)l * NIN * DM, scr, F.lane); continue; } r -= 2 * I_IN;
        if (r < 2 * I_P) { const int l = r / I_P; conv_plain(r % I_P, INP(22) + (size_t)l * RW * DM, RW, DM, WSP(bf16, WS_WPA) + (size_t)l * DM * RW, scr, F.lane); continue; } r -= 2 * I_P;
        if (r < 2 * I_P) { const int l = r / I_P; conv_plain(r % I_P, INP(23) + (size_t)l * RW * DM, RW, DM, WSP(bf16, WS_WPB) + (size_t)l * DM * RW, scr, F.lane); continue; } r -= 2 * I_P;
        if (r < 2 * I_O) { const int l = r / I_O; conv_plain(r % I_O, INP(24) + (size_t)l * DM * DM, DM, DM, WSP(bf16, WS_WO) + (size_t)l * DM * DM, scr, F.lane); continue; } r -= 2 * I_O;
        if (r < I_GU) { conv_gu(r, INP(25), WSP(bf16, WS_WGU), 0, scr, F.lane); continue; } r -= I_GU;
        if (r < I_GU) { conv_gu(r, INP(26), WSP(bf16, WS_WGU), 128, scr, F.lane); continue; } r -= I_GU;
        if (r < I_DN) { conv_plain(r, INP(27), FF, DM, WSP(bf16, WS_WDN), scr, F.lane); continue; } r -= I_DN;
        if (r < 4 * I_L) { const int ld = r / I_L; conv_plain(r % I_L, INP(11) + (size_t)ld * 64 * RW, 64, RW, lora + (size_t)ld * RW * 64, scr, F.lane); continue; } r -= 4 * I_L;
        if (r < 4 * I_L) { const int ld = r / I_L; conv_plain(r % I_L, INP(13) + (size_t)ld * 64 * RW, 64, RW, lora + (size_t)(4 + ld) * RW * 64, scr, F.lane); continue; } r -= 4 * I_L;
        { const int l = r / I_G2; conv_plain(r % I_G2, INP(14) + (size_t)l * 128 * RW, 128, RW, lora + (size_t)8 * RW * 64 + (size_t)l * RW * 128, scr, F.lane); }
    }
}
__device__ __forceinline__ void moe_conv(Frame& F) {
    LAS float* scr = (LAS float*)(F.lds + F.wave * 8448);
    const int gw = F.vcu * NWAVES + F.wave, NGW = F.G * NWAVES;
    constexpr int I_GU = 16 * 112, I_DN = 56 * 32, I_E = 2 * I_GU + I_DN;
    for (int it = gw; it < NE * I_E; it += NGW) {
        const int e = it / I_E; int r = it % I_E; GAS bf16* base = WSP(bf16, WS_MW) + (size_t)e * (21 * MiB / 2);
        if (r < I_GU) { conv_gu(r, INP(29) + (size_t)e * DM * FF, base, 0, scr, F.lane); continue; } r -= I_GU;
        if (r < I_GU) { conv_gu(r, INP(30) + (size_t)e * DM * FF, base, 128, scr, F.lane); continue; } r -= I_GU;
        conv_plain(r, INP(31) + (size_t)e * FF * DM, FF, DM, base + (size_t)2 * FF * DM, scr, F.lane);
    }
}

template <bool ROUTER>
__device__ __forceinline__ void norm_mod_phase(Frame& F, int l, int which, const GAS float* xlat, const GAS float* xctx, int nrows, GAS bf16* H) {
    const int gw = F.vcu * NWAVES + F.wave, NGW = F.G * NWAVES;
    const GAS float* gain = INP(which ? 7 : 6) + l * DM;
    const GAS float* modl = WSP(float, WS_MOD) + (size_t)l * 33 * 6144 + (which ? 3072 : 0);
    for (int m = gw; m < nrows; m += NGW) {
        const GAS float* xr = m < NL ? xlat + (size_t)m * DM : xctx + (size_t)(m - NL) * DM;
        const GAS float* mv = modl + (size_t)row_bi(m) * 6144;
        f32x4 v[4]; float s = 0.f;
#pragma unroll
        for (int j = 0; j < 4; ++j) { v[j] = *(const GAS f32x4*)(xr + 4 * F.lane + 256 * j); s += (v[j].x * v[j].x + v[j].y * v[j].y) + (v[j].z * v[j].z + v[j].w * v[j].w); }
        const float rstd = rsq_(wave_sum(s) * (1.0f / DM) + 1e-6f);
        float lg[8];
        if (ROUTER) {
#pragma unroll
            for (int e = 0; e < 8; ++e) lg[e] = 0.f; }
#pragma unroll
        for (int j = 0; j < 4; ++j) { const int c = 4 * F.lane + 256 * j;
            const f32x4 g = *(const GAS f32x4*)(gain + c), sh = *(const GAS f32x4*)(mv + c), sc = *(const GAS f32x4*)(mv + 1024 + c);
            const f32x4 hv = v[j] * rstd * g * (sc + 1.0f) + sh;
            v2u o; o.x = pk2(hv.x, hv.y); o.y = pk2(hv.z, hv.w);
            *(GAS v2u*)(H + (size_t)m * DM + c) = o;
            if (ROUTER) { const GAS float* rw = INP(28) + (size_t)c * 8;
#pragma unroll
                for (int q = 0; q < 4; ++q) { const f32x4 r0 = *(const GAS f32x4*)(rw + q * 8), r1 = *(const GAS f32x4*)(rw + q * 8 + 4); const float hq = hv[q];
                    lg[0] = fmaf(hq, r0.x, lg[0]); lg[1] = fmaf(hq, r0.y, lg[1]); lg[2] = fmaf(hq, r0.z, lg[2]); lg[3] = fmaf(hq, r0.w, lg[3]);
                    lg[4] = fmaf(hq, r1.x, lg[4]); lg[5] = fmaf(hq, r1.y, lg[5]); lg[6] = fmaf(hq, r1.z, lg[6]); lg[7] = fmaf(hq, r1.w, lg[7]); } }
        }
        if (ROUTER) {
#pragma unroll
            for (int e = 0; e < 8; ++e) lg[e] = wave_sum(lg[e]);
            int e0 = 0; float l0 = lg[0];
#pragma unroll
            for (int e = 1; e < 8; ++e) if (lg[e] > l0) { l0 = lg[e]; e0 = e; }
            int e1 = -1; float l1 = -INFINITY;
#pragma unroll
            for (int e = 0; e < 8; ++e) if (e != e0 && lg[e] > l1) { l1 = lg[e]; e1 = e; }
            const float w1 = rcp_(1.0f + __expf(l0 - l1)), w0 = 1.0f - w1;
            if (F.lane == 0) {
                GAS int* te = (GAS int*)(F.ws + WS_MOETAB + MT_TOKE) + 2 * m; GAS float* tw = (GAS float*)(F.ws + WS_MOETAB + MT_TOKW) + 2 * m;
                te[0] = e0; te[1] = e1; tw[0] = w0; tw[1] = w1;
                __hip_atomic_fetch_add((LAS unsigned*)&F.MISC[16 + e0], 1u, __ATOMIC_RELAXED, __HIP_MEMORY_SCOPE_WORKGROUP); __hip_atomic_fetch_add((LAS unsigned*)&F.MISC[16 + e1], 1u, __ATOMIC_RELAXED, __HIP_MEMORY_SCOPE_WORKGROUP);
            }
        }
    }
    if (ROUTER) { __syncthreads(); if (F.tid < 8) { const unsigned c = F.MISC[16 + F.tid]; if (c) __hip_atomic_fetch_add(F.ctl + CW_HIST + 64 * F.tid, c, RLX_AGENT); } __syncthreads(); }
}

using pg8::Unit;
struct EpiIn {
    static constexpr bool PERM = true, AFTER_DRAIN = false;
    GAS bf16 *PR, *Q, *KB, *VB, *G;
    __device__ __forceinline__ void operator()(const f32x4 (&acc)[2][2][4][2], const Unit& u, int wr, int wc, int fr, int fq) const {
        const int row0 = u.pm * 256 + wr * 64 + fr, cb = wc * 32 + 8 * fq, pn = u.pn;
#pragma unroll
        for (int ai = 0; ai < 2; ++ai)
#pragma unroll
            for (int m = 0; m < 4; ++m) { const int r = row0 + ai * 128 + m * 16;
#pragma unroll
                for (int bj = 0; bj < 2; ++bj) { f32x4 v0 = acc[ai][bj][m][0], v1 = acc[ai][bj][m][1]; GAS bf16* dst;
                    if (pn < 7) dst = PR + (size_t)r * RCOLS + pn * 256 + bj * 128 + cb;
                    else if (pn < 9) dst = Q + (size_t)r * 512 + (pn - 7) * 256 + bj * 128 + cb;
                    else if (pn == 9) dst = (bj == 0 ? KB : VB) + (size_t)row_kv(r) * 128 + cb;
                    else { dst = G + (size_t)r * GCOLS + (pn - 10) * 256 + bj * 128 + cb;
#pragma unroll
                        for (int q = 0; q < 4; ++q) { v0[q] = sigmoidf_(v0[q]); v1[q] = sigmoidf_(v1[q]); } }
                    v4u w; w.x = pk2(v0[0], v0[1]); w.y = pk2(v0[2], v0[3]); w.z = pk2(v1[0], v1[1]); w.w = pk2(v1[2], v1[3]);
                    *(GAS v4u*)dst = w; } }
    }
};
template <int MODE> struct EpiMerge {
    static constexpr bool PERM = true, AFTER_DRAIN = false;
    const GAS bf16* G; GAS bf16* MG;
    __device__ __forceinline__ void operator()(const f32x4 (&acc)[2][2][4][2], const Unit& u, int wr, int wc, int fr, int fq) const {
        const int row0 = u.pm * 256 + wr * 64 + fr, col0 = u.pn * 256 + wc * 32 + 8 * fq;
#pragma unroll
        for (int ai = 0; ai < 2; ++ai)
#pragma unroll
            for (int m = 0; m < 4; ++m) { const int r = row0 + ai * 128 + m * 16;
#pragma unroll
                for (int bj = 0; bj < 2; ++bj) { const int c = col0 + bj * 128;
                    const v4u g = *(const GAS v4u*)(G + (size_t)r * GCOLS + MODE * DM + c);
                    const f32x4 a0 = acc[ai][bj][m][0], a1 = acc[ai][bj][m][1];
                    float o[8] = { bflo(g.x) * a0[0], bfhi(g.x) * a0[1], bflo(g.y) * a0[2], bfhi(g.y) * a0[3], bflo(g.z) * a1[0], bfhi(g.z) * a1[1], bflo(g.w) * a1[2], bfhi(g.w) * a1[3] };
                    GAS bf16* dst = MG + (size_t)r * DM + c;
                    if (MODE == 1) { const v4u p = *(const GAS v4u*)dst; o[0] += bflo(p.x); o[1] += bfhi(p.x); o[2] += bflo(p.y); o[3] += bfhi(p.y); o[4] += bflo(p.z); o[5] += bfhi(p.z); o[6] += bflo(p.w); o[7] += bfhi(p.w); }
                    v4u w; w.x = pk2(o[0], o[1]); w.y = pk2(o[2], o[3]); w.z = pk2(o[4], o[5]); w.w = pk2(o[6], o[7]);
                    *(GAS v4u*)dst = w; } }
    }
};
struct EpiRes {
    static constexpr bool PERM = false, AFTER_DRAIN = false;
    const GAS float *base_lat, *base_ctx; GAS float *out_lat, *out_ctx; const GAS float* gt;
    __device__ __forceinline__ void operator()(const f32x4 (&acc)[2][2][4][2], const Unit& u, int wr, int wc, int fr, int fq) const {
        const bool lat = u.pm < NL / 256; const int bi = lat ? (u.pm >> 3) : 32;
        const int rr0 = (lat ? u.pm * 256 : u.pm * 256 - NL) + wr * 64 + fr, col0 = u.pn * 256 + wc * 32 + 4 * fq;
        const GAS float* bp = lat ? base_lat : base_ctx; GAS float* op = lat ? out_lat : out_ctx; const GAS float* gv = gt + (size_t)bi * 6144 + col0;
        f32x4 g[2][2];
#pragma unroll
        for (int bj = 0; bj < 2; ++bj)
#pragma unroll
            for (int n = 0; n < 2; ++n) g[bj][n] = *(const GAS f32x4*)(gv + bj * 128 + n * 16);
#pragma unroll
        for (int ai = 0; ai < 2; ++ai)
#pragma unroll
            for (int m = 0; m < 4; ++m) { const size_t off = (size_t)(rr0 + ai * 128 + m * 16) * DM + col0;
#pragma unroll
                for (int bj = 0; bj < 2; ++bj)
#pragma unroll
                    for (int n = 0; n < 2; ++n) { const f32x4 b = *(const GAS f32x4*)(bp + off + bj * 128 + n * 16); *(GAS f32x4*)(op + off + bj * 128 + n * 16) = b + g[bj][n] * acc[ai][bj][m][n]; }
                asm volatile("" ::: "memory"); }
    }
};
struct EpiGU {
    static constexpr bool PERM = true, AFTER_DRAIN = false;
    GAS bf16* ACT; int pm0;
    __device__ __forceinline__ void operator()(const f32x4 (&acc)[2][2][4][2], const Unit& u, int wr, int wc, int fr, int fq) const {
        const int row0 = (u.pm - pm0) * 256 + wr * 64 + fr, col0 = u.pn * 128 + wc * 32 + 8 * fq;
#pragma unroll
        for (int ai = 0; ai < 2; ++ai)
#pragma unroll
            for (int m = 0; m < 4; ++m) { const int r = row0 + ai * 128 + m * 16; float o[8];
#pragma unroll
                for (int n = 0; n < 2; ++n)
#pragma unroll
                    for (int q = 0; q < 4; ++q) { const float gte = acc[ai][0][m][n][q], up = acc[ai][1][m][n][q]; o[4 * n + q] = gte * sigmoidf_(gte) * up; }
                v4u w; w.x = pk2(o[0], o[1]); w.y = pk2(o[2], o[3]); w.z = pk2(o[4], o[5]); w.w = pk2(o[6], o[7]);
                *(GAS v4u*)(ACT + (size_t)r * FF + col0) = w; }
    }
};
struct EpiStore {
    static constexpr bool PERM = true, AFTER_DRAIN = false;
    GAS bf16* O;
    __device__ __forceinline__ void operator()(const f32x4 (&acc)[2][2][4][2], const Unit& u, int wr, int wc, int fr, int fq) const {
        const int row0 = u.pm * 256 + wr * 64 + fr, col0 = u.pn * 256 + wc * 32 + 8 * fq;
#pragma unroll
        for (int ai = 0; ai < 2; ++ai)
#pragma unroll
            for (int m = 0; m < 4; ++m) { const int r = row0 + ai * 128 + m * 16;
#pragma unroll
                for (int bj = 0; bj < 2; ++bj) { const f32x4 v0 = acc[ai][bj][m][0], v1 = acc[ai][bj][m][1];
                    v4u w; w.x = pk2(v0[0], v0[1]); w.y = pk2(v0[2], v0[3]); w.z = pk2(v1[0], v1[1]); w.w = pk2(v1[2], v1[3]);
                    *(GAS v4u*)(O + (size_t)r * DM + col0 + bj * 128) = w; } }
    }
};
struct MoeOrder {
    const char* A; const char* W; size_t a_tstep, b_tstep, w_estep; int tile0, a_tile0, ntl, nN, G, c; const LAS int* tile_e;
    __device__ bool next(int i, Unit& u) const { const long L = (long)i * G + c; if (L >= (long)ntl * nN) return false; u.pn = (int)(L / ntl); u.pm = tile0 + (int)(L % ntl); return true; }
    __device__ __forceinline__ const char* a_base(const Unit& u) const { return A + (size_t)(u.pm - a_tile0) * a_tstep; }
    __device__ __forceinline__ const char* b_base(const Unit& u) const { return W + (size_t)tile_e[u.pm] * w_estep + (size_t)u.pn * b_tstep; }
    __device__ __forceinline__ void a_ready(const Unit&) const {}
    __device__ __forceinline__ void done(const Unit&) const {}
};

__device__ __forceinline__ void qk_phase(Frame& F, int l) {
    const int gw = F.vcu * NWAVES + F.wave, NGW = F.G * NWAVES, lane = F.lane, d0 = 8 * (lane & 7);
    const GAS float* rt = WSP(float, WS_ROPE);
    GAS bf16* Q = WSP(bf16, WS_Q); GAS bf16* KB = WSP(bf16, WS_KB);
    float gq[8], gk[8];
#pragma unroll
    for (int e = 0; e < 8; ++e) { gq[e] = INP(20)[l * 64 + d0 + e]; gk[e] = INP(21)[l * 64 + d0 + e]; }
    for (int m = gw; m < MA; m += NGW) {
        const bool lat = m < NL; const int t = m & 2047, pr = t >> 6, pc = t & 63;
        float cs[4], sn[4];
        if (lat) {
#pragma unroll
            for (int pi = 0; pi < 4; ++pi) { const int i = 4 * (lane & 7) + pi, pos = i < 16 ? pr : pc, f = i & 15; cs[pi] = rt[pos * 16 + f]; sn[pi] = rt[1024 + pos * 16 + f]; } }
        { GAS bf16* p = Q + (size_t)m * 512 + 8 * lane; const v4u w = *(const GAS v4u*)p;
          float x[8] = { bflo(w.x), bfhi(w.x), bflo(w.y), bfhi(w.y), bflo(w.z), bfhi(w.z), bflo(w.w), bfhi(w.w) };
          float ss = 0.f;
#pragma unroll
          for (int e = 0; e < 8; ++e) ss += x[e] * x[e];
          ss += __shfl_xor(ss, 1); ss += __shfl_xor(ss, 2); ss += __shfl_xor(ss, 4);
          const float r = rsq_(ss * (1.0f / 64.0f) + 1e-6f);
#pragma unroll
          for (int e = 0; e < 8; ++e) x[e] = x[e] * r * gq[e];
          if (lat) {
#pragma unroll
              for (int pi = 0; pi < 4; ++pi) { const float x0 = x[2 * pi], x1 = x[2 * pi + 1]; x[2 * pi] = x0 * cs[pi] - x1 * sn[pi]; x[2 * pi + 1] = x0 * sn[pi] + x1 * cs[pi]; } }
          const float C2 = attn_body::C2;
          v4u o; o.x = pk2(x[0] * C2, x[1] * C2); o.y = pk2(x[2] * C2, x[3] * C2); o.z = pk2(x[4] * C2, x[5] * C2); o.w = pk2(x[6] * C2, x[7] * C2);
          *(GAS v4u*)p = o; }
        { GAS bf16* p = KB + (size_t)row_kv(m) * 128 + 8 * (lane & 15); v4u w = (v4u){0u, 0u, 0u, 0u}; if (lane < 16) w = *(const GAS v4u*)p;
          float x[8] = { bflo(w.x), bfhi(w.x), bflo(w.y), bfhi(w.y), bflo(w.z), bfhi(w.z), bflo(w.w), bfhi(w.w) };
          float ss = 0.f;
#pragma unroll
          for (int e = 0; e < 8; ++e) ss += x[e] * x[e];
          ss += __shfl_xor(ss, 1); ss += __shfl_xor(ss, 2); ss += __shfl_xor(ss, 4);
          const float r = rsq_(ss * (1.0f / 64.0f) + 1e-6f);
#pragma unroll
          for (int e = 0; e < 8; ++e) x[e] = x[e] * r * gk[e];
          if (lat) {
#pragma unroll
              for (int pi = 0; pi < 4; ++pi) { const float x0 = x[2 * pi], x1 = x[2 * pi + 1]; x[2 * pi] = x0 * cs[pi] - x1 * sn[pi]; x[2 * pi + 1] = x0 * sn[pi] + x1 * cs[pi]; } }
          v4u o; o.x = pk2(x[0], x[1]); o.y = pk2(x[2], x[3]); o.z = pk2(x[4], x[5]); o.w = pk2(x[6], x[7]);
          if (lane < 16) *(GAS v4u*)p = o; }
    }
}

constexpr int SC_RAW = 0, SC_SV = 11520, SC_KT = SC_SV + 24576, SC_KK = SC_KT + 4096, SC_TWA = SC_KK + 4096, SC_ADA = SC_TWA + 2304, SC_YO = SC_ADA + 2304, SC_BON = SC_YO + 4096, SC_DIR = SC_BON + 256;
static_assert(2 * SC_DIR <= RING_BYTES, "scan LDS");
__device__ __forceinline__ float dpp_quad_sum(float v) {
    v += __builtin_bit_cast(float, __builtin_amdgcn_mov_dpp(__builtin_bit_cast(int, v), 0xB1, 0xF, 0xF, true));
    v += __builtin_bit_cast(float, __builtin_amdgcn_mov_dpp(__builtin_bit_cast(int, v), 0x4E, 0xF, 0xF, true));
    return v;
}
__device__ __forceinline__ void scan_phase(Frame& F, int l) {
    const int d = F.tid >> 8, dt = F.tid & 255, w4 = F.wave & 3, lane = F.lane;
    LAS unsigned char* L = F.lds + d * SC_DIR;
    LAS float* SV = (LAS float*)(L + SC_SV); LAS float* KT = (LAS float*)(L + SC_KT); LAS float* KK = (LAS float*)(L + SC_KK);
    LAS float* YO = (LAS float*)(L + SC_YO); LAS float* BON = (LAS float*)(L + SC_BON);
    const GAS bf16* PR = WSP(bf16, WS_PR);
    GAS bf16* Yd = WSP(bf16, d == 0 ? WS_YF : WS_YB);
    GAS float* bonus = WSP(float, WS_BONUS) + (size_t)d * MA * 8;
    const int j = dt >> 4, cg = dt & 15;
    const int st_j = d == 0 ? j : 15 - j;
    for (int p = F.vcu; p < NB * 8; p += F.G) {
        const int b = p >> 3, h = p & 7;
        const GAS bf16* w2t = WSP(bf16, WS_LORA) + (size_t)((l * 2 + d) * RW + h * 64 + 16 * w4 + (lane & 15)) * 64 + 8 * (lane >> 4);
        const GAS bf16* a2t = w2t + (size_t)4 * RW * 64;
        const int ccol = h * 64 + 16 * w4 + (lane & 15);
        const float w0c = INP(10)[(l * 2 + d) * RW + ccol], a0c = INP(12)[(l * 2 + d) * RW + ccol], kac = INP(16)[l * RW + ccol], rkc = INP(17)[l * RW + ccol];
        const GAS float* mup = INP(9) + (size_t)(l * 2) * RCOLS + 4 * cg; const GAS float* kkp = INP(15) + l * RW + h * 64 + 4 * cg;
        float S[16];
#pragma unroll
        for (int i = 0; i < 16; ++i) S[i] = 0.f;
        v4u raw[3];
#define SC_GEOM(c) const int s0_ = 16 * (c); const bool isctx_ = s0_ < TC; const int pos0_ = isctx_ ? s0_ : s0_ - TC; const int len_ = isctx_ ? TC : TL; \
        const int rowbase_ = isctx_ ? NL + b * TC : b * TL; const int toklo_ = d == 0 ? pos0_ : len_ - 16 - pos0_;
#define SC_LOAD(c) do { SC_GEOM(c) _Pragma("unroll") for (int i = 0; i < 3; ++i) { const int pp = dt + 256 * i; raw[i] = (v4u){0u, 0u, 0u, 0u}; \
            if (pp < 720) { const int row = pp / 40, rem = pp % 40, grp = rem >> 3, c8 = rem & 7; const int tr = toklo_ - 1 + row; \
                const int gc = grp == 0 ? h * 64 : grp == 1 ? 512 + h * 64 : grp == 2 ? 1024 + h * 64 : grp == 3 ? 1536 : 1600; \
                if (tr >= 0 && tr < len_) raw[i] = *(const GAS v4u*)(PR + (size_t)(rowbase_ + tr) * RCOLS + gc + 8 * c8); } } } while (0)
        SC_LOAD(0);
        for (int c = 0; c < KVT / 16; ++c) {
            SC_GEOM(c)
#pragma unroll
            for (int i = 0; i < 3; ++i) { const int pp = dt + 256 * i; if (pp < 720) { const int row = pp / 40, rem = pp % 40; *(LAS v4u*)(L + SC_RAW + (row * 320 + rem * 8) * 2) = raw[i]; } }
            __syncthreads();
            if (c + 1 < KVT / 16) SC_LOAD(c + 1);
            {
                f32x4 xs[5];
#pragma unroll
                for (int g = 0; g < 5; ++g) {
                    const v2u a0 = *(const LAS v2u*)(L + SC_RAW + ((j + 0) * 320 + g * 64 + 4 * cg) * 2), a1 = *(const LAS v2u*)(L + SC_RAW + ((j + 1) * 320 + g * 64 + 4 * cg) * 2), a2 = *(const LAS v2u*)(L + SC_RAW + ((j + 2) * 320 + g * 64 + 4 * cg) * 2);
                    const f32x4 x0 = (f32x4){bflo(a0.x), bfhi(a0.x), bflo(a0.y), bfhi(a0.y)}, x1 = (f32x4){bflo(a1.x), bfhi(a1.x), bflo(a1.y), bfhi(a1.y)}, x2 = (f32x4){bflo(a2.x), bfhi(a2.x), bflo(a2.y), bfhi(a2.y)};
                    const int gc = g == 0 ? h * 64 : g == 1 ? 512 + h * 64 : g == 2 ? 1024 + h * 64 : g == 3 ? 1536 : 1600;
                    const f32x4 mu0 = *(const GAS f32x4*)(mup + gc), mu1 = *(const GAS f32x4*)(mup + RCOLS + gc);
                    xs[g] = x1 + mu0 * (x0 - x1) + mu1 * (x2 - x1);
                }
                *(LAS f32x4*)(SV + (0 * 16 + st_j) * 64 + 4 * cg) = xs[0];
                *(LAS f32x4*)(SV + (3 * 16 + st_j) * 64 + 4 * cg) = xs[2];
                *(LAS f32x4*)(KT + j * 64 + 4 * cg) = xs[1];
                const f32x4 kkf = xs[1] * *(const GAS f32x4*)kkp; float ss = (kkf.x * kkf.x + kkf.y * kkf.y) + (kkf.z * kkf.z + kkf.w * kkf.w);
                ss += __shfl_xor(ss, 1); ss += __shfl_xor(ss, 2); ss += __shfl_xor(ss, 4); ss += __shfl_xor(ss, 8);
                const float inv = 1.0f / fmaxf(sqrtf(ss), 1e-12f); const f32x4 kk = kkf * inv;
                *(LAS f32x4*)(KK + j * 64 + 4 * cg) = kk;
                *(LAS f32x4*)(SV + (4 * 16 + st_j) * 64 + 4 * cg) = -kk;
                v2u tw; tw.x = pk2(tanhf(xs[3].x), tanhf(xs[3].y)); tw.y = pk2(tanhf(xs[3].z), tanhf(xs[3].w));
                *(LAS v2u*)(L + SC_TWA + (j * 72 + 4 * cg) * 2) = tw;
                v2u ad; ad.x = pk2(xs[4].x, xs[4].y); ad.y = pk2(xs[4].z, xs[4].w);
                *(LAS v2u*)(L + SC_ADA + (j * 72 + 4 * cg) * 2) = ad;
            }
            __syncthreads();
            {
                const int ao = ((lane & 15) * 72 + 8 * (lane >> 4)) * 2;
                const bf16x8 At0 = *(const LAS bf16x8*)(L + SC_TWA + ao), At1 = *(const LAS bf16x8*)(L + SC_TWA + ao + 64), Aa0 = *(const LAS bf16x8*)(L + SC_ADA + ao), Aa1 = *(const LAS bf16x8*)(L + SC_ADA + ao + 64);
                const bf16x8 Bw0 = *(const GAS bf16x8*)w2t, Bw1 = *(const GAS bf16x8*)(w2t + 32), Ba0 = *(const GAS bf16x8*)a2t, Ba1 = *(const GAS bf16x8*)(a2t + 32);
                f32x4 zw = (f32x4){0.f, 0.f, 0.f, 0.f}, za = (f32x4){0.f, 0.f, 0.f, 0.f};
                zw = __builtin_amdgcn_mfma_f32_16x16x32_bf16(At0, Bw0, zw, 0, 0, 0); zw = __builtin_amdgcn_mfma_f32_16x16x32_bf16(At1, Bw1, zw, 0, 0, 0);
                za = __builtin_amdgcn_mfma_f32_16x16x32_bf16(Aa0, Ba0, za, 0, 0, 0); za = __builtin_amdgcn_mfma_f32_16x16x32_bf16(Aa1, Ba1, za, 0, 0, 0);
                const int cl = 16 * w4 + (lane & 15);
#pragma unroll
                for (int i = 0; i < 4; ++i) { const int jj = 4 * (lane >> 4) + i, st = d == 0 ? jj : 15 - jj;
                    const float sg = sigmoidf_(w0c + zw[i]); SV[(1 * 16 + st) * 64 + cl] = __expf(-0.6065306597f * sg);
                    const float al = sigmoidf_(a0c + za[i]);
                    const float kv = KT[jj * 64 + cl] * (1.0f + (al - 1.0f) * kac); SV[(2 * 16 + st) * 64 + cl] = kv;
                    SV[(5 * 16 + st) * 64 + cl] = KK[jj * 64 + cl] * al;
                    float bp = SV[(0 * 16 + st) * 64 + cl] * kv * rkc;
                    bp += __shfl_xor(bp, 1); bp += __shfl_xor(bp, 2); bp += __shfl_xor(bp, 4); bp += __shfl_xor(bp, 8);
                    if ((lane & 15) == 0) BON[w4 * 16 + jj] = bp; }
            }
            __syncthreads();
            {
                const int ri = 16 * w4 + (lane >> 2), q = lane & 3;
#pragma unroll 1
                for (int s = 0; s < 16; ++s) {
                    const LAS float* base = SV + s * 64 + 16 * q;
                    f32x4 na[4], wv[4], bv[4], kv[4], rv[4];
#pragma unroll
                    for (int i = 0; i < 4; ++i) { na[i] = *(const LAS f32x4*)(base + 4 * 16 * 64 + 4 * i); wv[i] = *(const LAS f32x4*)(base + 1 * 16 * 64 + 4 * i); bv[i] = *(const LAS f32x4*)(base + 5 * 16 * 64 + 4 * i);
                        kv[i] = *(const LAS f32x4*)(base + 2 * 16 * 64 + 4 * i); rv[i] = *(const LAS f32x4*)(base + 4 * i); }
                    const float vi = SV[(3 * 16 + s) * 64 + ri];
                    float d0 = 0.f, d1 = 0.f, d2 = 0.f, d3 = 0.f;
#pragma unroll
                    for (int i = 0; i < 4; ++i) { d0 = fmaf(S[4 * i], na[i].x, d0); d1 = fmaf(S[4 * i + 1], na[i].y, d1); d2 = fmaf(S[4 * i + 2], na[i].z, d2); d3 = fmaf(S[4 * i + 3], na[i].w, d3); }
                    const float sa = dpp_quad_sum((d0 + d1) + (d2 + d3));
                    float y0 = 0.f, y1 = 0.f, y2 = 0.f, y3 = 0.f;
#pragma unroll
                    for (int i = 0; i < 4; ++i) {
                        S[4 * i] = fmaf(vi, kv[i].x, fmaf(sa, bv[i].x, S[4 * i] * wv[i].x)); S[4 * i + 1] = fmaf(vi, kv[i].y, fmaf(sa, bv[i].y, S[4 * i + 1] * wv[i].y));
                        S[4 * i + 2] = fmaf(vi, kv[i].z, fmaf(sa, bv[i].z, S[4 * i + 2] * wv[i].z)); S[4 * i + 3] = fmaf(vi, kv[i].w, fmaf(sa, bv[i].w, S[4 * i + 3] * wv[i].w));
                        y0 = fmaf(S[4 * i], rv[i].x, y0); y1 = fmaf(S[4 * i + 1], rv[i].y, y1); y2 = fmaf(S[4 * i + 2], rv[i].z, y2); y3 = fmaf(S[4 * i + 3], rv[i].w, y3); }
                    const float y = dpp_quad_sum((y0 + y1) + (y2 + y3));
                    if (q == 0) YO[s * 64 + ri] = y;
                }
            }
            __syncthreads();
            if (dt < 128) { const int s = dt >> 3, c8 = dt & 7; const int tok = d == 0 ? pos0_ + s : len_ - 1 - (pos0_ + s);
                const f32x4 a = *(const LAS f32x4*)(YO + s * 64 + 8 * c8), bq = *(const LAS f32x4*)(YO + s * 64 + 8 * c8 + 4);
                v4u w; w.x = pk2(a.x, a.y); w.y = pk2(a.z, a.w); w.z = pk2(bq.x, bq.y); w.w = pk2(bq.z, bq.w);
                *(GAS v4u*)(Yd + (size_t)(rowbase_ + tok) * RW + h * 64 + 8 * c8) = w; }
            else if (dt < 144) { const int jj = dt - 128; bonus[(size_t)(rowbase_ + toklo_ + jj) * 8 + h] = (BON[jj] + BON[16 + jj]) + (BON[32 + jj] + BON[48 + jj]); }
        }
        __syncthreads();
#undef SC_LOAD
#undef SC_GEOM
    }
}

constexpr int RO_PITCH = 136;
static_assert(RW * RO_PITCH * 2 <= MISC_OFF, "rwkv_out LDS");
__device__ __forceinline__ void rwkv_out_phase(Frame& F, int l, int nrows) {
    const int gw = F.vcu * NWAVES + F.wave, NGW = F.G * NWAVES, lane = F.lane, jr = lane & 15, fq = lane >> 4;
    const GAS bf16* PR = WSP(bf16, WS_PR); const GAS bf16* YF = WSP(bf16, WS_YF); const GAS bf16* YB = WSP(bf16, WS_YB); GAS bf16* YR = WSP(bf16, WS_YR);
    const GAS float* bon0 = WSP(float, WS_BONUS); const GAS float* bon1 = bon0 + (size_t)MA * 8;
    const GAS bf16* g2t = WSP(bf16, WS_LORA) + (size_t)8 * RW * 64 + (size_t)l * RW * 128;
    const GAS float* m0 = INP(9) + (size_t)(l * 2) * RCOLS; const GAS float* m1 = m0 + RCOLS;
    const GAS float* lw = INP(18) + l * RW; const GAS float* lb = INP(19) + l * RW;
    for (int i = F.tid; i < RW * 16; i += 512) { const int n = i >> 4, c8 = i & 15; *(LAS v4u*)(F.lds + (n * RO_PITCH + 8 * c8) * 2) = *(const GAS v4u*)(g2t + (size_t)n * 128 + 8 * c8); }
    __syncthreads();
    for (int unit = gw; unit < nrows / 16; unit += NGW) {
        const int m = unit * 16 + jr;
        const int pos = m < NL ? (m & 2047) : ((m - NL) & 255), len = m < NL ? TL : TC;
        const bool hp = pos > 0, hn = pos < len - 1;
        const GAS bf16* pr = PR + (size_t)m * RCOLS;
        bf16x8 Af[4];
#pragma unroll
        for (int ks = 0; ks < 4; ++ks) { const int col = 1664 + 8 * fq + 32 * ks;
            const v4u z = (v4u){0u, 0u, 0u, 0u}; const v4u w1 = *(const GAS v4u*)(pr + col); const v4u w0 = hp ? *(const GAS v4u*)(pr - RCOLS + col) : z; const v4u w2 = hn ? *(const GAS v4u*)(pr + RCOLS + col) : z;
            const unsigned u0[4] = {w0.x, w0.y, w0.z, w0.w}, u1[4] = {w1.x, w1.y, w1.z, w1.w}, u2[4] = {w2.x, w2.y, w2.z, w2.w}; unsigned o[4];
#pragma unroll
            for (int e = 0; e < 4; ++e) { const f32x2 a = *(const GAS f32x2*)(m0 + col + 2 * e), bq = *(const GAS f32x2*)(m1 + col + 2 * e);
                const float xl = bflo(u1[e]), xh = bfhi(u1[e]);
                const float vl = xl + a.x * (bflo(u0[e]) - xl) + bq.x * (bflo(u2[e]) - xl), vh = xh + a.y * (bfhi(u0[e]) - xh) + bq.y * (bfhi(u2[e]) - xh);
                o[e] = pk2(sigmoidf_(vl), sigmoidf_(vh)); }
            Af[ks] = __builtin_bit_cast(bf16x8, (v4u){o[0], o[1], o[2], o[3]}); }
        for (int hh = 0; hh < 8; ++hh) {
            const float bon = 0.5f * (bon0[(size_t)m * 8 + hh] + bon1[(size_t)m * 8 + hh]);
            f32x4 y[4], g[4];
#pragma unroll
            for (int nt = 0; nt < 4; ++nt) { const int c0 = hh * 64 + 16 * nt;
                f32x4 acc = (f32x4){0.f, 0.f, 0.f, 0.f};
#pragma unroll
                for (int ks = 0; ks < 4; ++ks) { const bf16x8 Bf = *(const LAS bf16x8*)(F.lds + ((c0 + jr) * RO_PITCH + 8 * fq + 32 * ks) * 2); acc = __builtin_amdgcn_mfma_f32_16x16x32_bf16(Bf, Af[ks], acc, 0, 0, 0); }
                g[nt] = acc;
                const int col = c0 + 4 * fq; const v2u a = *(const GAS v2u*)(YF + (size_t)m * RW + col), bq = *(const GAS v2u*)(YB + (size_t)m * RW + col);
                y[nt] = (f32x4){bflo(a.x) + bflo(bq.x), bfhi(a.x) + bfhi(bq.x), bflo(a.y) + bflo(bq.y), bfhi(a.y) + bfhi(bq.y)}; }
            float s = 0.f;
#pragma unroll
            for (int nt = 0; nt < 4; ++nt) s += (y[nt].x + y[nt].y) + (y[nt].z + y[nt].w);
            s += __shfl_xor(s, 16); s += __shfl_xor(s, 32);
            const float mean = s * (1.0f / 64.0f); float qv = 0.f;
#pragma unroll
            for (int nt = 0; nt < 4; ++nt) { y[nt] = y[nt] - mean; qv += (y[nt].x * y[nt].x + y[nt].y * y[nt].y) + (y[nt].z * y[nt].z + y[nt].w * y[nt].w); }
            qv += __shfl_xor(qv, 16); qv += __shfl_xor(qv, 32);
            const float rstd = rsq_(qv * (1.0f / 64.0f) + 64e-5f);
#pragma unroll
            for (int nt = 0; nt < 4; ++nt) { const int col = hh * 64 + 16 * nt + 4 * fq, vc = 1024 + col;
                const v2u z = (v2u){0u, 0u}; const v2u w1 = *(const GAS v2u*)(pr + vc); const v2u w0 = hp ? *(const GAS v2u*)(pr - RCOLS + vc) : z; const v2u w2 = hn ? *(const GAS v2u*)(pr + RCOLS + vc) : z;
                const f32x4 x0 = (f32x4){bflo(w0.x), bfhi(w0.x), bflo(w0.y), bfhi(w0.y)}, x1 = (f32x4){bflo(w1.x), bfhi(w1.x), bflo(w1.y), bfhi(w1.y)}, x2 = (f32x4){bflo(w2.x), bfhi(w2.x), bflo(w2.y), bfhi(w2.y)};
                const f32x4 vs = x1 + *(const GAS f32x4*)(m0 + vc) * (x0 - x1) + *(const GAS f32x4*)(m1 + vc) * (x2 - x1);
                const f32x4 o = (y[nt] * rstd * *(const GAS f32x4*)(lw + col) + *(const GAS f32x4*)(lb + col) + vs * bon) * g[nt];
                v2u w; w.x = pk2(o.x, o.y); w.y = pk2(o.z, o.w);
                *(GAS v2u*)(YR + (size_t)m * RW + col) = w; }
        }
    }
    __syncthreads();
}

__device__ __forceinline__ void attn_phase(Frame& F, int l, char* lds_generic, size_t q_off) {
    typedef attn_body::bf16 abf;
    abf* Q = (abf*)(F.ws + q_off); const abf* KB = (const abf*)(F.ws + WS_KB); const abf* VB = (const abf*)(F.ws + WS_VB);
    for (int p = F.vcu; p < NB * 8; p += F.G) {
        const int b = p >> 3, hq = p & 7, kvh = hq >> 2;
        const abf* Kh = KB + (size_t)b * KVT * 128 + kvh * 64; const abf* Vh = VB + (size_t)b * KVT * 128 + kvh * 64;
        const int nu = l == 0 ? 9 : 8;
        for (int u = 0; u < nu; ++u) {
            const bool cx = u == 8;
            abf* Qu = Q + (size_t)(cx ? NL + b * TC : b * TL + u * 256) * 512 + hq * 64;
            attn_body::attn_unit<8>(Qu, cx ? Kh + (size_t)TL * 128 : Kh, cx ? Vh + (size_t)TL * 128 : Vh, Qu, cx ? TC / 64 : KVT / 64, lds_generic);
        }
    }
}

__device__ __forceinline__ int moe_tiles(Frame& F, LAS int* tile_e) {
    int nt = 0;
    for (int e = 0; e < NE; ++e) { const int cnt = (int)__hip_atomic_load(F.ctl + CW_HIST + 64 * e, RLX_AGENT); const int t = (cnt + 255) >> 8;
        for (int i = F.tid; i < t; i += 512) tile_e[nt + i] = e; nt += t; }
    __syncthreads();
    return nt;
}
__device__ __forceinline__ void moe_slots(Frame& F) {
    volatile LAS unsigned* M = F.MISC;
    const GAS int* toke = (const GAS int*)(F.ws + WS_MOETAB + MT_TOKE); GAS int* toks = (GAS int*)(F.ws + WS_MOETAB + MT_TOKS);
    const GAS bf16* H2 = WSP(bf16, WS_H2M); GAS bf16* XB = WSP(bf16, WS_XB);
    LAS int* slotl = (LAS int*)F.lds;
    for (int tb = F.vcu; tb < NL / 256; tb += F.G) {
        if (F.tid < 8) M[32 + F.tid] = 0u;
        if (F.tid == 0) { unsigned ps = 0; for (int e = 0; e < NE; ++e) { M[48 + e] = ps; const unsigned cnt = __hip_atomic_load(F.ctl + CW_HIST + 64 * e, RLX_AGENT); ps += ((cnt + 255u) >> 8) << 8; } }
        __syncthreads();
        int e_my = 0, rank = 0;
        { const int a = F.tid; e_my = toke[(size_t)tb * 512 + a]; rank = (int)__hip_atomic_fetch_add((LAS unsigned*)&M[32 + e_my], 1u, __ATOMIC_RELAXED, __HIP_MEMORY_SCOPE_WORKGROUP); }
        __syncthreads();
        if (F.tid < 8) M[40 + F.tid] = __hip_atomic_fetch_add(F.ctl + CW_CURS + 64 * F.tid, M[32 + F.tid], RLX_AGENT);
        __syncthreads();
        const int slot = (int)(M[48 + e_my] + M[40 + e_my]) + rank;
        toks[(size_t)tb * 512 + F.tid] = slot; slotl[F.tid] = slot;
        __syncthreads();
        for (int a = F.wave; a < 512; a += NWAVES) { const int tok = tb * 256 + (a >> 1); const int sl = slotl[a];
            const GAS v4u* src = (const GAS v4u*)(H2 + (size_t)tok * DM); GAS v4u* dst = (GAS v4u*)(XB + (size_t)sl * DM);
            const v4u x0 = src[F.lane], x1 = src[64 + F.lane]; dst[F.lane] = x0; dst[64 + F.lane] = x1; }
        __syncthreads();
    }
}
__device__ __forceinline__ void moe_final(Frame& F) {
    const int gw = F.vcu * NWAVES + F.wave, NGW = F.G * NWAVES;
    const GAS int* toks = (const GAS int*)(F.ws + WS_MOETAB + MT_TOKS); const GAS float* tokw = (const GAS float*)(F.ws + WS_MOETAB + MT_TOKW);
    const GAS bf16* YM = WSP(bf16, WS_YM); const GAS float* gt = WSP(float, WS_MOD) + (size_t)33 * 6144 + 5120;
    for (int m = gw; m < NL; m += NGW) {
        const int s0 = toks[2 * m], s1 = toks[2 * m + 1]; const float w0 = tokw[2 * m], w1 = tokw[2 * m + 1];
        const GAS float* gv = gt + (size_t)(m >> 11) * 6144; GAS float* xr = F.out + (size_t)m * DM;
        f32x4 v[4]; float s = 0.f;
#pragma unroll
        for (int j = 0; j < 4; ++j) { const int c = 4 * F.lane + 256 * j;
            const v2u a = *(const GAS v2u*)(YM + (size_t)s0 * DM + c), bq = *(const GAS v2u*)(YM + (size_t)s1 * DM + c);
            const f32x4 ya = (f32x4){bflo(a.x), bfhi(a.x), bflo(a.y), bfhi(a.y)}, yb = (f32x4){bflo(bq.x), bfhi(bq.x), bflo(bq.y), bfhi(bq.y)};
            v[j] = *(const GAS f32x4*)(xr + c) + *(const GAS f32x4*)(gv + c) * (ya * w0 + yb * w1);
            s += (v[j].x * v[j].x + v[j].y * v[j].y) + (v[j].z * v[j].z + v[j].w * v[j].w); }
        const float rstd = rsq_(wave_sum(s) * (1.0f / DM) + 1e-6f);
#pragma unroll
        for (int j = 0; j < 4; ++j) { const int c = 4 * F.lane + 256 * j; *(GAS f32x4*)(xr + c) = v[j] * rstd * *(const GAS f32x4*)(INP(32) + c); }
    }
}
constexpr int S2_RS = 0, S2_VS = 4096, S2_KS = 8192, S2_KK = 12288, S2_W = 16384, S2_KT = 20480, S2_BB = 24576, S2_RAW = 16384;
constexpr int S2_RQT = 0, S2_S16 = 11520, S2_D1T = 20736, S2_D2T = 24576;
constexpr int S2_C0 = 28672, S2_TWA = S2_C0, S2_ADA = S2_C0 + 2304, S2_GA = S2_C0, S2_GBT = S2_C0 + 4608, S2_RTF = S2_C0 + 9216, S2_BCT = S2_C0 + 13312, S2_KCF = S2_C0 + 16384,
              S2_G15 = S2_C0 + 20480, S2_ATT = S2_C0 + 20736, S2_VT = S2_C0 + 23808;
constexpr int S2_M0 = S2_C0 + 26880, S2_MAB = S2_M0, S2_MAK = S2_M0 + 1088, S2_MBRT = S2_M0 + 1856, S2_MKR = S2_M0 + 2624, S2_TA = S2_M0 + 3648, S2_TT = S2_M0 + 4416, S2_C1A = S2_M0 + 5184;
constexpr int S2_YO = S2_M0 + 5952, S2_BON = S2_YO + 4096, S2_DIR = S2_BON + 256;
static_assert(2 * S2_DIR <= MISC_OFF && S2_D2T + 3840 <= S2_C0 && S2_RAW + 11520 <= S2_C0, "scan LDS map");
__device__ __forceinline__ bf16x8 lds_frag(const LAS unsigned char* p) { return *(const LAS bf16x8*)p; }
__device__ __forceinline__ bf16x8 lds_frag16(const LAS unsigned char* row, int lane) { bf16x8 z = (bf16x8){0, 0, 0, 0, 0, 0, 0, 0}; if (lane < 32) z = *(const LAS bf16x8*)(row + 16 * (lane >> 4)); return z; }
__device__ __forceinline__ float tanh_fast(float x) { const float e = __expf(2.0f * x); return 1.0f - 2.0f * rcp_(e + 1.0f); }
__device__ __forceinline__ void st_bf(LAS unsigned char* p, float v) { *(LAS unsigned short*)p = (unsigned short)(pk2(v, 0.f) & 0xffffu); }

#define S2_IDS() int tl_ = F.tid; asm volatile("" : "+v"(tl_)); const int dt = tl_ & 255, lane = tl_ & 63, lr = lane & 15, lq = lane >> 4; const int wv_ = __builtin_amdgcn_readfirstlane(tl_ >> 6); const int w4 = wv_ & 3, d = wv_ >> 2; \
    LAS unsigned char* const L = F.lds + d * S2_DIR; (void)dt; (void)lr; (void)lq; (void)w4; (void)lane
#define S2_F32(name, off) LAS float* const name = (LAS float*)(L + (off))
#define S2_BAR() asm volatile("s_waitcnt lgkmcnt(0)\n\ts_barrier" ::: "memory")
__device__ __forceinline__ void scan_phase2(Frame& F, int l) {
    const GAS bf16* PR = WSP(bf16, WS_PR);
    for (int p = F.vcu; p < NB * 8; p += F.G) {
        const int b = p >> 3, h = p & 7;
        f32x4 S[4];
#pragma unroll
        for (int i = 0; i < 4; ++i) S[i] = (f32x4){0.f, 0.f, 0.f, 0.f};
        v4u raw[3];
        int prow[3], pcol[3], plds[3];
        f32x4 mu0[5], mu1[5], kkc; bf16x8 Bw0, Bw1, Ba0, Ba1; float w0c, a0c, kac, rkc;
        { S2_IDS();
#pragma unroll
          for (int i = 0; i < 3; ++i) { const int pp = dt + 256 * i, row = pp / 40, rem = pp % 40, grp = rem >> 3, c8 = rem & 7;
              prow[i] = pp < 720 ? row : -100000; pcol[i] = (grp == 0 ? h * 64 : grp == 1 ? 512 + h * 64 : grp == 2 ? 1024 + h * 64 : grp == 3 ? 1536 : 1600) + 8 * c8; plds[i] = (row * 320 + rem * 8) * 2; }
          const int cg = dt & 15; const GAS float* mup = INP(9) + (size_t)(l * 2) * RCOLS + 4 * cg;
#pragma unroll
          for (int g = 0; g < 5; ++g) { const int gc = g == 0 ? h * 64 : g == 1 ? 512 + h * 64 : g == 2 ? 1024 + h * 64 : g == 3 ? 1536 : 1600; mu0[g] = *(const GAS f32x4*)(mup + gc); mu1[g] = *(const GAS f32x4*)(mup + RCOLS + gc); }
          kkc = *(const GAS f32x4*)(INP(15) + l * RW + h * 64 + 4 * cg);
          const GAS bf16* w2t = WSP(bf16, WS_LORA) + (size_t)((l * 2 + d) * RW + h * 64 + 16 * w4 + lr) * 64 + 8 * lq; const GAS bf16* a2t = w2t + (size_t)4 * RW * 64;
          Bw0 = *(const GAS bf16x8*)w2t; Bw1 = *(const GAS bf16x8*)(w2t + 32); Ba0 = *(const GAS bf16x8*)a2t; Ba1 = *(const GAS bf16x8*)(a2t + 32);
          const int ccol = h * 64 + 16 * w4 + lr;
          w0c = INP(10)[(l * 2 + d) * RW + ccol]; a0c = INP(12)[(l * 2 + d) * RW + ccol]; kac = INP(16)[l * RW + ccol]; rkc = INP(17)[l * RW + ccol]; }
#define SC_GEOM(c) const int s0_ = 16 * (c); const bool isctx_ = s0_ < TC; const int pos0_ = isctx_ ? s0_ : s0_ - TC; const int len_ = isctx_ ? TC : TL; \
        const int rowbase_ = isctx_ ? NL + b * TC : b * TL; const int toklo_ = d == 0 ? pos0_ : len_ - 16 - pos0_;
#define SC_LOAD(c) do { SC_GEOM(c) _Pragma("unroll") for (int i = 0; i < 3; ++i) { const int tr = toklo_ - 1 + prow[i]; raw[i] = (v4u){0u, 0u, 0u, 0u}; \
            if (tr >= 0 && tr < len_) raw[i] = *(const GAS v4u*)(PR + (size_t)(rowbase_ + tr) * RCOLS + pcol[i]); } } while (0)
        { S2_IDS(); SC_LOAD(0); }
        for (int c = 0; c < KVT / 16; ++c) {
            { S2_IDS();
#pragma unroll
              for (int i = 0; i < 3; ++i) { if (prow[i] >= 0) *(LAS v4u*)(L + S2_RAW + plds[i]) = raw[i]; }
              S2_BAR();
              if (c + 1 < KVT / 16) SC_LOAD(c + 1); }
            { S2_IDS(); S2_F32(RS, S2_RS); S2_F32(VS, S2_VS); S2_F32(KS, S2_KS); S2_F32(KK, S2_KK);
              const int j = dt >> 4, cg = dt & 15, st_j = d == 0 ? j : 15 - j;
              f32x4 xs[5];
#pragma unroll
              for (int g = 0; g < 5; ++g) {
                  const v2u a0 = *(const LAS v2u*)(L + S2_RAW + ((j + 0) * 320 + g * 64 + 4 * cg) * 2), a1 = *(const LAS v2u*)(L + S2_RAW + ((j + 1) * 320 + g * 64 + 4 * cg) * 2), a2 = *(const LAS v2u*)(L + S2_RAW + ((j + 2) * 320 + g * 64 + 4 * cg) * 2);
                  const f32x4 x0 = (f32x4){bflo(a0.x), bfhi(a0.x), bflo(a0.y), bfhi(a0.y)}, x1 = (f32x4){bflo(a1.x), bfhi(a1.x), bflo(a1.y), bfhi(a1.y)}, x2 = (f32x4){bflo(a2.x), bfhi(a2.x), bflo(a2.y), bfhi(a2.y)};
                  xs[g] = x1 + mu0[g] * (x0 - x1) + mu1[g] * (x2 - x1);
              }
              *(LAS f32x4*)(RS + st_j * 64 + 4 * cg) = xs[0];
              *(LAS f32x4*)(VS + st_j * 64 + 4 * cg) = xs[2];
              *(LAS f32x4*)(KS + j * 64 + 4 * cg) = xs[1];
              const f32x4 kkf = xs[1] * kkc; float ss = (kkf.x * kkf.x + kkf.y * kkf.y) + (kkf.z * kkf.z + kkf.w * kkf.w);
              ss += __shfl_xor(ss, 1); ss += __shfl_xor(ss, 2); ss += __shfl_xor(ss, 4); ss += __shfl_xor(ss, 8);
              const float inv = 1.0f / fmaxf(sqrtf(ss), 1e-12f);
              *(LAS f32x4*)(KK + j * 64 + 4 * cg) = kkf * inv;
              v2u tw; tw.x = pk2(tanh_fast(xs[3].x), tanh_fast(xs[3].y)); tw.y = pk2(tanh_fast(xs[3].z), tanh_fast(xs[3].w));
              *(LAS v2u*)(L + S2_TWA + (j * 72 + 4 * cg) * 2) = tw;
              v2u ad; ad.x = pk2(xs[4].x, xs[4].y); ad.y = pk2(xs[4].z, xs[4].w);
              *(LAS v2u*)(L + S2_ADA + (j * 72 + 4 * cg) * 2) = ad;
            }
            S2_BAR();
            { S2_IDS(); S2_F32(RS, S2_RS); S2_F32(KS, S2_KS); S2_F32(KK, S2_KK); S2_F32(Wd, S2_W); S2_F32(KT, S2_KT); S2_F32(BB, S2_BB); S2_F32(BON, S2_BON);
              const int ao = (lr * 72 + 8 * lq) * 2;
              const bf16x8 At0 = lds_frag(L + S2_TWA + ao), At1 = lds_frag(L + S2_TWA + ao + 64), Aa0 = lds_frag(L + S2_ADA + ao), Aa1 = lds_frag(L + S2_ADA + ao + 64);
              f32x4 zw = (f32x4){0.f, 0.f, 0.f, 0.f}, za = (f32x4){0.f, 0.f, 0.f, 0.f};
              zw = __builtin_amdgcn_mfma_f32_16x16x32_bf16(At0, Bw0, zw, 0, 0, 0); zw = __builtin_amdgcn_mfma_f32_16x16x32_bf16(At1, Bw1, zw, 0, 0, 0);
              za = __builtin_amdgcn_mfma_f32_16x16x32_bf16(Aa0, Ba0, za, 0, 0, 0); za = __builtin_amdgcn_mfma_f32_16x16x32_bf16(Aa1, Ba1, za, 0, 0, 0);
              const int cl = 16 * w4 + lr;
#pragma unroll
              for (int i = 0; i < 4; ++i) { const int jj = 4 * lq + i, st = d == 0 ? jj : 15 - jj;
                  const float sg = sigmoidf_(w0c + zw[i]); Wd[st * 64 + cl] = __expf(-0.6065306597f * sg);
                  const float al = sigmoidf_(a0c + za[i]);
                  const float kv = KS[jj * 64 + cl] * (1.0f + (al - 1.0f) * kac); KT[st * 64 + cl] = kv;
                  BB[st * 64 + cl] = KK[jj * 64 + cl] * al;
                  float bp = RS[st * 64 + cl] * kv * rkc;
                  bp += __shfl_xor(bp, 1); bp += __shfl_xor(bp, 2); bp += __shfl_xor(bp, 4); bp += __shfl_xor(bp, 8);
                  if (lr == 0) BON[w4 * 16 + jj] = bp; }
            }
            S2_BAR();
            { S2_IDS(); S2_F32(RS, S2_RS); S2_F32(VS, S2_VS); S2_F32(KK, S2_KK); S2_F32(Wd, S2_W); S2_F32(KT, S2_KT); S2_F32(BB, S2_BB); S2_F32(RTF, S2_RTF); S2_F32(KCF, S2_KCF); S2_F32(G15, S2_G15);
              const int cc = lane; float g = 1.f, gp[4], gt[4];
#pragma unroll
              for (int t = 0; t < 16; ++t) { const float wt = Wd[t * 64 + cc]; if ((t >> 2) == w4) gp[t & 3] = g; g *= wt; if ((t >> 2) == w4) gt[t & 3] = g; }
              if (w4 == 0) G15[cc] = g;
              unsigned pa[2], pb[2], pv[2];
#pragma unroll
              for (int i = 0; i < 4; ++i) { const int t = 4 * w4 + i, jm = d == 0 ? t : 15 - t;
                  const float ig = 1.0f / gt[i], sc = g * ig;
                  const float av = -KK[jm * 64 + cc] * gp[i], rv = RS[t * 64 + cc] * gt[i], bv = BB[t * 64 + cc], kv = KT[t * 64 + cc];
                  st_bf(L + S2_GA + (t * 72 + cc) * 2, bv * ig); st_bf(L + S2_GA + ((16 + t) * 72 + cc) * 2, kv * ig);
                  st_bf(L + S2_GBT + (t * 72 + cc) * 2, av); st_bf(L + S2_GBT + ((16 + t) * 72 + cc) * 2, rv);
                  RTF[t * 64 + cc] = rv; KCF[t * 64 + cc] = kv * sc;
                  const float bc = bv * sc, vv = VS[t * 64 + cc];
                  if (i & 1) { pa[i >> 1] = pk2(__uint_as_float(pa[i >> 1]), av); pb[i >> 1] = pk2(__uint_as_float(pb[i >> 1]), bc); pv[i >> 1] = pk2(__uint_as_float(pv[i >> 1]), vv); }
                  else { pa[i >> 1] = __float_as_uint(av); pb[i >> 1] = __float_as_uint(bc); pv[i >> 1] = __float_as_uint(vv); } }
              *(LAS v2u*)(L + S2_ATT + (cc * 24 + 4 * w4) * 2) = (v2u){pa[0], pa[1]};
              *(LAS v2u*)(L + S2_BCT + (cc * 24 + 4 * w4) * 2) = (v2u){pb[0], pb[1]};
              *(LAS v2u*)(L + S2_VT + (cc * 24 + 4 * w4) * 2) = (v2u){pv[0], pv[1]};
            }
            S2_BAR();
            { S2_IDS(); S2_F32(MAB, S2_MAB); S2_F32(MKR, S2_MKR);
              const int mt = w4 >> 1, nt = w4 & 1, ao = ((16 * mt + lr) * 72 + 8 * lq) * 2, bo = ((16 * nt + lr) * 72 + 8 * lq) * 2;
              f32x4 acc = (f32x4){0.f, 0.f, 0.f, 0.f};
              acc = __builtin_amdgcn_mfma_f32_16x16x32_bf16(lds_frag(L + S2_GA + ao), lds_frag(L + S2_GBT + bo), acc, 0, 0, 0);
              acc = __builtin_amdgcn_mfma_f32_16x16x32_bf16(lds_frag(L + S2_GA + ao + 64), lds_frag(L + S2_GBT + bo + 64), acc, 0, 0, 0);
#pragma unroll
              for (int i = 0; i < 4; ++i) { const int s = 4 * lq + i, t = lr; const bool keep = nt == 0 ? (s < t) : (s <= t); const float v = keep ? acc[i] : 0.f;
                  if (w4 == 0) MAB[s * 16 + t] = v;
                  else if (w4 == 2) st_bf(L + S2_MAK + (s * 24 + t) * 2, v);
                  else if (w4 == 1) st_bf(L + S2_MBRT + (t * 24 + s) * 2, v);
                  else MKR[s * 16 + t] = v; }
            }
            S2_BAR();
            { S2_IDS(); S2_F32(MAB, S2_MAB);
              if (dt < 16) { const int t = dt; float Tc[16];
#pragma unroll
                for (int s = 15; s >= 0; --s) { float a = (s == t) ? 1.f : 0.f; asm volatile("" ::: "memory");
                    float mr[16];
#pragma unroll
                    for (int q4 = (s + 1) / 4; q4 < 4; ++q4) { const f32x4 mv = *(const LAS f32x4*)(MAB + s * 16 + 4 * q4); mr[4 * q4] = mv.x; mr[4 * q4 + 1] = mv.y; mr[4 * q4 + 2] = mv.z; mr[4 * q4 + 3] = mv.w; }
#pragma unroll
                    for (int jx = s + 1; jx < 16; ++jx) a = fmaf(mr[jx], Tc[jx], a);
                    Tc[s] = a; }
                unsigned tt[8];
#pragma unroll
                for (int s = 0; s < 16; ++s) st_bf(L + S2_TA + (s * 24 + t) * 2, Tc[s]);
#pragma unroll
                for (int s = 0; s < 8; ++s) tt[s] = pk2(Tc[2 * s], Tc[2 * s + 1]);
                *(LAS v4u*)(L + S2_TT + (t * 24) * 2) = (v4u){tt[0], tt[1], tt[2], tt[3]}; *(LAS v4u*)(L + S2_TT + (t * 24 + 8) * 2) = (v4u){tt[4], tt[5], tt[6], tt[7]}; }
            }
            S2_BAR();
            { S2_IDS();
#pragma unroll
              for (int rep = 0; rep < 2; ++rep) { const int task = w4 + 4 * rep; if (task < 6) {
                  const bf16x8 Af = lds_frag16(L + (task == 0 ? S2_MAK : S2_TA) + lr * 48, lane);
                  const bf16x8 Bf = task == 0 ? lds_frag16(L + S2_TT + lr * 48, lane) : task == 1 ? lds_frag16(L + S2_MBRT + lr * 48, lane) : lds_frag16(L + S2_BCT + (16 * (task - 2) + lr) * 48, lane);
                  const f32x4 acc = __builtin_amdgcn_mfma_f32_16x16x32_bf16(Af, Bf, (f32x4){0.f, 0.f, 0.f, 0.f}, 0, 0, 0);
                  if (task == 0) {
#pragma unroll
                      for (int i = 0; i < 4; ++i) st_bf(L + S2_C1A + ((4 * lq + i) * 24 + lr) * 2, acc[i]); }
                  else { const int n = 16 * (task - 1) + lr; *(LAS v2u*)(L + S2_D1T + (n * 24 + 4 * lq) * 2) = (v2u){pk2(acc[0], acc[1]), pk2(acc[2], acc[3])}; } } }
            }
            S2_BAR();
            { S2_IDS(); S2_F32(MKR, S2_MKR); S2_F32(KCF, S2_KCF);
#pragma unroll
              for (int rep = 0; rep < 2; ++rep) { const int nt = w4 + 4 * rep; if (nt < 5) {
                  const bf16x8 Af = lds_frag16(L + S2_C1A + lr * 48, lane);
                  const bf16x8 Bf = nt == 0 ? lds_frag16(L + S2_MBRT + lr * 48, lane) : lds_frag16(L + S2_BCT + (16 * (nt - 1) + lr) * 48, lane);
                  f32x4 acc;
#pragma unroll
                  for (int i = 0; i < 4; ++i) acc[i] = nt == 0 ? MKR[(4 * lq + i) * 16 + lr] : KCF[(4 * lq + i) * 64 + 16 * (nt - 1) + lr];
                  acc = __builtin_amdgcn_mfma_f32_16x16x32_bf16(Af, Bf, acc, 0, 0, 0);
                  const int n = 16 * nt + lr; *(LAS v2u*)(L + S2_D2T + (n * 24 + 4 * lq) * 2) = (v2u){pk2(acc[0], acc[1]), pk2(acc[2], acc[3])}; } }
            }
            S2_BAR();
            f32x4 accP[5];
            { S2_IDS(); S2_F32(RTF, S2_RTF);
              const bf16x8 Aa = lds_frag16(L + S2_ATT + (16 * w4 + lr) * 48, lane), Av = lds_frag16(L + S2_VT + (16 * w4 + lr) * 48, lane);
#pragma unroll
              for (int nt = 0; nt < 5; ++nt) {
                  const bf16x8 B1 = lds_frag16(L + S2_D1T + (16 * nt + lr) * 48, lane), B2 = lds_frag16(L + S2_D2T + (16 * nt + lr) * 48, lane);
                  f32x4 a1 = (f32x4){0.f, 0.f, 0.f, 0.f};
                  if (nt == 0) {
#pragma unroll
                      for (int i = 0; i < 4; ++i) a1[i] = RTF[lr * 64 + 16 * w4 + 4 * lq + i]; }
                  a1 = __builtin_amdgcn_mfma_f32_16x16x32_bf16(Aa, B1, a1, 0, 0, 0);
                  accP[nt] = __builtin_amdgcn_mfma_f32_16x16x32_bf16(Av, B2, (f32x4){0.f, 0.f, 0.f, 0.f}, 0, 0, 0);
                  *(LAS v2u*)(L + S2_RQT + ((16 * nt + lr) * 72 + 16 * w4 + 4 * lq) * 2) = (v2u){pk2(a1[0], a1[1]), pk2(a1[2], a1[3])};
              }
              LAS unsigned char* Sw = L + S2_S16 + w4 * 2304;
#pragma unroll
              for (int nt = 0; nt < 4; ++nt)
#pragma unroll
                  for (int i = 0; i < 4; ++i) st_bf(Sw + ((4 * lq + i) * 72 + 16 * nt + lr) * 2, S[nt][i]);
            }
            S2_BAR();
            { S2_IDS(); S2_F32(G15, S2_G15); S2_F32(YO, S2_YO);
              const LAS unsigned char* Sw = L + S2_S16 + w4 * 2304;
              const bf16x8 As0 = lds_frag(Sw + (lr * 72 + 8 * lq) * 2), As1 = lds_frag(Sw + (lr * 72 + 8 * lq) * 2 + 64);
#pragma unroll
              for (int nt = 0; nt < 5; ++nt) { const int bo = ((16 * nt + lr) * 72 + 8 * lq) * 2;
                  accP[nt] = __builtin_amdgcn_mfma_f32_16x16x32_bf16(As0, lds_frag(L + S2_RQT + bo), accP[nt], 0, 0, 0);
                  accP[nt] = __builtin_amdgcn_mfma_f32_16x16x32_bf16(As1, lds_frag(L + S2_RQT + bo + 64), accP[nt], 0, 0, 0); }
#pragma unroll
              for (int i = 0; i < 4; ++i) YO[lr * 64 + 16 * w4 + 4 * lq + i] = accP[0][i];
#pragma unroll
              for (int nt = 0; nt < 4; ++nt) { const float g = G15[16 * nt + lr]; S[nt] = S[nt] * g + accP[1 + nt]; }
            }
            S2_BAR();
            { S2_IDS(); S2_F32(YO, S2_YO); S2_F32(BON, S2_BON); SC_GEOM(c)
              if (dt < 128) { const int s = dt >> 3, c8 = dt & 7; const int tok = d == 0 ? pos0_ + s : len_ - 1 - (pos0_ + s);
                  GAS bf16* Yd = WSP(bf16, d == 0 ? WS_YF : WS_YB);
                  const f32x4 a = *(const LAS f32x4*)(YO + s * 64 + 8 * c8), bq = *(const LAS f32x4*)(YO + s * 64 + 8 * c8 + 4);
                  v4u w; w.x = pk2(a.x, a.y); w.y = pk2(a.z, a.w); w.z = pk2(bq.x, bq.y); w.w = pk2(bq.z, bq.w);
                  *(GAS v4u*)(Yd + (size_t)(rowbase_ + tok) * RW + h * 64 + 8 * c8) = w; }
              else if (dt < 144) { const int jj = dt - 128; GAS float* bonus = WSP(float, WS_BONUS) + (size_t)d * MA * 8;
                  bonus[(size_t)(rowbase_ + toklo_ + jj) * 8 + h] = (BON[jj] + BON[16 + jj]) + (BON[32 + jj] + BON[48 + jj]); }
            }
        }
        __syncthreads();
#undef SC_LOAD
#undef SC_GEOM
    }
}
constexpr int S3_RAW = 0, S3_KS = 11520, S3_KK = 15616, S3_RS = 19712, S3_VS = 23808, S3_TWA = 27904, S3_ADA = 30208, S3_R1END = 32512;
constexpr int S3_GA = 0, S3_GBT = 4608;
constexpr int S3_MAK = 11520, S3_MBRT = 12288, S3_TA = 13056, S3_TT = 13824, S3_MKR = 14592, S3_MAB = 15616;
constexpr int S3_RQ0 = 0;
constexpr int S3_WSC = 16640, S3_WSC_STRIDE = 6144;
constexpr int S3_BCREST = S3_WSC + 4 * S3_WSC_STRIDE;
constexpr int S3_RTF = S3_BCREST, S3_KCF = S3_RTF + 4096, S3_G15 = S3_KCF + 4096, S3_ATT = S3_G15 + 256, S3_BCT = S3_ATT + 3072, S3_VT = S3_BCT + 3072;
constexpr int S3_S16 = S3_VT + 3072, S3_YO = S3_S16 + 9216, S3_BON = S3_YO + 4096, S3_DIR = S3_BON + 256;
static_assert(S3_MAB + 1024 <= S3_WSC && S3_WSC >= S3_KK && 2 * S3_DIR <= MISC_OFF && S3_RQ0 + 4 * 2304 <= S3_MAK, "scan3 LDS map");
#define S3_BAR() asm volatile("s_waitcnt lgkmcnt(0)\n\ts_barrier" ::: "memory")
#define S3_WAVE_SYNC() asm volatile("s_waitcnt lgkmcnt(0)" ::: "memory")
#define S3_IDS() int tl_ = F.tid; asm volatile("" : "+v"(tl_)); const int dt = tl_ & 255, lane = tl_ & 63, lr = lane & 15, lq = lane >> 4; const int wv_ = __builtin_amdgcn_readfirstlane(tl_ >> 6); const int w4 = wv_ & 3, d = wv_ >> 2; \
    LAS unsigned char* const L = F.lds + d * S3_DIR; (void)dt; (void)lr; (void)lq; (void)w4; (void)lane
#define S3_F32(name, off) LAS float* const name = (LAS float*)(L + (off))
__device__ __forceinline__ f32x4 mfma16(bf16x8 a, bf16x8 b, f32x4 c) { return __builtin_amdgcn_mfma_f32_16x16x32_bf16(a, b, c, 0, 0, 0); }

__device__ __forceinline__ void scan_phase3(Frame& F, int l) {
    const GAS bf16* PR = WSP(bf16, WS_PR);
    for (int p = F.vcu; p < NB * 8; p += F.G) {
        const int b = p >> 3, h = p & 7;
        f32x4 S[4];
#pragma unroll
        for (int i = 0; i < 4; ++i) S[i] = (f32x4){0.f, 0.f, 0.f, 0.f};
        v4u raw[3];
        int prow[3], pcol[3], plds[3];
        f32x4 mu0[5], mu1[5], kkc; bf16x8 Bw0, Bw1, Ba0, Ba1; float w0c, a0c, kac, rkc;
        { S3_IDS();
#pragma unroll
          for (int i = 0; i < 3; ++i) { const int pp = dt + 256 * i, row = pp / 40, rem = pp % 40, grp = rem >> 3, c8 = rem & 7;
              prow[i] = pp < 720 ? row : -100000; pcol[i] = (grp == 0 ? h * 64 : grp == 1 ? 512 + h * 64 : grp == 2 ? 1024 + h * 64 : grp == 3 ? 1536 : 1600) + 8 * c8; plds[i] = (row * 320 + rem * 8) * 2; }
          const int cg = dt & 15; const GAS float* mup = INP(9) + (size_t)(l * 2) * RCOLS + 4 * cg;
#pragma unroll
          for (int g = 0; g < 5; ++g) { const int gc = g == 0 ? h * 64 : g == 1 ? 512 + h * 64 : g == 2 ? 1024 + h * 64 : g == 3 ? 1536 : 1600; mu0[g] = *(const GAS f32x4*)(mup + gc); mu1[g] = *(const GAS f32x4*)(mup + RCOLS + gc); }
          kkc = *(const GAS f32x4*)(INP(15) + l * RW + h * 64 + 4 * cg);
          const GAS bf16* w2t = WSP(bf16, WS_LORA) + (size_t)((l * 2 + d) * RW + h * 64 + 16 * w4 + lr) * 64 + 8 * lq; const GAS bf16* a2t = w2t + (size_t)4 * RW * 64;
          Bw0 = *(const GAS bf16x8*)w2t; Bw1 = *(const GAS bf16x8*)(w2t + 32); Ba0 = *(const GAS bf16x8*)a2t; Ba1 = *(const GAS bf16x8*)(a2t + 32);
          const int ccol = h * 64 + 16 * w4 + lr;
          w0c = INP(10)[(l * 2 + d) * RW + ccol]; a0c = INP(12)[(l * 2 + d) * RW + ccol]; kac = INP(16)[l * RW + ccol]; rkc = INP(17)[l * RW + ccol];
          for (int i = dt; i < 9216 / 16; i += 256) *(LAS v4u*)(L + S3_S16 + 16 * i) = (v4u){0u, 0u, 0u, 0u}; }
#define SC_GEOM(c) const int s0_ = 16 * (c); const bool isctx_ = s0_ < TC; const int pos0_ = isctx_ ? s0_ : s0_ - TC; const int len_ = isctx_ ? TC : TL; \
        const int rowbase_ = isctx_ ? NL + b * TC : b * TL; const int toklo_ = d == 0 ? pos0_ : len_ - 16 - pos0_;
#define SC_LOAD(c) do { SC_GEOM(c) _Pragma("unroll") for (int i = 0; i < 3; ++i) { const int tr = toklo_ - 1 + prow[i]; raw[i] = (v4u){0u, 0u, 0u, 0u}; \
            if (tr >= 0 && tr < len_) raw[i] = *(const GAS v4u*)(PR + (size_t)(rowbase_ + tr) * RCOLS + pcol[i]); } } while (0)
        { S3_IDS(); SC_LOAD(0); }
        for (int c = 0; c < KVT / 16; ++c) {
            { S3_IDS();
#pragma unroll
              for (int i = 0; i < 3; ++i) { if (prow[i] >= 0) *(LAS v4u*)(L + S3_RAW + plds[i]) = raw[i]; }
              S3_BAR();
              if (c + 1 < KVT / 16) SC_LOAD(c + 1); }
            { S3_IDS(); S3_F32(RS, S3_RS); S3_F32(VS, S3_VS); S3_F32(KS, S3_KS); S3_F32(KK, S3_KK);
              const int j = dt >> 4, cg = dt & 15;
              f32x4 xs[5];
#pragma unroll
              for (int g = 0; g < 5; ++g) {
                  const v2u a0 = *(const LAS v2u*)(L + S3_RAW + ((j + 0) * 320 + g * 64 + 4 * cg) * 2), a1 = *(const LAS v2u*)(L + S3_RAW + ((j + 1) * 320 + g * 64 + 4 * cg) * 2), a2 = *(const LAS v2u*)(L + S3_RAW + ((j + 2) * 320 + g * 64 + 4 * cg) * 2);
                  const f32x4 x0 = (f32x4){bflo(a0.x), bfhi(a0.x), bflo(a0.y), bfhi(a0.y)}, x1 = (f32x4){bflo(a1.x), bfhi(a1.x), bflo(a1.y), bfhi(a1.y)}, x2 = (f32x4){bflo(a2.x), bfhi(a2.x), bflo(a2.y), bfhi(a2.y)};
                  xs[g] = x1 + mu0[g] * (x0 - x1) + mu1[g] * (x2 - x1);
              }
              *(LAS f32x4*)(RS + j * 64 + 4 * cg) = xs[0];
              *(LAS f32x4*)(VS + j * 64 + 4 * cg) = xs[2];
              *(LAS f32x4*)(KS + j * 64 + 4 * cg) = xs[1];
              const f32x4 kkf = xs[1] * kkc; float ss = (kkf.x * kkf.x + kkf.y * kkf.y) + (kkf.z * kkf.z + kkf.w * kkf.w);
              ss += __shfl_xor(ss, 1); ss += __shfl_xor(ss, 2); ss += __shfl_xor(ss, 4); ss += __shfl_xor(ss, 8);
              const float inv = rsq_(fmaxf(ss, 1e-24f));
              *(LAS f32x4*)(KK + j * 64 + 4 * cg) = kkf * inv;
              v2u tw; tw.x = pk2(tanh_fast(xs[3].x), tanh_fast(xs[3].y)); tw.y = pk2(tanh_fast(xs[3].z), tanh_fast(xs[3].w));
              *(LAS v2u*)(L + S3_TWA + (j * 72 + 4 * cg) * 2) = tw;
              v2u ad; ad.x = pk2(xs[4].x, xs[4].y); ad.y = pk2(xs[4].z, xs[4].w);
              *(LAS v2u*)(L + S3_ADA + (j * 72 + 4 * cg) * 2) = ad;
            }
            S3_BAR();
            { S3_IDS(); S3_F32(RS, S3_RS); S3_F32(VS, S3_VS); S3_F32(KS, S3_KS); S3_F32(KK, S3_KK); S3_F32(RTF, S3_RTF); S3_F32(KCF, S3_KCF); S3_F32(G15, S3_G15); S3_F32(BON, S3_BON);
              const int ao = (lr * 72 + 8 * lq) * 2;
              const bf16x8 At0 = lds_frag(L + S3_TWA + ao), At1 = lds_frag(L + S3_TWA + ao + 64), Aa0 = lds_frag(L + S3_ADA + ao), Aa1 = lds_frag(L + S3_ADA + ao + 64);
              f32x4 zw = mfma16(At0, Bw0, (f32x4){0.f, 0.f, 0.f, 0.f}); zw = mfma16(At1, Bw1, zw);
              f32x4 za = mfma16(Aa0, Ba0, (f32x4){0.f, 0.f, 0.f, 0.f}); za = mfma16(Aa1, Ba1, za);
              const int cl = 16 * w4 + lr;
              float wv[4], kt[4], bb[4], kkv[4], rsv[4], vsv[4];
#pragma unroll
              for (int i = 0; i < 4; ++i) { const int jj = 4 * lq + i;
                  wv[i] = __expf(-0.6065306597f * sigmoidf_(w0c + zw[i]));
                  const float al = sigmoidf_(a0c + za[i]);
                  kkv[i] = KK[jj * 64 + cl]; rsv[i] = RS[jj * 64 + cl]; vsv[i] = VS[jj * 64 + cl];
                  kt[i] = KS[jj * 64 + cl] * (1.0f + (al - 1.0f) * kac); bb[i] = kkv[i] * al;
                  float bp = rsv[i] * kt[i] * rkc;
                  bp += __shfl_xor(bp, 1); bp += __shfl_xor(bp, 2); bp += __shfl_xor(bp, 4); bp += __shfl_xor(bp, 8);
                  if (lr == 0) BON[w4 * 16 + jj] = bp; }
              const int gq = d == 0 ? lq : 3 - lq;
              float e0 = d == 0 ? wv[0] : wv[3], e1 = d == 0 ? wv[1] : wv[2], e2 = d == 0 ? wv[2] : wv[1], e3 = d == 0 ? wv[3] : wv[0];
              const float c0 = e0, c1 = c0 * e1, c2 = c1 * e2, c3 = c2 * e3;
              const float t0 = __shfl(c3, (d == 0 ? 0 : 48) + lr), t1 = __shfl(c3, (d == 0 ? 16 : 32) + lr), t2 = __shfl(c3, (d == 0 ? 32 : 16) + lr), t3 = __shfl(c3, (d == 0 ? 48 : 0) + lr);
              const float pre = gq == 0 ? 1.0f : gq == 1 ? t0 : gq == 2 ? t0 * t1 : t0 * t1 * t2;
              const float g15 = (t0 * t1) * (t2 * t3);
              const float gin[4] = { pre * c0, pre * c1, pre * c2, pre * c3 }, gex[4] = { pre, pre * c0, pre * c1, pre * c2 };
              if (lq == 0) G15[cl] = g15;
              float avs[4], bcs[4], vvs[4];
#pragma unroll
              for (int k = 0; k < 4; ++k) { const int i = d == 0 ? k : 3 - k, t = 4 * gq + k;
                  const float ig = rcp_(gin[k]), sc = g15 * ig;
                  const float av = -kkv[i] * gex[k], rv = rsv[i] * gin[k];
                  st_bf(L + S3_GA + (t * 72 + cl) * 2, bb[i] * ig); st_bf(L + S3_GA + ((16 + t) * 72 + cl) * 2, kt[i] * ig);
                  st_bf(L + S3_GBT + (t * 72 + cl) * 2, av); st_bf(L + S3_GBT + ((16 + t) * 72 + cl) * 2, rv);
                  RTF[t * 64 + cl] = rv; KCF[t * 64 + cl] = kt[i] * sc;
                  avs[k] = av; bcs[k] = bb[i] * sc; vvs[k] = vsv[i]; }
              *(LAS v2u*)(L + S3_ATT + (cl * 24 + 4 * gq) * 2) = (v2u){pk2(avs[0], avs[1]), pk2(avs[2], avs[3])};
              *(LAS v2u*)(L + S3_BCT + (cl * 24 + 4 * gq) * 2) = (v2u){pk2(bcs[0], bcs[1]), pk2(bcs[2], bcs[3])};
              *(LAS v2u*)(L + S3_VT + (cl * 24 + 4 * gq) * 2) = (v2u){pk2(vvs[0], vvs[1]), pk2(vvs[2], vvs[3])};
            }
            S3_BAR();
            { S3_IDS(); S3_F32(MAB, S3_MAB); S3_F32(MKR, S3_MKR);
              const int mt = w4 >> 1, nt = w4 & 1, ao = ((16 * mt + lr) * 72 + 8 * lq) * 2, bo = ((16 * nt + lr) * 72 + 8 * lq) * 2;
              f32x4 acc = mfma16(lds_frag(L + S3_GA + ao), lds_frag(L + S3_GBT + bo), (f32x4){0.f, 0.f, 0.f, 0.f});
              acc = mfma16(lds_frag(L + S3_GA + ao + 64), lds_frag(L + S3_GBT + bo + 64), acc);
#pragma unroll
              for (int i = 0; i < 4; ++i) { const int s = 4 * lq + i, t = lr; const bool keep = nt == 0 ? (s < t) : (s <= t); const float v = keep ? acc[i] : 0.f;
                  if (w4 == 0) MAB[s * 16 + t] = v;
                  else if (w4 == 2) st_bf(L + S3_MAK + (s * 24 + t) * 2, v);
                  else if (w4 == 1) st_bf(L + S3_MBRT + (t * 24 + s) * 2, v);
                  else MKR[s * 16 + t] = v; }
              if (w4 == 0) { S3_WAVE_SYNC();
                  if (lane < 16) { const int t = lane; float Tc[16];
#pragma unroll
                    for (int s = 15; s >= 0; --s) { float a = (s == t) ? 1.f : 0.f; asm volatile("" ::: "memory");
                        float mr[16];
#pragma unroll
                        for (int q4 = (s + 1) / 4; q4 < 4; ++q4) { const f32x4 mv = *(const LAS f32x4*)(MAB + s * 16 + 4 * q4); mr[4 * q4] = mv.x; mr[4 * q4 + 1] = mv.y; mr[4 * q4 + 2] = mv.z; mr[4 * q4 + 3] = mv.w; }
#pragma unroll
                        for (int jx = s + 1; jx < 16; ++jx) a = fmaf(mr[jx], Tc[jx], a);
                        Tc[s] = a; }
                    unsigned tt[8];
#pragma unroll
                    for (int s = 0; s < 16; ++s) st_bf(L + S3_TA + (s * 24 + t) * 2, Tc[s]);
#pragma unroll
                    for (int s = 0; s < 8; ++s) tt[s] = pk2(Tc[2 * s], Tc[2 * s + 1]);
                    *(LAS v4u*)(L + S3_TT + (t * 24) * 2) = (v4u){tt[0], tt[1], tt[2], tt[3]}; *(LAS v4u*)(L + S3_TT + (t * 24 + 8) * 2) = (v4u){tt[4], tt[5], tt[6], tt[7]}; } }
            }
            S3_BAR();
            { S3_IDS(); S3_F32(MKR, S3_MKR); S3_F32(KCF, S3_KCF); S3_F32(RTF, S3_RTF); S3_F32(G15, S3_G15); S3_F32(YO, S3_YO);
              const int cb = (w4 + 3) & 3;
              LAS unsigned char* const Wsc = L + S3_WSC + w4 * S3_WSC_STRIDE;
              LAS unsigned char* const Rq0 = L + S3_RQ0 + w4 * 2304;
              const bf16x8 Ata = lds_frag16(L + S3_TA + lr * 48, lane);
              { const f32x4 c1 = mfma16(lds_frag16(L + S3_MAK + lr * 48, lane), lds_frag16(L + S3_TT + lr * 48, lane), (f32x4){0.f, 0.f, 0.f, 0.f});
#pragma unroll
                for (int i = 0; i < 4; ++i) st_bf(Wsc + ((4 * lq + i) * 24 + lr) * 2, c1[i]); }
              S3_WAVE_SYNC();
              const bf16x8 Ac1 = lds_frag16(Wsc + lr * 48, lane);
              { const bf16x8 B0 = lds_frag16(L + S3_MBRT + lr * 48, lane), BE = lds_frag16(L + S3_BCT + (16 * cb + lr) * 48, lane);
                f32x4 i0, iE;
#pragma unroll
                for (int i = 0; i < 4; ++i) { i0[i] = MKR[(4 * lq + i) * 16 + lr]; iE[i] = KCF[(4 * lq + i) * 64 + 16 * cb + lr]; }
                const f32x4 d10 = mfma16(Ata, B0, (f32x4){0.f, 0.f, 0.f, 0.f}), d20 = mfma16(Ac1, B0, i0), d1E = mfma16(Ata, BE, (f32x4){0.f, 0.f, 0.f, 0.f}), d2E = mfma16(Ac1, BE, iE);
                *(LAS v2u*)(Wsc + 768 + (lr * 24 + 4 * lq) * 2) = (v2u){pk2(d10[0], d10[1]), pk2(d10[2], d10[3])};
                *(LAS v2u*)(Wsc + 1536 + (lr * 24 + 4 * lq) * 2) = (v2u){pk2(d20[0], d20[1]), pk2(d20[2], d20[3])};
                *(LAS v2u*)(Wsc + 2304 + (lr * 24 + 4 * lq) * 2) = (v2u){pk2(d1E[0], d1E[1]), pk2(d1E[2], d1E[3])};
                *(LAS v2u*)(Wsc + 3072 + (lr * 24 + 4 * lq) * 2) = (v2u){pk2(d2E[0], d2E[1]), pk2(d2E[2], d2E[3])}; }
              S3_WAVE_SYNC();
              const bf16x8 Bd10 = lds_frag16(Wsc + 768 + lr * 48, lane), Bd20 = lds_frag16(Wsc + 1536 + lr * 48, lane), Bd1E = lds_frag16(Wsc + 2304 + lr * 48, lane), Bd2E = lds_frag16(Wsc + 3072 + lr * 48, lane);
              f32x4 accY, accS[4];
#pragma unroll
              for (int mt = 0; mt < 4; ++mt) {
                  const bf16x8 Aa = lds_frag16(L + S3_ATT + (16 * mt + lr) * 48, lane), Av = lds_frag16(L + S3_VT + (16 * mt + lr) * 48, lane);
                  f32x4 r0;
#pragma unroll
                  for (int i = 0; i < 4; ++i) r0[i] = RTF[lr * 64 + 16 * mt + 4 * lq + i];
                  r0 = mfma16(Aa, Bd10, r0);
                  const f32x4 q1 = mfma16(Aa, Bd1E, (f32x4){0.f, 0.f, 0.f, 0.f});
                  *(LAS v2u*)(Rq0 + (lr * 72 + 16 * mt + 4 * lq) * 2) = (v2u){pk2(r0[0], r0[1]), pk2(r0[2], r0[3])};
                  *(LAS v2u*)(Wsc + 3840 + (lr * 72 + 16 * mt + 4 * lq) * 2) = (v2u){pk2(q1[0], q1[1]), pk2(q1[2], q1[3])};
                  accS[mt] = mfma16(Av, Bd2E, (f32x4){0.f, 0.f, 0.f, 0.f});
                  if (mt == w4) accY = mfma16(Av, Bd20, (f32x4){0.f, 0.f, 0.f, 0.f});
              }
              S3_WAVE_SYNC();
#pragma unroll
              for (int ks = 0; ks < 2; ++ks) {
                  const bf16x8 Bq0 = lds_frag(Rq0 + (lr * 72 + 8 * lq + 32 * ks) * 2), Bq1 = lds_frag(Wsc + 3840 + (lr * 72 + 8 * lq + 32 * ks) * 2);
#pragma unroll
                  for (int mt = 0; mt < 4; ++mt) { const bf16x8 As = lds_frag(L + S3_S16 + ((16 * mt + lr) * 72 + 8 * lq + 32 * ks) * 2);
                      accS[mt] = mfma16(As, Bq1, accS[mt]);
                      if (mt == w4) accY = mfma16(As, Bq0, accY); } }
#pragma unroll
              for (int i = 0; i < 4; ++i) YO[lr * 64 + 16 * w4 + 4 * lq + i] = accY[i];
              const float g = G15[16 * cb + lr];
#pragma unroll
              for (int mt = 0; mt < 4; ++mt) S[mt] = S[mt] * g + accS[mt];
            }
            S3_BAR();
            { S3_IDS(); const int cb = (w4 + 3) & 3;
#pragma unroll
              for (int mt = 0; mt < 4; ++mt)
#pragma unroll
                  for (int i = 0; i < 4; ++i) st_bf(L + S3_S16 + ((16 * mt + 4 * lq + i) * 72 + 16 * cb + lr) * 2, S[mt][i]);
            }
            { S3_IDS(); S3_F32(YO, S3_YO); S3_F32(BON, S3_BON); SC_GEOM(c)
              if (dt < 128) { const int s = dt >> 3, c8 = dt & 7; const int tok = d == 0 ? pos0_ + s : len_ - 1 - (pos0_ + s);
                  GAS bf16* Yd = WSP(bf16, d == 0 ? WS_YF : WS_YB);
                  const f32x4 a = *(const LAS f32x4*)(YO + s * 64 + 8 * c8), bq = *(const LAS f32x4*)(YO + s * 64 + 8 * c8 + 4);
                  v4u w; w.x = pk2(a.x, a.y); w.y = pk2(a.z, a.w); w.z = pk2(bq.x, bq.y); w.w = pk2(bq.z, bq.w);
                  *(GAS v4u*)(Yd + (size_t)(rowbase_ + tok) * RW + h * 64 + 8 * c8) = w; }
              else if (dt < 144) { const int jj = dt - 128; GAS float* bonus = WSP(float, WS_BONUS) + (size_t)d * MA * 8;
                  bonus[(size_t)(rowbase_ + toklo_ + jj) * 8 + h] = (BON[jj] + BON[16 + jj]) + (BON[32 + jj] + BON[48 + jj]); }
            }
        }
        __syncthreads();
#undef SC_LOAD
#undef SC_GEOM
    }
}
__global__ void __launch_bounds__(NWAVES * 64, 2) fwd_kernel(Args args) {
    extern __shared__ __attribute__((aligned(16))) unsigned char lds[];
    Frame F;
    F.lds = (LAS unsigned char*)lds;
    F.MISC = (volatile LAS unsigned*)(F.lds + MISC_OFF);
    F.tid = threadIdx.x; F.lane = F.tid & 63; F.wave = __builtin_amdgcn_readfirstlane(F.tid >> 6);
    F.G = gridDim.x; { const int bx = blockIdx.x; F.vcu = (F.G % 8 == 0) ? (bx % 8) * (F.G / 8) + bx / 8 : bx; }
    F.ws = args.ws; F.out = args.out; F.ctl = (gu32*)(args.ws + WS_CTL);
    for (int u = F.tid; u < 128; u += NWAVES * 64) ((LAS unsigned*)(F.lds + MISC_OFF))[u] = 0u;
    if (F.tid < 33) { const unsigned long long pv = (unsigned long long)args.in[F.tid]; ((LAS unsigned*)(F.lds + PTAB_OFF))[2 * F.tid] = (unsigned)pv; ((LAS unsigned*)(F.lds + PTAB_OFF))[2 * F.tid + 1] = (unsigned)(pv >> 32); }
    __syncthreads();
    const int vcu0 = F.vcu;
    const bool fused = args.mode == 0;
    XcdBarrier bar; bar.bar = (unsigned*)(F.ctl + CW_BAR); bar.x = 0; bar.st = nullptr;
    if (fused) bar = xcd_barrier_post((unsigned*)(F.ctl + CW_BAR), F.MISC + 8);
#ifndef REP_PRO
#define REP_PRO 1
#endif
#ifndef REP_NORM
#define REP_NORM 1
#endif
#ifndef REP_GEMM1
#define REP_GEMM1 1
#endif
#ifndef REP_SCAN
#define REP_SCAN 1
#endif
#ifndef REP_ROUT
#define REP_ROUT 1
#endif
#ifndef REP_ATTN_DUMMY
#define REP_ATTN_DUMMY 0
#endif
#ifndef REP_MERGEA
#define REP_MERGEA 1
#endif
#ifndef REP_GU
#define REP_GU 1
#endif
#ifndef REP_DOWN_DUMMY
#define REP_DOWN_DUMMY 0
#endif
#ifndef REP_MOECONV
#define REP_MOECONV 1
#endif
#ifndef REP_MOEGEMM
#define REP_MOEGEMM 1
#endif
#define REPEAT(n) for (int rep_ = 0; rep_ < (n); ++rep_)
#ifndef SITE_MASK
#define SITE_MASK 0xFFFF
#endif
#define RUN(L, S) (((SITE_MASK >> (S)) & 1) && (fused || (args.l == (L) && args.site == (S))))
#define GRID_BAR() do { if (fused) xcd_barrier(bar); } while (0)
#define SITE_BEGIN() do { int t_ = threadIdx.x; asm volatile("" : "+v"(t_)); F.tid = t_; F.lane = t_ & 63; F.wave = __builtin_amdgcn_readfirstlane(t_ >> 6); int v_ = vcu0; asm volatile("" : "+s"(v_)); F.vcu = v_; unsigned long long w_ = (unsigned long long)args.ws, o_ = (unsigned long long)args.out; asm volatile("" : "+s"(w_), "+s"(o_)); F.ws = (unsigned char*)w_; F.out = (GAS float*)o_; F.ctl = (gu32*)(F.ws + WS_CTL); } while (0)
    GAS float* const XC = WSP(float, WS_XC);
    GAS float* const MOD = WSP(float, WS_MOD);
    LAS int* const tile_e = (LAS int*)(F.lds + RING_BYTES);

    if (RUN(0, 0)) { SITE_BEGIN(); REPEAT(REP_PRO) p0_prologue(F); GRID_BAR(); }

    for (int l = 0; l < 2; ++l) {
        const GAS float* xlat = l == 0 ? INP(0) : (const GAS float*)F.out;
        const GAS float* xctx = l == 0 ? INP(2) : (const GAS float*)XC;
        const int nM_mix = l == 0 ? MA / 256 : NL / 256;
        if (RUN(l, 1)) { SITE_BEGIN(); REPEAT(REP_NORM) norm_mod_phase<false>(F, l, 0, xlat, xctx, MA, WSP(bf16, WS_H)); GRID_BAR(); }
        if (RUN(l, 2)) { SITE_BEGIN();
            pg8::StdOrder S; S.init(WSGEN(bf16, WS_H), WSGEN(bf16, WS_WIN) + (size_t)l * NIN * DM, DM, MA / 256, NIN / 256, F.G, (int)blockIdx.x);
            EpiIn E{WSP(bf16, WS_PR), WSP(bf16, WS_Q), WSP(bf16, WS_KB), WSP(bf16, WS_VB), WSP(bf16, WS_G)};
            REPEAT(REP_GEMM1) pg8::gemm_phase<EpiIn, pg8::StdOrder, true, true>(F.lds, DM, S, E);
            GRID_BAR();
        }
        if (RUN(l, 3)) { SITE_BEGIN();
#ifndef NO_SCAN
            REPEAT(REP_SCAN) scan_phase3(F, l);
#endif
#ifndef NO_QK
            qk_phase(F, l);
#endif
            GRID_BAR(); }
        if (RUN(l, 4)) { SITE_BEGIN(); REPEAT(REP_ROUT) rwkv_out_phase(F, l, nM_mix * 256); REPEAT(REP_ATTN_DUMMY) attn_phase(F, l, (char*)lds, WS_YF); attn_phase(F, l, (char*)lds, WS_Q); GRID_BAR(); }
        if (RUN(l, 5)) { SITE_BEGIN();
            { pg8::StdOrder S; S.init(WSGEN(bf16, WS_YR), WSGEN(bf16, WS_WPA) + (size_t)l * DM * RW, RW, nM_mix, DM / 256, F.G, (int)blockIdx.x);
              EpiMerge<0> E{WSP(bf16, WS_G), WSP(bf16, WS_MG)};
              REPEAT(REP_MERGEA) pg8::gemm_phase<EpiMerge<0>, pg8::StdOrder, true, true>(F.lds, RW, S, E); }
            __syncthreads();
            { pg8::StdOrder S; S.init(WSGEN(bf16, WS_Q), WSGEN(bf16, WS_WPB) + (size_t)l * DM * RW, RW, nM_mix, DM / 256, F.G, (int)blockIdx.x);
              EpiMerge<1> E{WSP(bf16, WS_G), WSP(bf16, WS_MG)};
              pg8::gemm_phase<EpiMerge<1>, pg8::StdOrder, true, true>(F.lds, RW, S, E); }
            GRID_BAR();
        }
        if (RUN(l, 6)) { SITE_BEGIN();
            pg8::StdOrder S; S.init(WSGEN(bf16, WS_MG), WSGEN(bf16, WS_WO) + (size_t)l * DM * DM, DM, nM_mix, DM / 256, F.G, (int)blockIdx.x);
            EpiRes E{xlat, xctx, F.out, XC, MOD + (size_t)l * 33 * 6144 + 2048};
            pg8::gemm_phase<EpiRes, pg8::StdOrder, true, true>(F.lds, DM, S, E);
            GRID_BAR();
        }
        if (RUN(l, 7)) { SITE_BEGIN();
            if (l == 0) norm_mod_phase<false>(F, l, 1, F.out, XC, MA, WSP(bf16, WS_H));
            else norm_mod_phase<true>(F, l, 1, F.out, XC, NL, WSP(bf16, WS_H2M));
            GRID_BAR();
        }
        if (l == 0) {
            if (RUN(0, 8)) { SITE_BEGIN();
                pg8::StdOrder S; S.init(WSGEN(bf16, WS_H), WSGEN(bf16, WS_WGU), DM, MA / 256, 2 * FF / 256, F.G, (int)blockIdx.x);
                EpiGU E{WSP(bf16, WS_ACT), 0};
                REPEAT(REP_GU) pg8::gemm_phase<EpiGU, pg8::StdOrder, true, true>(F.lds, DM, S, E);
                GRID_BAR();
            }
            if (RUN(0, 9)) { SITE_BEGIN();
                pg8::StdOrder S; S.init(WSGEN(bf16, WS_ACT), WSGEN(bf16, WS_WDN), FF, MA / 256, DM / 256, F.G, (int)blockIdx.x);
                EpiRes E{F.out, XC, F.out, XC, MOD + 5120};
                REPEAT(REP_DOWN_DUMMY) { EpiStore ED{WSP(bf16, WS_H)}; pg8::gemm_phase<EpiStore, pg8::StdOrder, true, true>(F.lds, FF, S, ED); __syncthreads(); }
                pg8::gemm_phase<EpiRes, pg8::StdOrder, true, true>(F.lds, FF, S, E);
                GRID_BAR();
            }
        } else {
            if (RUN(1, 10)) { SITE_BEGIN(); REPEAT(REP_MOECONV) moe_conv(F); __syncthreads(); moe_slots(F); GRID_BAR(); }
            int ntile = 0;
            if (fused || args.site == 11 || args.site == 12) ntile = moe_tiles(F, tile_e);
            for (int ch = 0; ch < MOE_NCHUNK; ++ch) {
                if (!fused && ch != args.chunk) continue;
                const int t0 = ch * MOE_CH_TILES; if (t0 >= ntile) break;
                const int ntl = (ch == MOE_NCHUNK - 1 || (ntile - t0) < MOE_CH_TILES) ? (ntile - t0) : MOE_CH_TILES;
                if (RUN(1, 11)) { SITE_BEGIN();
                    MoeOrder S{(const char*)(F.ws + WS_XB), (const char*)(F.ws + WS_MW), (size_t)256 * DM * 2, (size_t)256 * DM * 2, (size_t)21 * MiB, t0, 0, ntl, 2 * FF / 256, F.G, (int)blockIdx.x, tile_e};
                    EpiGU E{WSP(bf16, WS_ACTC), t0};
                    REPEAT(REP_MOEGEMM) pg8::gemm_phase<EpiGU, MoeOrder, true, true>(F.lds, DM, S, E);
                    GRID_BAR();
                }
                if (RUN(1, 12)) { SITE_BEGIN();
                    MoeOrder S{(const char*)(F.ws + WS_ACTC), (const char*)(F.ws + WS_MW) + (size_t)2 * FF * DM * 2, (size_t)256 * FF * 2, (size_t)256 * FF * 2, (size_t)21 * MiB, t0, t0, ntl, DM / 256, F.G, (int)blockIdx.x, tile_e};
                    EpiStore E{WSP(bf16, WS_YM)};
                    REPEAT(REP_MOEGEMM) pg8::gemm_phase<EpiStore, MoeOrder, true, true>(F.lds, FF, S, E);
                    GRID_BAR();
                }
            }
            if (RUN(1, 13)) { SITE_BEGIN(); moe_final(F); }
        }
    }
#undef RUN
#undef GRID_BAR
}

extern "C" void kernel_launch(void* const* d_in, const GAS int* in_sizes, int n_in, void* d_out, int out_size, void* d_ws, size_t ws_size, hipStream_t stream) {
    static int grid = 0;
    if (grid == 0) {
        if (n_in != 33 || in_sizes[0] != NL * DM || out_size != NL * DM || ws_size < WS_END) { fprintf(stderr, "kernel_launch: unexpected problem (n_in %d, x %d, out %d, ws %zu < %zu); nothing launched\n", n_in, n_in > 0 ? in_sizes[0] : -1, out_size, ws_size, (size_t)WS_END); grid = -1; return; }
        int dev = 0, cus = 0, per_cu = 0;
        if (hipGetDevice(&dev) != hipSuccess || hipDeviceGetAttribute(&cus, hipDeviceAttributeMultiprocessorCount, dev) != hipSuccess) { fprintf(stderr, "kernel_launch: device query failed\n"); grid = -1; return; }
        if (hipFuncSetAttribute((const void*)fwd_kernel, hipFuncAttributeMaxDynamicSharedMemorySize, LDS_BYTES) != hipSuccess) { fprintf(stderr, "kernel_launch: hipFuncSetAttribute failed\n"); grid = -1; return; }
        if (hipOccupancyMaxActiveBlocksPerMultiprocessor(&per_cu, (const void*)fwd_kernel, NWAVES * 64, LDS_BYTES) != hipSuccess || per_cu < 1) { fprintf(stderr, "kernel_launch: occupancy query reports %d workgroups per CU\n", per_cu); }
        (void)hipGetLastError();
        grid = cus;
        fprintf(stderr, "kernel_launch: grid %d, occupancy query %d\n", grid, per_cu);
    }
    if (grid < 0) return;
    if (hipMemsetAsync((char*)d_ws + WS_CTL, 0, CTL_ZERO_BYTES, stream) != hipSuccess) { fprintf(stderr, "kernel_launch: memset failed\n"); return; }
    Args a{};
    for (int i = 0; i < 33; ++i) a.in[i] = (const GAS float*)d_in[i];
    a.out = (GAS float*)d_out; a.ws = (unsigned char*)d_ws;
#if MK_FUSED
    a.mode = 0; a.l = 0; a.site = 0; a.chunk = 0;
    hipLaunchKernelGGL(fwd_kernel, dim3(grid), dim3(NWAVES * 64), LDS_BYTES, stream, a);
#else
    a.mode = 1;
    auto step = [&](int l, int site, int chunk) { a.l = l; a.site = site; a.chunk = chunk; hipLaunchKernelGGL(fwd_kernel, dim3(grid), dim3(NWAVES * 64), LDS_BYTES, stream, a); };
    step(0, 0, 0);
    for (int l = 0; l < 2; ++l) {
        for (int s = 1; s <= 7; ++s) step(l, s, 0);
        if (l == 0) { step(0, 8, 0); step(0, 9, 0); }
        else { step(1, 10, 0); for (int ch = 0; ch < MOE_NCHUNK; ++ch) { step(1, 11, ch); step(1, 12, ch); } step(1, 13, 0); }
    }
#endif
    const hipError_t le = hipPeekAtLastError();
    if (le != hipSuccess) fprintf(stderr, "kernel_launch: launch failed: %s\n", hipGetErrorName(le));
}
```

```cpp
#include <hip/hip_runtime.h>
#include <hip/hip_bf16.h>
#include <cstdio>
#include <cstdint>
#include <cmath>

#ifndef MK_FUSED
#define MK_FUSED 1
#endif

constexpr int DM = 1024, NB = 32, TL = 2048, TC = 256;
constexpr int NL = NB * TL;
constexpr int NC = NB * TC;
constexpr int MA = NL + NC;
constexpr int RW = 512, RCOLS = 1792, ACOLS = 768, GCOLS = 2048, NIN = 4608;
constexpr int FF = 3584, NE = 8;
constexpr int KVT = TL + TC;
constexpr int MOE_ROWS = 2 * NL + NE * 256;
constexpr int MOE_CH_TILES = 64;
constexpr int MOE_NCHUNK = 8;
constexpr int MOE_LAST_TILES = 72;

constexpr size_t MiB = 1u << 20;
constexpr size_t WS_CTL = 0, CTL_ZERO_BYTES = 1 * MiB;
constexpr size_t WS_MOD = 1 * MiB;
constexpr size_t WS_ROPE = 3 * MiB;
constexpr size_t WS_LORA = 4 * MiB;
constexpr size_t WS_BONUS = 5 * MiB;
constexpr size_t WS_MOETAB = 10 * MiB;
constexpr size_t WS_WIN = 16 * MiB;
constexpr size_t WS_WPA = 34 * MiB;
constexpr size_t WS_WPB = 36 * MiB;
constexpr size_t WS_WO = 38 * MiB;
constexpr size_t WS_WGU = 42 * MiB;
constexpr size_t WS_WDN = 56 * MiB;
constexpr size_t WS_XC = 64 * MiB;
constexpr size_t WS_X16 = 752 * MiB;
constexpr size_t WS_H = 96 * MiB;
constexpr size_t WS_YF = 96 * MiB, WS_YB = 168 * MiB;
constexpr size_t WS_PR = 240 * MiB;
constexpr size_t WS_MG = 240 * MiB;
constexpr size_t WS_Q = 492 * MiB;
constexpr size_t WS_KB = 564 * MiB, WS_VB = 582 * MiB;
constexpr size_t WS_G = 600 * MiB;
constexpr size_t WS_YR = 888 * MiB;
constexpr size_t WS_ACT = 240 * MiB;
constexpr size_t WS_H2M = 80 * MiB;
constexpr size_t WS_MW = 208 * MiB;
constexpr size_t WS_XB = 376 * MiB;
constexpr size_t WS_YM = 488 * MiB;
constexpr int FFN_NCHUNK = 5, FFN_C0 = MA / 256 - (FFN_NCHUNK - 1) * MOE_CH_TILES;
static_assert(FFN_C0 > 0 && FFN_C0 <= MOE_CH_TILES, "ffn chunks");
constexpr size_t WS_ACTC = 896 * MiB;
constexpr size_t WS_ACTC1 = WS_XB;
constexpr size_t WS_END = 1024 * MiB;
static_assert(WS_H + (size_t)MA * DM * 2 <= WS_PR && WS_PR + (size_t)MA * RCOLS * 2 <= WS_Q && WS_Q + (size_t)MA * 512 * 2 <= WS_KB, "ws map 1");
static_assert(WS_KB + (size_t)MA * 128 * 2 <= WS_VB && WS_VB + (size_t)MA * 128 * 2 <= WS_G && WS_G + (size_t)MA * GCOLS * 2 <= WS_YR && WS_YR + (size_t)MA * 512 * 2 <= WS_END, "ws map 2");
static_assert(WS_ACT + (size_t)MA * FF * 2 <= WS_END && WS_H2M + (size_t)NL * DM * 2 <= WS_MW && WS_MW + (size_t)NE * 21 * MiB <= WS_XB && WS_H2M >= WS_XC, "ws map 3");
static_assert(WS_YM + (size_t)MOE_ROWS * DM * 2 <= WS_ACTC && WS_ACTC + (size_t)MOE_LAST_TILES * 256 * FF * 2 <= WS_END, "ws map 4");
static_assert(WS_ACTC1 + (size_t)MOE_CH_TILES * 256 * FF * 2 <= WS_YM, "ws map 4b");
static_assert(WS_YM + (size_t)MOE_ROWS * DM * 2 <= WS_X16 && WS_G + (size_t)MA * GCOLS <= WS_X16 && WS_X16 + (size_t)NL * DM * 2 <= WS_YR && WS_ACT + 240 * MiB <= WS_X16, "ws map 6");
static_assert(WS_WDN + (size_t)DM * FF * 2 <= WS_XC && WS_BONUS + (size_t)2 * MA * 8 * 4 <= WS_MOETAB, "ws map 5");
constexpr size_t MT_TOKE = 0;
constexpr size_t MT_TOKW = 512 * 1024;
constexpr size_t MT_TOKS = 1024 * 1024;
constexpr size_t MT_ROWT = 1536 * 1024;
constexpr int CW_TMO = 0, CW_CODE = 1;
constexpr int CW_BAR = 4096;
constexpr int CW_HIST = 8192;
constexpr int CW_CURS = 8192 + 64 * 8;

constexpr int NWAVES = 8;
constexpr int LDS_BYTES = 147456;
constexpr int MISC_OFF = LDS_BYTES - 1024;
constexpr int PTAB_OFF = LDS_BYTES - 512;
constexpr int RING_BYTES = 131072;

#define GAS __attribute__((address_space(1)))
#define LAS __attribute__((address_space(3)))
typedef unsigned short bf16;
typedef unsigned v4u __attribute__((ext_vector_type(4)));
typedef unsigned v2u __attribute__((ext_vector_type(2)));
typedef float f32x4 __attribute__((ext_vector_type(4)));
typedef float f32x2 __attribute__((ext_vector_type(2)));
typedef short bf16x8 __attribute__((ext_vector_type(8)));
typedef GAS unsigned gu32;
#define RLX_AGENT __ATOMIC_RELAXED, __HIP_MEMORY_SCOPE_AGENT
#define LDS_WAIT() asm volatile("s_waitcnt lgkmcnt(0)" ::: "memory")
#define VM_WAIT() asm volatile("s_waitcnt vmcnt(0)" ::: "memory")
__device__ __forceinline__ float bf2f(unsigned b) { return __uint_as_float(b << 16); }
__device__ __forceinline__ float bflo(unsigned w) { return __uint_as_float(w << 16); }
__device__ __forceinline__ float bfhi(unsigned w) { return __uint_as_float(w & 0xffff0000u); }
typedef __bf16 bf16x2_t __attribute__((ext_vector_type(2)));
__device__ __forceinline__ unsigned pk2(float lo, float hi) { const f32x2 v = {lo, hi}; const bf16x2_t b = __builtin_convertvector(v, bf16x2_t); return __builtin_bit_cast(unsigned, b); }
__device__ __forceinline__ float rcp_(float x) { return __builtin_amdgcn_rcpf(x); }
__device__ __forceinline__ float rsq_(float x) { return __builtin_amdgcn_rsqf(x); }
__device__ __forceinline__ float sigmoidf_(float x) { return rcp_(1.0f + __expf(-x)); }

__device__ __forceinline__ float row8_sum(float v) {
    v += __builtin_bit_cast(float, __builtin_amdgcn_mov_dpp(__builtin_bit_cast(int, v), 0xB1, 0xF, 0xF, true));
    v += __builtin_bit_cast(float, __builtin_amdgcn_mov_dpp(__builtin_bit_cast(int, v), 0x4E, 0xF, 0xF, true));
    v += __builtin_bit_cast(float, __builtin_amdgcn_mov_dpp(__builtin_bit_cast(int, v), 0x141, 0xF, 0xF, true));
    return v;
}
__device__ __forceinline__ float lane_get(float v, int src) { return __builtin_bit_cast(float, __builtin_amdgcn_ds_bpermute(src << 2, __builtin_bit_cast(int, v))); }
__device__ __forceinline__ float row16_sum(float v) {
    v += __builtin_bit_cast(float, __builtin_amdgcn_mov_dpp(__builtin_bit_cast(int, v), 0xB1, 0xF, 0xF, true));
    v += __builtin_bit_cast(float, __builtin_amdgcn_mov_dpp(__builtin_bit_cast(int, v), 0x4E, 0xF, 0xF, true));
    v += __builtin_bit_cast(float, __builtin_amdgcn_mov_dpp(__builtin_bit_cast(int, v), 0x141, 0xF, 0xF, true));
    v += __builtin_bit_cast(float, __builtin_amdgcn_mov_dpp(__builtin_bit_cast(int, v), 0x140, 0xF, 0xF, true));
    return v;
}
__device__ __forceinline__ float xsum16(float v) { const auto r = __builtin_amdgcn_permlane16_swap(__float_as_uint(v), __float_as_uint(v), false, false); return __uint_as_float(r[0]) + __uint_as_float(r[1]); }
__device__ __forceinline__ float xsum32(float v) { const auto r = __builtin_amdgcn_permlane32_swap(__float_as_uint(v), __float_as_uint(v), false, false); return __uint_as_float(r[0]) + __uint_as_float(r[1]); }
__device__ __forceinline__ float wave_sum(float v) { return xsum32(xsum16(row16_sum(v))); }
__device__ __forceinline__ int row_bi(int m) { return m < NL ? (m >> 11) : 32; }
__device__ __forceinline__ int row_kv(int m) { return m < NL ? (m >> 11) * KVT + (m & 2047) : ((m - NL) >> 8) * KVT + TL + ((m - NL) & 255); }
namespace pg8 {
#define PG8_LAS __attribute__((address_space(3)))
#define PG8_GAS __attribute__((address_space(1)))
typedef unsigned short bf16_t;
typedef short bf16x8 __attribute__((ext_vector_type(8)));
typedef float f32x4 __attribute__((ext_vector_type(4)));
typedef unsigned u32x4 __attribute__((ext_vector_type(4)));
constexpr int NL_ROWS = 65536;
constexpr int BM = 256, BK = 64, HALF = 128, HTB = HALF * BK * 2  , STAGE_BYTES = 8 * HTB, NXCD = 8, WGM = 8;

__host__ __device__ __forceinline__ int lds_byte(int r, int c) { const int st = (r >> 4) * 2 + (c >> 5), rr = r & 15, cc = c & 31, ob = rr * 64 + cc * 2; return st * 1024 + (ob ^ (((ob >> 9) & 1) << 5)); }
__host__ __device__ __forceinline__ void stage_rc(int b, int& R, int& C) { const int st = b / 1024, sb = b % 1024, swz = sb ^ (((sb >> 9) & 1) << 5); R = (st >> 1) * 16 + swz / 64; C = (st & 1) * 32 + (swz % 64) / 2; }
__host__ __device__ __forceinline__ int perm32(int rho) { const int n = rho >> 4, i = rho & 15; return 8 * (i >> 2) + 4 * n + (i & 3); }

struct Unit { int pm, pn, part; };

struct StdOrder {
    static constexpr bool GATHER = false;
    const char* A; const char* Bt; size_t tstep; int nM, nN, nwg, G, c;
    __device__ void init(const void* A_, const void* Bt_, int K, int nM_, int nN_, int G_, int c_) { A = (const char*)A_; Bt = (const char*)Bt_; tstep = (size_t)BM * K * 2; nM = nM_; nN = nN_; nwg = nM * nN; G = G_; c = c_; }
    __device__ bool next(int i, Unit& u) const {
        const long L = (long)i * G + c; if (L >= nwg) return false;
        int wgid = (int)L; { const int q = nwg / NXCD, r = nwg % NXCD, xcd = wgid % NXCD, off = wgid / NXCD; wgid = (xcd < r ? xcd * (q + 1) : r * (q + 1) + (xcd - r) * q) + off; }
        const int nig = WGM * nN, gid = wgid / nig, fm = gid * WGM, gsz = (nM - fm) < WGM ? (nM - fm) : WGM;
        u.pm = fm + ((wgid % nig) % gsz); u.pn = (wgid % nig) / gsz; u.part = 0; return true;
    }
    __device__ __forceinline__ const char* a_base(const Unit& u) const { return A + (size_t)u.pm * tstep; }
    __device__ __forceinline__ const char* b_base(const Unit& u) const { return Bt + (size_t)u.pn * tstep; }
    __device__ __forceinline__ void a_ready(const Unit&) const {}
    __device__ __forceinline__ void done(const Unit&) const {}
};
struct In1Order : StdOrder {
    __device__ bool next(int i, Unit& u) const {
        const long L = (long)i * G + c; const int nlat = (NL_ROWS / BM) * nN;
        if (L < nlat) { StdOrder s = *this; s.nM = NL_ROWS / BM; s.nwg = nlat; return s.next(i, u); }
        const int r = (int)(L - nlat); if (r >= (nM - NL_ROWS / BM) * 8) return false;
        const int nct = nM - NL_ROWS / BM, q = r / nct; u.pm = NL_ROWS / BM + r % nct; u.pn = q < 7 ? q : 9; u.part = 0; return true;
    }
};
struct PairOrder : StdOrder {
    const char* A2; const char* Bt2;
    __device__ bool next(int i, Unit& u) const { if (!StdOrder::next(i >> 1, u)) return false; u.part = i & 1; return true; }
    __device__ __forceinline__ const char* a_base(const Unit& u) const { return (u.part ? A2 : A) + (size_t)u.pm * tstep; }
    __device__ __forceinline__ const char* b_base(const Unit& u) const { return (u.part ? Bt2 : Bt) + (size_t)u.pn * tstep; }
};
template <class Epi, class Sched, bool ALIGN_EPI = false, bool SP2 = false>
__device__ __forceinline__ void gemm_phase(PG8_LAS unsigned char* lds, const int K, const Sched& S, const Epi& E, const int tid_in) {
    int tid_l = tid_in; asm volatile("" : "+v"(tid_l));
    const int tid = tid_l, wid = __builtin_amdgcn_readfirstlane(tid >> 6), lane = tid & 63, wr = wid >> 2, wc = wid & 3, fr = lane & 15, fq = lane >> 4;
    const int nt = K / BK;
    unsigned voffA[2], voffB[2];
#pragma unroll
    for (int i = 0; i < 2; ++i) { int R, C; stage_rc(tid * 16 + i * 8192, R, C); const int Rb = Epi::PERM ? ((R & ~31) + perm32(R & 31)) : R;
        voffA[i] = (unsigned)(R * K + C) * 2u; voffB[i] = (unsigned)(Rb * K + C) * 2u; }
    const size_t kstep = (size_t)(BK * 2);
    const size_t hstep = (size_t)HALF * K * 2;
    const unsigned ldsw = (unsigned)wid * 1024u;
    const int aoff = lds_byte(wr * 64 + fr, fq * 8), boff = lds_byte(wc * 32 + fr, fq * 8);
#define PG8_SA(b, h) (((b) * 2 + (h)) * HTB)
#define PG8_SB(b, h) ((4 + (b) * 2 + (h)) * HTB)
#define PG8_STAGE(bufoff, gbase, voff) do { _Pragma("unroll") for (int _i = 0; _i < 2; ++_i) \
        __builtin_amdgcn_global_load_lds((const unsigned*)((const char*)(gbase) + (voff)[_i]), (PG8_LAS unsigned*)(lds + (bufoff) + ldsw + _i * 8192), 16, 0, 0); } while (0)
#define PG8_STA(bufoff, gbase, h) do { if constexpr (Sched::GATHER) PG8_STAGE(bufoff, gbase, gA[h]); else PG8_STAGE(bufoff, (gbase) + ((h) ? hstep : (size_t)0), voffA); } while (0)
#define PG8_LDA(dst, b, h) do { _Pragma("unroll") for (int m = 0; m < 4; ++m) _Pragma("unroll") for (int k = 0; k < 2; ++k) dst[m][k] = *(const PG8_LAS bf16x8*)(lds + PG8_SA(b, h) + aoff + m * 2048 + k * 1024); } while (0)
#define PG8_LDB(dst, b, h) do { _Pragma("unroll") for (int n = 0; n < 2; ++n) _Pragma("unroll") for (int k = 0; k < 2; ++k) dst[n][k] = *(const PG8_LAS bf16x8*)(lds + PG8_SB(b, h) + boff + n * 2048 + k * 1024); } while (0)
#define PG8_MMA(ai, bj, At, Bt) do { __builtin_amdgcn_s_setprio(1); _Pragma("unroll") for (int m = 0; m < 4; ++m) _Pragma("unroll") for (int n = 0; n < 2; ++n) _Pragma("unroll") for (int k = 0; k < 2; ++k) \
        acc[ai][bj][m][n] = __builtin_amdgcn_mfma_f32_16x16x32_bf16(Bt[n][k], At[m][k], acc[ai][bj][m][n], 0, 0, 0); __builtin_amdgcn_s_setprio(0); } while (0)
#define PG8_WAIT_V(n) asm volatile("s_waitcnt vmcnt(" #n ")" ::: "memory")
#define PG8_WAIT_L(n) asm volatile("s_waitcnt lgkmcnt(" #n ")" ::: "memory")
#define PG8_BAR __builtin_amdgcn_s_barrier()
#define PG8_SCHED __builtin_amdgcn_sched_barrier(0)
    Unit cur, nxt; int ui = 0;
    if (!S.next(0, cur)) return;
    static_assert(!Sched::GATHER || SP2, "gather needs the SP2 schedule");
    [[maybe_unused]] unsigned gA[2][2], gN[2][2];
#define PG8_ROWS(g, u) do { const PG8_GAS int* rt_ = S.row_tab() + (u).pm * 256; _Pragma("unroll") for (int _i = 0; _i < 2; ++_i) { int R_, C_; stage_rc(tid * 16 + _i * 8192, R_, C_); \
        g[0][_i] = (unsigned)rt_[R_] * (unsigned)(K * 2) + (unsigned)(C_ * 2); g[1][_i] = (unsigned)rt_[HALF + R_] * (unsigned)(K * 2) + (unsigned)(C_ * 2); } } while (0)
    if constexpr (Sched::GATHER) PG8_ROWS(gA, cur);
    f32x4 acc[2][2][4][2];
#pragma unroll
    for (int a = 0; a < 2; ++a)
#pragma unroll
        for (int b = 0; b < 2; ++b)
#pragma unroll
            for (int m = 0; m < 4; ++m)
#pragma unroll
                for (int n = 0; n < 2; ++n) acc[a][b][m][n] = (f32x4){0.f, 0.f, 0.f, 0.f};
    bf16x8 At[4][2], B0[2][2], B1[2][2];
    const char* cA = S.a_base(cur); const char* cB = S.b_base(cur);
    S.a_ready(cur);
    if constexpr (SP2) {
        PG8_STAGE(PG8_SB(0, 0), cB, voffB); PG8_STAGE(PG8_SB(0, 1), cB + hstep, voffB); PG8_STA(PG8_SA(0, 0), cA, 0); PG8_STA(PG8_SA(0, 1), cA, 1);
        if (wr == 1) PG8_BAR;
        PG8_WAIT_V(2); PG8_BAR;
        PG8_STAGE(PG8_SB(1, 0), cB + kstep, voffB); PG8_STA(PG8_SA(1, 0), cA + kstep, 0); PG8_STAGE(PG8_SB(1, 1), cB + hstep + kstep, voffB);
        PG8_WAIT_V(6); PG8_BAR;
    } else {
        PG8_STAGE(PG8_SB(0, 0), cB, voffB); PG8_STAGE(PG8_SA(0, 0), cA, voffA); PG8_STAGE(PG8_SB(0, 1), cB + hstep, voffB); PG8_STAGE(PG8_SA(0, 1), cA + hstep, voffA);
        if (wr == 1) PG8_BAR;
        PG8_WAIT_V(4); PG8_BAR;
        PG8_STAGE(PG8_SB(1, 0), cB + kstep, voffB); PG8_STAGE(PG8_SA(1, 0), cA + kstep, voffA); PG8_STAGE(PG8_SB(1, 1), cB + hstep + kstep, voffB);
        PG8_WAIT_V(6); PG8_BAR;
    }
    for (;;) {
        const bool has_next = S.next(ui + 1, nxt);
        const char* nA = has_next ? S.a_base(nxt) : cA; const char* nB = has_next ? S.b_base(nxt) : cB;
        if constexpr (Sched::GATHER) { if (has_next) PG8_ROWS(gN, nxt); }
        for (int t = 0; t < nt; t += 2) {
            const bool last = (t == nt - 2);
            const char* a1 = cA + (size_t)(t + 1) * kstep;
            const char* a2 = last ? nA : cA + (size_t)(t + 2) * kstep; const char* b2 = last ? nB : cB + (size_t)(t + 2) * kstep;
            const char* a3 = a2 + kstep; const char* b3 = b2 + kstep;
            if (last && has_next) S.a_ready(nxt);
            if constexpr (SP2) {
            PG8_LDB(B0, 0, 0); PG8_LDB(B1, 0, 1); PG8_SCHED; PG8_LDA(At, 0, 0); PG8_STA(PG8_SA(1, 1), a1, 1);
            if constexpr (Sched::GATHER) { if (last && has_next) { _Pragma("unroll") for (int h_ = 0; h_ < 2; ++h_) _Pragma("unroll") for (int i_ = 0; i_ < 2; ++i_) gA[h_][i_] = gN[h_][i_]; } }
            PG8_WAIT_V(8); PG8_WAIT_L(0); PG8_BAR; PG8_MMA(0, 0, At, B0); PG8_MMA(0, 1, At, B1); PG8_BAR; PG8_SCHED;
            PG8_LDA(At, 0, 1); PG8_STAGE(PG8_SB(0, 0), b2, voffB); PG8_STAGE(PG8_SB(0, 1), b2 + hstep, voffB); PG8_STA(PG8_SA(0, 0), a2, 0);
            PG8_WAIT_V(8); PG8_WAIT_L(0); PG8_BAR; PG8_MMA(1, 0, At, B0); PG8_MMA(1, 1, At, B1); PG8_BAR; PG8_SCHED;
            PG8_LDB(B0, 1, 0); PG8_LDB(B1, 1, 1); PG8_SCHED; PG8_LDA(At, 1, 0); PG8_STA(PG8_SA(0, 1), a2, 1);
            PG8_WAIT_V(8); PG8_WAIT_L(0); PG8_BAR; PG8_MMA(0, 0, At, B0); PG8_MMA(0, 1, At, B1); PG8_BAR; PG8_SCHED;
            PG8_LDA(At, 1, 1); PG8_STAGE(PG8_SB(1, 0), b3, voffB); PG8_STAGE(PG8_SB(1, 1), b3 + hstep, voffB); PG8_STA(PG8_SA(1, 0), a3, 0);
            PG8_WAIT_V(8); PG8_WAIT_L(0); PG8_BAR; PG8_MMA(1, 0, At, B0); PG8_MMA(1, 1, At, B1); PG8_BAR; PG8_SCHED;
            } else {
            PG8_LDB(B0, 0, 0); PG8_SCHED; PG8_LDA(At, 0, 0); PG8_STAGE(PG8_SA(1, 1), a1 + hstep, voffA);
            PG8_WAIT_L(8); PG8_BAR; PG8_WAIT_L(0); PG8_MMA(0, 0, At, B0); PG8_BAR; PG8_SCHED;
            PG8_LDB(B1, 0, 1); PG8_STAGE(PG8_SB(0, 0), b2, voffB);
            PG8_BAR; PG8_WAIT_L(0); PG8_MMA(0, 1, At, B1); PG8_BAR;
            PG8_LDA(At, 0, 1); PG8_STAGE(PG8_SA(0, 0), a2, voffA);
            PG8_BAR; PG8_WAIT_L(0); PG8_MMA(1, 0, At, B0); PG8_BAR; PG8_SCHED;
            PG8_STAGE(PG8_SB(0, 1), b2 + hstep, voffB);
            PG8_WAIT_V(6); PG8_BAR; PG8_MMA(1, 1, At, B1); PG8_BAR;
            PG8_LDB(B0, 1, 0); PG8_SCHED; PG8_LDA(At, 1, 0); PG8_STAGE(PG8_SA(0, 1), a2 + hstep, voffA);
            PG8_WAIT_L(8); PG8_BAR; PG8_WAIT_L(0); PG8_MMA(0, 0, At, B0); PG8_BAR; PG8_SCHED;
            PG8_LDB(B1, 1, 1); PG8_STAGE(PG8_SB(1, 0), b3, voffB);
            PG8_BAR; PG8_WAIT_L(0); PG8_MMA(0, 1, At, B1); PG8_BAR;
            PG8_LDA(At, 1, 1); PG8_STAGE(PG8_SA(1, 0), a3, voffA);
            PG8_BAR; PG8_WAIT_L(0); PG8_MMA(1, 0, At, B0); PG8_BAR; PG8_SCHED;
            PG8_STAGE(PG8_SB(1, 1), b3 + hstep, voffB);
            PG8_WAIT_V(6); PG8_BAR; PG8_MMA(1, 1, At, B1); PG8_BAR;
            }
        }
        if constexpr (ALIGN_EPI) { if (wr == 0) PG8_BAR; }
        if constexpr (!Epi::AFTER_DRAIN) { E(acc, cur, wr, wc, fr, fq); S.done(cur); }
        if (!has_next) break;
        if (!(Epi::CARRY && cur.part == 0)) {
#pragma unroll
        for (int a = 0; a < 2; ++a)
#pragma unroll
            for (int b = 0; b < 2; ++b)
#pragma unroll
                for (int m = 0; m < 4; ++m)
#pragma unroll
                    for (int n = 0; n < 2; ++n) acc[a][b][m][n] = (f32x4){0.f, 0.f, 0.f, 0.f}; }
        cur = nxt; cA = nA; cB = nB; ++ui;
        if constexpr (ALIGN_EPI) { if (wr == 1) PG8_BAR; }
    }
    PG8_WAIT_V(0);
    if constexpr (!ALIGN_EPI) { if (wr == 0) PG8_BAR; }
    PG8_BAR;
    if constexpr (Epi::AFTER_DRAIN) { E.fused(acc, cur, wr, wc, fr, fq, lds, wid, lane); S.done(cur); }
#undef PG8_SA
#undef PG8_SB
#undef PG8_STAGE
#undef PG8_STA
#undef PG8_ROWS
#undef PG8_LDA
#undef PG8_LDB
#undef PG8_MMA
#undef PG8_WAIT_V
#undef PG8_WAIT_L
#undef PG8_BAR
#undef PG8_SCHED
}
}

#include <hip/hip_bf16.h>
#include <cmath>
namespace attn_body {
using bf16=__hip_bfloat16;
using bf16x8=__attribute__((ext_vector_type(8)))short;
using s16x4=__attribute__((ext_vector_type(4)))short;
using f32x16=__attribute__((ext_vector_type(16)))float;
using u32x4=__attribute__((ext_vector_type(4)))unsigned;
constexpr int D=64,QP=512,KP=128;
constexpr int NW=8,QBLK=32,QB=QBLK*NW,KVBLK=64;
constexpr int ATTN_UNIT_ROWS=QB;
__device__ __forceinline__ int crow(int r,int hi){return (r&3)+8*(r>>2)+4*hi;}
#define SBAR() __builtin_amdgcn_sched_barrier(0)
__device__ __forceinline__ void cmask(f32x16&p0,f32x16&p1,int jb,int qrel,int hi){
  const float NEG=-INFINITY; int kb=64*jb+4*hi;
  #pragma unroll
  for(int r=0;r<16;++r){int kv=kb+(r&3)+8*(r>>2); if(kv>qrel)p0[r]=NEG; if(kv+32>qrel)p1[r]=NEG;}
}

constexpr int NSLOT=3, SLOTB=8192;
constexpr int LDS_K=0, LDS_V=NSLOT*SLOTB, LDS_WS=2*NSLOT*SLOTB, LDS_OST=LDS_WS+NW*64*4, LDS_BYTES=LDS_OST+NW*4096;
constexpr float C2=0.125f*1.4426950408889634f;
__device__ __forceinline__ void glds16(const void*gsrc,unsigned lds_dst){unsigned keep;
  asm volatile("s_mov_b32 %0, m0\n\ts_mov_b32 m0, %2\n\ts_nop 0\n\tglobal_load_lds_dwordx4 %1, off\n\ts_mov_b32 m0, %0":"=&s"(keep):"v"(gsrc),"s"(lds_dst):"memory");}
__device__ __forceinline__ float max3f(float a,float b,float c){float r;asm("v_max3_f32 %0, %1, %2, %3":"=v"(r):"v"(a),"v"(b),"v"(c));return r;}
__device__ __forceinline__ float max2f(float a,float b){float r;asm("v_max_f32_e32 %0, %1, %2":"=v"(r):"v"(a),"v"(b));return r;}
__device__ __forceinline__ float fadd_s(float a,float b){float r;asm("v_add_f32_e32 %0, %1, %2":"=v"(r):"v"(a),"v"(b));return r;}
__device__ __forceinline__ float fsub_s(float a,float b){float r;asm("v_sub_f32_e32 %0, %1, %2":"=v"(r):"v"(a),"v"(b));return r;}
typedef float f32x2_t __attribute__((ext_vector_type(2))); typedef __bf16 bf16x2_t __attribute__((ext_vector_type(2)));
__device__ __forceinline__ unsigned cvtpk_s(float lo,float hi){f32x2_t v={lo,hi};bf16x2_t b=__builtin_convertvector(v,bf16x2_t);return __builtin_bit_cast(unsigned,b);}
#define WAIT_BAR(N) asm volatile("s_waitcnt vmcnt(" #N ") lgkmcnt(0)\n\ts_barrier":::"memory")

__device__ __forceinline__ void qkt(f32x16&p0,f32x16&p1,const char*Kslot,const bf16x8*qr,const f32x16&negm,int r32,int hi){
  const char*kb=Kslot+hi*1024+r32*16;
  #pragma unroll
  for(int d0=0;d0<4;++d0){
    const bf16x8 b0=*reinterpret_cast<const bf16x8*>(kb+d0*2048);
    const bf16x8 b1=*reinterpret_cast<const bf16x8*>(kb+d0*2048+512);
    if(d0==0){p0=__builtin_amdgcn_mfma_f32_32x32x16_bf16(b0,qr[0],negm,0,0,0);p1=__builtin_amdgcn_mfma_f32_32x32x16_bf16(b1,qr[0],negm,0,0,0);}
    else{p0=__builtin_amdgcn_mfma_f32_32x32x16_bf16(b0,qr[d0],p0,0,0,0);p1=__builtin_amdgcn_mfma_f32_32x32x16_bf16(b1,qr[d0],p1,0,0,0);}}
}
typedef __attribute__((address_space(3))) const char* lds_cptr;
typedef short v4i16_t __attribute__((ext_vector_type(4)));
__device__ __forceinline__ void kload8(bf16x8*kf,lds_cptr kp){
  kf[0]=*(const __attribute__((address_space(3))) bf16x8*)(kp);      kf[1]=*(const __attribute__((address_space(3))) bf16x8*)(kp+512);
  kf[2]=*(const __attribute__((address_space(3))) bf16x8*)(kp+2048); kf[3]=*(const __attribute__((address_space(3))) bf16x8*)(kp+2560);
  kf[4]=*(const __attribute__((address_space(3))) bf16x8*)(kp+4096); kf[5]=*(const __attribute__((address_space(3))) bf16x8*)(kp+4608);
  kf[6]=*(const __attribute__((address_space(3))) bf16x8*)(kp+6144); kf[7]=*(const __attribute__((address_space(3))) bf16x8*)(kp+6656);
}
__device__ __forceinline__ void kload2(bf16x8*kf,lds_cptr kp,int j){ kf[2*j]=*(const __attribute__((address_space(3))) bf16x8*)(kp+j*2048); kf[2*j+1]=*(const __attribute__((address_space(3))) bf16x8*)(kp+j*2048+512); }
__device__ __forceinline__ s16x4 vtr(lds_cptr p){ return __builtin_bit_cast(s16x4,__builtin_amdgcn_ds_read_tr16_b64_v4i16((__attribute__((address_space(3))) v4i16_t*)p)); }
__device__ __forceinline__ float rowmax(const f32x16&p0,const f32x16&p1){
  float a=max3f(p0[0],p0[1],p1[0]),b=max3f(p0[2],p0[3],p1[1]);a=max3f(a,p1[2],p1[3]);
  #pragma unroll
  for(int r=4;r<16;r+=4){a=max3f(a,p0[r],p0[r+1]);b=max3f(b,p0[r+2],p0[r+3]);a=max3f(a,p1[r],p1[r+1]);b=max3f(b,p1[r+2],p1[r+3]);}
  const float m=max2f(a,b);
  auto rr=__builtin_amdgcn_permlane32_swap(__float_as_uint(m),__float_as_uint(m),false,false);
  return max2f(__uint_as_float(rr[0]),__uint_as_float(rr[1]));
}
__device__ __forceinline__ void pv(f32x16*o,int vb,bf16x8 pa0,bf16x8 pa1,bf16x8 pa2,bf16x8 pa3){
  #pragma unroll
  for(int d0=0;d0<2;++d0){s16x4 lo[4],hi[4];
    #pragma unroll
    for(int ks=0;ks<4;++ks){
      asm volatile("ds_read_b64_tr_b16 %0,%1 offset:%c2":"=&v"(lo[ks]):"v"(vb),"i"(d0*4096+ks*1024):"memory");
      asm volatile("ds_read_b64_tr_b16 %0,%1 offset:%c2":"=&v"(hi[ks]):"v"(vb),"i"(d0*4096+ks*1024+512):"memory");}
    asm volatile("s_waitcnt lgkmcnt(0)":::"memory");SBAR();
    #define PK(k) (bf16x8){lo[k][0],lo[k][1],lo[k][2],lo[k][3],hi[k][0],hi[k][1],hi[k][2],hi[k][3]}
    o[d0]=__builtin_amdgcn_mfma_f32_32x32x16_bf16(pa0,PK(0),o[d0],0,0,0);
    o[d0]=__builtin_amdgcn_mfma_f32_32x32x16_bf16(pa1,PK(1),o[d0],0,0,0);
    o[d0]=__builtin_amdgcn_mfma_f32_32x32x16_bf16(pa2,PK(2),o[d0],0,0,0);
    o[d0]=__builtin_amdgcn_mfma_f32_32x32x16_bf16(pa3,PK(3),o[d0],0,0,0);
    #undef PK
  }
}

#ifndef ATTN_STORE16
#define ATTN_STORE16(p,v) (*(u32x4*)(p)=(v))
#endif
template<int THRL> __device__ __forceinline__ void attn_unit(const bf16*Qu,const bf16*__restrict__ Kh,const bf16*__restrict__ Vh,bf16*Ou,const int NT,char*shm,const int tid_in){
  int tid_l=tid_in; asm volatile("":"+v"(tid_l));
  const int tid=tid_l,lane=tid&63,r32=lane&31,hi=lane>>5; const int wid=__builtin_amdgcn_readfirstlane(tid>>6);
  const bf16*Qw=Qu+(long)(wid*QBLK)*QP;
  const unsigned lds0=(unsigned)(uintptr_t)shm;
  float*wsf=(float*)(shm+LDS_WS)+wid*64;
  const bf16*ksrc=Kh+(long)lane*KP+wid*8;
  const bf16*vsrc=Vh+(long)(16*(wid&3)+(lane>>2))*KP+(wid>>2)*32+(lane&3)*8;
  const unsigned kdst=lds0+LDS_K+wid*1024, vdst=lds0+LDS_V+wid*1024;
  #define DMA_K(t,slot) glds16(ksrc+(long)(t)*KVBLK*KP,(unsigned)__builtin_amdgcn_readfirstlane(kdst+(slot)))
  #define DMA_V(t,slot) glds16(vsrc+(long)(t)*KVBLK*KP,(unsigned)__builtin_amdgcn_readfirstlane(vdst+(slot)))
  const int vb0=(int)(lds0+LDS_V)+((lane>>4)&1)*32+(lane&3)*8+(4*hi+((lane&15)>>2))*64;
  const char*Kbase=shm+LDS_K; bf16x8 kf[8];
  const lds_cptr shm3=(lds_cptr)shm; const lds_cptr kp0=shm3+LDS_K+hi*1024+r32*16; const lds_cptr vp0=shm3+LDS_V+((lane>>4)&1)*32+(lane&3)*8+(4*hi+((lane&15)>>2))*64;
  DMA_K(0,0);DMA_V(0,0);DMA_K(1,SLOTB);
  bf16x8 qr[4];
  #pragma unroll
  for(int d0=0;d0<4;++d0)qr[d0]=*reinterpret_cast<const bf16x8*>(&Qw[(long)r32*QP+d0*16+hi*8]);
  float mhat=0.f,l_reg=0.f;f32x16 o[2];o[0]=f32x16{};o[1]=f32x16{};f32x16 negm=f32x16{};asm volatile("":"+v"(negm));
  #define CMASK(P0,P1,t) do{}while(0)
  bool resc=false;
  #define START(P0,P1) do{ const float rm=rowmax(P0,P1); resc=false; \
    { const float dl=rm; mhat=fadd_s(mhat,dl); \
      _Pragma("unroll") for(int r=0;r<16;++r){P0[r]=fsub_s(P0[r],dl);P1[r]=fsub_s(P1[r],dl);} \
      _Pragma("unroll") for(int r=0;r<16;++r)negm[r]=-mhat; asm volatile("":"+v"(negm)); } \
    _Pragma("unroll") for(int r=0;r<16;++r)P0[r]=__builtin_amdgcn_exp2f(P0[r]); }while(0)
  #define RESC() do{ if(resc){ asm volatile("s_waitcnt lgkmcnt(0)":::"memory"); \
      _Pragma("unroll") for(int d_=0;d_<2;++d_) _Pragma("unroll") for(int r=0;r<16;++r)o[d_][r]*=wsf[crow(r,hi)]; } }while(0)
  f32x16 pA0,pA1,pB0,pB1;
  int sl_prev=0,sl_cur=0,sl_next=SLOTB;
  #define ROT() do{sl_prev=sl_cur;sl_cur=sl_next;sl_next=(sl_next==(NSLOT-1)*SLOTB)?0:sl_next+SLOTB;}while(0)
  DMA_K(2,2*SLOTB);
  WAIT_BAR(3);
  qkt(pA0,pA1,Kbase,qr,negm,r32,hi);asm volatile("s_nop 15\n\ts_nop 7":"+v"(pA0),"+v"(pA1));CMASK(pA0,pA1,0);
  START(pA0,pA1);
  _Pragma("unroll") for(int r=0;r<16;++r)pA1[r]=__builtin_amdgcn_exp2f(pA1[r]);
  WAIT_BAR(0);
  DMA_K(3,0);DMA_V(1,SLOTB);
  ROT();
  kload8(kf,kp0+sl_cur);
  WAIT_BAR(2);
  s16x4 vlo[8],vhi[8]; u32x4 pw0,pw1,pw2,pw3;
  #define PKW(P,B) cvtpk_s(P[B],P[B+1])
  #define PAF(k) __builtin_bit_cast(bf16x8,pw##k)
  #define VFR(i) (bf16x8){vlo[i][0],vlo[i][1],vlo[i][2],vlo[i][3],vhi[i][0],vhi[i][1],vhi[i][2],vhi[i][3]}
  #define PIN(x) asm volatile("":"+v"(x))
  #define MX3(a,b,c) __builtin_fmaxf(__builtin_fmaxf((a),(b)),(c))
  #define GAPA(MF,A0,A1,A2,A3,W0,W1,PW) do{ MF; sacc+=A0; sacc+=A1; sacc+=A2; sacc+=A3; PIN(sacc); W0; W1; PIN(PW); SBAR(); }while(0)
  #define EX(v) __builtin_amdgcn_exp2f(v)
  #define GAPB(MF,X,B) do{ MF; X[B]=EX(X[B]); X[B+1]=EX(X[B+1]); X[B+2]=EX(X[B+2]); X[B+3]=EX(X[B+3]); PIN(X); SBAR(); }while(0)
  #define VRD(i) do{ vlo[i]=vtr(vp_+(((i)>>2)*4096+((i)&3)*1024)); vhi[i]=vtr(vp_+(((i)>>2)*4096+((i)&3)*1024+512)); }while(0)
  #define KRD(G,j) do{ if(G){ kload2(kf,kp0+sl_next,j); SBAR(); } }while(0)
  #define STEP(C0,C1,P0,P1,t,GK,GV,GL) do{ SBAR(); \
    const lds_cptr vp_=vp0+sl_prev; \
    VRD(0); SBAR(); float sacc=(P0[0]+P0[1]); \
    GAPA(C0=__builtin_amdgcn_mfma_f32_32x32x16_bf16(kf[0],qr[0],negm,0,0,0), P0[2],P0[3],P0[4],P0[5],     pw0[0]=PKW(P0,0), pw0[1]=PKW(P0,2), pw0); \
    VRD(4); SBAR(); GAPA(C1=__builtin_amdgcn_mfma_f32_32x32x16_bf16(kf[1],qr[0],negm,0,0,0), P0[6],P0[7],P0[8],P0[9],     pw0[2]=PKW(P0,4), pw0[3]=PKW(P0,6), pw0); \
    VRD(1); SBAR(); GAPA(C0=__builtin_amdgcn_mfma_f32_32x32x16_bf16(kf[2],qr[1],C0,0,0,0),   P0[10],P0[11],P0[12],P0[13], pw1[0]=PKW(P0,8), pw1[1]=PKW(P0,10), pw1); \
    VRD(5); SBAR(); GAPA(C1=__builtin_amdgcn_mfma_f32_32x32x16_bf16(kf[3],qr[1],C1,0,0,0),   P0[14],P0[15],P1[0],P1[1],   pw1[2]=PKW(P0,12),pw1[3]=PKW(P0,14), pw1); \
    VRD(2); SBAR(); GAPA(C0=__builtin_amdgcn_mfma_f32_32x32x16_bf16(kf[4],qr[2],C0,0,0,0),   P1[2],P1[3],P1[4],P1[5],     pw2[0]=PKW(P1,0), pw2[1]=PKW(P1,2), pw2); \
    VRD(6); SBAR(); GAPA(C1=__builtin_amdgcn_mfma_f32_32x32x16_bf16(kf[5],qr[2],C1,0,0,0),   P1[6],P1[7],P1[8],P1[9],     pw2[2]=PKW(P1,4), pw2[3]=PKW(P1,6), pw2); \
    VRD(3); SBAR(); GAPA(C0=__builtin_amdgcn_mfma_f32_32x32x16_bf16(kf[6],qr[3],C0,0,0,0),   P1[10],P1[11],P1[12],P1[13], pw3[0]=PKW(P1,8), pw3[1]=PKW(P1,10), pw3); \
    VRD(7); SBAR(); GAPA(C1=__builtin_amdgcn_mfma_f32_32x32x16_bf16(kf[7],qr[3],C1,0,0,0),   P1[14],P1[15],0.f,0.f,       pw3[2]=PKW(P1,12),pw3[3]=PKW(P1,14), pw3); \
    l_reg+=sacc; \
    if(GK){DMA_K((t)+3,sl_cur);} if(GV){DMA_V((t)+1,sl_next);} \
    CMASK(C0,C1,t); \
    { float a=MX3(C0[0],C0[1],C1[0]),b=MX3(C0[2],C0[3],C1[1]); a=MX3(a,C1[2],C1[3]); \
      _Pragma("unroll") for(int r=4;r<16;r+=4){a=MX3(a,C0[r],C0[r+1]);b=MX3(b,C0[r+2],C0[r+3]);a=MX3(a,C1[r],C1[r+1]);b=MX3(b,C1[r+2],C1[r+3]);} \
      float rm=__builtin_fmaxf(a,b); { auto rr=__builtin_amdgcn_permlane32_swap(__float_as_uint(rm),__float_as_uint(rm),false,false); rm=__builtin_fmaxf(__uint_as_float(rr[0]),__uint_as_float(rr[1])); } \
      resc=false; \
      if(__builtin_expect(__any(rm>(float)THRL),0)){ const float dl=__builtin_fmaxf(rm,0.f); mhat+=dl; \
        _Pragma("unroll") for(int r=0;r<16;++r){C0[r]-=dl;C1[r]-=dl;} \
        _Pragma("unroll") for(int r=0;r<16;++r)negm[r]=-mhat; asm volatile("":"+v"(negm)); \
        const float f=__builtin_amdgcn_exp2f(-dl); l_reg*=f; if(hi==0)wsf[r32]=f; resc=true; } } \
    SBAR(); \
    GAPB(o[0]=__builtin_amdgcn_mfma_f32_32x32x16_bf16(PAF(0),VFR(0),o[0],0,0,0), C0,0); \
    GAPB(o[1]=__builtin_amdgcn_mfma_f32_32x32x16_bf16(PAF(0),VFR(4),o[1],0,0,0), C0,4); \
    KRD(GL,0); GAPB(o[0]=__builtin_amdgcn_mfma_f32_32x32x16_bf16(PAF(1),VFR(1),o[0],0,0,0), C0,8); \
    KRD(GL,1); GAPB(o[1]=__builtin_amdgcn_mfma_f32_32x32x16_bf16(PAF(1),VFR(5),o[1],0,0,0), C0,12); \
    KRD(GL,2); GAPB(o[0]=__builtin_amdgcn_mfma_f32_32x32x16_bf16(PAF(2),VFR(2),o[0],0,0,0), C1,0); \
    KRD(GL,3); GAPB(o[1]=__builtin_amdgcn_mfma_f32_32x32x16_bf16(PAF(2),VFR(6),o[1],0,0,0), C1,4); \
    GAPB(o[0]=__builtin_amdgcn_mfma_f32_32x32x16_bf16(PAF(3),VFR(3),o[0],0,0,0), C1,8); \
    GAPB(o[1]=__builtin_amdgcn_mfma_f32_32x32x16_bf16(PAF(3),VFR(7),o[1],0,0,0), C1,12); \
    }while(0)
  int t=1;
  for(;t+5<NT;t+=2){
    STEP(pB0,pB1,pA0,pA1,t,true,true,true);     WAIT_BAR(2); RESC(); ROT();
    STEP(pA0,pA1,pB0,pB1,t+1,true,true,true);   WAIT_BAR(2); RESC(); ROT();
  }
  #define ENDW(tt) do{ if((tt)+3<NT){WAIT_BAR(2);} else if((tt)+2<NT){WAIT_BAR(1);} else {WAIT_BAR(0);} }while(0)
  for(;t+1<NT;t+=2){
    STEP(pB0,pB1,pA0,pA1,t,(t+3<NT),(t+1<NT),(t+1<NT));       ENDW(t);   RESC(); ROT();
    STEP(pA0,pA1,pB0,pB1,t+1,(t+4<NT),(t+2<NT),(t+2<NT));     ENDW(t+1); RESC(); ROT();
  }
  STEP(pB0,pB1,pA0,pA1,NT-1,false,false,false); RESC();
  { float sacc=pB0[0]+pB0[1]; _Pragma("unroll") for(int r=2;r<16;++r)sacc+=pB0[r]; _Pragma("unroll") for(int r=0;r<16;++r)sacc+=pB1[r]; l_reg+=sacc;
    pw0=(u32x4){PKW(pB0,0),PKW(pB0,2),PKW(pB0,4),PKW(pB0,6)};pw1=(u32x4){PKW(pB0,8),PKW(pB0,10),PKW(pB0,12),PKW(pB0,14)};pw2=(u32x4){PKW(pB1,0),PKW(pB1,2),PKW(pB1,4),PKW(pB1,6)};pw3=(u32x4){PKW(pB1,8),PKW(pB1,10),PKW(pB1,12),PKW(pB1,14)};
    SBAR(); pv(o,vb0+sl_cur,PAF(0),PAF(1),PAF(2),PAF(3)); }
  #undef PKW
  #undef PAF
  #undef VFR
  #undef PIN
  #undef MX3
  #undef GAPA
  #undef GAPB
  #undef EX
  #undef VRD
  #undef KRD
  #undef STEP
  #undef ENDW
  {auto rr=__builtin_amdgcn_permlane32_swap(__float_as_uint(l_reg),__float_as_uint(l_reg),false,false);l_reg=__uint_as_float(rr[0])+__uint_as_float(rr[1]);}
  if(hi==0)wsf[32+r32]=l_reg;asm volatile("s_waitcnt lgkmcnt(0)":::"memory");
  float rli[16];
  #pragma unroll
  for(int r=0;r<16;++r)rli[r]=__builtin_amdgcn_rcpf(wsf[32+crow(r,hi)]);
  bf16*Ow=Ou+(long)(wid*QBLK)*QP;
  { bf16*stg=(bf16*)(shm+LDS_OST)+wid*2048;
    #pragma unroll
    for(int r=0;r<16;++r){const int orow=crow(r,hi);
      #pragma unroll
      for(int d0=0;d0<2;++d0)stg[orow*64+d0*32+r32]=__float2bfloat16(o[d0][r]*rli[r]);}
    asm volatile("s_waitcnt lgkmcnt(0)":::"memory");
    #pragma unroll
    for(int i=0;i<4;++i){const int row=i*8+(lane>>3),ch=lane&7; const u32x4 v=*(const u32x4*)(stg+row*64+ch*8); ATTN_STORE16(Ow+(long)row*QP+ch*8,v);} }
  asm volatile("s_waitcnt lgkmcnt(0)\n\ts_barrier":::"memory");
  #undef DMA_K
  #undef DMA_V
  #undef CMASK
  #undef START
  #undef RESC
  #undef ROT
}
constexpr int ATTN_LDS_BYTES=LDS_BYTES;
#undef SBAR
#undef WAIT_BAR
}

#define XB_TMO      128
#define XB_XCNT(j)  (256  + 64 * (j))
#define XB_XSUB(j)  (1280 + 64 * (j))
#define XB_XGEN(j)  (2304 + 64 * (j))
#define XB_TOP      3328
#define XB_TOPGEN   3392
#define XCD_BAR_WORDS 3456
#define XB_SPIN_CAP (1u << 18)

__device__ __forceinline__ unsigned xb_ld(unsigned* p)              { return __hip_atomic_load(p, __ATOMIC_RELAXED, __HIP_MEMORY_SCOPE_AGENT); }
__device__ __forceinline__ unsigned xb_add(unsigned* p, unsigned v) { return __hip_atomic_fetch_add(p, v, __ATOMIC_RELAXED, __HIP_MEMORY_SCOPE_AGENT); }
__device__ __forceinline__ unsigned xb_xcc_id() { return (unsigned)__builtin_amdgcn_s_getreg((3 << 11) | 20) & 0xFu; }
#define XB_SPIN(cond, bar) do { unsigned _sp = 0; while (cond) { __builtin_amdgcn_s_sleep(1); \
    if ((++_sp & 255u) == 0u) { if (xb_ld(&(bar)[XB_TMO])) break; if (_sp > XB_SPIN_CAP) { atomicAdd(&(bar)[XB_TMO], 1u); break; } } } } while (0)

struct XcdBarrier {
    unsigned* bar; unsigned x;
    volatile LAS unsigned* st;
};

__device__ __forceinline__ XcdBarrier xcd_barrier_post(unsigned* bar, volatile LAS unsigned* st) {
    XcdBarrier b; b.bar = bar; b.x = xb_xcc_id(); b.st = st;
    if (threadIdx.x == 0) (void)xb_add(&bar[XB_XCNT(b.x)], 1u);
    return b;
}
__device__ __forceinline__ void xcd_barrier_complete(unsigned* bar, unsigned x, unsigned& nloc, unsigned& nx) {
    const unsigned G = gridDim.x * gridDim.y * gridDim.z;
    unsigned sum, cnt, mine, sp = 0u;
    for (;;) {
        sum = 0u; cnt = 0u; mine = 0u;
#pragma unroll
        for (unsigned j = 0; j < 16; ++j) { const unsigned c = xb_ld(&bar[XB_XCNT(j)]); sum += c; cnt += (c > 0u) ? 1u : 0u; mine = (j == x) ? c : mine; }
        if (sum == G) break;
        __builtin_amdgcn_s_sleep(1);
        if ((++sp & 255u) == 0u) { if (xb_ld(&bar[XB_TMO])) break; if (sp > XB_SPIN_CAP) { atomicAdd(&bar[XB_TMO], 1u); break; } }
    }
    nloc = mine > 0u ? mine : 1u; nx = cnt > 0u ? cnt : 1u;
}

__device__ __forceinline__ void xcd_barrier(const XcdBarrier& b, const int tid_in) {
    asm volatile("s_waitcnt vmcnt(0)" ::: "memory");
    __syncthreads();
    if (tid_in == 0) {
        unsigned* bar = b.bar;
        __builtin_amdgcn_s_waitcnt(0);
        unsigned nloc = b.st[0], nx = b.st[1];
        if (nloc == 0u) { xcd_barrier_complete(bar, b.x, nloc, nx); b.st[0] = nloc; b.st[1] = nx; }
        const unsigned old = xb_add(&bar[XB_XSUB(b.x)], 1u);
        const unsigned gen = old / nloc;
        if (old + 1u == (gen + 1u) * nloc) {
            __builtin_amdgcn_fence(__ATOMIC_RELEASE, "agent");
            asm volatile("s_waitcnt vmcnt(0)" ::: "memory");
            const unsigned og = xb_add(&bar[XB_TOP], 1u);
            const unsigned tg = og / nx;
            if (og + 1u == (tg + 1u) * nx) xb_add(&bar[XB_TOPGEN], 1u);
            else XB_SPIN(xb_ld(&bar[XB_TOPGEN]) == tg, bar);
            __builtin_amdgcn_fence(__ATOMIC_ACQUIRE, "agent");
            xb_add(&bar[XB_XGEN(b.x)], 1u);
            asm volatile("s_waitcnt vmcnt(0)" ::: "memory");
        } else {
            XB_SPIN(xb_ld(&bar[XB_XGEN(b.x)]) == gen, bar);
            __builtin_amdgcn_fence(__ATOMIC_ACQUIRE, "agent");
            asm volatile("s_waitcnt vmcnt(0)" ::: "memory");
        }
    }
    __syncthreads();
}

struct Args { const GAS float* in[33]; GAS float* out; unsigned char* ws; int mode, l, site, chunk; };
struct Frame {
    LAS unsigned char* lds; volatile LAS unsigned* MISC; gu32* ctl;
    int tid, lane, wave, vcu, G;
    unsigned char* ws; GAS float* out;
};
#define WSP(T, off) ((GAS T*)(F.ws + (off)))
#define WSGEN(T, off) ((T*)(F.ws + (off)))
__device__ __forceinline__ const GAS float* inptr(LAS unsigned char* lds, int i) { const LAS unsigned* p = (const LAS unsigned*)(lds + PTAB_OFF) + 2 * i; const unsigned lo = __builtin_amdgcn_readfirstlane(p[0]), hi = __builtin_amdgcn_readfirstlane(p[1]); return (const GAS float*)(((unsigned long long)hi << 32) | lo); }
#define INP(i) inptr(F.lds, (i))

__device__ __forceinline__ void conv_item(const GAS float* W, int Nsrc, int k0, int c0, GAS bf16* WT, int K, int drow0, LAS float* scr, int lane) {
#pragma unroll
    for (int i = 0; i < 8; ++i) { const int kk = 8 * i + (lane >> 3), nn = 4 * (lane & 7); const f32x4 v = *(const GAS f32x4*)(W + (size_t)(k0 + kk) * Nsrc + c0 + nn);
        scr[kk * 33 + nn] = v.x; scr[kk * 33 + nn + 1] = v.y; scr[kk * 33 + nn + 2] = v.z; scr[kk * 33 + nn + 3] = v.w; }
    LDS_WAIT(); asm volatile("" ::: "memory");
    const int c = lane & 7;
#pragma unroll
    for (int j = 0; j < 4; ++j) { const int n = (lane >> 3) + 8 * j; const LAS float* s = scr + (8 * c) * 33 + n;
        v4u o; o.x = pk2(s[0 * 33], s[1 * 33]); o.y = pk2(s[2 * 33], s[3 * 33]); o.z = pk2(s[4 * 33], s[5 * 33]); o.w = pk2(s[6 * 33], s[7 * 33]);
        *(GAS v4u*)(WT + (size_t)(drow0 + n) * K + k0 + 8 * c) = o; }
    LDS_WAIT(); asm volatile("" ::: "memory");
}
__device__ __forceinline__ void conv_plain(int item, const GAS float* W, int K, int N, GAS bf16* WT, LAS float* scr, int lane) {
    const int ng = N / 32, kb = item / ng, g = item % ng; conv_item(W, N, 64 * kb, 32 * g, WT, K, 32 * g, scr, lane);
}
__device__ __forceinline__ void conv_gu(int item, const GAS float* W, GAS bf16* WT, int off, LAS float* scr, int lane) {
    const int ng = FF / 32, kb = item / ng, g = item % ng; conv_item(W, FF, 64 * kb, 32 * g, WT, DM, 256 * (g >> 2) + off + 32 * (g & 3), scr, lane);
}
__device__ __forceinline__ void mod_task(Frame& F, int task) {
    const int l = task / 96, nb = task % 96;
    LAS float* S = (LAS float*)F.lds;
    for (int i = F.tid; i < 33 * 1024; i += 512) { const int bi = i >> 10, k = i & 1023; const float c = bi < 32 ? INP(1)[bi * 1024 + k] : INP(3)[k]; S[k * 33 + bi] = c / (1.0f + __expf(-c)); }
    __syncthreads();
    const GAS float* W = INP(4) + (size_t)l * DM * 6144 + nb * 64 + F.lane;
    float acc[33];
#pragma unroll
    for (int bi = 0; bi < 33; ++bi) acc[bi] = 0.f;
    const int k0 = F.wave * 128;
    for (int k = k0; k < k0 + 128; ++k) { const float w = W[(size_t)k * 6144];
#pragma unroll
        for (int bi = 0; bi < 33; ++bi) acc[bi] = fmaf(S[k * 33 + bi], w, acc[bi]); }
    __syncthreads();
    LAS float* P = (LAS float*)F.lds;
#pragma unroll
    for (int bi = 0; bi < 33; ++bi) P[(F.wave * 33 + bi) * 64 + F.lane] = acc[bi];
    __syncthreads();
    GAS float* mod = WSP(float, WS_MOD);
    for (int o = F.tid; o < 33 * 64; o += 512) { const int bi = o >> 6, cc = o & 63; float s = 0.f;
#pragma unroll
        for (int w = 0; w < 8; ++w) s += P[(w * 33 + bi) * 64 + cc];
        const int n = nb * 64 + cc; mod[(size_t)(l * 33 + bi) * 6144 + n] = s + INP(5)[l * 6144 + n]; }
    __syncthreads();
}
__device__ __forceinline__ void p0_prologue(Frame& F) {
    for (int t = F.vcu; t < 192; t += F.G) mod_task(F, t);
    if (F.vcu == F.G - 1) { GAS float* rt = WSP(float, WS_ROPE);
        for (int i = F.tid; i < 1024; i += 512) { const int pos = i >> 4, f = i & 15; const float inv = powf(10000.0f, -(float)f / 16.0f); const float a = (float)pos * inv; rt[i] = cosf(a); rt[1024 + i] = sinf(a); } }
    { GAS v4u* rz = (GAS v4u*)(F.ws + WS_MOETAB + MT_ROWT); for (int i = F.vcu * 512 + F.tid; i < MOE_ROWS / 4; i += F.G * 512) rz[i] = (v4u){0u, 0u, 0u, 0u}; }
    LAS float* scr = (LAS float*)(F.lds + F.wave * 8448);
    const int gw = F.vcu * NWAVES + F.wave, NGW = F.G * NWAVES;
    constexpr int I_IN = 16 * 144, I_P = 8 * 32, I_O = 16 * 32, I_GU = 16 * 112, I_DN = 56 * 32, I_L = 16, I_G2 = 32;
    constexpr int NITEMS = 2 * I_IN + 4 * I_P + 2 * I_O + 2 * I_GU + I_DN + 8 * I_L + 2 * I_G2;
    GAS bf16* lora = WSP(bf16, WS_LORA);
    for (int it = gw; it < NITEMS; it += NGW) {
        int r = it;
        if (r < 2 * I_IN) { const int l = r / I_IN; conv_plain(r % I_IN, INP(8) + (size_t)l * DM * NIN, DM, NIN, WSP(bf16, WS_WIN) + (size_t)l * NIN * DM, scr, F.lane); continue; } r -= 2 * I_IN;
        if (r < 2 * I_P) { const int l = r / I_P; conv_plain(r % I_P, INP(22) + (size_t)l * RW * DM, RW, DM, WSP(bf16, WS_WPA) + (size_t)l * DM * RW, scr, F.lane); continue; } r -= 2 * I_P;
        if (r < 2 * I_P) { const int l = r / I_P; conv_plain(r % I_P, INP(23) + (size_t)l * RW * DM, RW, DM, WSP(bf16, WS_WPB) + (size_t)l * DM * RW, scr, F.lane); continue; } r -= 2 * I_P;
        if (r < 2 * I_O) { const int l = r / I_O; conv_plain(r % I_O, INP(24) + (size_t)l * DM * DM, DM, DM, WSP(bf16, WS_WO) + (size_t)l * DM * DM, scr, F.lane); continue; } r -= 2 * I_O;
        if (r < I_GU) { conv_gu(r, INP(25), WSP(bf16, WS_WGU), 0, scr, F.lane); continue; } r -= I_GU;
        if (r < I_GU) { conv_gu(r, INP(26), WSP(bf16, WS_WGU), 128, scr, F.lane); continue; } r -= I_GU;
        if (r < I_DN) { conv_plain(r, INP(27), FF, DM, WSP(bf16, WS_WDN), scr, F.lane); continue; } r -= I_DN;
        if (r < 4 * I_L) { const int ld = r / I_L; conv_plain(r % I_L, INP(11) + (size_t)ld * 64 * RW, 64, RW, lora + (size_t)ld * RW * 64, scr, F.lane); continue; } r -= 4 * I_L;
        if (r < 4 * I_L) { const int ld = r / I_L; conv_plain(r % I_L, INP(13) + (size_t)ld * 64 * RW, 64, RW, lora + (size_t)(4 + ld) * RW * 64, scr, F.lane); continue; } r -= 4 * I_L;
        { const int l = r / I_G2; conv_plain(r % I_G2, INP(14) + (size_t)l * 128 * RW, 128, RW, lora + (size_t)8 * RW * 64 + (size_t)l * RW * 128, scr, F.lane); }
    }
}
__device__ __forceinline__ void moe_conv(Frame& F) {
    LAS float* scr = (LAS float*)(F.lds + F.wave * 8448);
    const int gw = F.vcu * NWAVES + F.wave, NGW = F.G * NWAVES;
    constexpr int I_GU = 16 * 112, I_DN = 56 * 32, I_E = 2 * I_GU + I_DN;
    for (int it = gw; it < NE * I_E; it += NGW) {
        const int e = it / I_E; int r = it % I_E; GAS bf16* base = WSP(bf16, WS_MW) + (size_t)e * (21 * MiB / 2);
        if (r < I_GU) { conv_gu(r, INP(29) + (size_t)e * DM * FF, base, 0, scr, F.lane); continue; } r -= I_GU;
        if (r < I_GU) { conv_gu(r, INP(30) + (size_t)e * DM * FF, base, 128, scr, F.lane); continue; } r -= I_GU;
        conv_plain(r, INP(31) + (size_t)e * FF * DM, FF, DM, base + (size_t)2 * FF * DM, scr, F.lane);
    }
}

template <bool ROUTER, bool XBF>
__device__ __forceinline__ void norm_mod_phase(Frame& F, int l, int which, const GAS void* xlat, const GAS void* xctx, int nrows, GAS bf16* H) {
    const int gw = F.vcu * NWAVES + F.wave, NGW = F.G * NWAVES, lane = F.lane;
    const GAS float* gain = INP(which ? 7 : 6) + l * DM;
    const GAS float* modl = WSP(float, WS_MOD) + (size_t)l * 33 * 6144 + (which ? 3072 : 0);
    constexpr int RPITCH = 36;
    LAS float* RL = (LAS float*)F.lds;
    if (ROUTER) {
        for (int idx = F.tid; idx < 2048; idx += 512) { const int c = idx >> 1, hf = idx & 1;
            *(LAS f32x4*)(RL + (((c >> 8) * 64 + ((c & 255) >> 2)) * RPITCH + (c & 3) * 8 + 4 * hf)) = *(const GAS f32x4*)(INP(28) + (size_t)c * 8 + 4 * hf); }
        __syncthreads(); }
    const int rpw = (nrows + NGW - 1) / NGW, m_lo = gw * rpw, m_hi = (m_lo + rpw < nrows) ? m_lo + rpw : nrows;
    f32x4 gm[4], shv[4]; int cur_bi = -1;
#pragma unroll
    for (int j = 0; j < 4; ++j) { gm[j] = (f32x4){0.f, 0.f, 0.f, 0.f}; shv[j] = gm[j]; }
    auto xload = [&](int m, f32x4 (&v)[4]) {
        const size_t xo = m < NL ? (size_t)m * DM : (size_t)(m - NL) * DM; const GAS void* xb = m < NL ? xlat : xctx;
#pragma unroll
        for (int j = 0; j < 4; ++j) {
            if constexpr (XBF) { const v2u w = *(const GAS v2u*)((const GAS bf16*)xb + xo + 4 * lane + 256 * j); v[j] = (f32x4){bflo(w.x), bfhi(w.x), bflo(w.y), bfhi(w.y)}; }
            else v[j] = *(const GAS f32x4*)((const GAS float*)xb + xo + 4 * lane + 256 * j); } };
    f32x4 v[4], vn[4];
    if (m_lo < m_hi) xload(m_lo, v);
    for (int m = m_lo; m < m_hi; ++m) {
        if (m + 1 < m_hi) xload(m + 1, vn);
        const int bi = row_bi(m);
        if (bi != cur_bi) { cur_bi = bi; const GAS float* mv = modl + (size_t)bi * 6144;
#pragma unroll
            for (int j = 0; j < 4; ++j) { const int c = 4 * lane + 256 * j; gm[j] = *(const GAS f32x4*)(gain + c) * (*(const GAS f32x4*)(mv + 1024 + c) + 1.0f); shv[j] = *(const GAS f32x4*)(mv + c); } }
        float s = 0.f;
#pragma unroll
        for (int j = 0; j < 4; ++j) s += (v[j].x * v[j].x + v[j].y * v[j].y) + (v[j].z * v[j].z + v[j].w * v[j].w);
        const float rstd = rsq_(wave_sum(s) * (1.0f / DM) + 1e-6f);
        float lg[8];
        if (ROUTER) {
#pragma unroll
            for (int e = 0; e < 8; ++e) lg[e] = 0.f; }
#pragma unroll
        for (int j = 0; j < 4; ++j) { const int c = 4 * lane + 256 * j;
            const f32x4 hv = v[j] * rstd * gm[j] + shv[j];
            v2u o; o.x = pk2(hv.x, hv.y); o.y = pk2(hv.z, hv.w);
            *(GAS v2u*)(H + (size_t)m * DM + c) = o;
            if (ROUTER) { const LAS float* rw = RL + (j * 64 + lane) * RPITCH;
#pragma unroll
                for (int q = 0; q < 4; ++q) { const f32x4 r0 = *(const LAS f32x4*)(rw + q * 8), r1 = *(const LAS f32x4*)(rw + q * 8 + 4); const float hq = hv[q];
                    lg[0] = fmaf(hq, r0.x, lg[0]); lg[1] = fmaf(hq, r0.y, lg[1]); lg[2] = fmaf(hq, r0.z, lg[2]); lg[3] = fmaf(hq, r0.w, lg[3]);
                    lg[4] = fmaf(hq, r1.x, lg[4]); lg[5] = fmaf(hq, r1.y, lg[5]); lg[6] = fmaf(hq, r1.z, lg[6]); lg[7] = fmaf(hq, r1.w, lg[7]); } }
        }
        if (ROUTER) {
#pragma unroll
            for (int e = 0; e < 8; ++e) lg[e] = wave_sum(lg[e]);
            int e0 = 0; float l0 = lg[0];
#pragma unroll
            for (int e = 1; e < 8; ++e) if (lg[e] > l0) { l0 = lg[e]; e0 = e; }
            int e1 = -1; float l1 = -INFINITY;
#pragma unroll
            for (int e = 0; e < 8; ++e) if (e != e0 && lg[e] > l1) { l1 = lg[e]; e1 = e; }
            const float w1 = rcp_(1.0f + __expf(l0 - l1)), w0 = 1.0f - w1;
            if (lane == 0) {
                GAS int* te = (GAS int*)(F.ws + WS_MOETAB + MT_TOKE) + 2 * m; GAS float* tw = (GAS float*)(F.ws + WS_MOETAB + MT_TOKW) + 2 * m;
                te[0] = e0; te[1] = e1; tw[0] = w0; tw[1] = w1;
                __hip_atomic_fetch_add((LAS unsigned*)&F.MISC[16 + e0], 1u, __ATOMIC_RELAXED, __HIP_MEMORY_SCOPE_WORKGROUP); __hip_atomic_fetch_add((LAS unsigned*)&F.MISC[16 + e1], 1u, __ATOMIC_RELAXED, __HIP_MEMORY_SCOPE_WORKGROUP);
            }
        }
#pragma unroll
        for (int j = 0; j < 4; ++j) v[j] = vn[j];
    }
    if (ROUTER) { __syncthreads(); if (F.tid < 8) { const unsigned c = F.MISC[16 + F.tid]; if (c) __hip_atomic_fetch_add(F.ctl + CW_HIST + 64 * F.tid, c, RLX_AGENT); } __syncthreads(); }
}

using pg8::Unit;
template <bool SIG> struct EpiInT {
    static constexpr bool PERM = true, AFTER_DRAIN = false, CARRY = false;
    GAS bf16 *PR, *Q, *KB, *VB; GAS unsigned char* G8;
    __device__ __forceinline__ void operator()(const f32x4 (&acc)[2][2][4][2], const Unit& u, int wr, int wc, int fr, int fq) const {
        const int row0 = u.pm * 256 + wr * 64 + fr, cb = wc * 32 + 8 * fq, pn = u.pn;
#pragma unroll
        for (int ai = 0; ai < 2; ++ai)
#pragma unroll
            for (int m = 0; m < 4; ++m) { const int r = row0 + ai * 128 + m * 16;
#pragma unroll
                for (int bj = 0; bj < 2; ++bj) { f32x4 v0 = acc[ai][bj][m][0], v1 = acc[ai][bj][m][1]; GAS bf16* dst;
                    if (pn < 7) dst = PR + (size_t)r * RCOLS + pn * 256 + bj * 128 + cb;
                    else if (pn < 9) dst = Q + (size_t)r * 512 + (pn - 7) * 256 + bj * 128 + cb;
                    else if (pn == 9) dst = (bj == 0 ? KB : VB) + (size_t)row_kv(r) * 128 + cb;
                    else {
                        unsigned w0 = 0u, w1 = 0u;
#pragma unroll
                        for (int q = 0; q < 4; ++q) { w0 = __builtin_amdgcn_cvt_pk_u8_f32(__builtin_rintf(sigmoidf_(v0[q]) * 255.0f), q, w0); w1 = __builtin_amdgcn_cvt_pk_u8_f32(__builtin_rintf(sigmoidf_(v1[q]) * 255.0f), q, w1); }
                        *(GAS v2u*)(G8 + (size_t)r * GCOLS + (pn - 10) * 256 + bj * 128 + cb) = (v2u){w0, w1}; continue; }
                    v4u w; w.x = pk2(v0[0], v0[1]); w.y = pk2(v0[2], v0[3]); w.z = pk2(v1[0], v1[1]); w.w = pk2(v1[2], v1[3]);
                    *(GAS v4u*)dst = w; } }
    }
};
typedef EpiInT<true> EpiIn;
struct EpiMergeAB {
    static constexpr bool PERM = true, AFTER_DRAIN = false, CARRY = true;
    const GAS unsigned char* G8; GAS bf16* MG;
    __device__ __forceinline__ void operator()(f32x4 (&acc)[2][2][4][2], const Unit& u, int wr, int wc, int fr, int fq) const {
        const int row0 = u.pm * 256 + wr * 64 + fr, col0 = u.pn * 256 + wc * 32 + 8 * fq;
#pragma unroll
        for (int ai = 0; ai < 2; ++ai)
#pragma unroll
            for (int m = 0; m < 4; ++m) { const int r = row0 + ai * 128 + m * 16;
#pragma unroll
                for (int bj = 0; bj < 2; ++bj) { const int c = col0 + bj * 128;
                    const v2u gb = *(const GAS v2u*)(G8 + (size_t)r * GCOLS + DM + c);
                    float fb[8];
#pragma unroll
                    for (int q = 0; q < 4; ++q) { fb[q] = fmaxf((float)((gb.x >> (8 * q)) & 0xffu), 1.0f); fb[4 + q] = fmaxf((float)((gb.y >> (8 * q)) & 0xffu), 1.0f); }
                    if (u.part == 0) {
                        const v2u ga = *(const GAS v2u*)(G8 + (size_t)r * GCOLS + c);
#pragma unroll
                        for (int q = 0; q < 4; ++q) { acc[ai][bj][m][0][q] *= (float)((ga.x >> (8 * q)) & 0xffu) * rcp_(fb[q]); acc[ai][bj][m][1][q] *= (float)((ga.y >> (8 * q)) & 0xffu) * rcp_(fb[4 + q]); }
                    } else {
                        const f32x4 a0 = acc[ai][bj][m][0], a1 = acc[ai][bj][m][1]; const float s = 1.0f / 255.0f;
                        v4u w; w.x = pk2(a0[0] * fb[0] * s, a0[1] * fb[1] * s); w.y = pk2(a0[2] * fb[2] * s, a0[3] * fb[3] * s); w.z = pk2(a1[0] * fb[4] * s, a1[1] * fb[5] * s); w.w = pk2(a1[2] * fb[6] * s, a1[3] * fb[7] * s);
                        *(GAS v4u*)(MG + (size_t)r * DM + c) = w; } } }
    }
};
template <bool SRC32>
struct EpiResT {
    static constexpr bool PERM = true, AFTER_DRAIN = false, CARRY = false;
    const GAS void *base_lat, *base_ctx; GAS bf16 *out_lat, *out_ctx; const GAS float* gt;
    __device__ __forceinline__ void operator()(const f32x4 (&acc)[2][2][4][2], const Unit& u, int wr, int wc, int fr, int fq) const {
        const bool lat = u.pm < NL / 256; const int bi = lat ? (u.pm >> 3) : 32;
        const int rr0 = (lat ? u.pm * 256 : u.pm * 256 - NL) + wr * 64 + fr, col0 = u.pn * 256 + wc * 32 + 8 * fq;
        const GAS void* bp = lat ? base_lat : base_ctx; GAS bf16* op = lat ? out_lat : out_ctx; const GAS float* gv = gt + (size_t)bi * 6144 + col0;
        f32x4 g[2][2];
#pragma unroll
        for (int bj = 0; bj < 2; ++bj)
#pragma unroll
            for (int n = 0; n < 2; ++n) g[bj][n] = *(const GAS f32x4*)(gv + bj * 128 + n * 4);
#pragma unroll
        for (int ai = 0; ai < 2; ++ai)
#pragma unroll
            for (int m = 0; m < 4; ++m) { const size_t off = (size_t)(rr0 + ai * 128 + m * 16) * DM + col0;
#pragma unroll
                for (int bj = 0; bj < 2; ++bj) { f32x4 b0, b1;
                    if constexpr (SRC32) { b0 = *(const GAS f32x4*)((const GAS float*)bp + off + bj * 128); b1 = *(const GAS f32x4*)((const GAS float*)bp + off + bj * 128 + 4); }
                    else { const v4u w = *(const GAS v4u*)((const GAS bf16*)bp + off + bj * 128); b0 = (f32x4){bflo(w.x), bfhi(w.x), bflo(w.y), bfhi(w.y)}; b1 = (f32x4){bflo(w.z), bfhi(w.z), bflo(w.w), bfhi(w.w)}; }
                    const f32x4 r0 = b0 + g[bj][0] * acc[ai][bj][m][0], r1 = b1 + g[bj][1] * acc[ai][bj][m][1];
                    v4u o; o.x = pk2(r0.x, r0.y); o.y = pk2(r0.z, r0.w); o.z = pk2(r1.x, r1.y); o.w = pk2(r1.z, r1.w);
                    *(GAS v4u*)(op + off + bj * 128) = o; }
                asm volatile("" ::: "memory"); }
    }
};
struct EpiGU {
    static constexpr bool PERM = true, AFTER_DRAIN = false, CARRY = false;
    GAS bf16* ACT; int pm0;
    __device__ __forceinline__ void operator()(const f32x4 (&acc)[2][2][4][2], const Unit& u, int wr, int wc, int fr, int fq) const {
        const int row0 = (u.pm - pm0) * 256 + wr * 64 + fr, col0 = u.pn * 128 + wc * 32 + 8 * fq;
#pragma unroll
        for (int ai = 0; ai < 2; ++ai)
#pragma unroll
            for (int m = 0; m < 4; ++m) { const int r = row0 + ai * 128 + m * 16; float o[8];
#pragma unroll
                for (int n = 0; n < 2; ++n)
#pragma unroll
                    for (int q = 0; q < 4; ++q) { const float gte = acc[ai][0][m][n][q], up = acc[ai][1][m][n][q]; o[4 * n + q] = gte * sigmoidf_(gte) * up; }
                v4u w; w.x = pk2(o[0], o[1]); w.y = pk2(o[2], o[3]); w.z = pk2(o[4], o[5]); w.w = pk2(o[6], o[7]);
                *(GAS v4u*)(ACT + (size_t)r * FF + col0) = w; }
    }
};
struct EpiStore {
    static constexpr bool PERM = true, AFTER_DRAIN = false, CARRY = false;
    GAS bf16* O;
    __device__ __forceinline__ void operator()(const f32x4 (&acc)[2][2][4][2], const Unit& u, int wr, int wc, int fr, int fq) const {
        const int row0 = u.pm * 256 + wr * 64 + fr, col0 = u.pn * 256 + wc * 32 + 8 * fq;
#pragma unroll
        for (int ai = 0; ai < 2; ++ai)
#pragma unroll
            for (int m = 0; m < 4; ++m) { const int r = row0 + ai * 128 + m * 16;
#pragma unroll
                for (int bj = 0; bj < 2; ++bj) { const f32x4 v0 = acc[ai][bj][m][0], v1 = acc[ai][bj][m][1];
                    v4u w; w.x = pk2(v0[0], v0[1]); w.y = pk2(v0[2], v0[3]); w.z = pk2(v1[0], v1[1]); w.w = pk2(v1[2], v1[3]);
                    *(GAS v4u*)(O + (size_t)r * DM + col0 + bj * 128) = w; } }
    }
};
struct EpiNull {
    static constexpr bool PERM = true, AFTER_DRAIN = false, CARRY = false;
    GAS bf16* O;
    __device__ __forceinline__ void operator()(const f32x4 (&acc)[2][2][4][2], const Unit& u, int wr, int wc, int fr, int fq) const {
        float s = 0.f;
#pragma unroll
        for (int ai = 0; ai < 2; ++ai)
#pragma unroll
            for (int m = 0; m < 4; ++m)
#pragma unroll
                for (int bj = 0; bj < 2; ++bj) s += acc[ai][bj][m][0][0] + acc[ai][bj][m][1][3];
        if (s == 12345.678f) O[u.pm * 256 + wr * 64 + fr + wc + fq] = 0;
    }
};
template <bool GA>
struct MoeOrderT {
    static constexpr bool GATHER = GA;
    const char* A; const char* W; size_t a_tstep, b_tstep, w_estep; int tile0, a_tile0, ntl, nN, G, c; const LAS int* tile_e; int prev_ntl; const GAS int* rowt;
    __device__ __forceinline__ const GAS int* row_tab() const { return rowt; }
    __device__ bool next(int i, Unit& u) const {
        const int x = c & 7, j = c >> 3, Wn = G >> 3, s0 = (x * ntl) >> 3, nx = (((x + 1) * ntl) >> 3) - s0;
        int e = 0, qh = 0;
        if (prev_ntl) { const int D = 4 * ((((x + 1) * prev_ntl) >> 3) - ((x * prev_ntl) >> 3)); e = D % Wn; qh = (2 * nx * nN + 7 * e - 6 * Wn) / (2 * Wn); qh = qh < 0 ? 0 : qh; }
        int uu;
        if (j < e) { if (i >= qh) return false; uu = qh * j + i; }
        else uu = qh * e + i * (Wn - e) + (j - e);
        if (uu >= nx * nN) return false;
        const int q = uu / nx;
        u.pn = q; u.pm = tile0 + s0 + (uu - q * nx); u.part = 0; return true; }
    __device__ __forceinline__ const char* a_base(const Unit& u) const { return GA ? A : A + (size_t)(u.pm - a_tile0) * a_tstep; }
    __device__ __forceinline__ const char* b_base(const Unit& u) const { return W + (size_t)tile_e[u.pm] * w_estep + (size_t)u.pn * b_tstep; }
    __device__ __forceinline__ void a_ready(const Unit&) const {}
    __device__ __forceinline__ void done(const Unit&) const {}
};

__device__ __forceinline__ void qk_phase(Frame& F, int l) {
    const int gw = F.vcu * NWAVES + F.wave, NGW = F.G * NWAVES, lane = F.lane, d0 = 8 * (lane & 7);
    const GAS float* rt = WSP(float, WS_ROPE);
    GAS bf16* Q = WSP(bf16, WS_Q); GAS bf16* KB = WSP(bf16, WS_KB);
    float gq[8], gk[8];
#pragma unroll
    for (int e = 0; e < 8; ++e) { gq[e] = INP(20)[l * 64 + d0 + e]; gk[e] = INP(21)[l * 64 + d0 + e]; }
    constexpr int NR = 4;
    for (int m0 = gw; m0 < MA; m0 += NR * NGW) {
        v4u wq[NR], wk[NR]; float cs[NR][4], sn[NR][4];
#pragma unroll
        for (int r = 0; r < NR; ++r) { const int m = m0 + r * NGW; const bool ok = m < MA, lat = m < NL; const int t = m & 2047, pr = t >> 6, pc = t & 63;
            wq[r] = (v4u){0u, 0u, 0u, 0u}; wk[r] = (v4u){0u, 0u, 0u, 0u};
#pragma unroll
            for (int pi = 0; pi < 4; ++pi) { cs[r][pi] = 1.f; sn[r][pi] = 0.f; }
            if (ok && lat) {
#pragma unroll
                for (int pi = 0; pi < 4; ++pi) { const int i = 4 * (lane & 7) + pi, pos = i < 16 ? pr : pc, f = i & 15; cs[r][pi] = rt[pos * 16 + f]; sn[r][pi] = rt[1024 + pos * 16 + f]; } }
            if (ok && (lat || l == 0)) wq[r] = *(const GAS v4u*)(Q + (size_t)m * 512 + 8 * lane);
            if (ok && lane < 16) wk[r] = *(const GAS v4u*)(KB + (size_t)row_kv(m) * 128 + 8 * (lane & 15)); }
#pragma unroll
        for (int r = 0; r < NR; ++r) { const int m = m0 + r * NGW; const bool ok = m < MA, lat = m < NL;
            if (ok && (lat || l == 0)) { const v4u w = wq[r];
              float x[8] = { bflo(w.x), bfhi(w.x), bflo(w.y), bfhi(w.y), bflo(w.z), bfhi(w.z), bflo(w.w), bfhi(w.w) };
              float ss = 0.f;
#pragma unroll
              for (int e = 0; e < 8; ++e) ss += x[e] * x[e];
              ss = row8_sum(ss);
              const float rr = rsq_(ss * (1.0f / 64.0f) + 1e-6f);
#pragma unroll
              for (int e = 0; e < 8; ++e) x[e] = x[e] * rr * gq[e];
#pragma unroll
              for (int pi = 0; pi < 4; ++pi) { const float x0 = x[2 * pi], x1 = x[2 * pi + 1]; x[2 * pi] = x0 * cs[r][pi] - x1 * sn[r][pi]; x[2 * pi + 1] = x0 * sn[r][pi] + x1 * cs[r][pi]; }
              const float C2 = attn_body::C2;
              v4u o; o.x = pk2(x[0] * C2, x[1] * C2); o.y = pk2(x[2] * C2, x[3] * C2); o.z = pk2(x[4] * C2, x[5] * C2); o.w = pk2(x[6] * C2, x[7] * C2);
              *(GAS v4u*)(Q + (size_t)m * 512 + 8 * lane) = o; }
            if (ok) { const v4u w = wk[r];
              float x[8] = { bflo(w.x), bfhi(w.x), bflo(w.y), bfhi(w.y), bflo(w.z), bfhi(w.z), bflo(w.w), bfhi(w.w) };
              float ss = 0.f;
#pragma unroll
              for (int e = 0; e < 8; ++e) ss += x[e] * x[e];
              ss = row8_sum(ss);
              const float rr = rsq_(ss * (1.0f / 64.0f) + 1e-6f);
#pragma unroll
              for (int e = 0; e < 8; ++e) x[e] = x[e] * rr * gk[e];
#pragma unroll
              for (int pi = 0; pi < 4; ++pi) { const float x0 = x[2 * pi], x1 = x[2 * pi + 1]; x[2 * pi] = x0 * cs[r][pi] - x1 * sn[r][pi]; x[2 * pi + 1] = x0 * sn[r][pi] + x1 * cs[r][pi]; }
              v4u o; o.x = pk2(x[0], x[1]); o.y = pk2(x[2], x[3]); o.z = pk2(x[4], x[5]); o.w = pk2(x[6], x[7]);
              if (lane < 16) *(GAS v4u*)(KB + (size_t)row_kv(m) * 128 + 8 * (lane & 15)) = o; }
        }
    }
}

constexpr int RO_PITCH = 136;
static_assert(RW * RO_PITCH * 2 <= MISC_OFF, "rwkv_out LDS");
__device__ __forceinline__ void rwkv_out_phase(Frame& F, int l, int nrows) {
    const int gw = F.vcu * NWAVES + F.wave, NGW = F.G * NWAVES, lane = F.lane, jr = lane & 15, fq = lane >> 4;
    const GAS bf16* PR = WSP(bf16, WS_PR); const GAS bf16* YF = WSP(bf16, WS_YF); const GAS bf16* YB = WSP(bf16, WS_YB); GAS bf16* YR = WSP(bf16, WS_YR);
    const GAS float* bon0 = WSP(float, WS_BONUS); const GAS float* bon1 = bon0 + (size_t)MA * 8;
    const GAS bf16* g2t = WSP(bf16, WS_LORA) + (size_t)8 * RW * 64 + (size_t)l * RW * 128;
    const GAS float* m0 = INP(9) + (size_t)(l * 2) * RCOLS; const GAS float* m1 = m0 + RCOLS;
    const GAS float* lw = INP(18) + l * RW; const GAS float* lb = INP(19) + l * RW;
    for (int i = F.tid; i < RW * 16; i += 512) { const int n = i >> 4, c8 = i & 15, rho = n & 31, src = (n & ~31) + 8 * ((rho & 15) >> 2) + 4 * (rho >> 4) + (rho & 3);
        *(LAS v4u*)(F.lds + (n * RO_PITCH + 8 * c8) * 2) = *(const GAS v4u*)(g2t + (size_t)src * 128 + 8 * c8); }
    __syncthreads();
    for (int unit = gw; unit < nrows / 16; unit += NGW) {
        const int m = unit * 16 + jr;
        const int pos = m < NL ? (m & 2047) : ((m - NL) & 255), len = m < NL ? TL : TC;
        const bool hp = pos > 0, hn = pos < len - 1;
        const GAS bf16* pr = PR + (size_t)m * RCOLS;
        bf16x8 Af[4];
#pragma unroll
        for (int ks = 0; ks < 4; ++ks) { const int col = 1664 + 8 * fq + 32 * ks;
            const v4u z = (v4u){0u, 0u, 0u, 0u}; const v4u w1 = *(const GAS v4u*)(pr + col); const v4u w0 = hp ? *(const GAS v4u*)(pr - RCOLS + col) : z; const v4u w2 = hn ? *(const GAS v4u*)(pr + RCOLS + col) : z;
            const unsigned u0[4] = {w0.x, w0.y, w0.z, w0.w}, u1[4] = {w1.x, w1.y, w1.z, w1.w}, u2[4] = {w2.x, w2.y, w2.z, w2.w}; unsigned o[4];
#pragma unroll
            for (int e = 0; e < 4; ++e) { const f32x2 a = *(const GAS f32x2*)(m0 + col + 2 * e), bq = *(const GAS f32x2*)(m1 + col + 2 * e);
                const float xl = bflo(u1[e]), xh = bfhi(u1[e]);
                const float vl = xl + a.x * (bflo(u0[e]) - xl) + bq.x * (bflo(u2[e]) - xl), vh = xh + a.y * (bfhi(u0[e]) - xh) + bq.y * (bfhi(u2[e]) - xh);
                o[e] = pk2(sigmoidf_(vl), sigmoidf_(vh)); }
            Af[ks] = __builtin_bit_cast(bf16x8, (v4u){o[0], o[1], o[2], o[3]}); }
        for (int hh = 0; hh < 8; ++hh) {
            const float bon = 0.5f * (bon0[(size_t)m * 8 + hh] + bon1[(size_t)m * 8 + hh]);
            f32x4 y[2][2], g[2][2];
#pragma unroll
            for (int gp = 0; gp < 2; ++gp) { const int c0 = hh * 64 + 32 * gp;
#pragma unroll
                for (int n = 0; n < 2; ++n) { f32x4 acc = (f32x4){0.f, 0.f, 0.f, 0.f};
#pragma unroll
                    for (int ks = 0; ks < 4; ++ks) { const bf16x8 Bf = *(const LAS bf16x8*)(F.lds + ((c0 + 16 * n + jr) * RO_PITCH + 8 * fq + 32 * ks) * 2); acc = __builtin_amdgcn_mfma_f32_16x16x32_bf16(Bf, Af[ks], acc, 0, 0, 0); }
                    g[gp][n] = acc; }
                const int col = c0 + 8 * fq; const v4u a = *(const GAS v4u*)(YF + (size_t)m * RW + col), bq = *(const GAS v4u*)(YB + (size_t)m * RW + col);
                y[gp][0] = (f32x4){bflo(a.x) + bflo(bq.x), bfhi(a.x) + bfhi(bq.x), bflo(a.y) + bflo(bq.y), bfhi(a.y) + bfhi(bq.y)};
                y[gp][1] = (f32x4){bflo(a.z) + bflo(bq.z), bfhi(a.z) + bfhi(bq.z), bflo(a.w) + bflo(bq.w), bfhi(a.w) + bfhi(bq.w)}; }
            float s = 0.f;
#pragma unroll
            for (int gp = 0; gp < 2; ++gp)
#pragma unroll
                for (int n = 0; n < 2; ++n) s += (y[gp][n].x + y[gp][n].y) + (y[gp][n].z + y[gp][n].w);
            s = xsum32(xsum16(s));
            const float mean = s * (1.0f / 64.0f); float qv = 0.f;
#pragma unroll
            for (int gp = 0; gp < 2; ++gp)
#pragma unroll
                for (int n = 0; n < 2; ++n) { y[gp][n] = y[gp][n] - mean; qv += (y[gp][n].x * y[gp][n].x + y[gp][n].y * y[gp][n].y) + (y[gp][n].z * y[gp][n].z + y[gp][n].w * y[gp][n].w); }
            qv = xsum32(xsum16(qv));
            const float rstd = rsq_(qv * (1.0f / 64.0f) + 64e-5f);
#pragma unroll
            for (int gp = 0; gp < 2; ++gp) { const int col = hh * 64 + 32 * gp + 8 * fq, vc = 1024 + col;
                const v4u z = (v4u){0u, 0u, 0u, 0u}; const v4u w1 = *(const GAS v4u*)(pr + vc); const v4u w0 = hp ? *(const GAS v4u*)(pr - RCOLS + vc) : z; const v4u w2 = hn ? *(const GAS v4u*)(pr + RCOLS + vc) : z;
                const unsigned u0[4] = {w0.x, w0.y, w0.z, w0.w}, u1[4] = {w1.x, w1.y, w1.z, w1.w}, u2[4] = {w2.x, w2.y, w2.z, w2.w}; unsigned ow[4];
#pragma unroll
                for (int n = 0; n < 2; ++n) {
                    const f32x4 x0 = (f32x4){bflo(u0[2 * n]), bfhi(u0[2 * n]), bflo(u0[2 * n + 1]), bfhi(u0[2 * n + 1])}, x1 = (f32x4){bflo(u1[2 * n]), bfhi(u1[2 * n]), bflo(u1[2 * n + 1]), bfhi(u1[2 * n + 1])}, x2 = (f32x4){bflo(u2[2 * n]), bfhi(u2[2 * n]), bflo(u2[2 * n + 1]), bfhi(u2[2 * n + 1])};
                    const f32x4 vs = x1 + *(const GAS f32x4*)(m0 + vc + 4 * n) * (x0 - x1) + *(const GAS f32x4*)(m1 + vc + 4 * n) * (x2 - x1);
                    const f32x4 o = (y[gp][n] * rstd * *(const GAS f32x4*)(lw + col + 4 * n) + *(const GAS f32x4*)(lb + col + 4 * n) + vs * bon) * g[gp][n];
                    ow[2 * n] = pk2(o.x, o.y); ow[2 * n + 1] = pk2(o.z, o.w); }
                *(GAS v4u*)(YR + (size_t)m * RW + col) = (v4u){ow[0], ow[1], ow[2], ow[3]}; }
        }
    }
    __syncthreads();
}

__device__ __forceinline__ void attn_phase(Frame& F, int l, char* lds_generic, size_t q_off) {
    typedef attn_body::bf16 abf;
    abf* Q = (abf*)(F.ws + q_off); const abf* KB = (const abf*)(F.ws + WS_KB); const abf* VB = (const abf*)(F.ws + WS_VB);
    for (int p = F.vcu; p < NB * 8; p += F.G) {
        const int b = p >> 3, hq = p & 7, kvh = hq >> 2;
        const abf* Kh = KB + (size_t)b * KVT * 128 + kvh * 64; const abf* Vh = VB + (size_t)b * KVT * 128 + kvh * 64;
        const int nu = l == 0 ? 9 : 8;
        for (int u = 0; u < nu; ++u) {
            const bool cx = u == 8;
            abf* Qu = Q + (size_t)(cx ? NL + b * TC : b * TL + u * 256) * 512 + hq * 64;
            attn_body::attn_unit<8>(Qu, cx ? Kh + (size_t)TL * 128 : Kh, cx ? Vh + (size_t)TL * 128 : Vh, Qu, cx ? TC / 64 : KVT / 64, lds_generic, F.tid);
        }
    }
}

__device__ __forceinline__ int moe_tiles(Frame& F, LAS int* tile_e) {
    int nt = 0;
    for (int e = 0; e < NE; ++e) { const int cnt = (int)__hip_atomic_load(F.ctl + CW_HIST + 64 * e, RLX_AGENT); const int t = (cnt + 255) >> 8;
        for (int i = F.tid; i < t; i += 512) tile_e[nt + i] = e; nt += t; }
    __syncthreads();
    return nt;
}
__device__ __forceinline__ void moe_slots(Frame& F) {
    volatile LAS unsigned* M = F.MISC;
    const GAS int* toke = (const GAS int*)(F.ws + WS_MOETAB + MT_TOKE); GAS int* toks = (GAS int*)(F.ws + WS_MOETAB + MT_TOKS);
    GAS int* rowt = (GAS int*)(F.ws + WS_MOETAB + MT_ROWT);
    for (int tb = F.vcu; tb < NL / 256; tb += F.G) {
        if (F.tid < 8) M[32 + F.tid] = 0u;
        if (F.tid == 0) { unsigned ps = 0; for (int e = 0; e < NE; ++e) { M[48 + e] = ps; const unsigned cnt = __hip_atomic_load(F.ctl + CW_HIST + 64 * e, RLX_AGENT); ps += ((cnt + 255u) >> 8) << 8; } }
        __syncthreads();
        int e_my = 0, rank = 0;
        { const int a = F.tid; e_my = toke[(size_t)tb * 512 + a]; rank = (int)__hip_atomic_fetch_add((LAS unsigned*)&M[32 + e_my], 1u, __ATOMIC_RELAXED, __HIP_MEMORY_SCOPE_WORKGROUP); }
        __syncthreads();
        if (F.tid < 8) M[40 + F.tid] = __hip_atomic_fetch_add(F.ctl + CW_CURS + 64 * F.tid, M[32 + F.tid], RLX_AGENT);
        __syncthreads();
        const int slot = (int)(M[48 + e_my] + M[40 + e_my]) + rank;
        toks[(size_t)tb * 512 + F.tid] = slot; rowt[slot] = tb * 256 + (F.tid >> 1);
        __syncthreads();
    }
}
__device__ __forceinline__ void moe_final(Frame& F) {
    const int gw = F.vcu * NWAVES + F.wave, NGW = F.G * NWAVES, lane = F.lane;
    const GAS int* toks = (const GAS int*)(F.ws + WS_MOETAB + MT_TOKS); const GAS float* tokw = (const GAS float*)(F.ws + WS_MOETAB + MT_TOKW);
    const GAS bf16* YM = WSP(bf16, WS_YM); const GAS float* gt = WSP(float, WS_MOD) + (size_t)33 * 6144 + 5120;
    const GAS bf16* X16 = WSP(bf16, WS_X16);
    const int rpw = (NL + NGW - 1) / NGW, m_lo = gw * rpw, m_hi = m_lo + rpw < NL ? m_lo + rpw : NL;
    if (m_lo >= m_hi) return;
    const int c0 = 8 * lane;
    const int mi = m_lo + lane < m_hi ? m_lo + lane : m_lo;
    const v2u slv = *(const GAS v2u*)(toks + 2 * mi), wtv = *(const GAS v2u*)(tokw + 2 * mi);
    f32x4 gvv[2][2], wf[2][2]; int cur_b = -1;
#pragma unroll
    for (int j = 0; j < 2; ++j) { wf[j][0] = *(const GAS f32x4*)(INP(32) + c0 + 512 * j); wf[j][1] = *(const GAS f32x4*)(INP(32) + c0 + 512 * j + 4); gvv[j][0] = wf[j][0]; gvv[j][1] = wf[j][0]; }
    v4u ya[2][2], yb[2][2], xw[2][2];
    auto rload = [&](int r, v4u (&a)[2], v4u (&bq)[2], v4u (&x)[2]) { const int rr = r < m_hi - m_lo ? r : 0;
        const int s0 = __builtin_amdgcn_readlane((int)slv.x, rr), s1 = __builtin_amdgcn_readlane((int)slv.y, rr);
#pragma unroll
        for (int j = 0; j < 2; ++j) { const int c = c0 + 512 * j;
            a[j] = *(const GAS v4u*)(YM + (size_t)s0 * DM + c); bq[j] = *(const GAS v4u*)(YM + (size_t)s1 * DM + c); x[j] = *(const GAS v4u*)(X16 + (size_t)(m_lo + rr) * DM + c); } };
    rload(0, ya[0], yb[0], xw[0]); rload(1, ya[1], yb[1], xw[1]);
    for (int r0 = 0; r0 < m_hi - m_lo; r0 += 2) {
        v4u yan[2][2], ybn[2][2], xwn[2][2];
        rload(r0 + 2, yan[0], ybn[0], xwn[0]); rload(r0 + 3, yan[1], ybn[1], xwn[1]);
#pragma unroll
        for (int r = 0; r < 2; ++r) { const int rr = r0 + r, m = m_lo + rr;
            if (rr < m_hi - m_lo) {
            const float w0 = __uint_as_float((unsigned)__builtin_amdgcn_readlane((int)wtv.x, rr)), w1 = __uint_as_float((unsigned)__builtin_amdgcn_readlane((int)wtv.y, rr));
            if ((m >> 11) != cur_b) { cur_b = m >> 11; const GAS float* gv = gt + (size_t)cur_b * 6144 + c0;
#pragma unroll
                for (int j = 0; j < 2; ++j) { gvv[j][0] = *(const GAS f32x4*)(gv + 512 * j); gvv[j][1] = *(const GAS f32x4*)(gv + 512 * j + 4); } }
            GAS float* xr = F.out + (size_t)m * DM + c0;
            f32x4 v[2][2]; float s = 0.f;
#pragma unroll
            for (int j = 0; j < 2; ++j) {
                const v4u a = ya[r][j], bq = yb[r][j], x = xw[r][j];
                const f32x4 a0 = (f32x4){bflo(a.x), bfhi(a.x), bflo(a.y), bfhi(a.y)}, a1 = (f32x4){bflo(a.z), bfhi(a.z), bflo(a.w), bfhi(a.w)};
                const f32x4 b0 = (f32x4){bflo(bq.x), bfhi(bq.x), bflo(bq.y), bfhi(bq.y)}, b1 = (f32x4){bflo(bq.z), bfhi(bq.z), bflo(bq.w), bfhi(bq.w)};
                const f32x4 x0 = (f32x4){bflo(x.x), bfhi(x.x), bflo(x.y), bfhi(x.y)}, x1 = (f32x4){bflo(x.z), bfhi(x.z), bflo(x.w), bfhi(x.w)};
                v[j][0] = x0 + gvv[j][0] * (a0 * w0 + b0 * w1); v[j][1] = x1 + gvv[j][1] * (a1 * w0 + b1 * w1);
                s += ((v[j][0].x * v[j][0].x + v[j][0].y * v[j][0].y) + (v[j][0].z * v[j][0].z + v[j][0].w * v[j][0].w)) + ((v[j][1].x * v[j][1].x + v[j][1].y * v[j][1].y) + (v[j][1].z * v[j][1].z + v[j][1].w * v[j][1].w)); }
            const float rstd = rsq_(wave_sum(s) * (1.0f / DM) + 1e-6f);
#pragma unroll
            for (int j = 0; j < 2; ++j) { *(GAS f32x4*)(xr + 512 * j) = v[j][0] * rstd * wf[j][0]; *(GAS f32x4*)(xr + 512 * j + 4) = v[j][1] * rstd * wf[j][1]; } } }
#pragma unroll
        for (int r = 0; r < 2; ++r)
#pragma unroll
            for (int j = 0; j < 2; ++j) { ya[r][j] = yan[r][j]; yb[r][j] = ybn[r][j]; xw[r][j] = xwn[r][j]; }
    }
}
__device__ __forceinline__ bf16x8 lds_frag(const LAS unsigned char* p) { return *(const LAS bf16x8*)p; }
__device__ __forceinline__ bf16x8 lds_frag16(const LAS unsigned char* row, int lane) { bf16x8 z = (bf16x8){0, 0, 0, 0, 0, 0, 0, 0}; if (lane < 32) z = *(const LAS bf16x8*)(row + 16 * (lane >> 4)); return z; }
__device__ __forceinline__ float tanh_fast(float x) { const float e = __expf(2.0f * x); return 1.0f - 2.0f * rcp_(e + 1.0f); }
__device__ __forceinline__ void st_bf(LAS unsigned char* p, float v) { *(LAS unsigned short*)p = (unsigned short)(pk2(v, 0.f) & 0xffffu); }
constexpr int S3_RAW = 0, S3_KS = 11520, S3_KK = 15616, S3_RS = 19712, S3_VS = 23808, S3_TWA = 27904, S3_ADA = 30208, S3_R1END = 32512;
constexpr int S3_GA = 0, S3_GBT = 4608;
constexpr int S3_MAK = 11520, S3_MBRT = 12288, S3_TA = 13056, S3_TT = 13824, S3_MKR = 14592, S3_MAB = 15616;
constexpr int S3_RQ0 = 0;
constexpr int S3_WSC = 16640, S3_WSC_STRIDE = 6144;
constexpr int S3_BCREST = S3_WSC + 4 * S3_WSC_STRIDE;
constexpr int S3_RTF = S3_BCREST, S3_KCF = S3_RTF + 4096, S3_G15 = S3_KCF + 4096, S3_ATT = S3_G15 + 256, S3_BCT = S3_ATT + 3072, S3_VT = S3_BCT + 3072;
constexpr int S3_S16 = S3_VT + 3072, S3_YO = S3_S16 + 9216, S3_BON = S3_YO + 4096, S3_DIR = S3_BON + 256;
static_assert(S3_MAB + 1024 <= S3_WSC && S3_WSC >= S3_KK && 2 * S3_DIR <= MISC_OFF && S3_RQ0 + 4 * 2304 <= S3_MAK, "scan3 LDS map");
#ifndef S3_BAR_REP
#define S3_BAR_REP 0
#endif
#define S3_BAR() do { asm volatile("s_waitcnt lgkmcnt(0)\n\ts_barrier" ::: "memory"); for (int br_ = 0; br_ < S3_BAR_REP; ++br_) asm volatile("s_barrier" ::: "memory"); } while (0)
#define S3_WAVE_SYNC() do { } while (0)
#define S3_IDS() int tl_ = F.tid; asm volatile("" : "+v"(tl_)); const int dt = tl_ & 255, lane = tl_ & 63, lr = lane & 15, lq = lane >> 4; const int wv_ = __builtin_amdgcn_readfirstlane(tl_ >> 6); const int w4 = wv_ & 3, d = wv_ >> 2; \
    LAS unsigned char* const L = F.lds + d * S3_DIR; (void)dt; (void)lr; (void)lq; (void)w4; (void)lane
#define S3_F32(name, off) LAS float* const name = (LAS float*)(L + (off))
__device__ __forceinline__ f32x4 mfma16(bf16x8 a, bf16x8 b, f32x4 c) { return __builtin_amdgcn_mfma_f32_16x16x32_bf16(a, b, c, 0, 0, 0); }
__device__ __forceinline__ bf16x8 frag_lk16(const LAS unsigned char* row, int lq) { const v2u x = *(const LAS v2u*)(row + 8 * lq); return __builtin_bit_cast(bf16x8, (v4u){x.x, x.y, 0u, 0u}); }
__device__ __forceinline__ bf16x8 frag_lk32(const LAS unsigned char* row, int lq) { const v2u x = *(const LAS v2u*)(row + 8 * lq), y = *(const LAS v2u*)(row + 32 + 8 * lq); return __builtin_bit_cast(bf16x8, (v4u){x.x, x.y, y.x, y.y}); }
__device__ __forceinline__ bf16x8 pack_b(f32x4 t) { return __builtin_bit_cast(bf16x8, (v4u){pk2(t[0], t[1]), pk2(t[2], t[3]), 0u, 0u}); }
typedef short bf16x4 __attribute__((ext_vector_type(4)));
__device__ __forceinline__ f32x4 mfma16k(bf16x4 a, bf16x4 b, f32x4 c) { return __builtin_amdgcn_mfma_f32_16x16x16bf16_1k(a, b, c, 0, 0, 0); }
__device__ __forceinline__ bf16x4 frag_k16(const LAS unsigned char* row, int lq) { return __builtin_bit_cast(bf16x4, *(const LAS v2u*)(row + 8 * lq)); }
__device__ __forceinline__ bf16x4 pack_k16(f32x4 t) { return __builtin_bit_cast(bf16x4, (v2u){pk2(t[0], t[1]), pk2(t[2], t[3])}); }
__device__ __forceinline__ bf16x8 pack_b2(f32x4 t0, f32x4 t1) { return __builtin_bit_cast(bf16x8, (v4u){pk2(t0[0], t0[1]), pk2(t0[2], t0[3]), pk2(t1[0], t1[1]), pk2(t1[2], t1[3])}); }

#ifndef S3_REP_A
#define S3_REP_A 1
#endif
#ifndef S3_REP_BC
#define S3_REP_BC 1
#endif
#ifndef S3_REP_FG
#define S3_REP_FG 1
#endif
#ifndef S3_REP_DE
#define S3_REP_DE 1
#endif
__device__ __forceinline__ void scan_phase3(Frame& F, int l) {
    const GAS bf16* PR = WSP(bf16, WS_PR);
    for (int p = F.vcu; p < NB * 8; p += F.G) {
        const int b = p >> 3, h = p & 7;
        f32x4 S[4];
#pragma unroll
        for (int i = 0; i < 4; ++i) S[i] = (f32x4){0.f, 0.f, 0.f, 0.f};
        v4u raw[3];
        int prow[3], pcol[3], plds[3];
        f32x4 mu0[5], mu1[5], mu2[5], kkc; bf16x8 Bw0, Bw1, Ba0, Ba1; float w0c, a0c, kac, rkc;
        { S3_IDS();
#pragma unroll
          for (int i = 0; i < 3; ++i) { const int pp = dt + 256 * i, row = pp / 40, rem = pp % 40, grp = rem >> 3, c8 = rem & 7;
              prow[i] = pp < 720 ? row : -100000; pcol[i] = (grp == 0 ? h * 64 : grp == 1 ? 512 + h * 64 : grp == 2 ? 1024 + h * 64 : grp == 3 ? 1536 : 1600) + 8 * c8; plds[i] = (row * 320 + rem * 8) * 2; }
          const int cg = dt & 15; const GAS float* mup = INP(9) + (size_t)(l * 2) * RCOLS + 4 * cg;
#pragma unroll
          for (int g = 0; g < 5; ++g) { const int gc = g == 0 ? h * 64 : g == 1 ? 512 + h * 64 : g == 2 ? 1024 + h * 64 : g == 3 ? 1536 : 1600; mu0[g] = *(const GAS f32x4*)(mup + gc); mu1[g] = *(const GAS f32x4*)(mup + RCOLS + gc); mu2[g] = 1.0f - mu0[g] - mu1[g]; }
          kkc = *(const GAS f32x4*)(INP(15) + l * RW + h * 64 + 4 * cg);
          const GAS bf16* w2t = WSP(bf16, WS_LORA) + (size_t)((l * 2 + d) * RW + h * 64 + 16 * w4 + lr) * 64 + 8 * lq; const GAS bf16* a2t = w2t + (size_t)4 * RW * 64;
          Bw0 = *(const GAS bf16x8*)w2t; Bw1 = *(const GAS bf16x8*)(w2t + 32); Ba0 = *(const GAS bf16x8*)a2t; Ba1 = *(const GAS bf16x8*)(a2t + 32);
          const int ccol = h * 64 + 16 * w4 + lr;
          w0c = INP(10)[(l * 2 + d) * RW + ccol]; a0c = INP(12)[(l * 2 + d) * RW + ccol]; kac = INP(16)[l * RW + ccol]; rkc = INP(17)[l * RW + ccol];
          for (int i = dt; i < 9216 / 16; i += 256) *(LAS v4u*)(L + S3_S16 + 16 * i) = (v4u){0u, 0u, 0u, 0u}; }
#define SC_GEOM(c) const int s0_ = 16 * (c); const bool isctx_ = s0_ < TC; const int pos0_ = isctx_ ? s0_ : s0_ - TC; const int len_ = isctx_ ? TC : TL; \
        const int rowbase_ = isctx_ ? NL + b * TC : b * TL; const int toklo_ = d == 0 ? pos0_ : len_ - 16 - pos0_;
#define SC_LOAD(c) do { SC_GEOM(c) _Pragma("unroll") for (int i = 0; i < 3; ++i) { const int tr = toklo_ - 1 + prow[i]; raw[i] = (v4u){0u, 0u, 0u, 0u}; \
            if (tr >= 0 && tr < len_) raw[i] = *(const GAS v4u*)(PR + (size_t)(rowbase_ + tr) * RCOLS + pcol[i]); } } while (0)
        { S3_IDS(); SC_LOAD(0); }
        for (int c = 0; c < KVT / 16; ++c) {
            S3_IDS();
            {
#pragma unroll
              for (int i = 0; i < 3; ++i) { if (prow[i] >= 0) *(LAS v4u*)(L + S3_RAW + plds[i]) = raw[i]; }
              S3_BAR();
              if (c + 1 < KVT / 16) SC_LOAD(c + 1); }
            for (int rp_ = 0; rp_ < S3_REP_A; ++rp_) {
            { S3_F32(RS, S3_RS); S3_F32(VS, S3_VS); S3_F32(KS, S3_KS); S3_F32(KK, S3_KK);
              const int j = dt >> 4, cg = dt & 15;
              f32x4 xs[5];
#pragma unroll
              for (int g = 0; g < 5; ++g) {
                  const v2u a0 = *(const LAS v2u*)(L + S3_RAW + ((j + 0) * 320 + g * 64 + 4 * cg) * 2), a1 = *(const LAS v2u*)(L + S3_RAW + ((j + 1) * 320 + g * 64 + 4 * cg) * 2), a2 = *(const LAS v2u*)(L + S3_RAW + ((j + 2) * 320 + g * 64 + 4 * cg) * 2);
                  const f32x4 x0 = (f32x4){bflo(a0.x), bfhi(a0.x), bflo(a0.y), bfhi(a0.y)}, x1 = (f32x4){bflo(a1.x), bfhi(a1.x), bflo(a1.y), bfhi(a1.y)}, x2 = (f32x4){bflo(a2.x), bfhi(a2.x), bflo(a2.y), bfhi(a2.y)};
                  xs[g] = mu2[g] * x1 + mu0[g] * x0 + mu1[g] * x2;
              }
              *(LAS f32x4*)(RS + j * 64 + 4 * cg) = xs[0];
              *(LAS f32x4*)(VS + j * 64 + 4 * cg) = xs[2];
              *(LAS f32x4*)(KS + j * 64 + 4 * cg) = xs[1];
              const f32x4 kkf = xs[1] * kkc; float ss = (kkf.x * kkf.x + kkf.y * kkf.y) + (kkf.z * kkf.z + kkf.w * kkf.w);
              ss = row16_sum(ss);
              const float inv = rsq_(fmaxf(ss, 1e-24f));
              *(LAS f32x4*)(KK + j * 64 + 4 * cg) = kkf * inv;
              v2u tw; tw.x = pk2(tanh_fast(xs[3].x), tanh_fast(xs[3].y)); tw.y = pk2(tanh_fast(xs[3].z), tanh_fast(xs[3].w));
              *(LAS v2u*)(L + S3_TWA + (j * 72 + 4 * cg) * 2) = tw;
              v2u ad; ad.x = pk2(xs[4].x, xs[4].y); ad.y = pk2(xs[4].z, xs[4].w);
              *(LAS v2u*)(L + S3_ADA + (j * 72 + 4 * cg) * 2) = ad;
            }
            S3_BAR(); }
            for (int rp_ = 0; rp_ < S3_REP_BC; ++rp_) {
            if (__builtin_amdgcn_readfirstlane(F.tid >> 8) == 0)
            { constexpr int DC = 0; S3_F32(RS, S3_RS); S3_F32(VS, S3_VS); S3_F32(KS, S3_KS); S3_F32(KK, S3_KK); S3_F32(RTF, S3_RTF); S3_F32(KCF, S3_KCF); S3_F32(G15, S3_G15); S3_F32(BON, S3_BON);
              const int ao = (lr * 72 + 8 * lq) * 2;
              const bf16x8 At0 = lds_frag(L + S3_TWA + ao), At1 = lds_frag(L + S3_TWA + ao + 64), Aa0 = lds_frag(L + S3_ADA + ao), Aa1 = lds_frag(L + S3_ADA + ao + 64);
              f32x4 zw = mfma16(At0, Bw0, (f32x4){0.f, 0.f, 0.f, 0.f}); zw = mfma16(At1, Bw1, zw);
              f32x4 za = mfma16(Aa0, Ba0, (f32x4){0.f, 0.f, 0.f, 0.f}); za = mfma16(Aa1, Ba1, za);
              const int cl = 16 * w4 + lr;
              float wv[4], kt[4], bb[4], kkv[4], rsv[4], vsv[4];
#pragma unroll
              for (int i = 0; i < 4; ++i) { const int jj = 4 * lq + i;
                  wv[i] = __expf(-0.6065306597f * sigmoidf_(w0c + zw[i]));
                  const float al = sigmoidf_(a0c + za[i]);
                  kkv[i] = KK[jj * 64 + cl]; rsv[i] = RS[jj * 64 + cl]; vsv[i] = VS[jj * 64 + cl];
                  kt[i] = KS[jj * 64 + cl] * (1.0f + (al - 1.0f) * kac); bb[i] = kkv[i] * al;
                  float bp = rsv[i] * kt[i] * rkc;
                  bp = row16_sum(bp);
                  if (lr == 0) BON[w4 * 16 + jj] = bp; }
              const int gq = DC == 0 ? lq : 3 - lq;
              float e0 = DC == 0 ? wv[0] : wv[3], e1 = DC == 0 ? wv[1] : wv[2], e2 = DC == 0 ? wv[2] : wv[1], e3 = DC == 0 ? wv[3] : wv[0];
              const float c0 = e0, c1 = c0 * e1, c2 = c1 * e2, c3 = c2 * e3;
              const float t0 = lane_get(c3, (DC == 0 ? 0 : 48) + lr), t1 = lane_get(c3, (DC == 0 ? 16 : 32) + lr), t2 = lane_get(c3, (DC == 0 ? 32 : 16) + lr), t3 = lane_get(c3, (DC == 0 ? 48 : 0) + lr);
              const float pre = gq == 0 ? 1.0f : gq == 1 ? t0 : gq == 2 ? t0 * t1 : t0 * t1 * t2;
              const float g15 = (t0 * t1) * (t2 * t3);
              const float gin[4] = { pre * c0, pre * c1, pre * c2, pre * c3 }, gex[4] = { pre, pre * c0, pre * c1, pre * c2 };
              if (lq == 0) G15[cl] = g15;
              float avs[4], bcs[4], vvs[4];
#pragma unroll
              for (int k = 0; k < 4; ++k) { const int i = DC == 0 ? k : 3 - k, t = 4 * gq + k;
                  const float ig = rcp_(gin[k]), sc = g15 * ig;
                  const float av = -kkv[i] * gex[k], rv = rsv[i] * gin[k];
                  st_bf(L + S3_GA + (t * 72 + cl) * 2, bb[i] * ig); st_bf(L + S3_GA + ((16 + t) * 72 + cl) * 2, kt[i] * ig);
                  st_bf(L + S3_GBT + (t * 72 + cl) * 2, av); st_bf(L + S3_GBT + ((16 + t) * 72 + cl) * 2, rv);
                  RTF[t * 64 + cl] = rv; KCF[cl * 16 + t] = kt[i] * sc;
                  avs[k] = av; bcs[k] = bb[i] * sc; vvs[k] = vsv[i]; }
              *(LAS v2u*)(L + S3_ATT + (cl * 24 + 4 * gq) * 2) = (v2u){pk2(avs[0], avs[1]), pk2(avs[2], avs[3])};
              *(LAS v2u*)(L + S3_BCT + (cl * 24 + 4 * gq) * 2) = (v2u){pk2(bcs[0], bcs[1]), pk2(bcs[2], bcs[3])};
              *(LAS v2u*)(L + S3_VT + (cl * 24 + 4 * gq) * 2) = (v2u){pk2(vvs[0], vvs[1]), pk2(vvs[2], vvs[3])};
            }
            else
            { constexpr int DC = 1; S3_F32(RS, S3_RS); S3_F32(VS, S3_VS); S3_F32(KS, S3_KS); S3_F32(KK, S3_KK); S3_F32(RTF, S3_RTF); S3_F32(KCF, S3_KCF); S3_F32(G15, S3_G15); S3_F32(BON, S3_BON);
              const int ao = (lr * 72 + 8 * lq) * 2;
              const bf16x8 At0 = lds_frag(L + S3_TWA + ao), At1 = lds_frag(L + S3_TWA + ao + 64), Aa0 = lds_frag(L + S3_ADA + ao), Aa1 = lds_frag(L + S3_ADA + ao + 64);
              f32x4 zw = mfma16(At0, Bw0, (f32x4){0.f, 0.f, 0.f, 0.f}); zw = mfma16(At1, Bw1, zw);
              f32x4 za = mfma16(Aa0, Ba0, (f32x4){0.f, 0.f, 0.f, 0.f}); za = mfma16(Aa1, Ba1, za);
              const int cl = 16 * w4 + lr;
              float wv[4], kt[4], bb[4], kkv[4], rsv[4], vsv[4];
#pragma unroll
              for (int i = 0; i < 4; ++i) { const int jj = 4 * lq + i;
                  wv[i] = __expf(-0.6065306597f * sigmoidf_(w0c + zw[i]));
                  const float al = sigmoidf_(a0c + za[i]);
                  kkv[i] = KK[jj * 64 + cl]; rsv[i] = RS[jj * 64 + cl]; vsv[i] = VS[jj * 64 + cl];
                  kt[i] = KS[jj * 64 + cl] * (1.0f + (al - 1.0f) * kac); bb[i] = kkv[i] * al;
                  float bp = rsv[i] * kt[i] * rkc;
                  bp = row16_sum(bp);
                  if (lr == 0) BON[w4 * 16 + jj] = bp; }
              const int gq = DC == 0 ? lq : 3 - lq;
              float e0 = DC == 0 ? wv[0] : wv[3], e1 = DC == 0 ? wv[1] : wv[2], e2 = DC == 0 ? wv[2] : wv[1], e3 = DC == 0 ? wv[3] : wv[0];
              const float c0 = e0, c1 = c0 * e1, c2 = c1 * e2, c3 = c2 * e3;
              const float t0 = lane_get(c3, (DC == 0 ? 0 : 48) + lr), t1 = lane_get(c3, (DC == 0 ? 16 : 32) + lr), t2 = lane_get(c3, (DC == 0 ? 32 : 16) + lr), t3 = lane_get(c3, (DC == 0 ? 48 : 0) + lr);
              const float pre = gq == 0 ? 1.0f : gq == 1 ? t0 : gq == 2 ? t0 * t1 : t0 * t1 * t2;
              const float g15 = (t0 * t1) * (t2 * t3);
              const float gin[4] = { pre * c0, pre * c1, pre * c2, pre * c3 }, gex[4] = { pre, pre * c0, pre * c1, pre * c2 };
              if (lq == 0) G15[cl] = g15;
              float avs[4], bcs[4], vvs[4];
#pragma unroll
              for (int k = 0; k < 4; ++k) { const int i = DC == 0 ? k : 3 - k, t = 4 * gq + k;
                  const float ig = rcp_(gin[k]), sc = g15 * ig;
                  const float av = -kkv[i] * gex[k], rv = rsv[i] * gin[k];
                  st_bf(L + S3_GA + (t * 72 + cl) * 2, bb[i] * ig); st_bf(L + S3_GA + ((16 + t) * 72 + cl) * 2, kt[i] * ig);
                  st_bf(L + S3_GBT + (t * 72 + cl) * 2, av); st_bf(L + S3_GBT + ((16 + t) * 72 + cl) * 2, rv);
                  RTF[t * 64 + cl] = rv; KCF[cl * 16 + t] = kt[i] * sc;
                  avs[k] = av; bcs[k] = bb[i] * sc; vvs[k] = vsv[i]; }
              *(LAS v2u*)(L + S3_ATT + (cl * 24 + 4 * gq) * 2) = (v2u){pk2(avs[0], avs[1]), pk2(avs[2], avs[3])};
              *(LAS v2u*)(L + S3_BCT + (cl * 24 + 4 * gq) * 2) = (v2u){pk2(bcs[0], bcs[1]), pk2(bcs[2], bcs[3])};
              *(LAS v2u*)(L + S3_VT + (cl * 24 + 4 * gq) * 2) = (v2u){pk2(vvs[0], vvs[1]), pk2(vvs[2], vvs[3])};
            }
            S3_BAR(); }
            for (int rp_ = 0; rp_ < S3_REP_DE; ++rp_) {
            { S3_F32(MKR, S3_MKR);
              const int mt = w4 >> 1, nt = w4 & 1, ao = ((16 * mt + lr) * 72 + 8 * lq) * 2, bo = ((16 * nt + lr) * 72 + 8 * lq) * 2;
              const f32x4 z4 = (f32x4){0.f, 0.f, 0.f, 0.f};
              const bf16x8 ga0 = lds_frag(L + S3_GA + ao), ga1 = lds_frag(L + S3_GA + ao + 64), gb0 = lds_frag(L + S3_GBT + bo), gb1 = lds_frag(L + S3_GBT + bo + 64);
              f32x4 acc = mfma16(ga0, gb0, z4);
              acc = mfma16(ga1, gb1, acc);
              float vv[4];
#pragma unroll
              for (int i = 0; i < 4; ++i) vv[i] = (4 * lq + i + 1 - nt <= lr) ? acc[i] : 0.f;
              if (w4 == 2) {
#pragma unroll
                  for (int i = 0; i < 4; ++i) st_bf(L + S3_MAK + ((4 * lq + i) * 24 + lr) * 2, vv[i]); }
              else if (w4 == 1) *(LAS v2u*)(L + S3_MBRT + (lr * 24 + 4 * lq) * 2) = (v2u){pk2(vv[0], vv[1]), pk2(vv[2], vv[3])};
              else if (w4 == 3) *(LAS f32x4*)(MKR + lr * 16 + 4 * lq) = (f32x4){vv[0], vv[1], vv[2], vv[3]};
              else {
                  f32x4 pt = mfma16(gb0, ga0, z4);
                  pt = mfma16(gb1, ga1, pt);
                  f32x4 n, p, in, ip;
#pragma unroll
                  for (int i = 0; i < 4; ++i) { const int row = 4 * lq + i; n[i] = vv[i]; p[i] = row > lr ? pt[i] : 0.f; const float e = row == lr ? 1.f : 0.f; in[i] = n[i] + e; ip[i] = p[i] + e; }
                  const bf16x4 bn = pack_k16(n), bp = pack_k16(p);
                  const f32x4 n2 = mfma16k(bp, bn, z4), p2 = mfma16k(bn, bp, z4);
                  const bf16x4 bn2 = pack_k16(n2), bp2 = pack_k16(p2);
                  const f32x4 u1 = mfma16k(pack_k16(ip), bn2, in), u1t = mfma16k(pack_k16(in), bp2, ip);
                  const f32x4 n4 = mfma16k(bp2, bn2, z4), p4 = mfma16k(bn2, bp2, z4);
                  const bf16x4 bn4 = pack_k16(n4), bp4 = pack_k16(p4);
                  const f32x4 u2 = mfma16k(pack_k16(u1t), bn4, u1), u2t = mfma16k(pack_k16(u1), bp4, u1t);
                  const f32x4 n8 = mfma16k(bp4, bn4, z4);
                  const f32x4 T = mfma16k(pack_k16(u2t), pack_k16(n8), u2);
#pragma unroll
                  for (int i = 0; i < 4; ++i) st_bf(L + S3_TA + ((4 * lq + i) * 24 + lr) * 2, T[i]); }
            }
            S3_BAR(); }
            for (int rp_ = 0; rp_ < S3_REP_FG; ++rp_)
            { S3_F32(MKR, S3_MKR); S3_F32(KCF, S3_KCF); S3_F32(RTF, S3_RTF); S3_F32(G15, S3_G15); S3_F32(YO, S3_YO);
              const int cb = (w4 + 3) & 3;
              const f32x4 z4 = (f32x4){0.f, 0.f, 0.f, 0.f};
              const bf16x4 Ata = frag_k16(L + S3_TA + lr * 48, lq), B0 = frag_k16(L + S3_MBRT + lr * 48, lq), BE = frag_k16(L + S3_BCT + (16 * cb + lr) * 48, lq);
              const bf16x4 Amk = frag_k16(L + S3_MAK + lr * 48, lq);
              const f32x4 i0 = *(const LAS f32x4*)(MKR + lr * 16 + 4 * lq), iE = *(const LAS f32x4*)(KCF + (16 * cb + lr) * 16 + 4 * lq);
              bf16x4 Aa[4], Av[4]; bf16x8 As[2][4]; f32x4 ri[4];
#pragma unroll
              for (int mt = 0; mt < 4; ++mt) { Aa[mt] = frag_k16(L + S3_ATT + (16 * mt + lr) * 48, lq); Av[mt] = frag_k16(L + S3_VT + (16 * mt + lr) * 48, lq);
                  ri[mt] = *(const LAS f32x4*)(RTF + lr * 64 + 16 * mt + 4 * lq);
                  As[0][mt] = frag_lk32(L + S3_S16 + (16 * mt + lr) * 144, lq); As[1][mt] = frag_lk32(L + S3_S16 + (16 * mt + lr) * 144 + 64, lq); }
              const f32x4 g = *(const LAS f32x4*)(G15 + 16 * cb + 4 * lq);
              __builtin_amdgcn_sched_barrier(0);
              const f32x4 d10 = mfma16k(Ata, B0, z4), d1E = mfma16k(Ata, BE, z4);
              const bf16x4 Pd10 = pack_k16(d10), Pd1E = pack_k16(d1E);
              const f32x4 d20 = mfma16k(Amk, Pd10, i0), d2E = mfma16k(Amk, Pd1E, iE);
              const bf16x4 Pd20 = pack_k16(d20), Pd2E = pack_k16(d2E);
              f32x4 r0[4], q1[4], accS[4], accY = z4;
#pragma unroll
              for (int mt = 0; mt < 4; ++mt) {
                  r0[mt] = mfma16k(Aa[mt], Pd10, ri[mt]); q1[mt] = mfma16k(Aa[mt], Pd1E, z4); accS[mt] = mfma16k(Pd2E, Av[mt], z4);
                  if (mt == w4) accY = mfma16k(Av[mt], Pd20, z4);
              }
#pragma unroll
              for (int pp = 0; pp < 2; ++pp) {
                  const bf16x8 Bq1 = pack_b2(q1[2 * pp], q1[2 * pp + 1]), Bq0 = pack_b2(r0[2 * pp], r0[2 * pp + 1]);
#pragma unroll
                  for (int mt = 0; mt < 4; ++mt) { accS[mt] = mfma16(Bq1, As[pp][mt], accS[mt]);
                      if (mt == w4) accY = mfma16(As[pp][mt], Bq0, accY); } }
#pragma unroll
              for (int i = 0; i < 4; ++i) YO[lr * 64 + 16 * w4 + 4 * lq + i] = accY[i];
              if (rp_ == S3_REP_FG - 1) {
#pragma unroll
              for (int mt = 0; mt < 4; ++mt) S[mt] = S[mt] * g + accS[mt]; }
              else { asm volatile("" :: "v"(accS[0]), "v"(accS[1]), "v"(accS[2]), "v"(accS[3])); }
            }
            S3_BAR();
            { const int cb = (w4 + 3) & 3;
#pragma unroll
              for (int mt = 0; mt < 4; ++mt) *(LAS v2u*)(L + S3_S16 + ((16 * mt + lr) * 72 + 16 * cb + 4 * lq) * 2) = (v2u){pk2(S[mt][0], S[mt][1]), pk2(S[mt][2], S[mt][3])};
            }
            { S3_F32(YO, S3_YO); S3_F32(BON, S3_BON); SC_GEOM(c)
              if (dt < 128) { const int s = dt >> 3, c8 = dt & 7; const int tok = d == 0 ? pos0_ + s : len_ - 1 - (pos0_ + s);
                  GAS bf16* Yd = WSP(bf16, d == 0 ? WS_YF : WS_YB);
                  const f32x4 a = *(const LAS f32x4*)(YO + s * 64 + 8 * c8), bq = *(const LAS f32x4*)(YO + s * 64 + 8 * c8 + 4);
                  v4u w; w.x = pk2(a.x, a.y); w.y = pk2(a.z, a.w); w.z = pk2(bq.x, bq.y); w.w = pk2(bq.z, bq.w);
                  *(GAS v4u*)(Yd + (size_t)(rowbase_ + tok) * RW + h * 64 + 8 * c8) = w; }
              else if (dt < 144) { const int jj = dt - 128; GAS float* bonus = WSP(float, WS_BONUS) + (size_t)d * MA * 8;
                  bonus[(size_t)(rowbase_ + toklo_ + jj) * 8 + h] = (BON[jj] + BON[16 + jj]) + (BON[32 + jj] + BON[48 + jj]); }
            }
        }
        __syncthreads();
#undef SC_LOAD
#undef SC_GEOM
    }
}
__global__ void __launch_bounds__(NWAVES * 64, 2) fwd_kernel(Args args) {
    extern __shared__ __attribute__((aligned(16))) unsigned char lds[];
    Frame F;
    F.lds = (LAS unsigned char*)lds;
    F.MISC = (volatile LAS unsigned*)(F.lds + MISC_OFF);
    F.tid = threadIdx.x; F.lane = F.tid & 63; F.wave = __builtin_amdgcn_readfirstlane(F.tid >> 6);
    F.G = gridDim.x; { const int bx = blockIdx.x; F.vcu = (F.G % 8 == 0) ? (bx % 8) * (F.G / 8) + bx / 8 : bx; }
    F.ws = args.ws; F.out = args.out; F.ctl = (gu32*)(args.ws + WS_CTL);
    for (int u = F.tid; u < 128; u += NWAVES * 64) ((LAS unsigned*)(F.lds + MISC_OFF))[u] = 0u;
    if (F.tid < 33) { const unsigned long long pv = (unsigned long long)args.in[F.tid]; ((LAS unsigned*)(F.lds + PTAB_OFF))[2 * F.tid] = (unsigned)pv; ((LAS unsigned*)(F.lds + PTAB_OFF))[2 * F.tid + 1] = (unsigned)(pv >> 32); }
    __syncthreads();
    const int vcu0 = F.vcu, wave_s = F.wave;
    const bool fused = args.mode == 0;
    XcdBarrier bar; bar.bar = (unsigned*)(F.ctl + CW_BAR); bar.x = 0; bar.st = nullptr;
    if (fused) bar = xcd_barrier_post((unsigned*)(F.ctl + CW_BAR), F.MISC + 8);
#ifndef REP_PRO
#define REP_PRO 1
#endif
#ifndef REP_N7
#define REP_N7 1
#endif
#ifndef REP_FINAL
#define REP_FINAL 1
#endif
#ifndef REP_NORM
#define REP_NORM 1
#endif
#ifndef REP_GEMM1
#define REP_GEMM1 1
#endif
#ifndef REP_GEMM1_NOSIG
#define REP_GEMM1_NOSIG 0
#endif
#ifndef REP_GEMM1_NOEPI
#define REP_GEMM1_NOEPI 0
#endif
#ifndef REP_SCAN
#define REP_SCAN 1
#endif
#ifndef REP_ROUT
#define REP_ROUT 1
#endif
#ifndef REP_ATTN_DUMMY
#define REP_ATTN_DUMMY 0
#endif
#ifndef REP_MERGEA
#define REP_MERGEA 1
#endif
#ifndef REP_GU
#define REP_GU 1
#endif
#ifndef REP_DOWN_DUMMY
#define REP_DOWN_DUMMY 0
#endif
#ifndef REP_MOECONV
#define REP_MOECONV 1
#endif
#ifndef REP_MOEGEMM
#define REP_MOEGEMM 1
#endif
#define REPEAT(n) for (int rep_ = 0; rep_ < (n); ++rep_)
#ifndef SITE_MASK
#define SITE_MASK 0xFFFF
#endif
#define RUN(L, S) (((SITE_MASK >> (S)) & 1) && (fused || (args.l == (L) && args.site == (S))))
#ifndef REP_BAR
#define REP_BAR 0
#endif
#ifndef STAG_GEMM1
#define STAG_GEMM1 0
#endif
#ifndef STAG_GU
#define STAG_GU 0
#endif
#define STAGGER(ticks) do { const unsigned grp_ = (blockIdx.x >> 3) & 3u; if ((ticks) > 0 && grp_) { const unsigned long long t0_ = __builtin_amdgcn_s_memrealtime(), dl_ = (unsigned long long)(ticks) * grp_; while (__builtin_amdgcn_s_memrealtime() - t0_ < dl_) __builtin_amdgcn_s_sleep(32); } } while (0)
#define GRID_BAR() do { if (fused) { xcd_barrier(bar, F.tid); REPEAT(REP_BAR) xcd_barrier(bar, F.tid); } } while (0)
#define SITE_BEGIN() do { int t_; asm volatile("v_mbcnt_lo_u32_b32 %0, -1, 0\n\tv_mbcnt_hi_u32_b32 %0, -1, %0" : "=v"(t_)); t_ += wave_s * 64; asm volatile("" : "+v"(t_));     F.tid = t_; F.lane = t_ & 63; F.wave = __builtin_amdgcn_readfirstlane(t_ >> 6);     int v_ = vcu0; asm volatile("" : "+s"(v_)); F.vcu = v_; unsigned long long w_ = (unsigned long long)args.ws, o_ = (unsigned long long)args.out; asm volatile("" : "+s"(w_), "+s"(o_)); F.ws = (unsigned char*)w_; F.out = (GAS float*)o_; F.ctl = (gu32*)(F.ws + WS_CTL); } while (0)
    GAS bf16* const XC = WSP(bf16, WS_XC); GAS bf16* const X16 = WSP(bf16, WS_X16);
    GAS float* const MOD = WSP(float, WS_MOD);
    LAS int* const tile_e = (LAS int*)(F.lds + RING_BYTES);

    if (RUN(0, 0)) { SITE_BEGIN(); REPEAT(REP_PRO) p0_prologue(F); GRID_BAR(); }

    for (int l = 0; l < 2; ++l) {
        const int nM_mix = l == 0 ? MA / 256 : NL / 256;
        if (RUN(l, 1)) { SITE_BEGIN(); if (l == 0) norm_mod_phase<false, false>(F, l, 0, INP(0), INP(2), MA, WSP(bf16, WS_H)); else norm_mod_phase<false, true>(F, l, 0, X16, XC, MA, WSP(bf16, WS_H)); GRID_BAR(); }
        if (RUN(l, 2)) { SITE_BEGIN();
            pg8::StdOrder S; S.init(WSGEN(bf16, WS_H), WSGEN(bf16, WS_WIN) + (size_t)l * NIN * DM, DM, MA / 256, NIN / 256, F.G, (int)blockIdx.x);
            EpiIn E{WSP(bf16, WS_PR), WSP(bf16, WS_Q), WSP(bf16, WS_KB), WSP(bf16, WS_VB), WSP(unsigned char, WS_G)};
            STAGGER(STAG_GEMM1);
            REPEAT(REP_GEMM1_NOSIG) { EpiInT<false> EN2{WSP(bf16, WS_PR), WSP(bf16, WS_Q), WSP(bf16, WS_KB), WSP(bf16, WS_VB), WSP(unsigned char, WS_G)}; pg8::gemm_phase<EpiInT<false>, pg8::StdOrder, true, true>(F.lds, DM, S, EN2, F.tid); __syncthreads(); }
            if (l == 0) { REPEAT(REP_GEMM1) pg8::gemm_phase<EpiIn, pg8::StdOrder, true, true>(F.lds, DM, S, E, F.tid); }
            else { pg8::In1Order S1; *(pg8::StdOrder*)&S1 = S; REPEAT(REP_GEMM1) pg8::gemm_phase<EpiIn, pg8::In1Order, true, true>(F.lds, DM, S1, E, F.tid); }
            REPEAT(REP_GEMM1_NOEPI) { EpiNull EN{WSP(bf16, WS_YR)}; pg8::gemm_phase<EpiNull, pg8::StdOrder, true, true>(F.lds, DM, S, EN, F.tid); __syncthreads(); }
            GRID_BAR();
        }
        if (RUN(l, 3)) { SITE_BEGIN(); const bool early = ((F.vcu >> 3) & 1) != 0;
            if (early) qk_phase(F, l);
            REPEAT(REP_SCAN) scan_phase3(F, l);
            if (!early) qk_phase(F, l);
            GRID_BAR(); }
        if (RUN(l, 4)) { SITE_BEGIN(); const bool early = ((F.vcu >> 3) & 1) != 0;
            if (early) { REPEAT(REP_ROUT) { rwkv_out_phase(F, l, nM_mix * 256); __syncthreads(); } }
            attn_phase(F, l, (char*)lds, WS_Q);
            if (!early) { REPEAT(REP_ROUT) { __syncthreads(); rwkv_out_phase(F, l, nM_mix * 256); } }
            GRID_BAR(); }
        if (RUN(l, 5)) { SITE_BEGIN();
            pg8::PairOrder S; S.init(WSGEN(bf16, WS_YR), WSGEN(bf16, WS_WPA) + (size_t)l * DM * RW, RW, nM_mix, DM / 256, F.G, (int)blockIdx.x);
            S.A2 = (const char*)WSGEN(bf16, WS_Q); S.Bt2 = (const char*)(WSGEN(bf16, WS_WPB) + (size_t)l * DM * RW);
            EpiMergeAB E{WSP(unsigned char, WS_G), WSP(bf16, WS_MG)};
            REPEAT(REP_MERGEA) pg8::gemm_phase<EpiMergeAB, pg8::PairOrder, true, true>(F.lds, RW, S, E, F.tid);
            GRID_BAR();
        }
        if (RUN(l, 6)) { SITE_BEGIN();
            pg8::StdOrder S; S.init(WSGEN(bf16, WS_MG), WSGEN(bf16, WS_WO) + (size_t)l * DM * DM, DM, nM_mix, DM / 256, F.G, (int)blockIdx.x);
            if (l == 0) { EpiResT<true> E{INP(0), INP(2), X16, XC, MOD + 2048}; pg8::gemm_phase<EpiResT<true>, pg8::StdOrder, true, true>(F.lds, DM, S, E, F.tid); }
            else { EpiResT<false> E{X16, XC, X16, XC, MOD + (size_t)33 * 6144 + 2048}; pg8::gemm_phase<EpiResT<false>, pg8::StdOrder, true, true>(F.lds, DM, S, E, F.tid); }
            GRID_BAR();
        }
        if (RUN(l, 7)) { SITE_BEGIN();
            if (l == 0) { REPEAT(REP_N7) norm_mod_phase<false, true>(F, l, 1, X16, XC, MA, WSP(bf16, WS_H)); }
            else norm_mod_phase<true, true>(F, l, 1, X16, XC, NL, WSP(bf16, WS_H2M));
            GRID_BAR();
        }
        if (l == 0) {
            for (int ch = 0; ch <= FFN_NCHUNK; ++ch) {
                if (!fused && ch != args.chunk) continue;
                if (RUN(0, 8)) { SITE_BEGIN();
                    int pntl = 0;
                    if (ch >= 1) { const int t0 = ch == 1 ? 0 : FFN_C0 + (ch - 2) * MOE_CH_TILES, ntl = ch == 1 ? FFN_C0 : MOE_CH_TILES;
                        MoeOrderT<false> S{(const char*)(F.ws + WS_ACT + (size_t)((ch - 1) & 1) * (128 * MiB)), (const char*)(F.ws + WS_WDN), (size_t)256 * FF * 2, (size_t)256 * FF * 2, (size_t)0, t0, t0, ntl, DM / 256, F.G, (int)blockIdx.x, tile_e, 0, nullptr};
                        EpiResT<false> E{X16, XC, X16, XC, MOD + 5120};
                        pg8::gemm_phase<EpiResT<false>, MoeOrderT<false>, true, true>(F.lds, FF, S, E, F.tid);
                        pntl = ntl;
                    }
                    if (ch < FFN_NCHUNK) { const int t0 = ch == 0 ? 0 : FFN_C0 + (ch - 1) * MOE_CH_TILES, ntl = ch == 0 ? FFN_C0 : MOE_CH_TILES;
                        MoeOrderT<false> S{(const char*)(F.ws + WS_H), (const char*)(F.ws + WS_WGU), (size_t)256 * DM * 2, (size_t)256 * DM * 2, (size_t)0, t0, 0, ntl, 2 * FF / 256, F.G, (int)blockIdx.x, tile_e, pntl, nullptr};
                        EpiGU E{WSP(bf16, WS_ACT + (size_t)(ch & 1) * (128 * MiB)), t0};
                        REPEAT(REP_GU) pg8::gemm_phase<EpiGU, MoeOrderT<false>, true, true>(F.lds, DM, S, E, F.tid);
                    }
                    GRID_BAR();
                }
            }
        } else {
            if (RUN(1, 10)) { SITE_BEGIN(); REPEAT(REP_MOECONV) moe_conv(F); __syncthreads(); moe_slots(F); GRID_BAR(); }
            int ntile = 0;
            if (fused || args.site == 11) ntile = moe_tiles(F, tile_e);
            const int c0 = ntile > (MOE_NCHUNK - 1) * MOE_CH_TILES ? ntile - (MOE_NCHUNK - 1) * MOE_CH_TILES : 0;
            for (int ch = 0; ch <= MOE_NCHUNK; ++ch) {
                if (!fused && ch != args.chunk) continue;
                if (RUN(1, 11)) { SITE_BEGIN();
                    int pntl = 0;
                    if (ch >= 1) {
                        const int t0 = ch == 1 ? 0 : c0 + (ch - 2) * MOE_CH_TILES; const int rem = ntile - t0; const int ntl = ch == 1 ? c0 : (rem < 0 ? 0 : rem < MOE_CH_TILES ? rem : MOE_CH_TILES);
                        MoeOrderT<false> S{(const char*)(F.ws + (((ch - 1) & 1) ? WS_ACTC1 : WS_ACTC)), (const char*)(F.ws + WS_MW) + (size_t)2 * FF * DM * 2, (size_t)256 * FF * 2, (size_t)256 * FF * 2, (size_t)21 * MiB, t0, t0, ntl, DM / 256, F.G, (int)blockIdx.x, tile_e, 0, nullptr};
                        EpiStore E{WSP(bf16, WS_YM)};
                        REPEAT(REP_MOEGEMM) pg8::gemm_phase<EpiStore, MoeOrderT<false>, true, true>(F.lds, FF, S, E, F.tid);
                        pntl = ntl;
                    }
                    if (ch < MOE_NCHUNK) {
                        const int t0 = ch == 0 ? 0 : c0 + (ch - 1) * MOE_CH_TILES; const int rem = ntile - t0; const int ntl = ch == 0 ? c0 : (rem < 0 ? 0 : rem < MOE_CH_TILES ? rem : MOE_CH_TILES);
                        MoeOrderT<true> S{(const char*)(F.ws + WS_H2M), (const char*)(F.ws + WS_MW), (size_t)0, (size_t)256 * DM * 2, (size_t)21 * MiB, t0, 0, ntl, 2 * FF / 256, F.G, (int)blockIdx.x, tile_e, pntl, (const GAS int*)(F.ws + WS_MOETAB + MT_ROWT)};
                        EpiGU E{(ch & 1) ? WSP(bf16, WS_ACTC1) : WSP(bf16, WS_ACTC), t0};
                        REPEAT(REP_MOEGEMM) pg8::gemm_phase<EpiGU, MoeOrderT<true>, true, true>(F.lds, DM, S, E, F.tid);
                    }
                    GRID_BAR();
                }
            }
            if (RUN(1, 13)) { SITE_BEGIN(); REPEAT(REP_FINAL) moe_final(F); }
        }
    }
#undef RUN
#undef GRID_BAR
}

extern "C" void kernel_launch(void* const* d_in, const GAS int* in_sizes, int n_in, void* d_out, int out_size, void* d_ws, size_t ws_size, hipStream_t stream) {
    static int grid = 0;
    if (grid == 0) {
        if (n_in != 33 || in_sizes[0] != NL * DM || out_size != NL * DM || ws_size < WS_END) { fprintf(stderr, "kernel_launch: unexpected problem (n_in %d, x %d, out %d, ws %zu < %zu); nothing launched\n", n_in, n_in > 0 ? in_sizes[0] : -1, out_size, ws_size, (size_t)WS_END); grid = -1; return; }
        int dev = 0, cus = 0, per_cu = 0;
        if (hipGetDevice(&dev) != hipSuccess || hipDeviceGetAttribute(&cus, hipDeviceAttributeMultiprocessorCount, dev) != hipSuccess) { fprintf(stderr, "kernel_launch: device query failed\n"); grid = -1; return; }
        if (hipFuncSetAttribute((const void*)fwd_kernel, hipFuncAttributeMaxDynamicSharedMemorySize, LDS_BYTES) != hipSuccess) { fprintf(stderr, "kernel_launch: hipFuncSetAttribute failed\n"); grid = -1; return; }
        if (hipOccupancyMaxActiveBlocksPerMultiprocessor(&per_cu, (const void*)fwd_kernel, NWAVES * 64, LDS_BYTES) != hipSuccess || per_cu < 1) { fprintf(stderr, "kernel_launch: occupancy query reports %d workgroups per CU\n", per_cu); }
        (void)hipGetLastError();
        grid = cus;
        fprintf(stderr, "kernel_launch: grid %d, occupancy query %d\n", grid, per_cu);
    }
    if (grid < 0) return;
    if (hipMemsetAsync((char*)d_ws + WS_CTL, 0, CTL_ZERO_BYTES, stream) != hipSuccess) { fprintf(stderr, "kernel_launch: memset failed\n"); return; }
    Args a{};
    for (int i = 0; i < 33; ++i) a.in[i] = (const GAS float*)d_in[i];
    a.out = (GAS float*)d_out; a.ws = (unsigned char*)d_ws;
#if MK_FUSED
    a.mode = 0; a.l = 0; a.site = 0; a.chunk = 0;
    hipLaunchKernelGGL(fwd_kernel, dim3(grid), dim3(NWAVES * 64), LDS_BYTES, stream, a);
#else
    a.mode = 1;
    auto step = [&](int l, int site, int chunk) { a.l = l; a.site = site; a.chunk = chunk; hipLaunchKernelGGL(fwd_kernel, dim3(grid), dim3(NWAVES * 64), LDS_BYTES, stream, a); };
    step(0, 0, 0);
    for (int l = 0; l < 2; ++l) {
        for (int s = 1; s <= 7; ++s) step(l, s, 0);
        if (l == 0) { for (int ch = 0; ch <= FFN_NCHUNK; ++ch) step(0, 8, ch); }
        else { step(1, 10, 0); for (int ch = 0; ch <= MOE_NCHUNK; ++ch) step(1, 11, ch); step(1, 13, 0); }
    }
#endif
    const hipError_t le = hipPeekAtLastError();
    if (le != hipSuccess) fprintf(stderr, "kernel_launch: launch failed: %s\n", hipGetErrorName(le));
}
```

```cpp
#include <hip/hip_runtime.h>
#include <hip/hip_bf16.h>
#include <cstdio>
#include <cstdint>
#include <cmath>

#ifndef MK_FUSED
#define MK_FUSED 1
#endif

constexpr int DM = 1024, NB = 32, TL = 2048, TC = 256;
constexpr int NL = NB * TL;
constexpr int NC = NB * TC;
constexpr int MA = NL + NC;
constexpr int RW = 512, RCOLS = 1792, ACOLS = 768, GCOLS = 2048, NIN = 4608;
constexpr int FF = 3584, NE = 8;
constexpr int KVT = TL + TC;
constexpr int MOE_ROWS = 2 * NL + NE * 256;
constexpr int MOE_CH_TILES = 64;
constexpr int MOE_NCHUNK = 8;
constexpr int MOE_LAST_TILES = 72;

constexpr size_t MiB = 1u << 20;
constexpr size_t WS_CTL = 0, CTL_ZERO_BYTES = 1 * MiB;
constexpr size_t WS_MOD = 1 * MiB;
constexpr size_t WS_ROPE = 3 * MiB;
constexpr size_t WS_LORA = 4 * MiB;
constexpr size_t WS_BONUS = 5 * MiB;
constexpr size_t WS_MOETAB = 10 * MiB;
constexpr size_t WS_WIN = 16 * MiB;
constexpr size_t WS_WPA = 34 * MiB;
constexpr size_t WS_WPB = 36 * MiB;
constexpr size_t WS_WO = 38 * MiB;
constexpr size_t WS_WGU = 42 * MiB;
constexpr size_t WS_WDN = 56 * MiB;
constexpr size_t WS_XC = 64 * MiB;
constexpr size_t WS_X16 = 752 * MiB;
constexpr size_t WS_H = 96 * MiB;
constexpr size_t WS_YF = 96 * MiB, WS_YB = 168 * MiB;
constexpr size_t WS_PR = 240 * MiB;
constexpr size_t WS_MG = 240 * MiB;
constexpr size_t WS_Q = 492 * MiB;
constexpr size_t WS_KB = 564 * MiB, WS_VB = 582 * MiB;
constexpr size_t WS_G = 600 * MiB;
constexpr size_t WS_YR = 888 * MiB;
constexpr size_t WS_ACT = 240 * MiB;
constexpr size_t WS_H2M = 80 * MiB;
constexpr size_t WS_MW = 208 * MiB;
constexpr size_t WS_XB = 376 * MiB;
constexpr size_t WS_YM = 488 * MiB;
constexpr int FFN_NCHUNK = 5, FFN_C0 = MA / 256 - (FFN_NCHUNK - 1) * MOE_CH_TILES;
static_assert(FFN_C0 > 0 && FFN_C0 <= MOE_CH_TILES, "ffn chunks");
constexpr size_t WS_ACTC = 896 * MiB;
constexpr size_t WS_ACTC1 = WS_XB;
constexpr size_t WS_END = 1024 * MiB;
static_assert(WS_H + (size_t)MA * DM * 2 <= WS_PR && WS_PR + (size_t)MA * RCOLS * 2 <= WS_Q && WS_Q + (size_t)MA * 512 * 2 <= WS_KB, "ws map 1");
static_assert(WS_KB + (size_t)MA * 128 * 2 <= WS_VB && WS_VB + (size_t)MA * 128 * 2 <= WS_G && WS_G + (size_t)MA * GCOLS * 2 <= WS_YR && WS_YR + (size_t)MA * 512 * 2 <= WS_END, "ws map 2");
static_assert(WS_ACT + (size_t)MA * FF * 2 <= WS_END && WS_H2M + (size_t)NL * DM * 2 <= WS_MW && WS_MW + (size_t)NE * 21 * MiB <= WS_XB && WS_H2M >= WS_XC, "ws map 3");
static_assert(WS_YM + (size_t)MOE_ROWS * DM * 2 <= WS_ACTC && WS_ACTC + (size_t)MOE_LAST_TILES * 256 * FF * 2 <= WS_END, "ws map 4");
static_assert(WS_ACTC1 + (size_t)MOE_CH_TILES * 256 * FF * 2 <= WS_YM, "ws map 4b");
static_assert(WS_YM + (size_t)MOE_ROWS * DM * 2 <= WS_X16 && WS_G + (size_t)MA * GCOLS <= WS_X16 && WS_X16 + (size_t)NL * DM * 2 <= WS_YR && WS_ACT + 240 * MiB <= WS_X16, "ws map 6");
static_assert(WS_WDN + (size_t)DM * FF * 2 <= WS_XC && WS_BONUS + (size_t)2 * MA * 8 * 4 <= WS_MOETAB, "ws map 5");
constexpr size_t MT_TOKE = 0;
constexpr size_t MT_TOKW = 512 * 1024;
constexpr size_t MT_TOKS = 1024 * 1024;
constexpr size_t MT_ROWT = 1536 * 1024;
constexpr int CW_TMO = 0, CW_CODE = 1;
constexpr int CW_BAR = 4096;
constexpr int CW_HIST = 8192;
constexpr int CW_CURS = 8192 + 64 * 8;

constexpr int NWAVES = 8;
constexpr int LDS_BYTES = 147456;
constexpr int MISC_OFF = LDS_BYTES - 1024;
constexpr int PTAB_OFF = LDS_BYTES - 512;
constexpr int RING_BYTES = 131072;

#define GAS __attribute__((address_space(1)))
#define LAS __attribute__((address_space(3)))
typedef unsigned short bf16;
typedef unsigned v4u __attribute__((ext_vector_type(4)));
typedef unsigned v2u __attribute__((ext_vector_type(2)));
typedef float f32x4 __attribute__((ext_vector_type(4)));
typedef float f32x2 __attribute__((ext_vector_type(2)));
typedef short bf16x8 __attribute__((ext_vector_type(8)));
typedef GAS unsigned gu32;
#define RLX_AGENT __ATOMIC_RELAXED, __HIP_MEMORY_SCOPE_AGENT
#define LDS_WAIT() asm volatile("s_waitcnt lgkmcnt(0)" ::: "memory")
#define VM_WAIT() asm volatile("s_waitcnt vmcnt(0)" ::: "memory")
__device__ __forceinline__ float bf2f(unsigned b) { return __uint_as_float(b << 16); }
__device__ __forceinline__ float bflo(unsigned w) { return __uint_as_float(w << 16); }
__device__ __forceinline__ float bfhi(unsigned w) { return __uint_as_float(w & 0xffff0000u); }
typedef __bf16 bf16x2_t __attribute__((ext_vector_type(2)));
__device__ __forceinline__ unsigned pk2(float lo, float hi) { const f32x2 v = {lo, hi}; const bf16x2_t b = __builtin_convertvector(v, bf16x2_t); return __builtin_bit_cast(unsigned, b); }
__device__ __forceinline__ float rcp_(float x) { return __builtin_amdgcn_rcpf(x); }
__device__ __forceinline__ float rsq_(float x) { return __builtin_amdgcn_rsqf(x); }
__device__ __forceinline__ float sigmoidf_(float x) { return rcp_(1.0f + __expf(-x)); }

__device__ __forceinline__ float row8_sum(float v) {
    v += __builtin_bit_cast(float, __builtin_amdgcn_mov_dpp(__builtin_bit_cast(int, v), 0xB1, 0xF, 0xF, true));
    v += __builtin_bit_cast(float, __builtin_amdgcn_mov_dpp(__builtin_bit_cast(int, v), 0x4E, 0xF, 0xF, true));
    v += __builtin_bit_cast(float, __builtin_amdgcn_mov_dpp(__builtin_bit_cast(int, v), 0x141, 0xF, 0xF, true));
    return v;
}
__device__ __forceinline__ float lane_get(float v, int src) { return __builtin_bit_cast(float, __builtin_amdgcn_ds_bpermute(src << 2, __builtin_bit_cast(int, v))); }
__device__ __forceinline__ float row16_sum(float v) {
    v += __builtin_bit_cast(float, __builtin_amdgcn_mov_dpp(__builtin_bit_cast(int, v), 0xB1, 0xF, 0xF, true));
    v += __builtin_bit_cast(float, __builtin_amdgcn_mov_dpp(__builtin_bit_cast(int, v), 0x4E, 0xF, 0xF, true));
    v += __builtin_bit_cast(float, __builtin_amdgcn_mov_dpp(__builtin_bit_cast(int, v), 0x141, 0xF, 0xF, true));
    v += __builtin_bit_cast(float, __builtin_amdgcn_mov_dpp(__builtin_bit_cast(int, v), 0x140, 0xF, 0xF, true));
    return v;
}
__device__ __forceinline__ float xsum16(float v) { const auto r = __builtin_amdgcn_permlane16_swap(__float_as_uint(v), __float_as_uint(v), false, false); return __uint_as_float(r[0]) + __uint_as_float(r[1]); }
__device__ __forceinline__ float xsum32(float v) { const auto r = __builtin_amdgcn_permlane32_swap(__float_as_uint(v), __float_as_uint(v), false, false); return __uint_as_float(r[0]) + __uint_as_float(r[1]); }
__device__ __forceinline__ float wave_sum(float v) { return xsum32(xsum16(row16_sum(v))); }
__device__ __forceinline__ int row_bi(int m) { return m < NL ? (m >> 11) : 32; }
__device__ __forceinline__ int row_kv(int m) { return m < NL ? (m >> 11) * KVT + (m & 2047) : ((m - NL) >> 8) * KVT + TL + ((m - NL) & 255); }
namespace pg8 {
#define PG8_LAS __attribute__((address_space(3)))
#define PG8_GAS __attribute__((address_space(1)))
typedef unsigned short bf16_t;
typedef short bf16x8 __attribute__((ext_vector_type(8)));
typedef float f32x4 __attribute__((ext_vector_type(4)));
typedef unsigned u32x4 __attribute__((ext_vector_type(4)));
constexpr int NL_ROWS = 65536;
constexpr int BM = 256, BK = 64, HALF = 128, HTB = HALF * BK * 2  , STAGE_BYTES = 8 * HTB, NXCD = 8, WGM = 8;

__host__ __device__ __forceinline__ int lds_byte(int r, int c) { const int st = (r >> 4) * 2 + (c >> 5), rr = r & 15, cc = c & 31, ob = rr * 64 + cc * 2; return st * 1024 + (ob ^ (((ob >> 9) & 1) << 5)); }
__host__ __device__ __forceinline__ void stage_rc(int b, int& R, int& C) { const int st = b / 1024, sb = b % 1024, swz = sb ^ (((sb >> 9) & 1) << 5); R = (st >> 1) * 16 + swz / 64; C = (st & 1) * 32 + (swz % 64) / 2; }
__host__ __device__ __forceinline__ int perm32(int rho) { const int n = rho >> 4, i = rho & 15; return 8 * (i >> 2) + 4 * n + (i & 3); }

struct Unit { int pm, pn, part; };

struct StdOrder {
    static constexpr bool GATHER = false;
    const char* A; const char* Bt; size_t tstep; int nM, nN, nwg, G, c;
    __device__ void init(const void* A_, const void* Bt_, int K, int nM_, int nN_, int G_, int c_) { A = (const char*)A_; Bt = (const char*)Bt_; tstep = (size_t)BM * K * 2; nM = nM_; nN = nN_; nwg = nM * nN; G = G_; c = c_; }
    __device__ bool next(int i, Unit& u) const {
        const long L = (long)i * G + c; if (L >= nwg) return false;
        int wgid = (int)L; { const int q = nwg / NXCD, r = nwg % NXCD, xcd = wgid % NXCD, off = wgid / NXCD; wgid = (xcd < r ? xcd * (q + 1) : r * (q + 1) + (xcd - r) * q) + off; }
        const int nig = WGM * nN, gid = wgid / nig, fm = gid * WGM, gsz = (nM - fm) < WGM ? (nM - fm) : WGM;
        u.pm = fm + ((wgid % nig) % gsz); u.pn = (wgid % nig) / gsz; u.part = 0; return true;
    }
    __device__ __forceinline__ const char* a_base(const Unit& u) const { return A + (size_t)u.pm * tstep; }
    __device__ __forceinline__ const char* b_base(const Unit& u) const { return Bt + (size_t)u.pn * tstep; }
    __device__ __forceinline__ void a_ready(const Unit&) const {}
    __device__ __forceinline__ void done(const Unit&) const {}
};
struct In1Order : StdOrder {
    __device__ bool next(int i, Unit& u) const {
        const long L = (long)i * G + c; const int nlat = (NL_ROWS / BM) * nN;
        if (L < nlat) { StdOrder s = *this; s.nM = NL_ROWS / BM; s.nwg = nlat; return s.next(i, u); }
        const int r = (int)(L - nlat); if (r >= (nM - NL_ROWS / BM) * 8) return false;
        const int nct = nM - NL_ROWS / BM, q = r / nct; u.pm = NL_ROWS / BM + r % nct; u.pn = q < 7 ? q : 9; u.part = 0; return true;
    }
};
struct PairOrder : StdOrder {
    const char* A2; const char* Bt2;
    __device__ bool next(int i, Unit& u) const { if (!StdOrder::next(i >> 1, u)) return false; u.part = i & 1; return true; }
    __device__ __forceinline__ const char* a_base(const Unit& u) const { return (u.part ? A2 : A) + (size_t)u.pm * tstep; }
    __device__ __forceinline__ const char* b_base(const Unit& u) const { return (u.part ? Bt2 : Bt) + (size_t)u.pn * tstep; }
};
template <class Epi, class Sched, bool ALIGN_EPI = false, bool SP2 = false>
__device__ __forceinline__ void gemm_phase(PG8_LAS unsigned char* lds, const int K, const Sched& S, const Epi& E, const int tid_in) {
    int tid_l = tid_in; asm volatile("" : "+v"(tid_l));
    const int tid = tid_l, wid = __builtin_amdgcn_readfirstlane(tid >> 6), lane = tid & 63, wr = wid >> 2, wc = wid & 3, fr = lane & 15, fq = lane >> 4;
    const int nt = K / BK;
    unsigned voffA[2], voffB[2];
#pragma unroll
    for (int i = 0; i < 2; ++i) { int R, C; stage_rc(tid * 16 + i * 8192, R, C); const int Rb = Epi::PERM ? ((R & ~31) + perm32(R & 31)) : R;
        voffA[i] = (unsigned)(R * K + C) * 2u; voffB[i] = (unsigned)(Rb * K + C) * 2u; }
    const size_t kstep = (size_t)(BK * 2);
    const size_t hstep = (size_t)HALF * K * 2;
    const unsigned ldsw = (unsigned)wid * 1024u;
    const int aoff = lds_byte(wr * 64 + fr, fq * 8), boff = lds_byte(wc * 32 + fr, fq * 8);
#define PG8_SA(b, h) (((b) * 2 + (h)) * HTB)
#define PG8_SB(b, h) ((4 + (b) * 2 + (h)) * HTB)
#define PG8_STAGE(bufoff, gbase, voff) do { _Pragma("unroll") for (int _i = 0; _i < 2; ++_i) \
        __builtin_amdgcn_global_load_lds((const unsigned*)((const char*)(gbase) + (voff)[_i]), (PG8_LAS unsigned*)(lds + (bufoff) + ldsw + _i * 8192), 16, 0, 0); } while (0)
#define PG8_STA(bufoff, gbase, h) do { if constexpr (Sched::GATHER) PG8_STAGE(bufoff, gbase, gA[h]); else PG8_STAGE(bufoff, (gbase) + ((h) ? hstep : (size_t)0), voffA); } while (0)
#define PG8_LDA(dst, b, h) do { _Pragma("unroll") for (int m = 0; m < 4; ++m) _Pragma("unroll") for (int k = 0; k < 2; ++k) dst[m][k] = *(const PG8_LAS bf16x8*)(lds + PG8_SA(b, h) + aoff + m * 2048 + k * 1024); } while (0)
#define PG8_LDB(dst, b, h) do { _Pragma("unroll") for (int n = 0; n < 2; ++n) _Pragma("unroll") for (int k = 0; k < 2; ++k) dst[n][k] = *(const PG8_LAS bf16x8*)(lds + PG8_SB(b, h) + boff + n * 2048 + k * 1024); } while (0)
#define PG8_MMA(ai, bj, At, Bt) do { __builtin_amdgcn_s_setprio(1); _Pragma("unroll") for (int m = 0; m < 4; ++m) _Pragma("unroll") for (int n = 0; n < 2; ++n) _Pragma("unroll") for (int k = 0; k < 2; ++k) \
        acc[ai][bj][m][n] = __builtin_amdgcn_mfma_f32_16x16x32_bf16(Bt[n][k], At[m][k], acc[ai][bj][m][n], 0, 0, 0); __builtin_amdgcn_s_setprio(0); } while (0)
#define PG8_WAIT_V(n) asm volatile("s_waitcnt vmcnt(" #n ")" ::: "memory")
#define PG8_WAIT_L(n) asm volatile("s_waitcnt lgkmcnt(" #n ")" ::: "memory")
#define PG8_BAR __builtin_amdgcn_s_barrier()
#define PG8_SCHED __builtin_amdgcn_sched_barrier(0)
    Unit cur, nxt; int ui = 0;
    if (!S.next(0, cur)) return;
    static_assert(!Sched::GATHER || SP2, "gather needs the SP2 schedule");
    [[maybe_unused]] unsigned gA[2][2], gN[2][2];
#define PG8_ROWS(g, u) do { const PG8_GAS int* rt_ = S.row_tab() + (u).pm * 256; _Pragma("unroll") for (int _i = 0; _i < 2; ++_i) { int R_, C_; stage_rc(tid * 16 + _i * 8192, R_, C_); \
        g[0][_i] = (unsigned)rt_[R_] * (unsigned)(K * 2) + (unsigned)(C_ * 2); g[1][_i] = (unsigned)rt_[HALF + R_] * (unsigned)(K * 2) + (unsigned)(C_ * 2); } } while (0)
    if constexpr (Sched::GATHER) PG8_ROWS(gA, cur);
    f32x4 acc[2][2][4][2];
#pragma unroll
    for (int a = 0; a < 2; ++a)
#pragma unroll
        for (int b = 0; b < 2; ++b)
#pragma unroll
            for (int m = 0; m < 4; ++m)
#pragma unroll
                for (int n = 0; n < 2; ++n) acc[a][b][m][n] = (f32x4){0.f, 0.f, 0.f, 0.f};
    bf16x8 At[4][2], B0[2][2], B1[2][2];
    const char* cA = S.a_base(cur); const char* cB = S.b_base(cur);
    S.a_ready(cur);
    if constexpr (SP2) {
        PG8_STAGE(PG8_SB(0, 0), cB, voffB); PG8_STAGE(PG8_SB(0, 1), cB + hstep, voffB); PG8_STA(PG8_SA(0, 0), cA, 0); PG8_STA(PG8_SA(0, 1), cA, 1);
        if (wr == 1) PG8_BAR;
        PG8_WAIT_V(2); PG8_BAR;
        PG8_STAGE(PG8_SB(1, 0), cB + kstep, voffB); PG8_STA(PG8_SA(1, 0), cA + kstep, 0); PG8_STAGE(PG8_SB(1, 1), cB + hstep + kstep, voffB);
        PG8_WAIT_V(6); PG8_BAR;
    } else {
        PG8_STAGE(PG8_SB(0, 0), cB, voffB); PG8_STAGE(PG8_SA(0, 0), cA, voffA); PG8_STAGE(PG8_SB(0, 1), cB + hstep, voffB); PG8_STAGE(PG8_SA(0, 1), cA + hstep, voffA);
        if (wr == 1) PG8_BAR;
        PG8_WAIT_V(4); PG8_BAR;
        PG8_STAGE(PG8_SB(1, 0), cB + kstep, voffB); PG8_STAGE(PG8_SA(1, 0), cA + kstep, voffA); PG8_STAGE(PG8_SB(1, 1), cB + hstep + kstep, voffB);
        PG8_WAIT_V(6); PG8_BAR;
    }
    for (;;) {
        const bool has_next = S.next(ui + 1, nxt);
        const char* nA = has_next ? S.a_base(nxt) : cA; const char* nB = has_next ? S.b_base(nxt) : cB;
        if constexpr (Sched::GATHER) { if (has_next) PG8_ROWS(gN, nxt); }
        for (int t = 0; t < nt; t += 2) {
            const bool last = (t == nt - 2);
            const char* a1 = cA + (size_t)(t + 1) * kstep;
            const char* a2 = last ? nA : cA + (size_t)(t + 2) * kstep; const char* b2 = last ? nB : cB + (size_t)(t + 2) * kstep;
            const char* a3 = a2 + kstep; const char* b3 = b2 + kstep;
            if (last && has_next) S.a_ready(nxt);
            if constexpr (SP2) {
            PG8_LDB(B0, 0, 0); PG8_LDB(B1, 0, 1); PG8_SCHED; PG8_LDA(At, 0, 0); PG8_STA(PG8_SA(1, 1), a1, 1);
            if constexpr (Sched::GATHER) { if (last && has_next) { _Pragma("unroll") for (int h_ = 0; h_ < 2; ++h_) _Pragma("unroll") for (int i_ = 0; i_ < 2; ++i_) gA[h_][i_] = gN[h_][i_]; } }
            PG8_WAIT_V(8); PG8_WAIT_L(0); PG8_BAR; PG8_MMA(0, 0, At, B0); PG8_MMA(0, 1, At, B1); PG8_BAR; PG8_SCHED;
            PG8_LDA(At, 0, 1); PG8_STAGE(PG8_SB(0, 0), b2, voffB); PG8_STAGE(PG8_SB(0, 1), b2 + hstep, voffB); PG8_STA(PG8_SA(0, 0), a2, 0);
            PG8_WAIT_V(8); PG8_WAIT_L(0); PG8_BAR; PG8_MMA(1, 0, At, B0); PG8_MMA(1, 1, At, B1); PG8_BAR; PG8_SCHED;
            PG8_LDB(B0, 1, 0); PG8_LDB(B1, 1, 1); PG8_SCHED; PG8_LDA(At, 1, 0); PG8_STA(PG8_SA(0, 1), a2, 1);
            PG8_WAIT_V(8); PG8_WAIT_L(0); PG8_BAR; PG8_MMA(0, 0, At, B0); PG8_MMA(0, 1, At, B1); PG8_BAR; PG8_SCHED;
            PG8_LDA(At, 1, 1); PG8_STAGE(PG8_SB(1, 0), b3, voffB); PG8_STAGE(PG8_SB(1, 1), b3 + hstep, voffB); PG8_STA(PG8_SA(1, 0), a3, 0);
            PG8_WAIT_V(8); PG8_WAIT_L(0); PG8_BAR; PG8_MMA(1, 0, At, B0); PG8_MMA(1, 1, At, B1); PG8_BAR; PG8_SCHED;
            } else {
            PG8_LDB(B0, 0, 0); PG8_SCHED; PG8_LDA(At, 0, 0); PG8_STAGE(PG8_SA(1, 1), a1 + hstep, voffA);
            PG8_WAIT_L(8); PG8_BAR; PG8_WAIT_L(0); PG8_MMA(0, 0, At, B0); PG8_BAR; PG8_SCHED;
            PG8_LDB(B1, 0, 1); PG8_STAGE(PG8_SB(0, 0), b2, voffB);
            PG8_BAR; PG8_WAIT_L(0); PG8_MMA(0, 1, At, B1); PG8_BAR;
            PG8_LDA(At, 0, 1); PG8_STAGE(PG8_SA(0, 0), a2, voffA);
            PG8_BAR; PG8_WAIT_L(0); PG8_MMA(1, 0, At, B0); PG8_BAR; PG8_SCHED;
            PG8_STAGE(PG8_SB(0, 1), b2 + hstep, voffB);
            PG8_WAIT_V(6); PG8_BAR; PG8_MMA(1, 1, At, B1); PG8_BAR;
            PG8_LDB(B0, 1, 0); PG8_SCHED; PG8_LDA(At, 1, 0); PG8_STAGE(PG8_SA(0, 1), a2 + hstep, voffA);
            PG8_WAIT_L(8); PG8_BAR; PG8_WAIT_L(0); PG8_MMA(0, 0, At, B0); PG8_BAR; PG8_SCHED;
            PG8_LDB(B1, 1, 1); PG8_STAGE(PG8_SB(1, 0), b3, voffB);
            PG8_BAR; PG8_WAIT_L(0); PG8_MMA(0, 1, At, B1); PG8_BAR;
            PG8_LDA(At, 1, 1); PG8_STAGE(PG8_SA(1, 0), a3, voffA);
            PG8_BAR; PG8_WAIT_L(0); PG8_MMA(1, 0, At, B0); PG8_BAR; PG8_SCHED;
            PG8_STAGE(PG8_SB(1, 1), b3 + hstep, voffB);
            PG8_WAIT_V(6); PG8_BAR; PG8_MMA(1, 1, At, B1); PG8_BAR;
            }
        }
        if constexpr (ALIGN_EPI) { if (wr == 0) PG8_BAR; }
        if constexpr (!Epi::AFTER_DRAIN) { E(acc, cur, wr, wc, fr, fq); S.done(cur); }
        if (!has_next) break;
        if (!(Epi::CARRY && cur.part == 0)) {
#pragma unroll
        for (int a = 0; a < 2; ++a)
#pragma unroll
            for (int b = 0; b < 2; ++b)
#pragma unroll
                for (int m = 0; m < 4; ++m)
#pragma unroll
                    for (int n = 0; n < 2; ++n) acc[a][b][m][n] = (f32x4){0.f, 0.f, 0.f, 0.f}; }
        cur = nxt; cA = nA; cB = nB; ++ui;
        if constexpr (ALIGN_EPI) { if (wr == 1) PG8_BAR; }
    }
    PG8_WAIT_V(0);
    if constexpr (!ALIGN_EPI) { if (wr == 0) PG8_BAR; }
    PG8_BAR;
    if constexpr (Epi::AFTER_DRAIN) { E.fused(acc, cur, wr, wc, fr, fq, lds, wid, lane); S.done(cur); }
#undef PG8_SA
#undef PG8_SB
#undef PG8_STAGE
#undef PG8_STA
#undef PG8_ROWS
#undef PG8_LDA
#undef PG8_LDB
#undef PG8_MMA
#undef PG8_WAIT_V
#undef PG8_WAIT_L
#undef PG8_BAR
#undef PG8_SCHED
}
}

#include <hip/hip_bf16.h>
#include <cmath>
namespace attn_body {
using bf16=__hip_bfloat16;
using bf16x8=__attribute__((ext_vector_type(8)))short;
using s16x4=__attribute__((ext_vector_type(4)))short;
using f32x16=__attribute__((ext_vector_type(16)))float;
using u32x4=__attribute__((ext_vector_type(4)))unsigned;
constexpr int D=64,QP=512,KP=128;
constexpr int NW=8,QBLK=32,QB=QBLK*NW,KVBLK=64;
constexpr int ATTN_UNIT_ROWS=QB;
__device__ __forceinline__ int crow(int r,int hi){return (r&3)+8*(r>>2)+4*hi;}
#define SBAR() __builtin_amdgcn_sched_barrier(0)
__device__ __forceinline__ void cmask(f32x16&p0,f32x16&p1,int jb,int qrel,int hi){
  const float NEG=-INFINITY; int kb=64*jb+4*hi;
  #pragma unroll
  for(int r=0;r<16;++r){int kv=kb+(r&3)+8*(r>>2); if(kv>qrel)p0[r]=NEG; if(kv+32>qrel)p1[r]=NEG;}
}

constexpr int NSLOT=3, SLOTB=8192;
constexpr int LDS_K=0, LDS_V=NSLOT*SLOTB, LDS_WS=2*NSLOT*SLOTB, LDS_OST=LDS_WS+NW*64*4, LDS_BYTES=LDS_OST+NW*4096;
constexpr float C2=0.125f*1.4426950408889634f;
__device__ __forceinline__ void glds16(const void*gsrc,unsigned lds_dst){unsigned keep;
  asm volatile("s_mov_b32 %0, m0\n\ts_mov_b32 m0, %2\n\ts_nop 0\n\tglobal_load_lds_dwordx4 %1, off\n\ts_mov_b32 m0, %0":"=&s"(keep):"v"(gsrc),"s"(lds_dst):"memory");}
__device__ __forceinline__ float max3f(float a,float b,float c){float r;asm("v_max3_f32 %0, %1, %2, %3":"=v"(r):"v"(a),"v"(b),"v"(c));return r;}
__device__ __forceinline__ float max2f(float a,float b){float r;asm("v_max_f32_e32 %0, %1, %2":"=v"(r):"v"(a),"v"(b));return r;}
__device__ __forceinline__ float fadd_s(float a,float b){float r;asm("v_add_f32_e32 %0, %1, %2":"=v"(r):"v"(a),"v"(b));return r;}
__device__ __forceinline__ float fsub_s(float a,float b){float r;asm("v_sub_f32_e32 %0, %1, %2":"=v"(r):"v"(a),"v"(b));return r;}
typedef float f32x2_t __attribute__((ext_vector_type(2))); typedef __bf16 bf16x2_t __attribute__((ext_vector_type(2)));
__device__ __forceinline__ unsigned cvtpk_s(float lo,float hi){f32x2_t v={lo,hi};bf16x2_t b=__builtin_convertvector(v,bf16x2_t);return __builtin_bit_cast(unsigned,b);}
#define WAIT_BAR(N) asm volatile("s_waitcnt vmcnt(" #N ") lgkmcnt(0)\n\ts_barrier":::"memory")

__device__ __forceinline__ void qkt(f32x16&p0,f32x16&p1,const char*Kslot,const bf16x8*qr,const f32x16&negm,int r32,int hi){
  const char*kb=Kslot+hi*1024+r32*16;
  #pragma unroll
  for(int d0=0;d0<4;++d0){
    const bf16x8 b0=*reinterpret_cast<const bf16x8*>(kb+d0*2048);
    const bf16x8 b1=*reinterpret_cast<const bf16x8*>(kb+d0*2048+512);
    if(d0==0){p0=__builtin_amdgcn_mfma_f32_32x32x16_bf16(b0,qr[0],negm,0,0,0);p1=__builtin_amdgcn_mfma_f32_32x32x16_bf16(b1,qr[0],negm,0,0,0);}
    else{p0=__builtin_amdgcn_mfma_f32_32x32x16_bf16(b0,qr[d0],p0,0,0,0);p1=__builtin_amdgcn_mfma_f32_32x32x16_bf16(b1,qr[d0],p1,0,0,0);}}
}
typedef __attribute__((address_space(3))) const char* lds_cptr;
typedef short v4i16_t __attribute__((ext_vector_type(4)));
__device__ __forceinline__ void kload8(bf16x8*kf,lds_cptr kp){
  kf[0]=*(const __attribute__((address_space(3))) bf16x8*)(kp);      kf[1]=*(const __attribute__((address_space(3))) bf16x8*)(kp+512);
  kf[2]=*(const __attribute__((address_space(3))) bf16x8*)(kp+2048); kf[3]=*(const __attribute__((address_space(3))) bf16x8*)(kp+2560);
  kf[4]=*(const __attribute__((address_space(3))) bf16x8*)(kp+4096); kf[5]=*(const __attribute__((address_space(3))) bf16x8*)(kp+4608);
  kf[6]=*(const __attribute__((address_space(3))) bf16x8*)(kp+6144); kf[7]=*(const __attribute__((address_space(3))) bf16x8*)(kp+6656);
}
__device__ __forceinline__ void kload2(bf16x8*kf,lds_cptr kp,int j){ kf[2*j]=*(const __attribute__((address_space(3))) bf16x8*)(kp+j*2048); kf[2*j+1]=*(const __attribute__((address_space(3))) bf16x8*)(kp+j*2048+512); }
__device__ __forceinline__ s16x4 vtr(lds_cptr p){ return __builtin_bit_cast(s16x4,__builtin_amdgcn_ds_read_tr16_b64_v4i16((__attribute__((address_space(3))) v4i16_t*)p)); }
__device__ __forceinline__ float rowmax(const f32x16&p0,const f32x16&p1){
  float a=max3f(p0[0],p0[1],p1[0]),b=max3f(p0[2],p0[3],p1[1]);a=max3f(a,p1[2],p1[3]);
  #pragma unroll
  for(int r=4;r<16;r+=4){a=max3f(a,p0[r],p0[r+1]);b=max3f(b,p0[r+2],p0[r+3]);a=max3f(a,p1[r],p1[r+1]);b=max3f(b,p1[r+2],p1[r+3]);}
  const float m=max2f(a,b);
  auto rr=__builtin_amdgcn_permlane32_swap(__float_as_uint(m),__float_as_uint(m),false,false);
  return max2f(__uint_as_float(rr[0]),__uint_as_float(rr[1]));
}
__device__ __forceinline__ void pv(f32x16*o,int vb,bf16x8 pa0,bf16x8 pa1,bf16x8 pa2,bf16x8 pa3){
  #pragma unroll
  for(int d0=0;d0<2;++d0){s16x4 lo[4],hi[4];
    #pragma unroll
    for(int ks=0;ks<4;++ks){
      asm volatile("ds_read_b64_tr_b16 %0,%1 offset:%c2":"=&v"(lo[ks]):"v"(vb),"i"(d0*4096+ks*1024):"memory");
      asm volatile("ds_read_b64_tr_b16 %0,%1 offset:%c2":"=&v"(hi[ks]):"v"(vb),"i"(d0*4096+ks*1024+512):"memory");}
    asm volatile("s_waitcnt lgkmcnt(0)":::"memory");SBAR();
    #define PK(k) (bf16x8){lo[k][0],lo[k][1],lo[k][2],lo[k][3],hi[k][0],hi[k][1],hi[k][2],hi[k][3]}
    o[d0]=__builtin_amdgcn_mfma_f32_32x32x16_bf16(pa0,PK(0),o[d0],0,0,0);
    o[d0]=__builtin_amdgcn_mfma_f32_32x32x16_bf16(pa1,PK(1),o[d0],0,0,0);
    o[d0]=__builtin_amdgcn_mfma_f32_32x32x16_bf16(pa2,PK(2),o[d0],0,0,0);
    o[d0]=__builtin_amdgcn_mfma_f32_32x32x16_bf16(pa3,PK(3),o[d0],0,0,0);
    #undef PK
  }
}

#ifndef ATTN_STORE16
#define ATTN_STORE16(p,v) (*(u32x4*)(p)=(v))
#endif
template<int THRL> __device__ __forceinline__ void attn_unit(const bf16*Qu,const bf16*__restrict__ Kh,const bf16*__restrict__ Vh,bf16*Ou,const int NT,char*shm,const int tid_in){
  int tid_l=tid_in; asm volatile("":"+v"(tid_l));
  const int tid=tid_l,lane=tid&63,r32=lane&31,hi=lane>>5; const int wid=__builtin_amdgcn_readfirstlane(tid>>6);
  const bf16*Qw=Qu+(long)(wid*QBLK)*QP;
  const unsigned lds0=(unsigned)(uintptr_t)shm;
  float*wsf=(float*)(shm+LDS_WS)+wid*64;
  const bf16*ksrc=Kh+(long)lane*KP+wid*8;
  const bf16*vsrc=Vh+(long)(16*(wid&3)+(lane>>2))*KP+(wid>>2)*32+(lane&3)*8;
  const unsigned kdst=lds0+LDS_K+wid*1024, vdst=lds0+LDS_V+wid*1024;
  #define DMA_K(t,slot) glds16(ksrc+(long)(t)*KVBLK*KP,(unsigned)__builtin_amdgcn_readfirstlane(kdst+(slot)))
  #define DMA_V(t,slot) glds16(vsrc+(long)(t)*KVBLK*KP,(unsigned)__builtin_amdgcn_readfirstlane(vdst+(slot)))
  const int vb0=(int)(lds0+LDS_V)+((lane>>4)&1)*32+(lane&3)*8+(4*hi+((lane&15)>>2))*64;
  const char*Kbase=shm+LDS_K; bf16x8 kf[8];
  const lds_cptr shm3=(lds_cptr)shm; const lds_cptr kp0=shm3+LDS_K+hi*1024+r32*16; const lds_cptr vp0=shm3+LDS_V+((lane>>4)&1)*32+(lane&3)*8+(4*hi+((lane&15)>>2))*64;
  DMA_K(0,0);DMA_V(0,0);DMA_K(1,SLOTB);
  bf16x8 qr[4];
  #pragma unroll
  for(int d0=0;d0<4;++d0)qr[d0]=*reinterpret_cast<const bf16x8*>(&Qw[(long)r32*QP+d0*16+hi*8]);
  float mhat=0.f,l_reg=0.f;f32x16 o[2];o[0]=f32x16{};o[1]=f32x16{};f32x16 negm=f32x16{};asm volatile("":"+v"(negm));
  #define CMASK(P0,P1,t) do{}while(0)
  bool resc=false;
  #define START(P0,P1) do{ const float rm=rowmax(P0,P1); resc=false; \
    { const float dl=rm; mhat=fadd_s(mhat,dl); \
      _Pragma("unroll") for(int r=0;r<16;++r){P0[r]=fsub_s(P0[r],dl);P1[r]=fsub_s(P1[r],dl);} \
      _Pragma("unroll") for(int r=0;r<16;++r)negm[r]=-mhat; asm volatile("":"+v"(negm)); } \
    _Pragma("unroll") for(int r=0;r<16;++r)P0[r]=__builtin_amdgcn_exp2f(P0[r]); }while(0)
  #define RESC() do{ if(resc){ asm volatile("s_waitcnt lgkmcnt(0)":::"memory"); \
      _Pragma("unroll") for(int d_=0;d_<2;++d_) _Pragma("unroll") for(int r=0;r<16;++r)o[d_][r]*=wsf[crow(r,hi)]; } }while(0)
  f32x16 pA0,pA1,pB0,pB1;
  int sl_prev=0,sl_cur=0,sl_next=SLOTB;
  #define ROT() do{sl_prev=sl_cur;sl_cur=sl_next;sl_next=(sl_next==(NSLOT-1)*SLOTB)?0:sl_next+SLOTB;}while(0)
  DMA_K(2,2*SLOTB);
  WAIT_BAR(3);
  qkt(pA0,pA1,Kbase,qr,negm,r32,hi);asm volatile("s_nop 15\n\ts_nop 7":"+v"(pA0),"+v"(pA1));CMASK(pA0,pA1,0);
  START(pA0,pA1);
  _Pragma("unroll") for(int r=0;r<16;++r)pA1[r]=__builtin_amdgcn_exp2f(pA1[r]);
  WAIT_BAR(0);
  DMA_K(3,0);DMA_V(1,SLOTB);
  ROT();
  kload8(kf,kp0+sl_cur);
  WAIT_BAR(2);
  s16x4 vlo[8],vhi[8]; u32x4 pw0,pw1,pw2,pw3;
  #define PKW(P,B) cvtpk_s(P[B],P[B+1])
  #define PAF(k) __builtin_bit_cast(bf16x8,pw##k)
  #define VFR(i) (bf16x8){vlo[i][0],vlo[i][1],vlo[i][2],vlo[i][3],vhi[i][0],vhi[i][1],vhi[i][2],vhi[i][3]}
  #define PIN(x) asm volatile("":"+v"(x))
  #define MX3(a,b,c) __builtin_fmaxf(__builtin_fmaxf((a),(b)),(c))
  #define GAPA(MF,A0,A1,A2,A3,W0,W1,PW) do{ MF; sacc+=A0; sacc+=A1; sacc+=A2; sacc+=A3; PIN(sacc); W0; W1; PIN(PW); SBAR(); }while(0)
  #define EX(v) __builtin_amdgcn_exp2f(v)
  #define GAPB(MF,X,B) do{ MF; X[B]=EX(X[B]); X[B+1]=EX(X[B+1]); X[B+2]=EX(X[B+2]); X[B+3]=EX(X[B+3]); PIN(X); SBAR(); }while(0)
  #define VRD(i) do{ vlo[i]=vtr(vp_+(((i)>>2)*4096+((i)&3)*1024)); vhi[i]=vtr(vp_+(((i)>>2)*4096+((i)&3)*1024+512)); }while(0)
  #define KRD(G,j) do{ if(G){ kload2(kf,kp0+sl_next,j); SBAR(); } }while(0)
  #define STEP(C0,C1,P0,P1,t,GK,GV,GL) do{ SBAR(); \
    const lds_cptr vp_=vp0+sl_prev; \
    VRD(0); SBAR(); float sacc=(P0[0]+P0[1]); \
    GAPA(C0=__builtin_amdgcn_mfma_f32_32x32x16_bf16(kf[0],qr[0],negm,0,0,0), P0[2],P0[3],P0[4],P0[5],     pw0[0]=PKW(P0,0), pw0[1]=PKW(P0,2), pw0); \
    VRD(4); SBAR(); GAPA(C1=__builtin_amdgcn_mfma_f32_32x32x16_bf16(kf[1],qr[0],negm,0,0,0), P0[6],P0[7],P0[8],P0[9],     pw0[2]=PKW(P0,4), pw0[3]=PKW(P0,6), pw0); \
    VRD(1); SBAR(); GAPA(C0=__builtin_amdgcn_mfma_f32_32x32x16_bf16(kf[2],qr[1],C0,0,0,0),   P0[10],P0[11],P0[12],P0[13], pw1[0]=PKW(P0,8), pw1[1]=PKW(P0,10), pw1); \
    VRD(5); SBAR(); GAPA(C1=__builtin_amdgcn_mfma_f32_32x32x16_bf16(kf[3],qr[1],C1,0,0,0),   P0[14],P0[15],P1[0],P1[1],   pw1[2]=PKW(P0,12),pw1[3]=PKW(P0,14), pw1); \
    VRD(2); SBAR(); GAPA(C0=__builtin_amdgcn_mfma_f32_32x32x16_bf16(kf[4],qr[2],C0,0,0,0),   P1[2],P1[3],P1[4],P1[5],     pw2[0]=PKW(P1,0), pw2[1]=PKW(P1,2), pw2); \
    VRD(6); SBAR(); GAPA(C1=__builtin_amdgcn_mfma_f32_32x32x16_bf16(kf[5],qr[2],C1,0,0,0),   P1[6],P1[7],P1[8],P1[9],     pw2[2]=PKW(P1,4), pw2[3]=PKW(P1,6), pw2); \
    VRD(3); SBAR(); GAPA(C0=__builtin_amdgcn_mfma_f32_32x32x16_bf16(kf[6],qr[3],C0,0,0,0),   P1[10],P1[11],P1[12],P1[13], pw3[0]=PKW(P1,8), pw3[1]=PKW(P1,10), pw3); \
    VRD(7); SBAR(); GAPA(C1=__builtin_amdgcn_mfma_f32_32x32x16_bf16(kf[7],qr[3],C1,0,0,0),   P1[14],P1[15],0.f,0.f,       pw3[2]=PKW(P1,12),pw3[3]=PKW(P1,14), pw3); \
    l_reg+=sacc; \
    if(GK){DMA_K((t)+3,sl_cur);} if(GV){DMA_V((t)+1,sl_next);} \
    CMASK(C0,C1,t); \
    { float a=MX3(C0[0],C0[1],C1[0]),b=MX3(C0[2],C0[3],C1[1]); a=MX3(a,C1[2],C1[3]); \
      _Pragma("unroll") for(int r=4;r<16;r+=4){a=MX3(a,C0[r],C0[r+1]);b=MX3(b,C0[r+2],C0[r+3]);a=MX3(a,C1[r],C1[r+1]);b=MX3(b,C1[r+2],C1[r+3]);} \
      float rm=__builtin_fmaxf(a,b); { auto rr=__builtin_amdgcn_permlane32_swap(__float_as_uint(rm),__float_as_uint(rm),false,false); rm=__builtin_fmaxf(__uint_as_float(rr[0]),__uint_as_float(rr[1])); } \
      resc=false; \
      if(__builtin_expect(__any(rm>(float)THRL),0)){ const float dl=__builtin_fmaxf(rm,0.f); mhat+=dl; \
        _Pragma("unroll") for(int r=0;r<16;++r){C0[r]-=dl;C1[r]-=dl;} \
        _Pragma("unroll") for(int r=0;r<16;++r)negm[r]=-mhat; asm volatile("":"+v"(negm)); \
        const float f=__builtin_amdgcn_exp2f(-dl); l_reg*=f; if(hi==0)wsf[r32]=f; resc=true; } } \
    SBAR(); \
    GAPB(o[0]=__builtin_amdgcn_mfma_f32_32x32x16_bf16(PAF(0),VFR(0),o[0],0,0,0), C0,0); \
    GAPB(o[1]=__builtin_amdgcn_mfma_f32_32x32x16_bf16(PAF(0),VFR(4),o[1],0,0,0), C0,4); \
    KRD(GL,0); GAPB(o[0]=__builtin_amdgcn_mfma_f32_32x32x16_bf16(PAF(1),VFR(1),o[0],0,0,0), C0,8); \
    KRD(GL,1); GAPB(o[1]=__builtin_amdgcn_mfma_f32_32x32x16_bf16(PAF(1),VFR(5),o[1],0,0,0), C0,12); \
    KRD(GL,2); GAPB(o[0]=__builtin_amdgcn_mfma_f32_32x32x16_bf16(PAF(2),VFR(2),o[0],0,0,0), C1,0); \
    KRD(GL,3); GAPB(o[1]=__builtin_amdgcn_mfma_f32_32x32x16_bf16(PAF(2),VFR(6),o[1],0,0,0), C1,4); \
    GAPB(o[0]=__builtin_amdgcn_mfma_f32_32x32x16_bf16(PAF(3),VFR(3),o[0],0,0,0), C1,8); \
    GAPB(o[1]=__builtin_amdgcn_mfma_f32_32x32x16_bf16(PAF(3),VFR(7),o[1],0,0,0), C1,12); \
    }while(0)
  int t=1;
  for(;t+5<NT;t+=2){
    STEP(pB0,pB1,pA0,pA1,t,true,true,true);     WAIT_BAR(2); RESC(); ROT();
    STEP(pA0,pA1,pB0,pB1,t+1,true,true,true);   WAIT_BAR(2); RESC(); ROT();
  }
  #define ENDW(tt) do{ if((tt)+3<NT){WAIT_BAR(2);} else if((tt)+2<NT){WAIT_BAR(1);} else {WAIT_BAR(0);} }while(0)
  for(;t+1<NT;t+=2){
    STEP(pB0,pB1,pA0,pA1,t,(t+3<NT),(t+1<NT),(t+1<NT));       ENDW(t);   RESC(); ROT();
    STEP(pA0,pA1,pB0,pB1,t+1,(t+4<NT),(t+2<NT),(t+2<NT));     ENDW(t+1); RESC(); ROT();
  }
  STEP(pB0,pB1,pA0,pA1,NT-1,false,false,false); RESC();
  { float sacc=pB0[0]+pB0[1]; _Pragma("unroll") for(int r=2;r<16;++r)sacc+=pB0[r]; _Pragma("unroll") for(int r=0;r<16;++r)sacc+=pB1[r]; l_reg+=sacc;
    pw0=(u32x4){PKW(pB0,0),PKW(pB0,2),PKW(pB0,4),PKW(pB0,6)};pw1=(u32x4){PKW(pB0,8),PKW(pB0,10),PKW(pB0,12),PKW(pB0,14)};pw2=(u32x4){PKW(pB1,0),PKW(pB1,2),PKW(pB1,4),PKW(pB1,6)};pw3=(u32x4){PKW(pB1,8),PKW(pB1,10),PKW(pB1,12),PKW(pB1,14)};
    SBAR(); pv(o,vb0+sl_cur,PAF(0),PAF(1),PAF(2),PAF(3)); }
  #undef PKW
  #undef PAF
  #undef VFR
  #undef PIN
  #undef MX3
  #undef GAPA
  #undef GAPB
  #undef EX
  #undef VRD
  #undef KRD
  #undef STEP
  #undef ENDW
  {auto rr=__builtin_amdgcn_permlane32_swap(__float_as_uint(l_reg),__float_as_uint(l_reg),false,false);l_reg=__uint_as_float(rr[0])+__uint_as_float(rr[1]);}
  if(hi==0)wsf[32+r32]=l_reg;asm volatile("s_waitcnt lgkmcnt(0)":::"memory");
  float rli[16];
  #pragma unroll
  for(int r=0;r<16;++r)rli[r]=__builtin_amdgcn_rcpf(wsf[32+crow(r,hi)]);
  bf16*Ow=Ou+(long)(wid*QBLK)*QP;
  { bf16*stg=(bf16*)(shm+LDS_OST)+wid*2048;
    #pragma unroll
    for(int r=0;r<16;++r){const int orow=crow(r,hi);
      #pragma unroll
      for(int d0=0;d0<2;++d0)stg[orow*64+d0*32+r32]=__float2bfloat16(o[d0][r]*rli[r]);}
    asm volatile("s_waitcnt lgkmcnt(0)":::"memory");
    #pragma unroll
    for(int i=0;i<4;++i){const int row=i*8+(lane>>3),ch=lane&7; const u32x4 v=*(const u32x4*)(stg+row*64+ch*8); ATTN_STORE16(Ow+(long)row*QP+ch*8,v);} }
  asm volatile("s_waitcnt lgkmcnt(0)\n\ts_barrier":::"memory");
  #undef DMA_K
  #undef DMA_V
  #undef CMASK
  #undef START
  #undef RESC
  #undef ROT
}
constexpr int ATTN_LDS_BYTES=LDS_BYTES;
#undef SBAR
#undef WAIT_BAR
}

#define XB_TMO      128
#define XB_XCNT(j)  (256  + 64 * (j))
#define XB_XSUB(j)  (1280 + 64 * (j))
#define XB_XGEN(j)  (2304 + 64 * (j))
#define XB_TOP      3328
#define XB_TOPGEN   3392
#define XCD_BAR_WORDS 3456
#define XB_SPIN_CAP (1u << 18)

__device__ __forceinline__ unsigned xb_ld(unsigned* p)              { return __hip_atomic_load(p, __ATOMIC_RELAXED, __HIP_MEMORY_SCOPE_AGENT); }
__device__ __forceinline__ unsigned xb_add(unsigned* p, unsigned v) { return __hip_atomic_fetch_add(p, v, __ATOMIC_RELAXED, __HIP_MEMORY_SCOPE_AGENT); }
__device__ __forceinline__ unsigned xb_xcc_id() { return (unsigned)__builtin_amdgcn_s_getreg((3 << 11) | 20) & 0xFu; }
#define XB_SPIN(cond, bar) do { unsigned _sp = 0; while (cond) { __builtin_amdgcn_s_sleep(1); \
    if ((++_sp & 255u) == 0u) { if (xb_ld(&(bar)[XB_TMO])) break; if (_sp > XB_SPIN_CAP) { atomicAdd(&(bar)[XB_TMO], 1u); break; } } } } while (0)

struct XcdBarrier {
    unsigned* bar; unsigned x;
    volatile LAS unsigned* st;
};

__device__ __forceinline__ XcdBarrier xcd_barrier_post(unsigned* bar, volatile LAS unsigned* st) {
    XcdBarrier b; b.bar = bar; b.x = xb_xcc_id(); b.st = st;
    if (threadIdx.x == 0) (void)xb_add(&bar[XB_XCNT(b.x)], 1u);
    return b;
}
__device__ __forceinline__ void xcd_barrier_complete(unsigned* bar, unsigned x, unsigned& nloc, unsigned& nx) {
    const unsigned G = gridDim.x * gridDim.y * gridDim.z;
    unsigned sum, cnt, mine, sp = 0u;
    for (;;) {
        sum = 0u; cnt = 0u; mine = 0u;
#pragma unroll
        for (unsigned j = 0; j < 16; ++j) { const unsigned c = xb_ld(&bar[XB_XCNT(j)]); sum += c; cnt += (c > 0u) ? 1u : 0u; mine = (j == x) ? c : mine; }
        if (sum == G) break;
        __builtin_amdgcn_s_sleep(1);
        if ((++sp & 255u) == 0u) { if (xb_ld(&bar[XB_TMO])) break; if (sp > XB_SPIN_CAP) { atomicAdd(&bar[XB_TMO], 1u); break; } }
    }
    nloc = mine > 0u ? mine : 1u; nx = cnt > 0u ? cnt : 1u;
}

__device__ __forceinline__ void xcd_barrier(const XcdBarrier& b, const int tid_in) {
    asm volatile("s_waitcnt vmcnt(0)" ::: "memory");
    __syncthreads();
    if (tid_in == 0) {
        unsigned* bar = b.bar;
        __builtin_amdgcn_s_waitcnt(0);
        unsigned nloc = b.st[0], nx = b.st[1];
        if (nloc == 0u) { xcd_barrier_complete(bar, b.x, nloc, nx); b.st[0] = nloc; b.st[1] = nx; }
        const unsigned old = xb_add(&bar[XB_XSUB(b.x)], 1u);
        const unsigned gen = old / nloc;
        if (old + 1u == (gen + 1u) * nloc) {
            __builtin_amdgcn_fence(__ATOMIC_RELEASE, "agent");
            asm volatile("s_waitcnt vmcnt(0)" ::: "memory");
            const unsigned og = xb_add(&bar[XB_TOP], 1u);
            const unsigned tg = og / nx;
            if (og + 1u == (tg + 1u) * nx) xb_add(&bar[XB_TOPGEN], 1u);
            else XB_SPIN(xb_ld(&bar[XB_TOPGEN]) == tg, bar);
            __builtin_amdgcn_fence(__ATOMIC_ACQUIRE, "agent");
            xb_add(&bar[XB_XGEN(b.x)], 1u);
            asm volatile("s_waitcnt vmcnt(0)" ::: "memory");
        } else {
            XB_SPIN(xb_ld(&bar[XB_XGEN(b.x)]) == gen, bar);
            __builtin_amdgcn_fence(__ATOMIC_ACQUIRE, "agent");
            asm volatile("s_waitcnt vmcnt(0)" ::: "memory");
        }
    }
    __syncthreads();
}

struct Args { const GAS float* in[33]; GAS float* out; unsigned char* ws; int mode, l, site, chunk; };
struct Frame {
    LAS unsigned char* lds; volatile LAS unsigned* MISC; gu32* ctl;
    int tid, lane, wave, vcu, G;
    unsigned char* ws; GAS float* out;
};
#define WSP(T, off) ((GAS T*)(F.ws + (off)))
#define WSGEN(T, off) ((T*)(F.ws + (off)))
__device__ __forceinline__ const GAS float* inptr(LAS unsigned char* lds, int i) { const LAS unsigned* p = (const LAS unsigned*)(lds + PTAB_OFF) + 2 * i; const unsigned lo = __builtin_amdgcn_readfirstlane(p[0]), hi = __builtin_amdgcn_readfirstlane(p[1]); return (const GAS float*)(((unsigned long long)hi << 32) | lo); }
#define INP(i) inptr(F.lds, (i))

__device__ __forceinline__ void conv_item(const GAS float* W, int Nsrc, int k0, int c0, GAS bf16* WT, int K, int drow0, LAS float* scr, int lane) {
#pragma unroll
    for (int i = 0; i < 8; ++i) { const int kk = 8 * i + (lane >> 3), nn = 4 * (lane & 7); const f32x4 v = *(const GAS f32x4*)(W + (size_t)(k0 + kk) * Nsrc + c0 + nn);
        scr[kk * 33 + nn] = v.x; scr[kk * 33 + nn + 1] = v.y; scr[kk * 33 + nn + 2] = v.z; scr[kk * 33 + nn + 3] = v.w; }
    LDS_WAIT(); asm volatile("" ::: "memory");
    const int c = lane & 7;
#pragma unroll
    for (int j = 0; j < 4; ++j) { const int n = (lane >> 3) + 8 * j; const LAS float* s = scr + (8 * c) * 33 + n;
        v4u o; o.x = pk2(s[0 * 33], s[1 * 33]); o.y = pk2(s[2 * 33], s[3 * 33]); o.z = pk2(s[4 * 33], s[5 * 33]); o.w = pk2(s[6 * 33], s[7 * 33]);
        *(GAS v4u*)(WT + (size_t)(drow0 + n) * K + k0 + 8 * c) = o; }
    LDS_WAIT(); asm volatile("" ::: "memory");
}
__device__ __forceinline__ void conv_plain(int item, const GAS float* W, int K, int N, GAS bf16* WT, LAS float* scr, int lane) {
    const int ng = N / 32, kb = item / ng, g = item % ng; conv_item(W, N, 64 * kb, 32 * g, WT, K, 32 * g, scr, lane);
}
__device__ __forceinline__ void conv_gu(int item, const GAS float* W, GAS bf16* WT, int off, LAS float* scr, int lane) {
    const int ng = FF / 32, kb = item / ng, g = item % ng; conv_item(W, FF, 64 * kb, 32 * g, WT, DM, 256 * (g >> 2) + off + 32 * (g & 3), scr, lane);
}
__device__ __forceinline__ void mod_task(Frame& F, int task) {
    const int l = task / 96, nb = task % 96;
    LAS float* S = (LAS float*)F.lds;
    for (int i = F.tid; i < 33 * 1024; i += 512) { const int bi = i >> 10, k = i & 1023; const float c = bi < 32 ? INP(1)[bi * 1024 + k] : INP(3)[k]; S[k * 33 + bi] = c / (1.0f + __expf(-c)); }
    __syncthreads();
    const GAS float* W = INP(4) + (size_t)l * DM * 6144 + nb * 64 + F.lane;
    float acc[33];
#pragma unroll
    for (int bi = 0; bi < 33; ++bi) acc[bi] = 0.f;
    const int k0 = F.wave * 128;
    for (int k = k0; k < k0 + 128; ++k) { const float w = W[(size_t)k * 6144];
#pragma unroll
        for (int bi = 0; bi < 33; ++bi) acc[bi] = fmaf(S[k * 33 + bi], w, acc[bi]); }
    __syncthreads();
    LAS float* P = (LAS float*)F.lds;
#pragma unroll
    for (int bi = 0; bi < 33; ++bi) P[(F.wave * 33 + bi) * 64 + F.lane] = acc[bi];
    __syncthreads();
    GAS float* mod = WSP(float, WS_MOD);
    for (int o = F.tid; o < 33 * 64; o += 512) { const int bi = o >> 6, cc = o & 63; float s = 0.f;
#pragma unroll
        for (int w = 0; w < 8; ++w) s += P[(w * 33 + bi) * 64 + cc];
        const int n = nb * 64 + cc; mod[(size_t)(l * 33 + bi) * 6144 + n] = s + INP(5)[l * 6144 + n]; }
    __syncthreads();
}
__device__ __forceinline__ void p0_prologue(Frame& F) {
    for (int t = F.vcu; t < 192; t += F.G) mod_task(F, t);
    if (F.vcu == F.G - 1) { GAS float* rt = WSP(float, WS_ROPE);
        for (int i = F.tid; i < 1024; i += 512) { const int pos = i >> 4, f = i & 15; const float inv = powf(10000.0f, -(float)f / 16.0f); const float a = (float)pos * inv; rt[i] = cosf(a); rt[1024 + i] = sinf(a); } }
    { GAS v4u* rz = (GAS v4u*)(F.ws + WS_MOETAB + MT_ROWT); for (int i = F.vcu * 512 + F.tid; i < MOE_ROWS / 4; i += F.G * 512) rz[i] = (v4u){0u, 0u, 0u, 0u}; }
    LAS float* scr = (LAS float*)(F.lds + F.wave * 8448);
    const int gw = F.vcu * NWAVES + F.wave, NGW = F.G * NWAVES;
    constexpr int I_IN = 16 * 144, I_P = 8 * 32, I_O = 16 * 32, I_GU = 16 * 112, I_DN = 56 * 32, I_L = 16, I_G2 = 32;
    constexpr int NITEMS = 2 * I_IN + 4 * I_P + 2 * I_O + 2 * I_GU + I_DN + 8 * I_L + 2 * I_G2;
    GAS bf16* lora = WSP(bf16, WS_LORA);
    for (int it = gw; it < NITEMS; it += NGW) {
        int r = it;
        if (r < 2 * I_IN) { const int l = r / I_IN; conv_plain(r % I_IN, INP(8) + (size_t)l * DM * NIN, DM, NIN, WSP(bf16, WS_WIN) + (size_t)l * NIN * DM, scr, F.lane); continue; } r -= 2 * I_IN;
        if (r < 2 * I_P) { const int l = r / I_P; conv_plain(r % I_P, INP(22) + (size_t)l * RW * DM, RW, DM, WSP(bf16, WS_WPA) + (size_t)l * DM * RW, scr, F.lane); continue; } r -= 2 * I_P;
        if (r < 2 * I_P) { const int l = r / I_P; conv_plain(r % I_P, INP(23) + (size_t)l * RW * DM, RW, DM, WSP(bf16, WS_WPB) + (size_t)l * DM * RW, scr, F.lane); continue; } r -= 2 * I_P;
        if (r < 2 * I_O) { const int l = r / I_O; conv_plain(r % I_O, INP(24) + (size_t)l * DM * DM, DM, DM, WSP(bf16, WS_WO) + (size_t)l * DM * DM, scr, F.lane); continue; } r -= 2 * I_O;
        if (r < I_GU) { conv_gu(r, INP(25), WSP(bf16, WS_WGU), 0, scr, F.lane); continue; } r -= I_GU;
        if (r < I_GU) { conv_gu(r, INP(26), WSP(bf16, WS_WGU), 128, scr, F.lane); continue; } r -= I_GU;
        if (r < I_DN) { conv_plain(r, INP(27), FF, DM, WSP(bf16, WS_WDN), scr, F.lane); continue; } r -= I_DN;
        if (r < 4 * I_L) { const int ld = r / I_L; conv_plain(r % I_L, INP(11) + (size_t)ld * 64 * RW, 64, RW, lora + (size_t)ld * RW * 64, scr, F.lane); continue; } r -= 4 * I_L;
        if (r < 4 * I_L) { const int ld = r / I_L; conv_plain(r % I_L, INP(13) + (size_t)ld * 64 * RW, 64, RW, lora + (size_t)(4 + ld) * RW * 64, scr, F.lane); continue; } r -= 4 * I_L;
        { const int l = r / I_G2; conv_plain(r % I_G2, INP(14) + (size_t)l * 128 * RW, 128, RW, lora + (size_t)8 * RW * 64 + (size_t)l * RW * 128, scr, F.lane); }
    }
}
__device__ __forceinline__ void moe_conv(Frame& F) {
    LAS float* scr = (LAS float*)(F.lds + F.wave * 8448);
    const int gw = F.vcu * NWAVES + F.wave, NGW = F.G * NWAVES;
    constexpr int I_GU = 16 * 112, I_DN = 56 * 32, I_E = 2 * I_GU + I_DN;
    for (int it = gw; it < NE * I_E; it += NGW) {
        const int e = it / I_E; int r = it % I_E; GAS bf16* base = WSP(bf16, WS_MW) + (size_t)e * (21 * MiB / 2);
        if (r < I_GU) { conv_gu(r, INP(29) + (size_t)e * DM * FF, base, 0, scr, F.lane); continue; } r -= I_GU;
        if (r < I_GU) { conv_gu(r, INP(30) + (size_t)e * DM * FF, base, 128, scr, F.lane); continue; } r -= I_GU;
        conv_plain(r, INP(31) + (size_t)e * FF * DM, FF, DM, base + (size_t)2 * FF * DM, scr, F.lane);
    }
}

template <bool ROUTER, bool XBF>
__device__ __forceinline__ void norm_mod_phase(Frame& F, int l, int which, const GAS void* xlat, const GAS void* xctx, int nrows, GAS bf16* H) {
    const int gw = F.vcu * NWAVES + F.wave, NGW = F.G * NWAVES, lane = F.lane;
    const GAS float* gain = INP(which ? 7 : 6) + l * DM;
    const GAS float* modl = WSP(float, WS_MOD) + (size_t)l * 33 * 6144 + (which ? 3072 : 0);
    constexpr int RPITCH = 36;
    LAS float* RL = (LAS float*)F.lds;
    if (ROUTER) {
        for (int idx = F.tid; idx < 2048; idx += 512) { const int c = idx >> 1, hf = idx & 1;
            *(LAS f32x4*)(RL + (((c >> 8) * 64 + ((c & 255) >> 2)) * RPITCH + (c & 3) * 8 + 4 * hf)) = *(const GAS f32x4*)(INP(28) + (size_t)c * 8 + 4 * hf); }
        __syncthreads(); }
    const int rpw = (nrows + NGW - 1) / NGW, m_lo = gw * rpw, m_hi = (m_lo + rpw < nrows) ? m_lo + rpw : nrows;
    f32x4 gm[4], shv[4]; int cur_bi = -1;
#pragma unroll
    for (int j = 0; j < 4; ++j) { gm[j] = (f32x4){0.f, 0.f, 0.f, 0.f}; shv[j] = gm[j]; }
    auto xload = [&](int m, f32x4 (&v)[4]) {
        const size_t xo = m < NL ? (size_t)m * DM : (size_t)(m - NL) * DM; const GAS void* xb = m < NL ? xlat : xctx;
#pragma unroll
        for (int j = 0; j < 4; ++j) {
            if constexpr (XBF) { const v2u w = *(const GAS v2u*)((const GAS bf16*)xb + xo + 4 * lane + 256 * j); v[j] = (f32x4){bflo(w.x), bfhi(w.x), bflo(w.y), bfhi(w.y)}; }
            else v[j] = *(const GAS f32x4*)((const GAS float*)xb + xo + 4 * lane + 256 * j); } };
    f32x4 v[4], vn[4];
    if (m_lo < m_hi) xload(m_lo, v);
    for (int m = m_lo; m < m_hi; ++m) {
        if (m + 1 < m_hi) xload(m + 1, vn);
        const int bi = row_bi(m);
        if (bi != cur_bi) { cur_bi = bi; const GAS float* mv = modl + (size_t)bi * 6144;
#pragma unroll
            for (int j = 0; j < 4; ++j) { const int c = 4 * lane + 256 * j; gm[j] = *(const GAS f32x4*)(gain + c) * (*(const GAS f32x4*)(mv + 1024 + c) + 1.0f); shv[j] = *(const GAS f32x4*)(mv + c); } }
        float s = 0.f;
#pragma unroll
        for (int j = 0; j < 4; ++j) s += (v[j].x * v[j].x + v[j].y * v[j].y) + (v[j].z * v[j].z + v[j].w * v[j].w);
        const float rstd = rsq_(wave_sum(s) * (1.0f / DM) + 1e-6f);
        float lg[8];
        if (ROUTER) {
#pragma unroll
            for (int e = 0; e < 8; ++e) lg[e] = 0.f; }
#pragma unroll
        for (int j = 0; j < 4; ++j) { const int c = 4 * lane + 256 * j;
            const f32x4 hv = v[j] * rstd * gm[j] + shv[j];
            v2u o; o.x = pk2(hv.x, hv.y); o.y = pk2(hv.z, hv.w);
            *(GAS v2u*)(H + (size_t)m * DM + c) = o;
            if (ROUTER) { const LAS float* rw = RL + (j * 64 + lane) * RPITCH;
#pragma unroll
                for (int q = 0; q < 4; ++q) { const f32x4 r0 = *(const LAS f32x4*)(rw + q * 8), r1 = *(const LAS f32x4*)(rw + q * 8 + 4); const float hq = hv[q];
                    lg[0] = fmaf(hq, r0.x, lg[0]); lg[1] = fmaf(hq, r0.y, lg[1]); lg[2] = fmaf(hq, r0.z, lg[2]); lg[3] = fmaf(hq, r0.w, lg[3]);
                    lg[4] = fmaf(hq, r1.x, lg[4]); lg[5] = fmaf(hq, r1.y, lg[5]); lg[6] = fmaf(hq, r1.z, lg[6]); lg[7] = fmaf(hq, r1.w, lg[7]); } }
        }
        if (ROUTER) {
#pragma unroll
            for (int e = 0; e < 8; ++e) lg[e] = wave_sum(lg[e]);
            int e0 = 0; float l0 = lg[0];
#pragma unroll
            for (int e = 1; e < 8; ++e) if (lg[e] > l0) { l0 = lg[e]; e0 = e; }
            int e1 = -1; float l1 = -INFINITY;
#pragma unroll
            for (int e = 0; e < 8; ++e) if (e != e0 && lg[e] > l1) { l1 = lg[e]; e1 = e; }
            const float w1 = rcp_(1.0f + __expf(l0 - l1)), w0 = 1.0f - w1;
            if (lane == 0) {
                GAS int* te = (GAS int*)(F.ws + WS_MOETAB + MT_TOKE) + 2 * m; GAS float* tw = (GAS float*)(F.ws + WS_MOETAB + MT_TOKW) + 2 * m;
                te[0] = e0; te[1] = e1; tw[0] = w0; tw[1] = w1;
                __hip_atomic_fetch_add((LAS unsigned*)&F.MISC[16 + e0], 1u, __ATOMIC_RELAXED, __HIP_MEMORY_SCOPE_WORKGROUP); __hip_atomic_fetch_add((LAS unsigned*)&F.MISC[16 + e1], 1u, __ATOMIC_RELAXED, __HIP_MEMORY_SCOPE_WORKGROUP);
            }
        }
#pragma unroll
        for (int j = 0; j < 4; ++j) v[j] = vn[j];
    }
    if (ROUTER) { __syncthreads(); if (F.tid < 8) { const unsigned c = F.MISC[16 + F.tid]; if (c) __hip_atomic_fetch_add(F.ctl + CW_HIST + 64 * F.tid, c, RLX_AGENT); } __syncthreads(); }
}

using pg8::Unit;
template <bool SIG> struct EpiInT {
    static constexpr bool PERM = true, AFTER_DRAIN = false, CARRY = false;
    GAS bf16 *PR, *Q, *KB, *VB; GAS unsigned char* G8;
    __device__ __forceinline__ void operator()(const f32x4 (&acc)[2][2][4][2], const Unit& u, int wr, int wc, int fr, int fq) const {
        const int row0 = u.pm * 256 + wr * 64 + fr, cb = wc * 32 + 8 * fq, pn = u.pn;
#pragma unroll
        for (int ai = 0; ai < 2; ++ai)
#pragma unroll
            for (int m = 0; m < 4; ++m) { const int r = row0 + ai * 128 + m * 16;
#pragma unroll
                for (int bj = 0; bj < 2; ++bj) { f32x4 v0 = acc[ai][bj][m][0], v1 = acc[ai][bj][m][1]; GAS bf16* dst;
                    if (pn < 7) dst = PR + (size_t)r * RCOLS + pn * 256 + bj * 128 + cb;
                    else if (pn < 9) dst = Q + (size_t)r * 512 + (pn - 7) * 256 + bj * 128 + cb;
                    else if (pn == 9) dst = (bj == 0 ? KB : VB) + (size_t)row_kv(r) * 128 + cb;
                    else {
                        unsigned w0 = 0u, w1 = 0u;
#pragma unroll
                        for (int q = 0; q < 4; ++q) { w0 = __builtin_amdgcn_cvt_pk_u8_f32(__builtin_rintf(sigmoidf_(v0[q]) * 255.0f), q, w0); w1 = __builtin_amdgcn_cvt_pk_u8_f32(__builtin_rintf(sigmoidf_(v1[q]) * 255.0f), q, w1); }
                        *(GAS v2u*)(G8 + (size_t)r * GCOLS + (pn - 10) * 256 + bj * 128 + cb) = (v2u){w0, w1}; continue; }
                    v4u w; w.x = pk2(v0[0], v0[1]); w.y = pk2(v0[2], v0[3]); w.z = pk2(v1[0], v1[1]); w.w = pk2(v1[2], v1[3]);
                    *(GAS v4u*)dst = w; } }
    }
};
typedef EpiInT<true> EpiIn;
struct EpiMergeAB {
    static constexpr bool PERM = true, AFTER_DRAIN = false, CARRY = true;
    const GAS unsigned char* G8; GAS bf16* MG;
    __device__ __forceinline__ void operator()(f32x4 (&acc)[2][2][4][2], const Unit& u, int wr, int wc, int fr, int fq) const {
        const int row0 = u.pm * 256 + wr * 64 + fr, col0 = u.pn * 256 + wc * 32 + 8 * fq;
#pragma unroll
        for (int ai = 0; ai < 2; ++ai)
#pragma unroll
            for (int m = 0; m < 4; ++m) { const int r = row0 + ai * 128 + m * 16;
#pragma unroll
                for (int bj = 0; bj < 2; ++bj) { const int c = col0 + bj * 128;
                    const v2u gb = *(const GAS v2u*)(G8 + (size_t)r * GCOLS + DM + c);
                    float fb[8];
#pragma unroll
                    for (int q = 0; q < 4; ++q) { fb[q] = fmaxf((float)((gb.x >> (8 * q)) & 0xffu), 1.0f); fb[4 + q] = fmaxf((float)((gb.y >> (8 * q)) & 0xffu), 1.0f); }
                    if (u.part == 0) {
                        const v2u ga = *(const GAS v2u*)(G8 + (size_t)r * GCOLS + c);
#pragma unroll
                        for (int q = 0; q < 4; ++q) { acc[ai][bj][m][0][q] *= (float)((ga.x >> (8 * q)) & 0xffu) * rcp_(fb[q]); acc[ai][bj][m][1][q] *= (float)((ga.y >> (8 * q)) & 0xffu) * rcp_(fb[4 + q]); }
                    } else {
                        const f32x4 a0 = acc[ai][bj][m][0], a1 = acc[ai][bj][m][1]; const float s = 1.0f / 255.0f;
                        v4u w; w.x = pk2(a0[0] * fb[0] * s, a0[1] * fb[1] * s); w.y = pk2(a0[2] * fb[2] * s, a0[3] * fb[3] * s); w.z = pk2(a1[0] * fb[4] * s, a1[1] * fb[5] * s); w.w = pk2(a1[2] * fb[6] * s, a1[3] * fb[7] * s);
                        *(GAS v4u*)(MG + (size_t)r * DM + c) = w; } } }
    }
};
template <bool SRC32>
struct EpiResT {
    static constexpr bool PERM = true, AFTER_DRAIN = false, CARRY = false;
    const GAS void *base_lat, *base_ctx; GAS bf16 *out_lat, *out_ctx; const GAS float* gt;
    __device__ __forceinline__ void operator()(const f32x4 (&acc)[2][2][4][2], const Unit& u, int wr, int wc, int fr, int fq) const {
        const bool lat = u.pm < NL / 256; const int bi = lat ? (u.pm >> 3) : 32;
        const int rr0 = (lat ? u.pm * 256 : u.pm * 256 - NL) + wr * 64 + fr, col0 = u.pn * 256 + wc * 32 + 8 * fq;
        const GAS void* bp = lat ? base_lat : base_ctx; GAS bf16* op = lat ? out_lat : out_ctx; const GAS float* gv = gt + (size_t)bi * 6144 + col0;
#pragma unroll
        for (int ai = 0; ai < 2; ++ai) {
            f32x4 g[2][2];
#pragma unroll
            for (int bj = 0; bj < 2; ++bj)
#pragma unroll
                for (int n = 0; n < 2; ++n) g[bj][n] = *(const GAS f32x4*)(gv + bj * 128 + n * 4);
            v4u wb[4][2][SRC32 ? 2 : 1];
#pragma unroll
            for (int m = 0; m < 4; ++m) { const size_t off = (size_t)(rr0 + ai * 128 + m * 16) * DM + col0;
#pragma unroll
                for (int bj = 0; bj < 2; ++bj) {
                    if constexpr (SRC32) { wb[m][bj][0] = *(const GAS v4u*)((const GAS float*)bp + off + bj * 128); wb[m][bj][SRC32 ? 1 : 0] = *(const GAS v4u*)((const GAS float*)bp + off + bj * 128 + 4); }
                    else wb[m][bj][0] = *(const GAS v4u*)((const GAS bf16*)bp + off + bj * 128); } }
#pragma unroll
            for (int m = 0; m < 4; ++m) { const size_t off = (size_t)(rr0 + ai * 128 + m * 16) * DM + col0;
#pragma unroll
                for (int bj = 0; bj < 2; ++bj) { f32x4 b0, b1;
                    if constexpr (SRC32) { b0 = __builtin_bit_cast(f32x4, wb[m][bj][0]); b1 = __builtin_bit_cast(f32x4, wb[m][bj][SRC32 ? 1 : 0]); }
                    else { const v4u w = wb[m][bj][0]; b0 = (f32x4){bflo(w.x), bfhi(w.x), bflo(w.y), bfhi(w.y)}; b1 = (f32x4){bflo(w.z), bfhi(w.z), bflo(w.w), bfhi(w.w)}; }
                    const f32x4 r0 = b0 + g[bj][0] * acc[ai][bj][m][0], r1 = b1 + g[bj][1] * acc[ai][bj][m][1];
                    v4u o; o.x = pk2(r0.x, r0.y); o.y = pk2(r0.z, r0.w); o.z = pk2(r1.x, r1.y); o.w = pk2(r1.z, r1.w);
                    *(GAS v4u*)(op + off + bj * 128) = o; } }
        }
    }
};
struct EpiGU {
    static constexpr bool PERM = true, AFTER_DRAIN = false, CARRY = false;
    GAS bf16* ACT; int pm0;
    __device__ __forceinline__ void operator()(const f32x4 (&acc)[2][2][4][2], const Unit& u, int wr, int wc, int fr, int fq) const {
        const int row0 = (u.pm - pm0) * 256 + wr * 64 + fr, col0 = u.pn * 128 + wc * 32 + 8 * fq;
#pragma unroll
        for (int ai = 0; ai < 2; ++ai)
#pragma unroll
            for (int m = 0; m < 4; ++m) { const int r = row0 + ai * 128 + m * 16; float o[8];
#pragma unroll
                for (int n = 0; n < 2; ++n)
#pragma unroll
                    for (int q = 0; q < 4; ++q) { const float gte = acc[ai][0][m][n][q], up = acc[ai][1][m][n][q]; o[4 * n + q] = gte * sigmoidf_(gte) * up; }
                v4u w; w.x = pk2(o[0], o[1]); w.y = pk2(o[2], o[3]); w.z = pk2(o[4], o[5]); w.w = pk2(o[6], o[7]);
                *(GAS v4u*)(ACT + (size_t)r * FF + col0) = w; }
    }
};
struct EpiStore {
    static constexpr bool PERM = true, AFTER_DRAIN = false, CARRY = false;
    GAS bf16* O;
    __device__ __forceinline__ void operator()(const f32x4 (&acc)[2][2][4][2], const Unit& u, int wr, int wc, int fr, int fq) const {
        const int row0 = u.pm * 256 + wr * 64 + fr, col0 = u.pn * 256 + wc * 32 + 8 * fq;
#pragma unroll
        for (int ai = 0; ai < 2; ++ai)
#pragma unroll
            for (int m = 0; m < 4; ++m) { const int r = row0 + ai * 128 + m * 16;
#pragma unroll
                for (int bj = 0; bj < 2; ++bj) { const f32x4 v0 = acc[ai][bj][m][0], v1 = acc[ai][bj][m][1];
                    v4u w; w.x = pk2(v0[0], v0[1]); w.y = pk2(v0[2], v0[3]); w.z = pk2(v1[0], v1[1]); w.w = pk2(v1[2], v1[3]);
                    *(GAS v4u*)(O + (size_t)r * DM + col0 + bj * 128) = w; } }
    }
};
struct EpiNull {
    static constexpr bool PERM = true, AFTER_DRAIN = false, CARRY = false;
    GAS bf16* O;
    __device__ __forceinline__ void operator()(const f32x4 (&acc)[2][2][4][2], const Unit& u, int wr, int wc, int fr, int fq) const {
        float s = 0.f;
#pragma unroll
        for (int ai = 0; ai < 2; ++ai)
#pragma unroll
            for (int m = 0; m < 4; ++m)
#pragma unroll
                for (int bj = 0; bj < 2; ++bj) s += acc[ai][bj][m][0][0] + acc[ai][bj][m][1][3];
        if (s == 12345.678f) O[u.pm * 256 + wr * 64 + fr + wc + fq] = 0;
    }
};
template <bool GA>
struct MoeOrderT {
    static constexpr bool GATHER = GA;
    const char* A; const char* W; size_t a_tstep, b_tstep, w_estep; int tile0, a_tile0, ntl, nN, G, c; const LAS int* tile_e; int prev_ntl; const GAS int* rowt;
    __device__ __forceinline__ const GAS int* row_tab() const { return rowt; }
    __device__ bool next(int i, Unit& u) const {
        const int x = c & 7, j = c >> 3, Wn = G >> 3, s0 = (x * ntl) >> 3, nx = (((x + 1) * ntl) >> 3) - s0;
        int e = 0, qh = 0;
        if (prev_ntl) { const int D = 4 * ((((x + 1) * prev_ntl) >> 3) - ((x * prev_ntl) >> 3)); e = D % Wn; qh = (2 * nx * nN + 7 * e - 6 * Wn) / (2 * Wn); qh = qh < 0 ? 0 : qh; }
        int uu;
        if (j < e) { if (i >= qh) return false; uu = qh * j + i; }
        else uu = qh * e + i * (Wn - e) + (j - e);
        if (uu >= nx * nN) return false;
        const int q = uu / nx;
        u.pn = q; u.pm = tile0 + s0 + (uu - q * nx); u.part = 0; return true; }
    __device__ __forceinline__ const char* a_base(const Unit& u) const { return GA ? A : A + (size_t)(u.pm - a_tile0) * a_tstep; }
    __device__ __forceinline__ const char* b_base(const Unit& u) const { return W + (size_t)tile_e[u.pm] * w_estep + (size_t)u.pn * b_tstep; }
    __device__ __forceinline__ void a_ready(const Unit&) const {}
    __device__ __forceinline__ void done(const Unit&) const {}
};

__device__ __forceinline__ void qk_phase(Frame& F, int l) {
    const int gw = F.vcu * NWAVES + F.wave, NGW = F.G * NWAVES, lane = F.lane, d0 = 8 * (lane & 7);
    const GAS float* rt = WSP(float, WS_ROPE);
    GAS bf16* Q = WSP(bf16, WS_Q); GAS bf16* KB = WSP(bf16, WS_KB);
    float gq[8], gk[8];
#pragma unroll
    for (int e = 0; e < 8; ++e) { gq[e] = INP(20)[l * 64 + d0 + e]; gk[e] = INP(21)[l * 64 + d0 + e]; }
    constexpr int NR = 4;
    for (int m0 = gw; m0 < MA; m0 += NR * NGW) {
        v4u wq[NR], wk[NR]; float cs[NR][4], sn[NR][4];
#pragma unroll
        for (int r = 0; r < NR; ++r) { const int m = m0 + r * NGW; const bool ok = m < MA, lat = m < NL; const int t = m & 2047, pr = t >> 6, pc = t & 63;
            wq[r] = (v4u){0u, 0u, 0u, 0u}; wk[r] = (v4u){0u, 0u, 0u, 0u};
#pragma unroll
            for (int pi = 0; pi < 4; ++pi) { cs[r][pi] = 1.f; sn[r][pi] = 0.f; }
            if (ok && lat) {
#pragma unroll
                for (int pi = 0; pi < 4; ++pi) { const int i = 4 * (lane & 7) + pi, pos = i < 16 ? pr : pc, f = i & 15; cs[r][pi] = rt[pos * 16 + f]; sn[r][pi] = rt[1024 + pos * 16 + f]; } }
            if (ok && (lat || l == 0)) wq[r] = *(const GAS v4u*)(Q + (size_t)m * 512 + 8 * lane);
            if (ok && lane < 16) wk[r] = *(const GAS v4u*)(KB + (size_t)row_kv(m) * 128 + 8 * (lane & 15)); }
#pragma unroll
        for (int r = 0; r < NR; ++r) { const int m = m0 + r * NGW; const bool ok = m < MA, lat = m < NL;
            if (ok && (lat || l == 0)) { const v4u w = wq[r];
              float x[8] = { bflo(w.x), bfhi(w.x), bflo(w.y), bfhi(w.y), bflo(w.z), bfhi(w.z), bflo(w.w), bfhi(w.w) };
              float ss = 0.f;
#pragma unroll
              for (int e = 0; e < 8; ++e) ss += x[e] * x[e];
              ss = row8_sum(ss);
              const float rr = rsq_(ss * (1.0f / 64.0f) + 1e-6f);
#pragma unroll
              for (int e = 0; e < 8; ++e) x[e] = x[e] * rr * gq[e];
#pragma unroll
              for (int pi = 0; pi < 4; ++pi) { const float x0 = x[2 * pi], x1 = x[2 * pi + 1]; x[2 * pi] = x0 * cs[r][pi] - x1 * sn[r][pi]; x[2 * pi + 1] = x0 * sn[r][pi] + x1 * cs[r][pi]; }
              const float C2 = attn_body::C2;
              v4u o; o.x = pk2(x[0] * C2, x[1] * C2); o.y = pk2(x[2] * C2, x[3] * C2); o.z = pk2(x[4] * C2, x[5] * C2); o.w = pk2(x[6] * C2, x[7] * C2);
              *(GAS v4u*)(Q + (size_t)m * 512 + 8 * lane) = o; }
            if (ok) { const v4u w = wk[r];
              float x[8] = { bflo(w.x), bfhi(w.x), bflo(w.y), bfhi(w.y), bflo(w.z), bfhi(w.z), bflo(w.w), bfhi(w.w) };
              float ss = 0.f;
#pragma unroll
              for (int e = 0; e < 8; ++e) ss += x[e] * x[e];
              ss = row8_sum(ss);
              const float rr = rsq_(ss * (1.0f / 64.0f) + 1e-6f);
#pragma unroll
              for (int e = 0; e < 8; ++e) x[e] = x[e] * rr * gk[e];
#pragma unroll
              for (int pi = 0; pi < 4; ++pi) { const float x0 = x[2 * pi], x1 = x[2 * pi + 1]; x[2 * pi] = x0 * cs[r][pi] - x1 * sn[r][pi]; x[2 * pi + 1] = x0 * sn[r][pi] + x1 * cs[r][pi]; }
              v4u o; o.x = pk2(x[0], x[1]); o.y = pk2(x[2], x[3]); o.z = pk2(x[4], x[5]); o.w = pk2(x[6], x[7]);
              if (lane < 16) *(GAS v4u*)(KB + (size_t)row_kv(m) * 128 + 8 * (lane & 15)) = o; }
        }
    }
}

constexpr int RO_PITCH = 136;
static_assert(RW * RO_PITCH * 2 <= MISC_OFF, "rwkv_out LDS");
__device__ __forceinline__ void rwkv_out_phase(Frame& F, int l, int nrows) {
    const int gw = F.vcu * NWAVES + F.wave, NGW = F.G * NWAVES, lane = F.lane, jr = lane & 15, fq = lane >> 4;
    const GAS bf16* PR = WSP(bf16, WS_PR); const GAS bf16* YF = WSP(bf16, WS_YF); const GAS bf16* YB = WSP(bf16, WS_YB); GAS bf16* YR = WSP(bf16, WS_YR);
    const GAS float* bon0 = WSP(float, WS_BONUS); const GAS float* bon1 = bon0 + (size_t)MA * 8;
    const GAS bf16* g2t = WSP(bf16, WS_LORA) + (size_t)8 * RW * 64 + (size_t)l * RW * 128;
    const GAS float* m0 = INP(9) + (size_t)(l * 2) * RCOLS; const GAS float* m1 = m0 + RCOLS;
    const GAS float* lw = INP(18) + l * RW; const GAS float* lb = INP(19) + l * RW;
    for (int i = F.tid; i < RW * 16; i += 512) { const int n = i >> 4, c8 = i & 15, rho = n & 31, src = (n & ~31) + 8 * ((rho & 15) >> 2) + 4 * (rho >> 4) + (rho & 3);
        *(LAS v4u*)(F.lds + (n * RO_PITCH + 8 * c8) * 2) = *(const GAS v4u*)(g2t + (size_t)src * 128 + 8 * c8); }
    __syncthreads();
    for (int unit = gw; unit < nrows / 16; unit += NGW) {
        const int m = unit * 16 + jr;
        const int pos = m < NL ? (m & 2047) : ((m - NL) & 255), len = m < NL ? TL : TC;
        const bool hp = pos > 0, hn = pos < len - 1;
        const GAS bf16* pr = PR + (size_t)m * RCOLS;
        bf16x8 Af[4];
#pragma unroll
        for (int ks = 0; ks < 4; ++ks) { const int col = 1664 + 8 * fq + 32 * ks;
            const v4u z = (v4u){0u, 0u, 0u, 0u}; const v4u w1 = *(const GAS v4u*)(pr + col); const v4u w0 = hp ? *(const GAS v4u*)(pr - RCOLS + col) : z; const v4u w2 = hn ? *(const GAS v4u*)(pr + RCOLS + col) : z;
            const unsigned u0[4] = {w0.x, w0.y, w0.z, w0.w}, u1[4] = {w1.x, w1.y, w1.z, w1.w}, u2[4] = {w2.x, w2.y, w2.z, w2.w}; unsigned o[4];
#pragma unroll
            for (int e = 0; e < 4; ++e) { const f32x2 a = *(const GAS f32x2*)(m0 + col + 2 * e), bq = *(const GAS f32x2*)(m1 + col + 2 * e);
                const float xl = bflo(u1[e]), xh = bfhi(u1[e]);
                const float vl = xl + a.x * (bflo(u0[e]) - xl) + bq.x * (bflo(u2[e]) - xl), vh = xh + a.y * (bfhi(u0[e]) - xh) + bq.y * (bfhi(u2[e]) - xh);
                o[e] = pk2(sigmoidf_(vl), sigmoidf_(vh)); }
            Af[ks] = __builtin_bit_cast(bf16x8, (v4u){o[0], o[1], o[2], o[3]}); }
        for (int hh = 0; hh < 8; ++hh) {
            const float bon = 0.5f * (bon0[(size_t)m * 8 + hh] + bon1[(size_t)m * 8 + hh]);
            f32x4 y[2][2], g[2][2];
#pragma unroll
            for (int gp = 0; gp < 2; ++gp) { const int c0 = hh * 64 + 32 * gp;
#pragma unroll
                for (int n = 0; n < 2; ++n) { f32x4 acc = (f32x4){0.f, 0.f, 0.f, 0.f};
#pragma unroll
                    for (int ks = 0; ks < 4; ++ks) { const bf16x8 Bf = *(const LAS bf16x8*)(F.lds + ((c0 + 16 * n + jr) * RO_PITCH + 8 * fq + 32 * ks) * 2); acc = __builtin_amdgcn_mfma_f32_16x16x32_bf16(Bf, Af[ks], acc, 0, 0, 0); }
                    g[gp][n] = acc; }
                const int col = c0 + 8 * fq; const v4u a = *(const GAS v4u*)(YF + (size_t)m * RW + col), bq = *(const GAS v4u*)(YB + (size_t)m * RW + col);
                y[gp][0] = (f32x4){bflo(a.x) + bflo(bq.x), bfhi(a.x) + bfhi(bq.x), bflo(a.y) + bflo(bq.y), bfhi(a.y) + bfhi(bq.y)};
                y[gp][1] = (f32x4){bflo(a.z) + bflo(bq.z), bfhi(a.z) + bfhi(bq.z), bflo(a.w) + bflo(bq.w), bfhi(a.w) + bfhi(bq.w)}; }
            float s = 0.f;
#pragma unroll
            for (int gp = 0; gp < 2; ++gp)
#pragma unroll
                for (int n = 0; n < 2; ++n) s += (y[gp][n].x + y[gp][n].y) + (y[gp][n].z + y[gp][n].w);
            s = xsum32(xsum16(s));
            const float mean = s * (1.0f / 64.0f); float qv = 0.f;
#pragma unroll
            for (int gp = 0; gp < 2; ++gp)
#pragma unroll
                for (int n = 0; n < 2; ++n) { y[gp][n] = y[gp][n] - mean; qv += (y[gp][n].x * y[gp][n].x + y[gp][n].y * y[gp][n].y) + (y[gp][n].z * y[gp][n].z + y[gp][n].w * y[gp][n].w); }
            qv = xsum32(xsum16(qv));
            const float rstd = rsq_(qv * (1.0f / 64.0f) + 64e-5f);
#pragma unroll
            for (int gp = 0; gp < 2; ++gp) { const int col = hh * 64 + 32 * gp + 8 * fq, vc = 1024 + col;
                const v4u z = (v4u){0u, 0u, 0u, 0u}; const v4u w1 = *(const GAS v4u*)(pr + vc); const v4u w0 = hp ? *(const GAS v4u*)(pr - RCOLS + vc) : z; const v4u w2 = hn ? *(const GAS v4u*)(pr + RCOLS + vc) : z;
                const unsigned u0[4] = {w0.x, w0.y, w0.z, w0.w}, u1[4] = {w1.x, w1.y, w1.z, w1.w}, u2[4] = {w2.x, w2.y, w2.z, w2.w}; unsigned ow[4];
#pragma unroll
                for (int n = 0; n < 2; ++n) {
                    const f32x4 x0 = (f32x4){bflo(u0[2 * n]), bfhi(u0[2 * n]), bflo(u0[2 * n + 1]), bfhi(u0[2 * n + 1])}, x1 = (f32x4){bflo(u1[2 * n]), bfhi(u1[2 * n]), bflo(u1[2 * n + 1]), bfhi(u1[2 * n + 1])}, x2 = (f32x4){bflo(u2[2 * n]), bfhi(u2[2 * n]), bflo(u2[2 * n + 1]), bfhi(u2[2 * n + 1])};
                    const f32x4 vs = x1 + *(const GAS f32x4*)(m0 + vc + 4 * n) * (x0 - x1) + *(const GAS f32x4*)(m1 + vc + 4 * n) * (x2 - x1);
                    const f32x4 o = (y[gp][n] * rstd * *(const GAS f32x4*)(lw + col + 4 * n) + *(const GAS f32x4*)(lb + col + 4 * n) + vs * bon) * g[gp][n];
                    ow[2 * n] = pk2(o.x, o.y); ow[2 * n + 1] = pk2(o.z, o.w); }
                *(GAS v4u*)(YR + (size_t)m * RW + col) = (v4u){ow[0], ow[1], ow[2], ow[3]}; }
        }
    }
    __syncthreads();
}

__device__ __forceinline__ void attn_phase(Frame& F, int l, char* lds_generic, size_t q_off) {
    typedef attn_body::bf16 abf;
    abf* Q = (abf*)(F.ws + q_off); const abf* KB = (const abf*)(F.ws + WS_KB); const abf* VB = (const abf*)(F.ws + WS_VB);
    for (int p = F.vcu; p < NB * 8; p += F.G) {
        const int b = p >> 3, hq = p & 7, kvh = hq >> 2;
        const abf* Kh = KB + (size_t)b * KVT * 128 + kvh * 64; const abf* Vh = VB + (size_t)b * KVT * 128 + kvh * 64;
        const int nu = l == 0 ? 9 : 8;
        for (int u = 0; u < nu; ++u) {
            const bool cx = u == 8;
            abf* Qu = Q + (size_t)(cx ? NL + b * TC : b * TL + u * 256) * 512 + hq * 64;
            attn_body::attn_unit<8>(Qu, cx ? Kh + (size_t)TL * 128 : Kh, cx ? Vh + (size_t)TL * 128 : Vh, Qu, cx ? TC / 64 : KVT / 64, lds_generic, F.tid);
        }
    }
}

__device__ __forceinline__ int moe_tiles(Frame& F, LAS int* tile_e) {
    int nt = 0;
    for (int e = 0; e < NE; ++e) { const int cnt = (int)__hip_atomic_load(F.ctl + CW_HIST + 64 * e, RLX_AGENT); const int t = (cnt + 255) >> 8;
        for (int i = F.tid; i < t; i += 512) tile_e[nt + i] = e; nt += t; }
    __syncthreads();
    return nt;
}
__device__ __forceinline__ void moe_slots(Frame& F) {
    volatile LAS unsigned* M = F.MISC;
    const GAS int* toke = (const GAS int*)(F.ws + WS_MOETAB + MT_TOKE); GAS int* toks = (GAS int*)(F.ws + WS_MOETAB + MT_TOKS);
    GAS int* rowt = (GAS int*)(F.ws + WS_MOETAB + MT_ROWT);
    for (int tb = F.vcu; tb < NL / 256; tb += F.G) {
        if (F.tid < 8) M[32 + F.tid] = 0u;
        if (F.tid == 0) { unsigned ps = 0; for (int e = 0; e < NE; ++e) { M[48 + e] = ps; const unsigned cnt = __hip_atomic_load(F.ctl + CW_HIST + 64 * e, RLX_AGENT); ps += ((cnt + 255u) >> 8) << 8; } }
        __syncthreads();
        int e_my = 0, rank = 0;
        { const int a = F.tid; e_my = toke[(size_t)tb * 512 + a]; rank = (int)__hip_atomic_fetch_add((LAS unsigned*)&M[32 + e_my], 1u, __ATOMIC_RELAXED, __HIP_MEMORY_SCOPE_WORKGROUP); }
        __syncthreads();
        if (F.tid < 8) M[40 + F.tid] = __hip_atomic_fetch_add(F.ctl + CW_CURS + 64 * F.tid, M[32 + F.tid], RLX_AGENT);
        __syncthreads();
        const int slot = (int)(M[48 + e_my] + M[40 + e_my]) + rank;
        toks[(size_t)tb * 512 + F.tid] = slot; rowt[slot] = tb * 256 + (F.tid >> 1);
        __syncthreads();
    }
}
__device__ __forceinline__ void moe_final(Frame& F) {
    const int gw = F.vcu * NWAVES + F.wave, NGW = F.G * NWAVES, lane = F.lane;
    const GAS int* toks = (const GAS int*)(F.ws + WS_MOETAB + MT_TOKS); const GAS float* tokw = (const GAS float*)(F.ws + WS_MOETAB + MT_TOKW);
    const GAS bf16* YM = WSP(bf16, WS_YM); const GAS float* gt = WSP(float, WS_MOD) + (size_t)33 * 6144 + 5120;
    const GAS bf16* X16 = WSP(bf16, WS_X16);
    const int rpw = (NL + NGW - 1) / NGW, m_lo = gw * rpw, m_hi = m_lo + rpw < NL ? m_lo + rpw : NL;
    if (m_lo >= m_hi) return;
    const int c0 = 8 * lane;
    const int mi = m_lo + lane < m_hi ? m_lo + lane : m_lo;
    const v2u slv = *(const GAS v2u*)(toks + 2 * mi), wtv = *(const GAS v2u*)(tokw + 2 * mi);
    f32x4 gvv[2][2], wf[2][2]; int cur_b = -1;
#pragma unroll
    for (int j = 0; j < 2; ++j) { wf[j][0] = *(const GAS f32x4*)(INP(32) + c0 + 512 * j); wf[j][1] = *(const GAS f32x4*)(INP(32) + c0 + 512 * j + 4); gvv[j][0] = wf[j][0]; gvv[j][1] = wf[j][0]; }
    v4u ya[2][2], yb[2][2], xw[2][2];
    auto rload = [&](int r, v4u (&a)[2], v4u (&bq)[2], v4u (&x)[2]) { const int rr = r < m_hi - m_lo ? r : 0;
        const int s0 = __builtin_amdgcn_readlane((int)slv.x, rr), s1 = __builtin_amdgcn_readlane((int)slv.y, rr);
#pragma unroll
        for (int j = 0; j < 2; ++j) { const int c = c0 + 512 * j;
            a[j] = *(const GAS v4u*)(YM + (size_t)s0 * DM + c); bq[j] = *(const GAS v4u*)(YM + (size_t)s1 * DM + c); x[j] = *(const GAS v4u*)(X16 + (size_t)(m_lo + rr) * DM + c); } };
    rload(0, ya[0], yb[0], xw[0]); rload(1, ya[1], yb[1], xw[1]);
    for (int r0 = 0; r0 < m_hi - m_lo; r0 += 2) {
        v4u yan[2][2], ybn[2][2], xwn[2][2];
        rload(r0 + 2, yan[0], ybn[0], xwn[0]); rload(r0 + 3, yan[1], ybn[1], xwn[1]);
#pragma unroll
        for (int r = 0; r < 2; ++r) { const int rr = r0 + r, m = m_lo + rr;
            if (rr < m_hi - m_lo) {
            const float w0 = __uint_as_float((unsigned)__builtin_amdgcn_readlane((int)wtv.x, rr)), w1 = __uint_as_float((unsigned)__builtin_amdgcn_readlane((int)wtv.y, rr));
            if ((m >> 11) != cur_b) { cur_b = m >> 11; const GAS float* gv = gt + (size_t)cur_b * 6144 + c0;
#pragma unroll
                for (int j = 0; j < 2; ++j) { gvv[j][0] = *(const GAS f32x4*)(gv + 512 * j); gvv[j][1] = *(const GAS f32x4*)(gv + 512 * j + 4); } }
            GAS float* xr = F.out + (size_t)m * DM + c0;
            f32x4 v[2][2]; float s = 0.f;
#pragma unroll
            for (int j = 0; j < 2; ++j) {
                const v4u a = ya[r][j], bq = yb[r][j], x = xw[r][j];
                const f32x4 a0 = (f32x4){bflo(a.x), bfhi(a.x), bflo(a.y), bfhi(a.y)}, a1 = (f32x4){bflo(a.z), bfhi(a.z), bflo(a.w), bfhi(a.w)};
                const f32x4 b0 = (f32x4){bflo(bq.x), bfhi(bq.x), bflo(bq.y), bfhi(bq.y)}, b1 = (f32x4){bflo(bq.z), bfhi(bq.z), bflo(bq.w), bfhi(bq.w)};
                const f32x4 x0 = (f32x4){bflo(x.x), bfhi(x.x), bflo(x.y), bfhi(x.y)}, x1 = (f32x4){bflo(x.z), bfhi(x.z), bflo(x.w), bfhi(x.w)};
                v[j][0] = x0 + gvv[j][0] * (a0 * w0 + b0 * w1); v[j][1] = x1 + gvv[j][1] * (a1 * w0 + b1 * w1);
                s += ((v[j][0].x * v[j][0].x + v[j][0].y * v[j][0].y) + (v[j][0].z * v[j][0].z + v[j][0].w * v[j][0].w)) + ((v[j][1].x * v[j][1].x + v[j][1].y * v[j][1].y) + (v[j][1].z * v[j][1].z + v[j][1].w * v[j][1].w)); }
            const float rstd = rsq_(wave_sum(s) * (1.0f / DM) + 1e-6f);
#pragma unroll
            for (int j = 0; j < 2; ++j) { *(GAS f32x4*)(xr + 512 * j) = v[j][0] * rstd * wf[j][0]; *(GAS f32x4*)(xr + 512 * j + 4) = v[j][1] * rstd * wf[j][1]; } } }
#pragma unroll
        for (int r = 0; r < 2; ++r)
#pragma unroll
            for (int j = 0; j < 2; ++j) { ya[r][j] = yan[r][j]; yb[r][j] = ybn[r][j]; xw[r][j] = xwn[r][j]; }
    }
}
__device__ __forceinline__ bf16x8 lds_frag(const LAS unsigned char* p) { return *(const LAS bf16x8*)p; }
__device__ __forceinline__ bf16x8 lds_frag16(const LAS unsigned char* row, int lane) { bf16x8 z = (bf16x8){0, 0, 0, 0, 0, 0, 0, 0}; if (lane < 32) z = *(const LAS bf16x8*)(row + 16 * (lane >> 4)); return z; }
__device__ __forceinline__ float tanh_fast(float x) { const float e = __expf(2.0f * x); return 1.0f - 2.0f * rcp_(e + 1.0f); }
__device__ __forceinline__ void st_bf(LAS unsigned char* p, float v) { *(LAS unsigned short*)p = (unsigned short)(pk2(v, 0.f) & 0xffffu); }
constexpr int S3_RAW = 0, S3_KS = 11520, S3_KK = 15616, S3_RS = 19712, S3_VS = 23808, S3_TWA = 27904, S3_ADA = 30208, S3_R1END = 32512;
constexpr int S3_GA = 0, S3_GBT = 4608;
constexpr int S3_MAK = 11520, S3_MBRT = 12288, S3_TA = 13056, S3_TT = 13824, S3_MKR = 14592, S3_MAB = 15616;
constexpr int S3_RQ0 = 0;
constexpr int S3_WSC = 16640, S3_WSC_STRIDE = 6144;
constexpr int S3_BCREST = S3_WSC + 4 * S3_WSC_STRIDE;
constexpr int S3_RTF = S3_BCREST, S3_KCF = S3_RTF + 4096, S3_G15 = S3_KCF + 4096, S3_ATT = S3_G15 + 256, S3_BCT = S3_ATT + 3072, S3_VT = S3_BCT + 3072;
constexpr int S3_S16 = S3_VT + 3072, S3_YO = S3_S16 + 9216, S3_BON = S3_YO + 4096, S3_DIR = S3_BON + 256;
static_assert(S3_MAB + 1024 <= S3_WSC && S3_WSC >= S3_KK && 2 * S3_DIR <= MISC_OFF && S3_RQ0 + 4 * 2304 <= S3_MAK, "scan3 LDS map");
#ifndef S3_BAR_REP
#define S3_BAR_REP 0
#endif
#define S3_BAR() do { asm volatile("s_waitcnt lgkmcnt(0)\n\ts_barrier" ::: "memory"); for (int br_ = 0; br_ < S3_BAR_REP; ++br_) asm volatile("s_barrier" ::: "memory"); } while (0)
#define S3_WAVE_SYNC() do { } while (0)
#define S3_IDS() int tl_ = F.tid; asm volatile("" : "+v"(tl_)); const int dt = tl_ & 255, lane = tl_ & 63, lr = lane & 15, lq = lane >> 4; const int wv_ = __builtin_amdgcn_readfirstlane(tl_ >> 6); const int w4 = wv_ & 3, d = wv_ >> 2; \
    LAS unsigned char* const L = F.lds + d * S3_DIR; (void)dt; (void)lr; (void)lq; (void)w4; (void)lane
#define S3_F32(name, off) LAS float* const name = (LAS float*)(L + (off))
__device__ __forceinline__ f32x4 mfma16(bf16x8 a, bf16x8 b, f32x4 c) { return __builtin_amdgcn_mfma_f32_16x16x32_bf16(a, b, c, 0, 0, 0); }
__device__ __forceinline__ bf16x8 frag_lk16(const LAS unsigned char* row, int lq) { const v2u x = *(const LAS v2u*)(row + 8 * lq); return __builtin_bit_cast(bf16x8, (v4u){x.x, x.y, 0u, 0u}); }
__device__ __forceinline__ bf16x8 frag_lk32(const LAS unsigned char* row, int lq) { const v2u x = *(const LAS v2u*)(row + 8 * lq), y = *(const LAS v2u*)(row + 32 + 8 * lq); return __builtin_bit_cast(bf16x8, (v4u){x.x, x.y, y.x, y.y}); }
__device__ __forceinline__ bf16x8 pack_b(f32x4 t) { return __builtin_bit_cast(bf16x8, (v4u){pk2(t[0], t[1]), pk2(t[2], t[3]), 0u, 0u}); }
typedef short bf16x4 __attribute__((ext_vector_type(4)));
__device__ __forceinline__ f32x4 mfma16k(bf16x4 a, bf16x4 b, f32x4 c) { return __builtin_amdgcn_mfma_f32_16x16x16bf16_1k(a, b, c, 0, 0, 0); }
__device__ __forceinline__ bf16x4 frag_k16(const LAS unsigned char* row, int lq) { return __builtin_bit_cast(bf16x4, *(const LAS v2u*)(row + 8 * lq)); }
__device__ __forceinline__ bf16x4 pack_k16(f32x4 t) { return __builtin_bit_cast(bf16x4, (v2u){pk2(t[0], t[1]), pk2(t[2], t[3])}); }
__device__ __forceinline__ bf16x8 pack_b2(f32x4 t0, f32x4 t1) { return __builtin_bit_cast(bf16x8, (v4u){pk2(t0[0], t0[1]), pk2(t0[2], t0[3]), pk2(t1[0], t1[1]), pk2(t1[2], t1[3])}); }

#ifndef S3_REP_A
#define S3_REP_A 1
#endif
#ifndef S3_REP_BC
#define S3_REP_BC 1
#endif
#ifndef S3_REP_FG
#define S3_REP_FG 1
#endif
#ifndef S3_REP_DE
#define S3_REP_DE 1
#endif
__device__ __forceinline__ void scan_phase3(Frame& F, int l) {
    const GAS bf16* PR = WSP(bf16, WS_PR);
    for (int p = F.vcu; p < NB * 8; p += F.G) {
        const int b = p >> 3, h = p & 7;
        f32x4 S[4];
#pragma unroll
        for (int i = 0; i < 4; ++i) S[i] = (f32x4){0.f, 0.f, 0.f, 0.f};
        v4u raw[3];
        int prow[3], pcol[3], plds[3];
        f32x4 mu0[5], mu1[5], mu2[5], kkc; bf16x8 Bw0, Bw1, Ba0, Ba1; float w0c, a0c, kac, rkc;
        { S3_IDS();
#pragma unroll
          for (int i = 0; i < 3; ++i) { const int pp = dt + 256 * i, row = pp / 40, rem = pp % 40, grp = rem >> 3, c8 = rem & 7;
              prow[i] = pp < 720 ? row : -100000; pcol[i] = (grp == 0 ? h * 64 : grp == 1 ? 512 + h * 64 : grp == 2 ? 1024 + h * 64 : grp == 3 ? 1536 : 1600) + 8 * c8; plds[i] = (row * 320 + rem * 8) * 2; }
          const int cg = dt & 15; const GAS float* mup = INP(9) + (size_t)(l * 2) * RCOLS + 4 * cg;
#pragma unroll
          for (int g = 0; g < 5; ++g) { const int gc = g == 0 ? h * 64 : g == 1 ? 512 + h * 64 : g == 2 ? 1024 + h * 64 : g == 3 ? 1536 : 1600; mu0[g] = *(const GAS f32x4*)(mup + gc); mu1[g] = *(const GAS f32x4*)(mup + RCOLS + gc); mu2[g] = 1.0f - mu0[g] - mu1[g]; }
          kkc = *(const GAS f32x4*)(INP(15) + l * RW + h * 64 + 4 * cg);
          const GAS bf16* w2t = WSP(bf16, WS_LORA) + (size_t)((l * 2 + d) * RW + h * 64 + 16 * w4 + lr) * 64 + 8 * lq; const GAS bf16* a2t = w2t + (size_t)4 * RW * 64;
          Bw0 = *(const GAS bf16x8*)w2t; Bw1 = *(const GAS bf16x8*)(w2t + 32); Ba0 = *(const GAS bf16x8*)a2t; Ba1 = *(const GAS bf16x8*)(a2t + 32);
          const int ccol = h * 64 + 16 * w4 + lr;
          w0c = INP(10)[(l * 2 + d) * RW + ccol]; a0c = INP(12)[(l * 2 + d) * RW + ccol]; kac = INP(16)[l * RW + ccol]; rkc = INP(17)[l * RW + ccol];
          for (int i = dt; i < 9216 / 16; i += 256) *(LAS v4u*)(L + S3_S16 + 16 * i) = (v4u){0u, 0u, 0u, 0u}; }
#define SC_GEOM(c) const int s0_ = 16 * (c); const bool isctx_ = s0_ < TC; const int pos0_ = isctx_ ? s0_ : s0_ - TC; const int len_ = isctx_ ? TC : TL; \
        const int rowbase_ = isctx_ ? NL + b * TC : b * TL; const int toklo_ = d == 0 ? pos0_ : len_ - 16 - pos0_;
#define SC_LOAD(c) do { SC_GEOM(c) _Pragma("unroll") for (int i = 0; i < 3; ++i) { const int tr = toklo_ - 1 + prow[i]; raw[i] = (v4u){0u, 0u, 0u, 0u}; \
            if (tr >= 0 && tr < len_) raw[i] = *(const GAS v4u*)(PR + (size_t)(rowbase_ + tr) * RCOLS + pcol[i]); } } while (0)
        { S3_IDS(); SC_LOAD(0); }
        for (int c = 0; c < KVT / 16; ++c) {
            S3_IDS();
            {
#pragma unroll
              for (int i = 0; i < 3; ++i) { if (prow[i] >= 0) *(LAS v4u*)(L + S3_RAW + plds[i]) = raw[i]; }
              S3_BAR();
              if (c + 1 < KVT / 16) SC_LOAD(c + 1); }
            for (int rp_ = 0; rp_ < S3_REP_A; ++rp_) {
            { S3_F32(RS, S3_RS); S3_F32(VS, S3_VS); S3_F32(KS, S3_KS); S3_F32(KK, S3_KK);
              const int j = dt >> 4, cg = dt & 15;
              f32x4 xs[5];
#pragma unroll
              for (int g = 0; g < 5; ++g) {
                  const v2u a0 = *(const LAS v2u*)(L + S3_RAW + ((j + 0) * 320 + g * 64 + 4 * cg) * 2), a1 = *(const LAS v2u*)(L + S3_RAW + ((j + 1) * 320 + g * 64 + 4 * cg) * 2), a2 = *(const LAS v2u*)(L + S3_RAW + ((j + 2) * 320 + g * 64 + 4 * cg) * 2);
                  const f32x4 x0 = (f32x4){bflo(a0.x), bfhi(a0.x), bflo(a0.y), bfhi(a0.y)}, x1 = (f32x4){bflo(a1.x), bfhi(a1.x), bflo(a1.y), bfhi(a1.y)}, x2 = (f32x4){bflo(a2.x), bfhi(a2.x), bflo(a2.y), bfhi(a2.y)};
                  xs[g] = mu2[g] * x1 + mu0[g] * x0 + mu1[g] * x2;
              }
              *(LAS f32x4*)(RS + j * 64 + 4 * cg) = xs[0];
              *(LAS f32x4*)(VS + j * 64 + 4 * cg) = xs[2];
              *(LAS f32x4*)(KS + j * 64 + 4 * cg) = xs[1];
              const f32x4 kkf = xs[1] * kkc; float ss = (kkf.x * kkf.x + kkf.y * kkf.y) + (kkf.z * kkf.z + kkf.w * kkf.w);
              ss = row16_sum(ss);
              const float inv = rsq_(fmaxf(ss, 1e-24f));
              *(LAS f32x4*)(KK + j * 64 + 4 * cg) = kkf * inv;
              v2u tw; tw.x = pk2(tanh_fast(xs[3].x), tanh_fast(xs[3].y)); tw.y = pk2(tanh_fast(xs[3].z), tanh_fast(xs[3].w));
              *(LAS v2u*)(L + S3_TWA + (j * 72 + 4 * cg) * 2) = tw;
              v2u ad; ad.x = pk2(xs[4].x, xs[4].y); ad.y = pk2(xs[4].z, xs[4].w);
              *(LAS v2u*)(L + S3_ADA + (j * 72 + 4 * cg) * 2) = ad;
            }
            S3_BAR(); }
            for (int rp_ = 0; rp_ < S3_REP_BC; ++rp_) {
            if (__builtin_amdgcn_readfirstlane(F.tid >> 8) == 0)
            { constexpr int DC = 0; S3_F32(RS, S3_RS); S3_F32(VS, S3_VS); S3_F32(KS, S3_KS); S3_F32(KK, S3_KK); S3_F32(RTF, S3_RTF); S3_F32(KCF, S3_KCF); S3_F32(G15, S3_G15); S3_F32(BON, S3_BON);
              const int ao = (lr * 72 + 8 * lq) * 2;
              const bf16x8 At0 = lds_frag(L + S3_TWA + ao), At1 = lds_frag(L + S3_TWA + ao + 64), Aa0 = lds_frag(L + S3_ADA + ao), Aa1 = lds_frag(L + S3_ADA + ao + 64);
              f32x4 zw = mfma16(At0, Bw0, (f32x4){0.f, 0.f, 0.f, 0.f}); zw = mfma16(At1, Bw1, zw);
              f32x4 za = mfma16(Aa0, Ba0, (f32x4){0.f, 0.f, 0.f, 0.f}); za = mfma16(Aa1, Ba1, za);
              const int cl = 16 * w4 + lr;
              float wv[4], kt[4], bb[4], kkv[4], rsv[4], vsv[4];
#pragma unroll
              for (int i = 0; i < 4; ++i) { const int jj = 4 * lq + i;
                  wv[i] = __expf(-0.6065306597f * sigmoidf_(w0c + zw[i]));
                  const float al = sigmoidf_(a0c + za[i]);
                  kkv[i] = KK[jj * 64 + cl]; rsv[i] = RS[jj * 64 + cl]; vsv[i] = VS[jj * 64 + cl];
                  kt[i] = KS[jj * 64 + cl] * (1.0f + (al - 1.0f) * kac); bb[i] = kkv[i] * al;
                  float bp = rsv[i] * kt[i] * rkc;
                  bp = row16_sum(bp);
                  if (lr == 0) BON[w4 * 16 + jj] = bp; }
              const int gq = DC == 0 ? lq : 3 - lq;
              float e0 = DC == 0 ? wv[0] : wv[3], e1 = DC == 0 ? wv[1] : wv[2], e2 = DC == 0 ? wv[2] : wv[1], e3 = DC == 0 ? wv[3] : wv[0];
              const float c0 = e0, c1 = c0 * e1, c2 = c1 * e2, c3 = c2 * e3;
              const float t0 = lane_get(c3, (DC == 0 ? 0 : 48) + lr), t1 = lane_get(c3, (DC == 0 ? 16 : 32) + lr), t2 = lane_get(c3, (DC == 0 ? 32 : 16) + lr), t3 = lane_get(c3, (DC == 0 ? 48 : 0) + lr);
              const float pre = gq == 0 ? 1.0f : gq == 1 ? t0 : gq == 2 ? t0 * t1 : t0 * t1 * t2;
              const float g15 = (t0 * t1) * (t2 * t3);
              const float gin[4] = { pre * c0, pre * c1, pre * c2, pre * c3 }, gex[4] = { pre, pre * c0, pre * c1, pre * c2 };
              if (lq == 0) G15[cl] = g15;
              float avs[4], bcs[4], vvs[4];
#pragma unroll
              for (int k = 0; k < 4; ++k) { const int i = DC == 0 ? k : 3 - k, t = 4 * gq + k;
                  const float ig = rcp_(gin[k]), sc = g15 * ig;
                  const float av = -kkv[i] * gex[k], rv = rsv[i] * gin[k];
                  st_bf(L + S3_GA + (t * 72 + cl) * 2, bb[i] * ig); st_bf(L + S3_GA + ((16 + t) * 72 + cl) * 2, kt[i] * ig);
                  st_bf(L + S3_GBT + (t * 72 + cl) * 2, av); st_bf(L + S3_GBT + ((16 + t) * 72 + cl) * 2, rv);
                  RTF[t * 64 + cl] = rv; KCF[cl * 16 + t] = kt[i] * sc;
                  avs[k] = av; bcs[k] = bb[i] * sc; vvs[k] = vsv[i]; }
              *(LAS v2u*)(L + S3_ATT + (cl * 24 + 4 * gq) * 2) = (v2u){pk2(avs[0], avs[1]), pk2(avs[2], avs[3])};
              *(LAS v2u*)(L + S3_BCT + (cl * 24 + 4 * gq) * 2) = (v2u){pk2(bcs[0], bcs[1]), pk2(bcs[2], bcs[3])};
              *(LAS v2u*)(L + S3_VT + (cl * 24 + 4 * gq) * 2) = (v2u){pk2(vvs[0], vvs[1]), pk2(vvs[2], vvs[3])};
            }
            else
            { constexpr int DC = 1; S3_F32(RS, S3_RS); S3_F32(VS, S3_VS); S3_F32(KS, S3_KS); S3_F32(KK, S3_KK); S3_F32(RTF, S3_RTF); S3_F32(KCF, S3_KCF); S3_F32(G15, S3_G15); S3_F32(BON, S3_BON);
              const int ao = (lr * 72 + 8 * lq) * 2;
              const bf16x8 At0 = lds_frag(L + S3_TWA + ao), At1 = lds_frag(L + S3_TWA + ao + 64), Aa0 = lds_frag(L + S3_ADA + ao), Aa1 = lds_frag(L + S3_ADA + ao + 64);
              f32x4 zw = mfma16(At0, Bw0, (f32x4){0.f, 0.f, 0.f, 0.f}); zw = mfma16(At1, Bw1, zw);
              f32x4 za = mfma16(Aa0, Ba0, (f32x4){0.f, 0.f, 0.f, 0.f}); za = mfma16(Aa1, Ba1, za);
              const int cl = 16 * w4 + lr;
              float wv[4], kt[4], bb[4], kkv[4], rsv[4], vsv[4];
#pragma unroll
              for (int i = 0; i < 4; ++i) { const int jj = 4 * lq + i;
                  wv[i] = __expf(-0.6065306597f * sigmoidf_(w0c + zw[i]));
                  const float al = sigmoidf_(a0c + za[i]);
                  kkv[i] = KK[jj * 64 + cl]; rsv[i] = RS[jj * 64 + cl]; vsv[i] = VS[jj * 64 + cl];
                  kt[i] = KS[jj * 64 + cl] * (1.0f + (al - 1.0f) * kac); bb[i] = kkv[i] * al;
                  float bp = rsv[i] * kt[i] * rkc;
                  bp = row16_sum(bp);
                  if (lr == 0) BON[w4 * 16 + jj] = bp; }
              const int gq = DC == 0 ? lq : 3 - lq;
              float e0 = DC == 0 ? wv[0] : wv[3], e1 = DC == 0 ? wv[1] : wv[2], e2 = DC == 0 ? wv[2] : wv[1], e3 = DC == 0 ? wv[3] : wv[0];
              const float c0 = e0, c1 = c0 * e1, c2 = c1 * e2, c3 = c2 * e3;
              const float t0 = lane_get(c3, (DC == 0 ? 0 : 48) + lr), t1 = lane_get(c3, (DC == 0 ? 16 : 32) + lr), t2 = lane_get(c3, (DC == 0 ? 32 : 16) + lr), t3 = lane_get(c3, (DC == 0 ? 48 : 0) + lr);
              const float pre = gq == 0 ? 1.0f : gq == 1 ? t0 : gq == 2 ? t0 * t1 : t0 * t1 * t2;
              const float g15 = (t0 * t1) * (t2 * t3);
              const float gin[4] = { pre * c0, pre * c1, pre * c2, pre * c3 }, gex[4] = { pre, pre * c0, pre * c1, pre * c2 };
              if (lq == 0) G15[cl] = g15;
              float avs[4], bcs[4], vvs[4];
#pragma unroll
              for (int k = 0; k < 4; ++k) { const int i = DC == 0 ? k : 3 - k, t = 4 * gq + k;
                  const float ig = rcp_(gin[k]), sc = g15 * ig;
                  const float av = -kkv[i] * gex[k], rv = rsv[i] * gin[k];
                  st_bf(L + S3_GA + (t * 72 + cl) * 2, bb[i] * ig); st_bf(L + S3_GA + ((16 + t) * 72 + cl) * 2, kt[i] * ig);
                  st_bf(L + S3_GBT + (t * 72 + cl) * 2, av); st_bf(L + S3_GBT + ((16 + t) * 72 + cl) * 2, rv);
                  RTF[t * 64 + cl] = rv; KCF[cl * 16 + t] = kt[i] * sc;
                  avs[k] = av; bcs[k] = bb[i] * sc; vvs[k] = vsv[i]; }
              *(LAS v2u*)(L + S3_ATT + (cl * 24 + 4 * gq) * 2) = (v2u){pk2(avs[0], avs[1]), pk2(avs[2], avs[3])};
              *(LAS v2u*)(L + S3_BCT + (cl * 24 + 4 * gq) * 2) = (v2u){pk2(bcs[0], bcs[1]), pk2(bcs[2], bcs[3])};
              *(LAS v2u*)(L + S3_VT + (cl * 24 + 4 * gq) * 2) = (v2u){pk2(vvs[0], vvs[1]), pk2(vvs[2], vvs[3])};
            }
            S3_BAR(); }
            for (int rp_ = 0; rp_ < S3_REP_DE; ++rp_) {
            { S3_F32(MKR, S3_MKR);
              const int mt = w4 >> 1, nt = w4 & 1, ao = ((16 * mt + lr) * 72 + 8 * lq) * 2, bo = ((16 * nt + lr) * 72 + 8 * lq) * 2;
              const f32x4 z4 = (f32x4){0.f, 0.f, 0.f, 0.f};
              const bf16x8 ga0 = lds_frag(L + S3_GA + ao), ga1 = lds_frag(L + S3_GA + ao + 64), gb0 = lds_frag(L + S3_GBT + bo), gb1 = lds_frag(L + S3_GBT + bo + 64);
              f32x4 acc = mfma16(ga0, gb0, z4);
              acc = mfma16(ga1, gb1, acc);
              float vv[4];
#pragma unroll
              for (int i = 0; i < 4; ++i) vv[i] = (4 * lq + i + 1 - nt <= lr) ? acc[i] : 0.f;
              if (w4 == 2) {
#pragma unroll
                  for (int i = 0; i < 4; ++i) st_bf(L + S3_MAK + ((4 * lq + i) * 24 + lr) * 2, vv[i]); }
              else if (w4 == 1) *(LAS v2u*)(L + S3_MBRT + (lr * 24 + 4 * lq) * 2) = (v2u){pk2(vv[0], vv[1]), pk2(vv[2], vv[3])};
              else if (w4 == 3) *(LAS f32x4*)(MKR + lr * 16 + 4 * lq) = (f32x4){vv[0], vv[1], vv[2], vv[3]};
              else {
                  f32x4 pt = mfma16(gb0, ga0, z4);
                  pt = mfma16(gb1, ga1, pt);
                  f32x4 n, p, in, ip;
#pragma unroll
                  for (int i = 0; i < 4; ++i) { const int row = 4 * lq + i; n[i] = vv[i]; p[i] = row > lr ? pt[i] : 0.f; const float e = row == lr ? 1.f : 0.f; in[i] = n[i] + e; ip[i] = p[i] + e; }
                  const bf16x4 bn = pack_k16(n), bp = pack_k16(p);
                  const f32x4 n2 = mfma16k(bp, bn, z4), p2 = mfma16k(bn, bp, z4);
                  const bf16x4 bn2 = pack_k16(n2), bp2 = pack_k16(p2);
                  const f32x4 u1 = mfma16k(pack_k16(ip), bn2, in), u1t = mfma16k(pack_k16(in), bp2, ip);
                  const f32x4 n4 = mfma16k(bp2, bn2, z4), p4 = mfma16k(bn2, bp2, z4);
                  const bf16x4 bn4 = pack_k16(n4), bp4 = pack_k16(p4);
                  const f32x4 u2 = mfma16k(pack_k16(u1t), bn4, u1), u2t = mfma16k(pack_k16(u1), bp4, u1t);
                  const f32x4 n8 = mfma16k(bp4, bn4, z4);
                  const f32x4 T = mfma16k(pack_k16(u2t), pack_k16(n8), u2);
#pragma unroll
                  for (int i = 0; i < 4; ++i) st_bf(L + S3_TA + ((4 * lq + i) * 24 + lr) * 2, T[i]); }
            }
            S3_BAR(); }
            for (int rp_ = 0; rp_ < S3_REP_FG; ++rp_)
            { S3_F32(MKR, S3_MKR); S3_F32(KCF, S3_KCF); S3_F32(RTF, S3_RTF); S3_F32(G15, S3_G15); S3_F32(YO, S3_YO);
              const int cb = (w4 + 3) & 3;
              const f32x4 z4 = (f32x4){0.f, 0.f, 0.f, 0.f};
              const bf16x4 Ata = frag_k16(L + S3_TA + lr * 48, lq), B0 = frag_k16(L + S3_MBRT + lr * 48, lq), BE = frag_k16(L + S3_BCT + (16 * cb + lr) * 48, lq);
              const bf16x4 Amk = frag_k16(L + S3_MAK + lr * 48, lq);
              const f32x4 i0 = *(const LAS f32x4*)(MKR + lr * 16 + 4 * lq), iE = *(const LAS f32x4*)(KCF + (16 * cb + lr) * 16 + 4 * lq);
              bf16x4 Aa[4], Av[4]; bf16x8 As[2][4]; f32x4 ri[4];
#pragma unroll
              for (int mt = 0; mt < 4; ++mt) { Aa[mt] = frag_k16(L + S3_ATT + (16 * mt + lr) * 48, lq); Av[mt] = frag_k16(L + S3_VT + (16 * mt + lr) * 48, lq);
                  ri[mt] = *(const LAS f32x4*)(RTF + lr * 64 + 16 * mt + 4 * lq);
                  As[0][mt] = frag_lk32(L + S3_S16 + (16 * mt + lr) * 144, lq); As[1][mt] = frag_lk32(L + S3_S16 + (16 * mt + lr) * 144 + 64, lq); }
              const f32x4 g = *(const LAS f32x4*)(G15 + 16 * cb + 4 * lq);
              __builtin_amdgcn_sched_barrier(0);
              const f32x4 d10 = mfma16k(Ata, B0, z4), d1E = mfma16k(Ata, BE, z4);
              const bf16x4 Pd10 = pack_k16(d10), Pd1E = pack_k16(d1E);
              const f32x4 d20 = mfma16k(Amk, Pd10, i0), d2E = mfma16k(Amk, Pd1E, iE);
              const bf16x4 Pd20 = pack_k16(d20), Pd2E = pack_k16(d2E);
              f32x4 r0[4], q1[4], accS[4], accY = z4;
#pragma unroll
              for (int mt = 0; mt < 4; ++mt) {
                  r0[mt] = mfma16k(Aa[mt], Pd10, ri[mt]); q1[mt] = mfma16k(Aa[mt], Pd1E, z4); accS[mt] = mfma16k(Pd2E, Av[mt], z4);
                  if (mt == w4) accY = mfma16k(Av[mt], Pd20, z4);
              }
#pragma unroll
              for (int pp = 0; pp < 2; ++pp) {
                  const bf16x8 Bq1 = pack_b2(q1[2 * pp], q1[2 * pp + 1]), Bq0 = pack_b2(r0[2 * pp], r0[2 * pp + 1]);
#pragma unroll
                  for (int mt = 0; mt < 4; ++mt) { accS[mt] = mfma16(Bq1, As[pp][mt], accS[mt]);
                      if (mt == w4) accY = mfma16(As[pp][mt], Bq0, accY); } }
#pragma unroll
              for (int i = 0; i < 4; ++i) YO[lr * 64 + 16 * w4 + 4 * lq + i] = accY[i];
              if (rp_ == S3_REP_FG - 1) {
#pragma unroll
              for (int mt = 0; mt < 4; ++mt) S[mt] = S[mt] * g + accS[mt]; }
              else { asm volatile("" :: "v"(accS[0]), "v"(accS[1]), "v"(accS[2]), "v"(accS[3])); }
            }
            S3_BAR();
            { const int cb = (w4 + 3) & 3;
#pragma unroll
              for (int mt = 0; mt < 4; ++mt) *(LAS v2u*)(L + S3_S16 + ((16 * mt + lr) * 72 + 16 * cb + 4 * lq) * 2) = (v2u){pk2(S[mt][0], S[mt][1]), pk2(S[mt][2], S[mt][3])};
            }
            { S3_F32(YO, S3_YO); S3_F32(BON, S3_BON); SC_GEOM(c)
              if (dt < 128) { const int s = dt >> 3, c8 = dt & 7; const int tok = d == 0 ? pos0_ + s : len_ - 1 - (pos0_ + s);
                  GAS bf16* Yd = WSP(bf16, d == 0 ? WS_YF : WS_YB);
                  const f32x4 a = *(const LAS f32x4*)(YO + s * 64 + 8 * c8), bq = *(const LAS f32x4*)(YO + s * 64 + 8 * c8 + 4);
                  v4u w; w.x = pk2(a.x, a.y); w.y = pk2(a.z, a.w); w.z = pk2(bq.x, bq.y); w.w = pk2(bq.z, bq.w);
                  *(GAS v4u*)(Yd + (size_t)(rowbase_ + tok) * RW + h * 64 + 8 * c8) = w; }
              else if (dt < 144) { const int jj = dt - 128; GAS float* bonus = WSP(float, WS_BONUS) + (size_t)d * MA * 8;
                  bonus[(size_t)(rowbase_ + toklo_ + jj) * 8 + h] = (BON[jj] + BON[16 + jj]) + (BON[32 + jj] + BON[48 + jj]); }
            }
        }
        __syncthreads();
#undef SC_LOAD
#undef SC_GEOM
    }
}
__global__ void __launch_bounds__(NWAVES * 64, 2) fwd_kernel(Args args) {
    extern __shared__ __attribute__((aligned(16))) unsigned char lds[];
    Frame F;
    F.lds = (LAS unsigned char*)lds;
    F.MISC = (volatile LAS unsigned*)(F.lds + MISC_OFF);
    F.tid = threadIdx.x; F.lane = F.tid & 63; F.wave = __builtin_amdgcn_readfirstlane(F.tid >> 6);
    F.G = gridDim.x; { const int bx = blockIdx.x; F.vcu = (F.G % 8 == 0) ? (bx % 8) * (F.G / 8) + bx / 8 : bx; }
    F.ws = args.ws; F.out = args.out; F.ctl = (gu32*)(args.ws + WS_CTL);
    for (int u = F.tid; u < 128; u += NWAVES * 64) ((LAS unsigned*)(F.lds + MISC_OFF))[u] = 0u;
    if (F.tid < 33) { const unsigned long long pv = (unsigned long long)args.in[F.tid]; ((LAS unsigned*)(F.lds + PTAB_OFF))[2 * F.tid] = (unsigned)pv; ((LAS unsigned*)(F.lds + PTAB_OFF))[2 * F.tid + 1] = (unsigned)(pv >> 32); }
    __syncthreads();
    const int vcu0 = F.vcu, wave_s = F.wave;
    const bool fused = args.mode == 0;
    XcdBarrier bar; bar.bar = (unsigned*)(F.ctl + CW_BAR); bar.x = 0; bar.st = nullptr;
    if (fused) bar = xcd_barrier_post((unsigned*)(F.ctl + CW_BAR), F.MISC + 8);
#ifndef REP_PRO
#define REP_PRO 1
#endif
#ifndef REP_N7
#define REP_N7 1
#endif
#ifndef REP_FINAL
#define REP_FINAL 1
#endif
#ifndef REP_NORM
#define REP_NORM 1
#endif
#ifndef REP_GEMM1
#define REP_GEMM1 1
#endif
#ifndef REP_GEMM1_NOSIG
#define REP_GEMM1_NOSIG 0
#endif
#ifndef REP_GEMM1_NOEPI
#define REP_GEMM1_NOEPI 0
#endif
#ifndef REP_SCAN
#define REP_SCAN 1
#endif
#ifndef REP_ROUT
#define REP_ROUT 1
#endif
#ifndef REP_ATTN_DUMMY
#define REP_ATTN_DUMMY 0
#endif
#ifndef REP_MERGEA
#define REP_MERGEA 1
#endif
#ifndef REP_GU
#define REP_GU 1
#endif
#ifndef REP_DOWN_DUMMY
#define REP_DOWN_DUMMY 0
#endif
#ifndef REP_MOECONV
#define REP_MOECONV 1
#endif
#ifndef REP_MOEGEMM
#define REP_MOEGEMM 1
#endif
#define REPEAT(n) for (int rep_ = 0; rep_ < (n); ++rep_)
#ifndef SITE_MASK
#define SITE_MASK 0xFFFF
#endif
#define RUN(L, S) (((SITE_MASK >> (S)) & 1) && (fused || (args.l == (L) && args.site == (S))))
#ifndef REP_BAR
#define REP_BAR 0
#endif
#ifndef STAG_GEMM1
#define STAG_GEMM1 0
#endif
#ifndef STAG_GU
#define STAG_GU 0
#endif
#define STAGGER(ticks) do { const unsigned grp_ = (blockIdx.x >> 3) & 3u; if ((ticks) > 0 && grp_) { const unsigned long long t0_ = __builtin_amdgcn_s_memrealtime(), dl_ = (unsigned long long)(ticks) * grp_; while (__builtin_amdgcn_s_memrealtime() - t0_ < dl_) __builtin_amdgcn_s_sleep(32); } } while (0)
#define GRID_BAR() do { if (fused) { xcd_barrier(bar, F.tid); REPEAT(REP_BAR) xcd_barrier(bar, F.tid); } } while (0)
#define SITE_BEGIN() do { int t_; asm volatile("v_mbcnt_lo_u32_b32 %0, -1, 0\n\tv_mbcnt_hi_u32_b32 %0, -1, %0" : "=v"(t_)); t_ += wave_s * 64; asm volatile("" : "+v"(t_));     F.tid = t_; F.lane = t_ & 63; F.wave = __builtin_amdgcn_readfirstlane(t_ >> 6);     int v_ = vcu0; asm volatile("" : "+s"(v_)); F.vcu = v_; unsigned long long w_ = (unsigned long long)args.ws, o_ = (unsigned long long)args.out; asm volatile("" : "+s"(w_), "+s"(o_)); F.ws = (unsigned char*)w_; F.out = (GAS float*)o_; F.ctl = (gu32*)(F.ws + WS_CTL); } while (0)
    GAS bf16* const XC = WSP(bf16, WS_XC); GAS bf16* const X16 = WSP(bf16, WS_X16);
    GAS float* const MOD = WSP(float, WS_MOD);
    LAS int* const tile_e = (LAS int*)(F.lds + RING_BYTES);

    if (RUN(0, 0)) { SITE_BEGIN(); REPEAT(REP_PRO) p0_prologue(F); GRID_BAR(); }

    for (int l = 0; l < 2; ++l) {
        const int nM_mix = l == 0 ? MA / 256 : NL / 256;
        if (RUN(l, 1)) { SITE_BEGIN(); if (l == 0) norm_mod_phase<false, false>(F, l, 0, INP(0), INP(2), MA, WSP(bf16, WS_H)); else norm_mod_phase<false, true>(F, l, 0, X16, XC, MA, WSP(bf16, WS_H)); GRID_BAR(); }
        if (RUN(l, 2)) { SITE_BEGIN();
            pg8::StdOrder S; S.init(WSGEN(bf16, WS_H), WSGEN(bf16, WS_WIN) + (size_t)l * NIN * DM, DM, MA / 256, NIN / 256, F.G, (int)blockIdx.x);
            EpiIn E{WSP(bf16, WS_PR), WSP(bf16, WS_Q), WSP(bf16, WS_KB), WSP(bf16, WS_VB), WSP(unsigned char, WS_G)};
            STAGGER(STAG_GEMM1);
            REPEAT(REP_GEMM1_NOSIG) { EpiInT<false> EN2{WSP(bf16, WS_PR), WSP(bf16, WS_Q), WSP(bf16, WS_KB), WSP(bf16, WS_VB), WSP(unsigned char, WS_G)}; pg8::gemm_phase<EpiInT<false>, pg8::StdOrder, true, true>(F.lds, DM, S, EN2, F.tid); __syncthreads(); }
            if (l == 0) { REPEAT(REP_GEMM1) pg8::gemm_phase<EpiIn, pg8::StdOrder, true, true>(F.lds, DM, S, E, F.tid); }
            else { pg8::In1Order S1; *(pg8::StdOrder*)&S1 = S; REPEAT(REP_GEMM1) pg8::gemm_phase<EpiIn, pg8::In1Order, true, true>(F.lds, DM, S1, E, F.tid); }
            REPEAT(REP_GEMM1_NOEPI) { EpiNull EN{WSP(bf16, WS_YR)}; pg8::gemm_phase<EpiNull, pg8::StdOrder, true, true>(F.lds, DM, S, EN, F.tid); __syncthreads(); }
            GRID_BAR();
        }
        if (RUN(l, 3)) { SITE_BEGIN(); const bool early = ((F.vcu >> 3) & 1) != 0;
            if (early) qk_phase(F, l);
            REPEAT(REP_SCAN) scan_phase3(F, l);
            if (!early) qk_phase(F, l);
            GRID_BAR(); }
        if (RUN(l, 4)) { SITE_BEGIN(); const bool early = ((F.vcu >> 3) & 1) != 0;
            if (early) { REPEAT(REP_ROUT) { rwkv_out_phase(F, l, nM_mix * 256); __syncthreads(); } }
            attn_phase(F, l, (char*)lds, WS_Q);
            if (!early) { REPEAT(REP_ROUT) { __syncthreads(); rwkv_out_phase(F, l, nM_mix * 256); } }
            GRID_BAR(); }
        if (RUN(l, 5)) { SITE_BEGIN();
            pg8::PairOrder S; S.init(WSGEN(bf16, WS_YR), WSGEN(bf16, WS_WPA) + (size_t)l * DM * RW, RW, nM_mix, DM / 256, F.G, (int)blockIdx.x);
            S.A2 = (const char*)WSGEN(bf16, WS_Q); S.Bt2 = (const char*)(WSGEN(bf16, WS_WPB) + (size_t)l * DM * RW);
            EpiMergeAB E{WSP(unsigned char, WS_G), WSP(bf16, WS_MG)};
            REPEAT(REP_MERGEA) pg8::gemm_phase<EpiMergeAB, pg8::PairOrder, true, true>(F.lds, RW, S, E, F.tid);
            GRID_BAR();
        }
        if (RUN(l, 6)) { SITE_BEGIN();
            pg8::StdOrder S; S.init(WSGEN(bf16, WS_MG), WSGEN(bf16, WS_WO) + (size_t)l * DM * DM, DM, nM_mix, DM / 256, F.G, (int)blockIdx.x);
            if (l == 0) { EpiResT<true> E{INP(0), INP(2), X16, XC, MOD + 2048}; pg8::gemm_phase<EpiResT<true>, pg8::StdOrder, true, true>(F.lds, DM, S, E, F.tid); }
            else { EpiResT<false> E{X16, XC, X16, XC, MOD + (size_t)33 * 6144 + 2048}; pg8::gemm_phase<EpiResT<false>, pg8::StdOrder, true, true>(F.lds, DM, S, E, F.tid); }
            GRID_BAR();
        }
        if (RUN(l, 7)) { SITE_BEGIN();
            if (l == 0) { REPEAT(REP_N7) norm_mod_phase<false, true>(F, l, 1, X16, XC, MA, WSP(bf16, WS_H)); }
            else norm_mod_phase<true, true>(F, l, 1, X16, XC, NL, WSP(bf16, WS_H2M));
            GRID_BAR();
        }
        if (l == 0) {
            for (int ch = 0; ch <= FFN_NCHUNK; ++ch) {
                if (!fused && ch != args.chunk) continue;
                if (RUN(0, 8)) { SITE_BEGIN();
                    int pntl = 0;
                    if (ch >= 1) { const int t0 = ch == 1 ? 0 : FFN_C0 + (ch - 2) * MOE_CH_TILES, ntl = ch == 1 ? FFN_C0 : MOE_CH_TILES;
                        MoeOrderT<false> S{(const char*)(F.ws + WS_ACT + (size_t)((ch - 1) & 1) * (128 * MiB)), (const char*)(F.ws + WS_WDN), (size_t)256 * FF * 2, (size_t)256 * FF * 2, (size_t)0, t0, t0, ntl, DM / 256, F.G, (int)blockIdx.x, tile_e, 0, nullptr};
                        EpiResT<false> E{X16, XC, X16, XC, MOD + 5120};
                        pg8::gemm_phase<EpiResT<false>, MoeOrderT<false>, true, true>(F.lds, FF, S, E, F.tid);
                        pntl = ntl;
                    }
                    if (ch < FFN_NCHUNK) { const int t0 = ch == 0 ? 0 : FFN_C0 + (ch - 1) * MOE_CH_TILES, ntl = ch == 0 ? FFN_C0 : MOE_CH_TILES;
                        MoeOrderT<false> S{(const char*)(F.ws + WS_H), (const char*)(F.ws + WS_WGU), (size_t)256 * DM * 2, (size_t)256 * DM * 2, (size_t)0, t0, 0, ntl, 2 * FF / 256, F.G, (int)blockIdx.x, tile_e, pntl, nullptr};
                        EpiGU E{WSP(bf16, WS_ACT + (size_t)(ch & 1) * (128 * MiB)), t0};
                        REPEAT(REP_GU) pg8::gemm_phase<EpiGU, MoeOrderT<false>, true, true>(F.lds, DM, S, E, F.tid);
                    }
                    GRID_BAR();
                }
            }
        } else {
            if (RUN(1, 10)) { SITE_BEGIN(); REPEAT(REP_MOECONV) moe_conv(F); __syncthreads(); moe_slots(F); GRID_BAR(); }
            int ntile = 0;
            if (fused || args.site == 11) ntile = moe_tiles(F, tile_e);
            const int c0 = ntile > (MOE_NCHUNK - 1) * MOE_CH_TILES ? ntile - (MOE_NCHUNK - 1) * MOE_CH_TILES : 0;
            for (int ch = 0; ch <= MOE_NCHUNK; ++ch) {
                if (!fused && ch != args.chunk) continue;
                if (RUN(1, 11)) { SITE_BEGIN();
                    int pntl = 0;
                    if (ch >= 1) {
                        const int t0 = ch == 1 ? 0 : c0 + (ch - 2) * MOE_CH_TILES; const int rem = ntile - t0; const int ntl = ch == 1 ? c0 : (rem < 0 ? 0 : rem < MOE_CH_TILES ? rem : MOE_CH_TILES);
                        MoeOrderT<false> S{(const char*)(F.ws + (((ch - 1) & 1) ? WS_ACTC1 : WS_ACTC)), (const char*)(F.ws + WS_MW) + (size_t)2 * FF * DM * 2, (size_t)256 * FF * 2, (size_t)256 * FF * 2, (size_t)21 * MiB, t0, t0, ntl, DM / 256, F.G, (int)blockIdx.x, tile_e, 0, nullptr};
                        EpiStore E{WSP(bf16, WS_YM)};
                        REPEAT(REP_MOEGEMM) pg8::gemm_phase<EpiStore, MoeOrderT<false>, true, true>(F.lds, FF, S, E, F.tid);
                        pntl = ntl;
                    }
                    if (ch < MOE_NCHUNK) {
                        const int t0 = ch == 0 ? 0 : c0 + (ch - 1) * MOE_CH_TILES; const int rem = ntile - t0; const int ntl = ch == 0 ? c0 : (rem < 0 ? 0 : rem < MOE_CH_TILES ? rem : MOE_CH_TILES);
                        MoeOrderT<true> S{(const char*)(F.ws + WS_H2M), (const char*)(F.ws + WS_MW), (size_t)0, (size_t)256 * DM * 2, (size_t)21 * MiB, t0, 0, ntl, 2 * FF / 256, F.G, (int)blockIdx.x, tile_e, pntl, (const GAS int*)(F.ws + WS_MOETAB + MT_ROWT)};
                        EpiGU E{(ch & 1) ? WSP(bf16, WS_ACTC1) : WSP(bf16, WS_ACTC), t0};
                        REPEAT(REP_MOEGEMM) pg8::gemm_phase<EpiGU, MoeOrderT<true>, true, true>(F.lds, DM, S, E, F.tid);
                    }
                    GRID_BAR();
                }
            }
            if (RUN(1, 13)) { SITE_BEGIN(); REPEAT(REP_FINAL) moe_final(F); }
        }
    }
#undef RUN
#undef GRID_BAR
}

extern "C" void kernel_launch(void* const* d_in, const GAS int* in_sizes, int n_in, void* d_out, int out_size, void* d_ws, size_t ws_size, hipStream_t stream) {
    static int grid = 0;
    if (grid == 0) {
        if (n_in != 33 || in_sizes[0] != NL * DM || out_size != NL * DM || ws_size < WS_END) { fprintf(stderr, "kernel_launch: unexpected problem (n_in %d, x %d, out %d, ws %zu < %zu); nothing launched\n", n_in, n_in > 0 ? in_sizes[0] : -1, out_size, ws_size, (size_t)WS_END); grid = -1; return; }
        int dev = 0, cus = 0, per_cu = 0;
        if (hipGetDevice(&dev) != hipSuccess || hipDeviceGetAttribute(&cus, hipDeviceAttributeMultiprocessorCount, dev) != hipSuccess) { fprintf(stderr, "kernel_launch: device query failed\n"); grid = -1; return; }
        if (hipFuncSetAttribute((const void*)fwd_kernel, hipFuncAttributeMaxDynamicSharedMemorySize, LDS_BYTES) != hipSuccess) { fprintf(stderr, "kernel_launch: hipFuncSetAttribute failed\n"); grid = -1; return; }
        if (hipOccupancyMaxActiveBlocksPerMultiprocessor(&per_cu, (const void*)fwd_kernel, NWAVES * 64, LDS_BYTES) != hipSuccess || per_cu < 1) { fprintf(stderr, "kernel_launch: occupancy query reports %d workgroups per CU\n", per_cu); }
        (void)hipGetLastError();
        grid = cus;
        fprintf(stderr, "kernel_launch: grid %d, occupancy query %d\n", grid, per_cu);
    }
    if (grid < 0) return;
    if (hipMemsetAsync((char*)d_ws + WS_CTL, 0, CTL_ZERO_BYTES, stream) != hipSuccess) { fprintf(stderr, "kernel_launch: memset failed\n"); return; }
    Args a{};
    for (int i = 0; i < 33; ++i) a.in[i] = (const GAS float*)d_in[i];
    a.out = (GAS float*)d_out; a.ws = (unsigned char*)d_ws;
#if MK_FUSED
    a.mode = 0; a.l = 0; a.site = 0; a.chunk = 0;
    hipLaunchKernelGGL(fwd_kernel, dim3(grid), dim3(NWAVES * 64), LDS_BYTES, stream, a);
#else
    a.mode = 1;
    auto step = [&](int l, int site, int chunk) { a.l = l; a.site = site; a.chunk = chunk; hipLaunchKernelGGL(fwd_kernel, dim3(grid), dim3(NWAVES * 64), LDS_BYTES, stream, a); };
    step(0, 0, 0);
    for (int l = 0; l < 2; ++l) {
        for (int s = 1; s <= 7; ++s) step(l, s, 0);
        if (l == 0) { for (int ch = 0; ch <= FFN_NCHUNK; ++ch) step(0, 8, ch); }
        else { step(1, 10, 0); for (int ch = 0; ch <= MOE_NCHUNK; ++ch) step(1, 11, ch); step(1, 13, 0); }
    }
#endif
    const hipError_t le = hipPeekAtLastError();
    if (le != hipSuccess) fprintf(stderr, "kernel_launch: launch failed: %s\n", hipGetErrorName(le));
}
```
